# Optimizing an MI355X kernel written in HIP

```python
import jax, jax.numpy as jnp
from jax import lax
import numpy as np

D_MODEL = 1024
BATCH = 4
SEQ = 4096
DEPTH = 4

MEM_LEN = 256
MLA_HEADS = 8
MLA_NOPE = 64
MLA_ROPE = 32
MLA_V = 64
Q_LORA = 384
KV_LORA = 256
ROPE_THETA = 10000.0
Q_BLOCK = 128
HG_HEADS = 4
HG_KDIM = 128
HG_VDIM = 128
HG_CHUNK = 64
MEM_HEADS = 4
MEM_HDIM = 128
D_FF = 2816
N_BRANCH = 3
NORM_EPS = 1e-6

MLA_QK = MLA_NOPE + MLA_ROPE
HG_K = HG_HEADS * HG_KDIM
HG_V = HG_HEADS * HG_VDIM
MEM_W = MEM_HEADS * MEM_HDIM
IN_SPLITS = (Q_LORA, KV_LORA, MLA_ROPE, HG_K, HG_K, HG_V, HG_V, MEM_W, N_BRANCH * D_MODEL)
D_IN = sum(IN_SPLITS)

kernel_name = "hybrid_mla_hgrn2_memory_macaron"


def rmsnorm(x, g):
    xf = x.astype(jnp.float32)
    y = xf * lax.rsqrt(jnp.mean(xf * xf, axis=-1, keepdims=True) + NORM_EPS)
    return (y * g.astype(jnp.float32)).astype(x.dtype)


def swiglu(x, w_in, w_out):
    a, b = jnp.split(x @ w_in, 2, axis=-1)
    return (jax.nn.silu(a) * b) @ w_out


def split_sizes(z, sizes):
    idx = [int(v) for v in np.cumsum(sizes)[:-1]]
    return jnp.split(z, idx, axis=-1)


def apply_rope(t, cos, sin):
    tf = t.astype(jnp.float32)
    t1, t2 = jnp.split(tf, 2, axis=-1)
    out = jnp.concatenate([t1 * cos - t2 * sin, t2 * cos + t1 * sin], axis=-1)
    return out.astype(t.dtype)


def causal_mla_attention(q_nope, q_rope, k_nope, k_rope, v):
    B, S, H, _ = q_nope.shape
    nb = S // Q_BLOCK
    scale = MLA_QK ** -0.5
    k_pos = jnp.arange(S)

    def to_blocks(t):
        return jnp.moveaxis(t.reshape((B, nb, Q_BLOCK) + t.shape[2:]), 1, 0)

    def block(args):
        i, qn, qr = args
        s = jnp.einsum('bqhd,bkhd->bhqk', qn, k_nope) + jnp.einsum('bqhd,bkd->bhqk', qr, k_rope)
        s = s.astype(jnp.float32) * scale
        q_pos = i * Q_BLOCK + jnp.arange(Q_BLOCK)
        s = jnp.where(q_pos[:, None] >= k_pos[None, :], s, -jnp.inf)
        p = jax.nn.softmax(s, axis=-1).astype(v.dtype)
        return jnp.einsum('bhqk,bkhd->bqhd', p, v)

    o = lax.map(block, (jnp.arange(nb), to_blocks(q_nope), to_blocks(q_rope)))
    return jnp.moveaxis(o, 0, 1).reshape(B, S, H * MLA_V)


def mla_branch(c_q, c_kv, k_r, cos, sin, q_norm_g, kv_norm_g, w_uq, w_uk, w_uv):
    B, S, _ = c_q.shape
    q = (rmsnorm(c_q, q_norm_g) @ w_uq).reshape(B, S, MLA_HEADS, MLA_QK)
    q_nope = q[..., :MLA_NOPE]
    q_rope = apply_rope(q[..., MLA_NOPE:], cos[:, :, None, :], sin[:, :, None, :])
    k_rope = apply_rope(k_r, cos, sin)
    ckv = rmsnorm(c_kv, kv_norm_g)
    k_nope = (ckv @ w_uk).reshape(B, S, MLA_HEADS, MLA_NOPE)
    v = (ckv @ w_uv).reshape(B, S, MLA_HEADS, MLA_V)
    return causal_mla_attention(q_nope, q_rope, k_nope, k_rope, v)


def chunk_gated_recurrence(q, k, v, g):
    B, S, H, K = q.shape
    V = v.shape[-1]
    n = S // HG_CHUNK
    causal = jnp.tril(jnp.ones((HG_CHUNK, HG_CHUNK), dtype=bool))

    def chunks(t):
        return t.reshape(B, n, HG_CHUNK, H, t.shape[-1]).transpose(1, 0, 3, 2, 4)

    def step(state, inp):
        qc, kc, vc, gc = inp
        G = jnp.cumsum(gc, axis=2)
        o_inter = jnp.einsum('bhck,bhkv->bhcv', qc * jnp.exp(G), state)
        diff = G[:, :, :, None, :] - G[:, :, None, :, :]
        decay = jnp.exp(jnp.where(causal[:, :, None], diff, -jnp.inf))
        A = jnp.einsum('bhtsk,bhsk->bhts', qc[:, :, :, None, :] * decay, kc)
        o_intra = jnp.einsum('bhts,bhsv->bhtv', A, vc)
        G_last = G[:, :, -1:, :]
        new_state = jnp.exp(G_last[:, :, 0, :])[..., None] * state + jnp.einsum(
            'bhck,bhcv->bhkv', kc * jnp.exp(G_last - G), vc)
        return new_state, o_inter + o_intra

    s0 = jnp.zeros((B, H, K, V), jnp.float32)
    _, o = lax.scan(step, s0, (chunks(q), chunks(k), chunks(v), chunks(g)))
    return o.transpose(1, 0, 3, 2, 4).reshape(B, S, H, V)


def hgrn2_branch(q, f_logit, i_in, gate, lb, o_norm_g):
    B, S, _ = q.shape
    dt = q.dtype
    qf = jax.nn.silu(q.astype(jnp.float32)).reshape(B, S, HG_HEADS, HG_KDIM)
    z = f_logit.astype(jnp.float32)
    g = jnp.logaddexp(jnp.log(lb), jnp.log1p(-lb) + jax.nn.log_sigmoid(z))
    k = (1.0 - lb) * jax.nn.sigmoid(-z)
    g = g.reshape(B, S, HG_HEADS, HG_KDIM)
    k = k.reshape(B, S, HG_HEADS, HG_KDIM)
    v = i_in.astype(jnp.float32).reshape(B, S, HG_HEADS, HG_VDIM)
    o = chunk_gated_recurrence(qf, k, v, g)
    o = rmsnorm(o, o_norm_g) * jax.nn.silu(gate.astype(jnp.float32).reshape(B, S, HG_HEADS, HG_VDIM))
    return o.reshape(B, S, HG_V).astype(dt)


def memory_branch(q, mem_n, w_mem_kv):
    B, S, _ = q.shape
    M = mem_n.shape[1]
    qh = q.reshape(B, S, MEM_HEADS, MEM_HDIM)
    k, v = jnp.split(mem_n @ w_mem_kv, 2, axis=-1)
    k = k.reshape(B, M, MEM_HEADS, MEM_HDIM)
    v = v.reshape(B, M, MEM_HEADS, MEM_HDIM)
    s = jnp.einsum('bqhd,bmhd->bhqm', qh, k).astype(jnp.float32) * (MEM_HDIM ** -0.5)
    p = jax.nn.softmax(s, axis=-1).astype(v.dtype)
    return jnp.einsum('bhqm,bmhd->bqhd', p, v).reshape(B, S, MEM_W)


def setup_inputs(seed: int = 0) -> dict:
    key = jax.random.key(seed)
    ks = jax.random.split(key, 32)
    f32 = jnp.float32

    def w(k, shape, fan_in):
        return jax.random.normal(k, shape, f32) * (fan_in ** -0.5)

    def gain(k, shape):
        return 1.0 + 0.02 * jax.random.normal(k, shape, f32)

    x = jax.random.normal(ks[0], (BATCH, SEQ, D_MODEL), f32)
    mem = jax.random.normal(ks[1], (BATCH, MEM_LEN, D_MODEL), f32)
    offsets = jax.random.randint(ks[2], (BATCH, 1), 0, 1024, dtype=jnp.int32)
    positions = offsets + jnp.arange(SEQ, dtype=jnp.int32)[None, :]
    return {
        "x": x,
        "mem": mem,
        "positions": positions,
        "ffn1_norm": gain(ks[3], (DEPTH, D_MODEL)),
        "w_ffn1_in": w(ks[4], (DEPTH, D_MODEL, 2 * D_FF), D_MODEL),
        "w_ffn1_out": w(ks[5], (DEPTH, D_FF, D_MODEL), D_FF),
        "mix_norm": gain(ks[6], (DEPTH, D_MODEL)),
        "w_in": w(ks[7], (DEPTH, D_MODEL, D_IN), D_MODEL),
        "q_lat_norm": gain(ks[8], (DEPTH, Q_LORA)),
        "kv_lat_norm": gain(ks[9], (DEPTH, KV_LORA)),
        "w_uq": w(ks[10], (DEPTH, Q_LORA, MLA_HEADS * MLA_QK), Q_LORA),
        "w_uk": w(ks[11], (DEPTH, KV_LORA, MLA_HEADS * MLA_NOPE), KV_LORA),
        "w_uv": w(ks[12], (DEPTH, KV_LORA, MLA_HEADS * MLA_V), KV_LORA),
        "w_o_mla": w(ks[13], (DEPTH, MLA_HEADS * MLA_V, D_MODEL), MLA_HEADS * MLA_V),
        "hg_lower_bounds": jax.random.normal(ks[14], (DEPTH, HG_K), f32),
        "hg_out_norm": gain(ks[15], (DEPTH, HG_VDIM)),
        "w_o_hg": w(ks[16], (DEPTH, HG_V, D_MODEL), HG_V),
        "mem_norm": gain(ks[17], (DEPTH, D_MODEL)),
        "w_mem_kv": w(ks[18], (DEPTH, D_MODEL, 2 * MEM_W), D_MODEL),
        "w_o_mem": w(ks[19], (DEPTH, MEM_W, D_MODEL), MEM_W),
        "w_out": w(ks[20], (DEPTH, D_MODEL, D_MODEL), D_MODEL),
        "ffn2_norm": gain(ks[21], (DEPTH, D_MODEL)),
        "w_ffn2_in": w(ks[22], (DEPTH, D_MODEL, 2 * D_FF), D_MODEL),
        "w_ffn2_out": w(ks[23], (DEPTH, D_FF, D_MODEL), D_FF),
        "final_norm": gain(ks[24], (D_MODEL,)),
    }


def reference(x, mem, positions, ffn1_norm, w_ffn1_in, w_ffn1_out, mix_norm, w_in,
              q_lat_norm, kv_lat_norm, w_uq, w_uk, w_uv, w_o_mla, hg_lower_bounds,
              hg_out_norm, w_o_hg, mem_norm, w_mem_kv, w_o_mem, w_out, ffn2_norm,
              w_ffn2_in, w_ffn2_out, final_norm):
    B, S, D = x.shape
    inv_freq = ROPE_THETA ** (-jnp.arange(0, MLA_ROPE, 2, dtype=jnp.float32) / MLA_ROPE)
    ang = positions.astype(jnp.float32)[..., None] * inv_freq
    cos, sin = jnp.cos(ang), jnp.sin(ang)
    lbs = jnp.cumsum(jax.nn.softmax(hg_lower_bounds.astype(jnp.float32), axis=0), axis=0)
    lbs = lbs - lbs[0:1]

    for l in range(DEPTH):
        x = x + 0.5 * swiglu(rmsnorm(x, ffn1_norm[l]), w_ffn1_in[l], w_ffn1_out[l])
        u = rmsnorm(x, mix_norm[l])
        c_q, c_kv, k_r, hq, hf, hi, hgate, mq, gate_logits = split_sizes(u @ w_in[l], IN_SPLITS)
        y_mla = mla_branch(c_q, c_kv, k_r, cos, sin, q_lat_norm[l], kv_lat_norm[l],
                           w_uq[l], w_uk[l], w_uv[l]) @ w_o_mla[l]
        y_hg = hgrn2_branch(hq, hf, hi, hgate, lbs[l], hg_out_norm[l]) @ w_o_hg[l]
        mem_n = rmsnorm(mem, mem_norm[l])
        y_mem = memory_branch(mq, mem_n, w_mem_kv[l]) @ w_o_mem[l]
        gates = jax.nn.sigmoid(gate_logits.reshape(B, S, N_BRANCH, D))
        merged = gates[:, :, 0] * y_mla + gates[:, :, 1] * y_hg + gates[:, :, 2] * y_mem
        x = x + merged @ w_out[l]
        x = x + 0.5 * swiglu(rmsnorm(x, ffn2_norm[l]), w_ffn2_in[l], w_ffn2_out[l])

    return rmsnorm(x, final_norm)
```

```cpp
#include <hip/hip_runtime.h>
#include <hip/hip_cooperative_groups.h>
#include <cstdio>
#include <cstdint>
namespace cg = cooperative_groups;
#define DI __device__ __forceinline__
namespace pg8 {
#define PG8_LAS __attribute__((address_space(3)))
typedef unsigned short bf16_t;
typedef short bf16x8 __attribute__((ext_vector_type(8)));
typedef float f32x4 __attribute__((ext_vector_type(4)));
typedef unsigned u32x4 __attribute__((ext_vector_type(4)));
constexpr int BM = 256, BK = 64, HALF = 128, HTB = HALF * BK * 2  , STAGE_BYTES = 8 * HTB, NXCD = 8, WGM = 8;

__host__ __device__ __forceinline__ int lds_byte(int r, int c) { const int st = (r >> 4) * 2 + (c >> 5), rr = r & 15, cc = c & 31, ob = rr * 64 + cc * 2; return st * 1024 + (ob ^ (((ob >> 9) & 1) << 5)); }
__host__ __device__ __forceinline__ void stage_rc(int b, int& R, int& C) { const int st = b / 1024, sb = b % 1024, swz = sb ^ (((sb >> 9) & 1) << 5); R = (st >> 1) * 16 + swz / 64; C = (st & 1) * 32 + (swz % 64) / 2; }
__host__ __device__ __forceinline__ int perm32(int rho) { const int n = rho >> 4, i = rho & 15; return 8 * (i >> 2) + 4 * n + (i & 3); }

struct Unit { int pm, pn; };
struct Gemm { const bf16_t* A; const bf16_t* Bt; int M, N, K; };

struct StaticOrder {
    int nM, nN, nwg, G, c;
    __host__ __device__ void init(int M, int N, int G_, int c_) { nM = M / BM; nN = N / BM; nwg = nM * nN; G = G_; c = c_; }
    __host__ __device__ bool next(int i, Unit& u) const {
        const long L = (long)i * G + c; if (L >= nwg) return false;
        int wgid = (int)L; { const int q = nwg / NXCD, r = nwg % NXCD, xcd = wgid % NXCD, off = wgid / NXCD; wgid = (xcd < r ? xcd * (q + 1) : r * (q + 1) + (xcd - r) * q) + off; }
        const int nig = WGM * nN, gid = wgid / nig, fm = gid * WGM, gsz = (nM - fm) < WGM ? (nM - fm) : WGM;
        u.pm = fm + ((wgid % nig) % gsz); u.pn = (wgid % nig) / gsz; return true;
    }
    __device__ __forceinline__ void a_ready(const Unit&) const {}
    __device__ __forceinline__ void done(const Unit&) const {}
};
template <class Epi, class Sched, bool ALIGN_EPI = false, bool SP2 = false>
__device__ __forceinline__ void gemm_phase(PG8_LAS unsigned char* lds, const Gemm g, const Sched& S, const Epi& E) {
    int tid_o = threadIdx.x; asm volatile("" : "+v"(tid_o));
    const int tid = tid_o, wid = __builtin_amdgcn_readfirstlane(tid >> 6), lane = tid & 63, wr = wid >> 2, wc = wid & 3, fr = lane & 15, fq = lane >> 4;
    const int K = g.K, nt = K / BK;
    unsigned voffA[2], voffB[2];
#pragma unroll
    for (int i = 0; i < 2; ++i) { int R, C; stage_rc(tid * 16 + i * 8192, R, C); const int Rb = Epi::PERM ? ((R & ~31) + perm32(R & 31)) : R;
        voffA[i] = (unsigned)(R * K + C) * 2u; voffB[i] = (unsigned)(Rb * K + C) * 2u; }
    const size_t kstep = (size_t)(BK * 2);
    const size_t hstep = (size_t)HALF * K * 2;
    const size_t tstep = 2 * hstep;
    const unsigned ldsw = (unsigned)wid * 1024u;
    const int aoff = lds_byte(wr * 64 + fr, fq * 8), boff = lds_byte(wc * 32 + fr, fq * 8);
#define PG8_SA(b, h) (((b) * 2 + (h)) * HTB)
#define PG8_SB(b, h) ((4 + (b) * 2 + (h)) * HTB)
#define PG8_STAGE(bufoff, gbase, voff) do { _Pragma("unroll") for (int _i = 0; _i < 2; ++_i) \
        __builtin_amdgcn_global_load_lds((const unsigned*)((const char*)(gbase) + (voff)[_i]), (PG8_LAS unsigned*)(lds + (bufoff) + ldsw + _i * 8192), 16, 0, 0); } while (0)
#define PG8_LDA(dst, b, h) do { _Pragma("unroll") for (int m = 0; m < 4; ++m) _Pragma("unroll") for (int k = 0; k < 2; ++k) dst[m][k] = *(const PG8_LAS bf16x8*)(lds + PG8_SA(b, h) + aoff + m * 2048 + k * 1024); } while (0)
#define PG8_LDB(dst, b, h) do { _Pragma("unroll") for (int n = 0; n < 2; ++n) _Pragma("unroll") for (int k = 0; k < 2; ++k) dst[n][k] = *(const PG8_LAS bf16x8*)(lds + PG8_SB(b, h) + boff + n * 2048 + k * 1024); } while (0)
#define PG8_MMA(ai, bj, At, Bt) do { __builtin_amdgcn_s_setprio(1); _Pragma("unroll") for (int m = 0; m < 4; ++m) _Pragma("unroll") for (int n = 0; n < 2; ++n) _Pragma("unroll") for (int k = 0; k < 2; ++k) \
        acc[ai][bj][m][n] = __builtin_amdgcn_mfma_f32_16x16x32_bf16(Bt[n][k], At[m][k], acc[ai][bj][m][n], 0, 0, 0); __builtin_amdgcn_s_setprio(0); } while (0)
#define PG8_WAIT_V(n) asm volatile("s_waitcnt vmcnt(" #n ")" ::: "memory")
#define PG8_WAIT_L(n) asm volatile("s_waitcnt lgkmcnt(" #n ")" ::: "memory")
#define PG8_BAR __builtin_amdgcn_s_barrier()
#define PG8_SCHED __builtin_amdgcn_sched_barrier(0)
    Unit cur, nxt; int ui = 0;
    if (!S.next(0, cur)) return;
    f32x4 acc[2][2][4][2];
#pragma unroll
    for (int a = 0; a < 2; ++a)
#pragma unroll
        for (int b = 0; b < 2; ++b)
#pragma unroll
            for (int m = 0; m < 4; ++m)
#pragma unroll
                for (int n = 0; n < 2; ++n) acc[a][b][m][n] = (f32x4){0.f, 0.f, 0.f, 0.f};
    bf16x8 At[4][2], B0[2][2], B1[2][2];
    const char* cA = (const char*)g.A + (size_t)cur.pm * tstep; const char* cB = (const char*)g.Bt + (size_t)cur.pn * tstep;
    S.a_ready(cur);
    if constexpr (SP2) {
        PG8_STAGE(PG8_SB(0, 0), cB, voffB); PG8_STAGE(PG8_SB(0, 1), cB + hstep, voffB); PG8_STAGE(PG8_SA(0, 0), cA, voffA); PG8_STAGE(PG8_SA(0, 1), cA + hstep, voffA);
        if (wr == 1) PG8_BAR;
        PG8_WAIT_V(2); PG8_BAR;
        PG8_STAGE(PG8_SB(1, 0), cB + kstep, voffB); PG8_STAGE(PG8_SA(1, 0), cA + kstep, voffA); PG8_STAGE(PG8_SB(1, 1), cB + hstep + kstep, voffB);
        PG8_WAIT_V(6); PG8_BAR;
    } else {
        PG8_STAGE(PG8_SB(0, 0), cB, voffB); PG8_STAGE(PG8_SA(0, 0), cA, voffA); PG8_STAGE(PG8_SB(0, 1), cB + hstep, voffB); PG8_STAGE(PG8_SA(0, 1), cA + hstep, voffA);
        if (wr == 1) PG8_BAR;
        PG8_WAIT_V(4); PG8_BAR;
        PG8_STAGE(PG8_SB(1, 0), cB + kstep, voffB); PG8_STAGE(PG8_SA(1, 0), cA + kstep, voffA); PG8_STAGE(PG8_SB(1, 1), cB + hstep + kstep, voffB);
        PG8_WAIT_V(6); PG8_BAR;
    }
    for (;;) {
        const bool has_next = S.next(ui + 1, nxt);
        const char* nA = has_next ? (const char*)g.A + (size_t)nxt.pm * tstep : cA; const char* nB = has_next ? (const char*)g.Bt + (size_t)nxt.pn * tstep : cB;
        for (int t = 0; t < nt; t += 2) {
            const bool last = (t == nt - 2);
            const char* a1 = cA + (size_t)(t + 1) * kstep;
            const char* a2 = last ? nA : cA + (size_t)(t + 2) * kstep; const char* b2 = last ? nB : cB + (size_t)(t + 2) * kstep;
            const char* a3 = a2 + kstep; const char* b3 = b2 + kstep;
            if (last && has_next) S.a_ready(nxt);
            if constexpr (SP2) {
            PG8_LDB(B0, 0, 0); PG8_LDB(B1, 0, 1); PG8_SCHED; PG8_LDA(At, 0, 0); PG8_STAGE(PG8_SA(1, 1), a1 + hstep, voffA);
            PG8_WAIT_V(8); PG8_WAIT_L(0); PG8_BAR; PG8_MMA(0, 0, At, B0); PG8_MMA(0, 1, At, B1); PG8_BAR; PG8_SCHED;
            PG8_LDA(At, 0, 1); PG8_STAGE(PG8_SB(0, 0), b2, voffB); PG8_STAGE(PG8_SB(0, 1), b2 + hstep, voffB); PG8_STAGE(PG8_SA(0, 0), a2, voffA);
            PG8_WAIT_V(8); PG8_WAIT_L(0); PG8_BAR; PG8_MMA(1, 0, At, B0); PG8_MMA(1, 1, At, B1); PG8_BAR; PG8_SCHED;
            PG8_LDB(B0, 1, 0); PG8_LDB(B1, 1, 1); PG8_SCHED; PG8_LDA(At, 1, 0); PG8_STAGE(PG8_SA(0, 1), a2 + hstep, voffA);
            PG8_WAIT_V(8); PG8_WAIT_L(0); PG8_BAR; PG8_MMA(0, 0, At, B0); PG8_MMA(0, 1, At, B1); PG8_BAR; PG8_SCHED;
            PG8_LDA(At, 1, 1); PG8_STAGE(PG8_SB(1, 0), b3, voffB); PG8_STAGE(PG8_SB(1, 1), b3 + hstep, voffB); PG8_STAGE(PG8_SA(1, 0), a3, voffA);
            PG8_WAIT_V(8); PG8_WAIT_L(0); PG8_BAR; PG8_MMA(1, 0, At, B0); PG8_MMA(1, 1, At, B1); PG8_BAR; PG8_SCHED;
            } else {
            PG8_LDB(B0, 0, 0); PG8_SCHED; PG8_LDA(At, 0, 0); PG8_STAGE(PG8_SA(1, 1), a1 + hstep, voffA);
            PG8_WAIT_L(8); PG8_BAR; PG8_WAIT_L(0); PG8_MMA(0, 0, At, B0); PG8_BAR; PG8_SCHED;
            PG8_LDB(B1, 0, 1); PG8_STAGE(PG8_SB(0, 0), b2, voffB);
            PG8_BAR; PG8_WAIT_L(0); PG8_MMA(0, 1, At, B1); PG8_BAR;
            PG8_LDA(At, 0, 1); PG8_STAGE(PG8_SA(0, 0), a2, voffA);
            PG8_BAR; PG8_WAIT_L(0); PG8_MMA(1, 0, At, B0); PG8_BAR; PG8_SCHED;
            PG8_STAGE(PG8_SB(0, 1), b2 + hstep, voffB);
            PG8_WAIT_V(6); PG8_BAR; PG8_MMA(1, 1, At, B1); PG8_BAR;
            PG8_LDB(B0, 1, 0); PG8_SCHED; PG8_LDA(At, 1, 0); PG8_STAGE(PG8_SA(0, 1), a2 + hstep, voffA);
            PG8_WAIT_L(8); PG8_BAR; PG8_WAIT_L(0); PG8_MMA(0, 0, At, B0); PG8_BAR; PG8_SCHED;
            PG8_LDB(B1, 1, 1); PG8_STAGE(PG8_SB(1, 0), b3, voffB);
            PG8_BAR; PG8_WAIT_L(0); PG8_MMA(0, 1, At, B1); PG8_BAR;
            PG8_LDA(At, 1, 1); PG8_STAGE(PG8_SA(1, 0), a3, voffA);
            PG8_BAR; PG8_WAIT_L(0); PG8_MMA(1, 0, At, B0); PG8_BAR; PG8_SCHED;
            PG8_STAGE(PG8_SB(1, 1), b3 + hstep, voffB);
            PG8_WAIT_V(6); PG8_BAR; PG8_MMA(1, 1, At, B1); PG8_BAR;
            }
        }
        if constexpr (ALIGN_EPI) { if (wr == 0) PG8_BAR; }
        if constexpr (!Epi::AFTER_DRAIN) { E(acc, cur, wr, wc, fr, fq); S.done(cur); }
        if (!has_next) break;
#pragma unroll
        for (int a = 0; a < 2; ++a)
#pragma unroll
            for (int b = 0; b < 2; ++b)
#pragma unroll
                for (int m = 0; m < 4; ++m)
#pragma unroll
                    for (int n = 0; n < 2; ++n) acc[a][b][m][n] = (f32x4){0.f, 0.f, 0.f, 0.f};
        cur = nxt; cA = nA; cB = nB; ++ui;
        if constexpr (ALIGN_EPI) { if (wr == 1) PG8_BAR; }
    }
    PG8_WAIT_V(0);
    if constexpr (!ALIGN_EPI) { if (wr == 0) PG8_BAR; }
    PG8_BAR;
    if constexpr (Epi::AFTER_DRAIN) { E.fused(acc, cur, wr, wc, fr, fq, lds, wid, lane); S.done(cur); }
#undef PG8_SA
#undef PG8_SB
#undef PG8_STAGE
#undef PG8_LDA
#undef PG8_LDB
#undef PG8_MMA
#undef PG8_WAIT_V
#undef PG8_WAIT_L
#undef PG8_BAR
#undef PG8_SCHED
}
}

typedef unsigned short bf16;
#define LAS __attribute__((address_space(3)))
#define GAS __attribute__((address_space(1)))
typedef float f32x4 __attribute__((ext_vector_type(4)));
typedef float f32x16 __attribute__((ext_vector_type(16)));
typedef float f32x2_t __attribute__((ext_vector_type(2)));
typedef __bf16 bf16x2_t __attribute__((ext_vector_type(2)));
typedef short bf16x8 __attribute__((ext_vector_type(8)));
typedef short s16x4 __attribute__((ext_vector_type(4)));
typedef unsigned u32x4 __attribute__((ext_vector_type(4)));
typedef unsigned u32x2 __attribute__((ext_vector_type(2)));

constexpr int T = 16384, D = 1024, SEQ = 4096, NBATCH = 4, DFF = 2816, DEPTH = 4, NIN = 6400, DIN = 6304;
constexpr int NTHREADS = 512, NWAVES = 8;
constexpr float EPS = 1e-6f;
constexpr float QSCALE_MLA = 0.14724498f;
constexpr float QSCALE_MEM = 0.12751743f;

constexpr size_t MiB = 1u << 20;
constexpr size_t WT_W1IN = 0;
constexpr size_t WT_W1OUT = WT_W1IN + (size_t)5632 * 1024 * 2;
constexpr size_t WT_WIN = WT_W1OUT + (size_t)1024 * 2816 * 2;
constexpr size_t WT_WUQ = WT_WIN + (size_t)NIN * 1024 * 2;
constexpr size_t WT_WUKV = WT_WUQ + (size_t)768 * 384 * 2;
constexpr size_t WT_WOMLA = WT_WUKV + (size_t)1024 * 256 * 2;
constexpr size_t WT_WOHG = WT_WOMLA + (size_t)1024 * 512 * 2;
constexpr size_t WT_WOMEM = WT_WOHG + (size_t)1024 * 512 * 2;
constexpr size_t WT_WMEMKV = WT_WOMEM + (size_t)1024 * 512 * 2;
constexpr size_t WT_WOUT = WT_WMEMKV + (size_t)1024 * 1024 * 2;
constexpr size_t WT_W2IN = WT_WOUT + (size_t)1024 * 1024 * 2;
constexpr size_t WT_W2OUT = WT_W2IN + (size_t)5632 * 1024 * 2;
constexpr size_t WT_END = WT_W2OUT + (size_t)1024 * 2816 * 2;
static_assert(WT_END <= 54 * MiB, "weights");
constexpr size_t WS_XB = 54 * MiB;
constexpr size_t WS_SSQ = WS_XB + 32 * MiB;
constexpr size_t WS_SSQQ = WS_SSQ + 1 * MiB;
constexpr size_t WS_SSQKV = WS_SSQQ + 1 * MiB;
constexpr size_t WS_COS = WS_SSQKV + 1 * MiB;
constexpr size_t WS_SIN = WS_COS + 1 * MiB;
constexpr size_t WS_LBS = WS_SIN + 1 * MiB;
constexpr size_t WS_MEMB = WS_LBS + 65536;
constexpr size_t WS_MEMRSTD = WS_MEMB + 2 * MiB;
constexpr size_t WS_MK = WS_MEMRSTD + 65536;
constexpr size_t WS_MVT = WS_MK + 1 * MiB;
constexpr size_t WS_DEC = WS_MVT + 1 * MiB;
constexpr size_t WS_MIX = WS_DEC + 1 * MiB;
constexpr size_t WS_CQ = WS_MIX;
constexpr size_t WS_CKV = WS_CQ + 12 * MiB;
constexpr size_t WS_KR = WS_CKV + 8 * MiB;
constexpr size_t WS_HQ = WS_KR + 1 * MiB;
constexpr size_t WS_GG = WS_HQ + 16 * MiB;
constexpr size_t WS_HK = WS_GG + 32 * MiB;
constexpr size_t WS_HV = WS_HK + 16 * MiB;
constexpr size_t WS_HGT = WS_HV + 16 * MiB;
constexpr size_t WS_MQ = WS_HGT + 16 * MiB;
constexpr size_t WS_GATES = WS_MQ + 16 * MiB;
constexpr size_t WS_Q = WS_GATES + 96 * MiB;
constexpr size_t WS_KC = WS_Q + 24 * MiB;
constexpr size_t WS_VT = WS_KC + 24 * MiB;
constexpr size_t WS_LT = WS_VT + 16 * MiB;
constexpr size_t WS_AO = WS_LT + 64 * MiB;
constexpr size_t WS_END = WS_AO + 16 * MiB;
constexpr size_t WS_HO = WS_CQ;
constexpr size_t WS_MERGED = WS_GG;
constexpr size_t WS_MO = WS_Q;
constexpr size_t WS_H = WS_MIX;
static_assert(WS_H + (size_t)T * DFF * 2 <= WS_END, "h overlay");

constexpr int LDS_BYTES = 147456;

DI unsigned pk2(float lo, float hi) { f32x2_t v = {lo, hi}; bf16x2_t b = __builtin_convertvector(v, bf16x2_t); return __builtin_bit_cast(unsigned, b); }
DI u32x4 pk8(const float* v) { u32x4 w; w.x = pk2(v[0], v[1]); w.y = pk2(v[2], v[3]); w.z = pk2(v[4], v[5]); w.w = pk2(v[6], v[7]); return w; }
DI float bflo(unsigned w) { return __uint_as_float(w << 16); }
DI float bfhi(unsigned w) { return __uint_as_float(w & 0xffff0000u); }
DI void unpk8(u32x4 w, float* v) { v[0] = bflo(w.x); v[1] = bfhi(w.x); v[2] = bflo(w.y); v[3] = bfhi(w.y); v[4] = bflo(w.z); v[5] = bfhi(w.z); v[6] = bflo(w.w); v[7] = bfhi(w.w); }
DI float bf2f(bf16 b) { return __uint_as_float(((unsigned)b) << 16); }
DI bf16 f2bf(float f) { return (bf16)(pk2(f, 0.f) & 0xffffu); }
DI float sigmoidf_(float z) { return 1.0f / (1.0f + __expf(-z)); }
DI float wave_sum(float v) {
#pragma unroll
    for (int o = 1; o < 64; o <<= 1) v += __shfl_xor(v, o);
    return v;
}
DI float rowsum_q(const float* p, int fq, int nq) {
    float s = 0.f;
    if (fq < nq) { const f32x4 a = *(const f32x4*)(p + 4 * fq); s = (a.x + a.y) + (a.z + a.w); }
    s += __shfl_xor(s, 16); s += __shfl_xor(s, 32);
    return s;
}
DI float sum16(const float* p) {
    const f32x4 a = *(const f32x4*)p, b = *(const f32x4*)(p + 4), c = *(const f32x4*)(p + 8), d = *(const f32x4*)(p + 12);
    return ((a.x + a.y) + (a.z + a.w)) + ((b.x + b.y) + (b.z + b.w)) + ((c.x + c.y) + (c.z + c.w)) + ((d.x + d.y) + (d.z + d.w));
}

using pg8::Unit;
#define EPI_ARGS const f32x4 (&acc)[2][2][4][2], const Unit& u, int wr, int wc, int fr_in, int fq_in
#define EPI_OPAQUE int fr = fr_in, fq = fq_in; asm volatile("" : "+v"(fr), "+v"(fq));

struct EpiSwiglu {
    static constexpr bool PERM = true, AFTER_DRAIN = false;
    bf16* H; const float* ssq;
    DI void operator()(EPI_ARGS) const {
        EPI_OPAQUE
#pragma unroll
        for (int ai = 0; ai < 2; ++ai)
#pragma unroll
            for (int m = 0; m < 4; ++m) {
                const int row = u.pm * 256 + ai * 128 + wr * 64 + m * 16 + fr;
                const float rs = rsqrtf(rowsum_q(ssq + (size_t)row * 16, fq, 4) * (1.0f / 1024.0f) + EPS);
                float o[8];
#pragma unroll
                for (int n = 0; n < 2; ++n)
#pragma unroll
                    for (int j = 0; j < 4; ++j) { const float a = acc[ai][0][m][n][j] * rs, b = acc[ai][1][m][n][j] * rs; o[4 * n + j] = a * b / (1.0f + __expf(-a)); }
                *(u32x4*)(H + (size_t)row * DFF + u.pn * 128 + 32 * wc + 8 * fq) = pk8(o);
            }
    }
};

struct EpiResid {
    static constexpr bool PERM = true, AFTER_DRAIN = false;
    float* X; bf16* XB; float* ssq; float scale;
    DI void operator()(EPI_ARGS) const {
        EPI_OPAQUE
#pragma unroll
        for (int ai = 0; ai < 2; ++ai)
#pragma unroll
            for (int m = 0; m < 4; ++m) {
                const int row = u.pm * 256 + ai * 128 + wr * 64 + m * 16 + fr;
                float ss = 0.f;
#pragma unroll
                for (int bj = 0; bj < 2; ++bj) {
                    const size_t off = (size_t)row * D + u.pn * 256 + 128 * bj + 32 * wc + 8 * fq;
                    f32x4 x0 = *(const f32x4*)(X + off), x1 = *(const f32x4*)(X + off + 4);
                    x0 += scale * acc[ai][bj][m][0]; x1 += scale * acc[ai][bj][m][1];
                    *(f32x4*)(X + off) = x0; *(f32x4*)(X + off + 4) = x1;
                    float o[8] = {x0.x, x0.y, x0.z, x0.w, x1.x, x1.y, x1.z, x1.w};
                    *(u32x4*)(XB + off) = pk8(o);
#pragma unroll
                    for (int e = 0; e < 8; ++e) ss += o[e] * o[e];
                }
                ss += __shfl_xor(ss, 16); ss += __shfl_xor(ss, 32);
                if (fq == 0) ssq[(size_t)row * 16 + u.pn * 4 + wc] = ss;
            }
    }
};

struct EpiWin {
    static constexpr bool PERM = true, AFTER_DRAIN = false;
    const float* ssq; const float* lbs  ; const float* cosT; const float* sinT;
    bf16 *CQ, *CKV, *KC, *HQ, *HK, *HV, *HGT, *MQ, *GATES; float *GG, *SSQQ, *SSQKV;
    DI void operator()(EPI_ARGS) const {
        EPI_OPAQUE
#pragma unroll
        for (int ai = 0; ai < 2; ++ai)
#pragma unroll
            for (int m = 0; m < 4; ++m) {
                const int row = u.pm * 256 + ai * 128 + wr * 64 + m * 16 + fr;
                const float rs = rsqrtf(rowsum_q(ssq + (size_t)row * 16, fq, 4) * (1.0f / 1024.0f) + EPS);
#pragma unroll
                for (int bj = 0; bj < 2; ++bj) {
                    const int hh = 2 * u.pn + bj, cw = 32 * wc + 8 * fq;
                    float v[8];
#pragma unroll
                    for (int n = 0; n < 2; ++n)
#pragma unroll
                        for (int j = 0; j < 4; ++j) v[4 * n + j] = acc[ai][bj][m][n][j] * rs;
                    if (hh < 5) {
                        float ss = 0.f;
#pragma unroll
                        for (int e = 0; e < 8; ++e) ss += v[e] * v[e];
                        ss += __shfl_xor(ss, 16); ss += __shfl_xor(ss, 32);
                        if (hh < 3) { *(u32x4*)(CQ + (size_t)row * 384 + hh * 128 + cw) = pk8(v); if (fq == 0) SSQQ[(size_t)row * 16 + hh * 4 + wc] = ss; }
                        else { *(u32x4*)(CKV + (size_t)row * 256 + (hh - 3) * 128 + cw) = pk8(v); if (fq == 0) SSQKV[(size_t)row * 8 + (hh - 3) * 4 + wc] = ss; }
                    } else if (hh == 5) {
                        if (wc == 0) {
                            const f32x4 c = *(const f32x4*)(cosT + (size_t)row * 16 + 4 * fq), s = *(const f32x4*)(sinT + (size_t)row * 16 + 4 * fq);
                            u32x4 o;
                            o.x = pk2(v[0] * c.x - v[1] * s.x, v[1] * c.x + v[0] * s.x); o.y = pk2(v[2] * c.y - v[3] * s.y, v[3] * c.y + v[2] * s.y);
                            o.z = pk2(v[4] * c.z - v[5] * s.z, v[5] * c.z + v[4] * s.z); o.w = pk2(v[6] * c.w - v[7] * s.w, v[7] * c.w + v[6] * s.w);
                            bf16* kp = KC + ((size_t)(row >> 12) * 8 * SEQ + (row & 4095)) * 96 + 64 + 8 * fq;
#pragma unroll
                            for (int hd = 0; hd < 8; ++hd) *(u32x4*)(kp + (size_t)hd * SEQ * 96) = o;
                        }
                    } else if (hh < 10) {
#pragma unroll
                        for (int e = 0; e < 8; ++e) v[e] = v[e] * sigmoidf_(v[e]);
                        *(u32x4*)(HQ + (size_t)row * 512 + (hh - 6) * 128 + cw) = pk8(v);
                    } else if (hh < 14) {
                        const int c0 = (hh - 10) * 128 + cw;
                        const f32x4 l0 = *(const f32x4*)(lbs + c0), l1 = *(const f32x4*)(lbs + c0 + 4);
                        const float lb[8] = {l0.x, l0.y, l0.z, l0.w, l1.x, l1.y, l1.z, l1.w};
                        float g[8], k[8];
#pragma unroll
                        for (int e = 0; e < 8; ++e) { const float z = fminf(fmaxf(v[e], -60.f), 60.f); const float sg = 1.0f / (1.0f + __expf(-z));
                            g[e] = __logf(lb[e] + (1.0f - lb[e]) * sg); k[e] = (1.0f - lb[e]) / (1.0f + __expf(z)); }
                        *(f32x4*)(GG + (size_t)row * 512 + c0) = (f32x4){g[0], g[1], g[2], g[3]}; *(f32x4*)(GG + (size_t)row * 512 + c0 + 4) = (f32x4){g[4], g[5], g[6], g[7]};
                        *(u32x4*)(HK + (size_t)row * 512 + c0) = pk8(k);
                    } else if (hh < 18) {
                        *(u32x4*)(HV + (size_t)row * 512 + (hh - 14) * 128 + cw) = pk8(v);
                    } else if (hh < 22) {
#pragma unroll
                        for (int e = 0; e < 8; ++e) v[e] = v[e] * sigmoidf_(v[e]);
                        *(u32x4*)(HGT + (size_t)row * 512 + (hh - 18) * 128 + cw) = pk8(v);
                    } else if (hh < 26) {
#pragma unroll
                        for (int e = 0; e < 8; ++e) v[e] *= QSCALE_MEM;
                        *(u32x4*)(MQ + (size_t)row * 512 + (hh - 22) * 128 + cw) = pk8(v);
                    } else {
                        const int c0 = (hh - 26) * 128 + cw, br = c0 >> 10, cc = c0 & 1023;
#pragma unroll
                        for (int e = 0; e < 8; ++e) v[e] = sigmoidf_(v[e]);
                        *(u32x4*)(GATES + ((size_t)br * T + row) * 1024 + cc) = pk8(v);
                    }
                }
            }
    }
};

struct EpiQ {
    static constexpr bool PERM = true, AFTER_DRAIN = false;
    bf16* Q;
    DI void operator()(EPI_ARGS) const {
        EPI_OPAQUE
#pragma unroll
        for (int ai = 0; ai < 2; ++ai)
#pragma unroll
            for (int m = 0; m < 4; ++m) {
                const int row = u.pm * 256 + ai * 128 + wr * 64 + m * 16 + fr;
#pragma unroll
                for (int bj = 0; bj < 2; ++bj) {
                    float v[8];
#pragma unroll
                    for (int n = 0; n < 2; ++n)
#pragma unroll
                        for (int j = 0; j < 4; ++j) v[4 * n + j] = acc[ai][bj][m][n][j];
                    *(u32x4*)(Q + (size_t)row * 768 + u.pn * 256 + 128 * bj + 32 * wc + 8 * fq) = pk8(v);
                }
            }
    }
};

struct EpiKV {
    static constexpr bool PERM = true, AFTER_DRAIN = false;
    bf16* KC; bf16* VT; const float* ssqkv;
    DI void operator()(EPI_ARGS) const {
        EPI_OPAQUE
#pragma unroll
        for (int ai = 0; ai < 2; ++ai)
#pragma unroll
            for (int m = 0; m < 4; ++m) {
                const int row = u.pm * 256 + ai * 128 + wr * 64 + m * 16 + fr, b = row >> 12, s = row & 4095;
                const float rs = rsqrtf(rowsum_q(ssqkv + (size_t)row * 8, fq, 2) * (1.0f / 256.0f) + EPS);
#pragma unroll
                for (int bj = 0; bj < 2; ++bj) {
                    const int c0 = u.pn * 256 + 128 * bj + 32 * wc + 8 * fq;
                    float v[8];
#pragma unroll
                    for (int n = 0; n < 2; ++n)
#pragma unroll
                        for (int j = 0; j < 4; ++j) v[4 * n + j] = acc[ai][bj][m][n][j] * rs;
                    if (c0 < 512) {
                        const int hd = c0 >> 6, d = c0 & 63;
                        bf16* kp = KC + ((size_t)(b * 8 + hd) * SEQ + s) * 96;
                        *(u32x4*)(kp + d) = pk8(v);
                    } else {
                        const int c = c0 - 512, hd = c >> 6, dv = c & 63;
                        bf16* vp = VT + ((size_t)(b * 8 + hd) * 64 + dv) * SEQ + s;
#pragma unroll
                        for (int e = 0; e < 8; ++e) vp[(size_t)e * SEQ] = f2bf(v[e]);
                    }
                }
            }
    }
};

struct EpiMemKV {
    static constexpr bool PERM = true, AFTER_DRAIN = false;
    bf16* MK; bf16* MVT; const float* rstd;
    DI void operator()(EPI_ARGS) const {
        EPI_OPAQUE
#pragma unroll
        for (int ai = 0; ai < 2; ++ai)
#pragma unroll
            for (int m = 0; m < 4; ++m) {
                const int row = u.pm * 256 + ai * 128 + wr * 64 + m * 16 + fr, b = row >> 8, mm = row & 255;
                const float rs = rstd[row];
#pragma unroll
                for (int bj = 0; bj < 2; ++bj) {
                    const int c0 = u.pn * 256 + 128 * bj + 32 * wc + 8 * fq;
                    float v[8];
#pragma unroll
                    for (int n = 0; n < 2; ++n)
#pragma unroll
                        for (int j = 0; j < 4; ++j) v[4 * n + j] = acc[ai][bj][m][n][j] * rs;
                    if (c0 < 512) { const int hd = c0 >> 7, d = c0 & 127; *(u32x4*)(MK + ((size_t)(b * 4 + hd) * 256 + mm) * 128 + d) = pk8(v); }
                    else { const int c = c0 - 512, hd = c >> 7, dv = c & 127; bf16* vp = MVT + ((size_t)(b * 4 + hd) * 128 + dv) * 256 + mm;
#pragma unroll
                        for (int e = 0; e < 8; ++e) vp[(size_t)e * 256] = f2bf(v[e]); }
                }
            }
    }
};

struct EpiBranch {
    static constexpr bool PERM = true, AFTER_DRAIN = false;
    bf16* MG; const bf16* gate; int first;
    DI void operator()(EPI_ARGS) const {
        EPI_OPAQUE
#pragma unroll
        for (int ai = 0; ai < 2; ++ai)
#pragma unroll
            for (int m = 0; m < 4; ++m) {
                const int row = u.pm * 256 + ai * 128 + wr * 64 + m * 16 + fr;
#pragma unroll
                for (int bj = 0; bj < 2; ++bj) {
                    const size_t off = (size_t)row * 1024 + u.pn * 256 + 128 * bj + 32 * wc + 8 * fq;
                    float g[8], o[8];
                    unpk8(*(const u32x4*)(gate + off), g);
                    if (first) {
#pragma unroll
                        for (int e = 0; e < 8; ++e) o[e] = 0.f;
                    } else unpk8(*(const u32x4*)(MG + off), o);
#pragma unroll
                    for (int n = 0; n < 2; ++n)
#pragma unroll
                        for (int j = 0; j < 4; ++j) o[4 * n + j] += g[4 * n + j] * acc[ai][bj][m][n][j];
                    *(u32x4*)(MG + off) = pk8(o);
                }
            }
    }
};

template <class Epi> DI void run_gemm(LAS unsigned char* lds, const bf16* A, const bf16* Bt, int M, int N, int K, int rot, const Epi& E) {
    int Kv = K, Nv = N, Mv = M; asm volatile("" : "+s"(Kv), "+s"(Nv), "+s"(Mv));
    pg8::Gemm g{A, Bt, Mv, Nv, Kv}; pg8::StaticOrder S; const int G = (int)gridDim.x;
    S.init(Mv, Nv, G, (int)((blockIdx.x + (unsigned)G - (unsigned)rot) % (unsigned)G));
    pg8::gemm_phase<Epi, pg8::StaticOrder, true, true>(lds, g, S, E);
}

#define MFMA32(a, b, c) __builtin_amdgcn_mfma_f32_32x32x16_bf16((a), (b), (c), 0, 0, 0)
template <int DQK, int DV, bool CAUSAL>
DI void attn_item(LAS unsigned char* lds, const bf16* Qp, int qstride, const bf16* Kp, const bf16* VTp, int vt_stride, bf16* Op, int ostride, int q0, int nkeys,
                  const float* ssqq, const float* cosT, const float* sinT) {
    constexpr int KROW = DQK * 2 + 16, VROW = 144, KBYTES = 64 * KROW, VBYTES = DV * VROW, BUF = KBYTES + VBYTES;
    constexpr int NCK = 64 * DQK / 8, NCV = DV * 8, KS = DQK / 16, NDB = DV / 32;
    constexpr int CPR = DQK / 8;
    int tid_o = threadIdx.x; asm volatile("" : "+v"(tid_o)); const int tid = tid_o, wid = __builtin_amdgcn_readfirstlane(tid >> 6), lane = tid & 63, r = lane & 31, h = lane >> 5;
    const int ntiles = CAUSAL ? (q0 + 256) / 64 : nkeys / 64;
    const int qlo = q0 + wid * 32;
    bf16x8 qf[KS];
    { const bf16* qr = Qp + (size_t)(wid * 32 + r) * qstride + 8 * h;
#pragma unroll
      for (int ks = 0; ks < KS; ++ks) qf[ks] = *(const bf16x8*)(qr + 16 * ks);
      if (CAUSAL) {
          const float* sp = ssqq + (size_t)(wid * 32 + r) * 16;
          const f32x4 a = *(const f32x4*)sp, b = *(const f32x4*)(sp + 4), c = *(const f32x4*)(sp + 8);
          const float rs = rsqrtf((((a.x + a.y) + (a.z + a.w)) + ((b.x + b.y) + (b.z + b.w)) + ((c.x + c.y) + (c.z + c.w))) * (1.0f / 384.0f) + EPS) * QSCALE_MLA;
#pragma unroll
          for (int ks = 0; ks < KS; ++ks) {
              float v[8]; unpk8(__builtin_bit_cast(u32x4, qf[ks]), v);
              if (ks >= 4) {
                  const int i0 = 8 * (ks - 4) + 4 * h;
                  const f32x4 cs = *(const f32x4*)(cosT + (size_t)(wid * 32 + r) * 16 + i0), sn = *(const f32x4*)(sinT + (size_t)(wid * 32 + r) * 16 + i0);
                  const float t0 = v[0], t1 = v[1], t2 = v[2], t3 = v[3], t4 = v[4], t5 = v[5], t6 = v[6], t7 = v[7];
                  v[0] = t0 * cs.x - t1 * sn.x; v[1] = t1 * cs.x + t0 * sn.x; v[2] = t2 * cs.y - t3 * sn.y; v[3] = t3 * cs.y + t2 * sn.y;
                  v[4] = t4 * cs.z - t5 * sn.z; v[5] = t5 * cs.z + t4 * sn.z; v[6] = t6 * cs.w - t7 * sn.w; v[7] = t7 * cs.w + t6 * sn.w;
              }
#pragma unroll
              for (int e = 0; e < 8; ++e) v[e] *= rs;
              qf[ks] = __builtin_bit_cast(bf16x8, pk8(v));
          }
      } }
    f32x16 o[NDB];
#pragma unroll
    for (int db = 0; db < NDB; ++db)
#pragma unroll
        for (int i = 0; i < 16; ++i) o[db][i] = 0.f;
    float mrun = -1e30f, lrun = 0.f;
    const int kc0 = tid, kc1 = tid + 512; const bool k1on = kc1 < NCK;
    const int kr0 = kc0 / CPR, kcc0 = kc0 % CPR, kr1 = kc1 / CPR, kcc1 = kc1 % CPR;
    const int vc0 = tid, vc1 = tid + 512; const bool v1on = vc1 < NCV;
    u32x4 pk0, pk1 = {0, 0, 0, 0}, pv0, pv1 = {0, 0, 0, 0};
    const GAS u32x4* Kg = (const GAS u32x4*)Kp;
#define ATT_GLOAD(t_) do { pk0 = Kg[(size_t)(t_) * NCK + kc0]; if (k1on) pk1 = Kg[(size_t)(t_) * NCK + kc1]; \
        pv0 = *(const GAS u32x4*)(VTp + (size_t)(vc0 >> 3) * vt_stride + (t_) * 64 + (vc0 & 7) * 8); \
        if (v1on) pv1 = *(const GAS u32x4*)(VTp + (size_t)(vc1 >> 3) * vt_stride + (t_) * 64 + (vc1 & 7) * 8); } while (0)
#define ATT_LSTORE(buf_) do { LAS unsigned char* kb_ = lds + (buf_) * BUF; LAS unsigned char* vb_ = kb_ + KBYTES; \
        *(LAS u32x4*)(kb_ + kr0 * KROW + kcc0 * 16) = pk0; if (k1on) *(LAS u32x4*)(kb_ + kr1 * KROW + kcc1 * 16) = pk1; \
        *(LAS u32x4*)(vb_ + (vc0 >> 3) * VROW + (vc0 & 7) * 16) = pv0; if (v1on) *(LAS u32x4*)(vb_ + (vc1 >> 3) * VROW + (vc1 & 7) * 16) = pv1; } while (0)
    ATT_GLOAD(0); ATT_LSTORE(0);
    __syncthreads();
    for (int t = 0; t < ntiles; ++t) {
        const bool more = t + 1 < ntiles;
        if (more) ATT_GLOAD(t + 1);
        const bool active = !CAUSAL || (64 * t <= qlo + 31);
        if (active) {
            LAS unsigned char* kb = lds + (t & 1) * BUF; LAS unsigned char* vb = kb + KBYTES;
            f32x16 s0, s1;
#pragma unroll
            for (int i = 0; i < 16; ++i) { s0[i] = 0.f; s1[i] = 0.f; }
#pragma unroll
            for (int ks = 0; ks < KS; ++ks) {
                const bf16x8 k0 = *(const LAS bf16x8*)(kb + r * KROW + 32 * ks + 16 * h);
                const bf16x8 k1 = *(const LAS bf16x8*)(kb + (32 + r) * KROW + 32 * ks + 16 * h);
                s0 = MFMA32(k0, qf[ks], s0); s1 = MFMA32(k1, qf[ks], s1);
            }
            if (CAUSAL && (64 * t + 63 > qlo)) {
                const int qpos = qlo + r, kbase = 64 * t + 4 * h;
#pragma unroll
                for (int i = 0; i < 16; ++i) { const int key = kbase + (i & 3) + 8 * (i >> 2);
                    if (key > qpos) s0[i] = -1e30f; if (key + 32 > qpos) s1[i] = -1e30f; }
            }
            float mx = s0[0];
#pragma unroll
            for (int i = 1; i < 16; ++i) mx = fmaxf(mx, s0[i]);
#pragma unroll
            for (int i = 0; i < 16; ++i) mx = fmaxf(mx, s1[i]);
            mx = fmaxf(mx, __shfl_xor(mx, 32));
            const float mnew = fmaxf(mrun, mx), alpha = __builtin_amdgcn_exp2f(mrun - mnew);
            mrun = mnew;
            float ps = 0.f;
#pragma unroll
            for (int i = 0; i < 16; ++i) { s0[i] = __builtin_amdgcn_exp2f(s0[i] - mnew); s1[i] = __builtin_amdgcn_exp2f(s1[i] - mnew); ps += s0[i] + s1[i]; }
            lrun = lrun * alpha + ps;
#pragma unroll
            for (int db = 0; db < NDB; ++db)
#pragma unroll
                for (int i = 0; i < 16; ++i) o[db][i] *= alpha;
#pragma unroll
            for (int kb2 = 0; kb2 < 2; ++kb2)
#pragma unroll
                for (int s = 0; s < 2; ++s) {
                    u32x4 pw;
                    if (kb2 == 0) { pw.x = pk2(s0[8 * s], s0[8 * s + 1]); pw.y = pk2(s0[8 * s + 2], s0[8 * s + 3]); pw.z = pk2(s0[8 * s + 4], s0[8 * s + 5]); pw.w = pk2(s0[8 * s + 6], s0[8 * s + 7]); }
                    else { pw.x = pk2(s1[8 * s], s1[8 * s + 1]); pw.y = pk2(s1[8 * s + 2], s1[8 * s + 3]); pw.z = pk2(s1[8 * s + 4], s1[8 * s + 5]); pw.w = pk2(s1[8 * s + 6], s1[8 * s + 7]); }
                    const bf16x8 pf = __builtin_bit_cast(bf16x8, pw);
                    const int koff = (32 * kb2 + 16 * s + 4 * h) * 2;
#pragma unroll
                    for (int db = 0; db < NDB; ++db) {
                        const u32x2 lo = *(const LAS u32x2*)(vb + (32 * db + r) * VROW + koff), hi = *(const LAS u32x2*)(vb + (32 * db + r) * VROW + koff + 16);
                        u32x4 vw; vw.x = lo.x; vw.y = lo.y; vw.z = hi.x; vw.w = hi.y;
                        o[db] = MFMA32(__builtin_bit_cast(bf16x8, vw), pf, o[db]);
                    }
                }
        }
        if (more) ATT_LSTORE((t + 1) & 1);
        __syncthreads();
    }
    const float ltot = lrun + __shfl_xor(lrun, 32), inv = 1.0f / ltot;
    bf16* orow = Op + (size_t)(wid * 32 + r) * ostride + 4 * h;
#pragma unroll
    for (int db = 0; db < NDB; ++db)
#pragma unroll
        for (int g = 0; g < 4; ++g) {
            u32x2 w; w.x = pk2(o[db][4 * g] * inv, o[db][4 * g + 1] * inv); w.y = pk2(o[db][4 * g + 2] * inv, o[db][4 * g + 3] * inv);
            *(u32x2*)(orow + 32 * db + 8 * g) = w;
        }
}

template <int KSTEPS> DI void lds_mma(f32x16& c, const LAS unsigned char* A, int astride, const LAS unsigned char* Bt, int bstride, int r, int h) {
#pragma unroll
    for (int s = 0; s < KSTEPS; ++s) {
        const bf16x8 a = *(const LAS bf16x8*)(A + r * astride + 32 * s + 16 * h);
        const bf16x8 b = *(const LAS bf16x8*)(Bt + r * bstride + 32 * s + 16 * h);
        c = MFMA32(a, b, c);
    }
}

DI void hgrn_b1(LAS unsigned char* lds, int ch, float* GG, const bf16* HK, const bf16* HV, float* LT, float* DEC) {
    int tid_o = threadIdx.x; asm volatile("" : "+v"(tid_o)); const int tid = tid_o, wid = __builtin_amdgcn_readfirstlane(tid >> 6), lane = tid & 63, r = lane & 31, h = lane >> 5;
    const int bh = ch >> 6, c = ch & 63, b = bh >> 2, hd = bh & 3;
    const size_t t0 = (size_t)b * SEQ + c * 64;
    const int k = tid & 127, seg = tid >> 7;
    LAS float* segsum = (LAS float*)lds;
    LAS unsigned char* kdT = lds + 2048;
    LAS unsigned char* vT = kdT + 128 * 144;
    float g[16]; float run = 0.f;
    float* gp = GG + (t0 + seg * 16) * 512 + hd * 128 + k;
#pragma unroll
    for (int i = 0; i < 16; ++i) { run += gp[(size_t)i * 512]; g[i] = run; }
    segsum[seg * 128 + k] = run;
    __syncthreads();
    float off = 0.f, tot = 0.f;
#pragma unroll
    for (int s = 0; s < 4; ++s) { const float v = segsum[s * 128 + k]; if (s < seg) off += v; tot += v; }
    const bf16* kp = HK + (t0 + seg * 16) * 512 + hd * 128 + k;
    const bf16* vp = HV + (t0 + seg * 16) * 512 + hd * 128 + k;
#pragma unroll
    for (int i = 0; i < 16; ++i) {
        const float G = g[i] + off; gp[(size_t)i * 512] = G;
        const float kd = bf2f(kp[(size_t)i * 512]) * __expf(tot - G);
        *(LAS bf16*)(kdT + k * 144 + (seg * 16 + i) * 2) = f2bf(kd);
        *(LAS bf16*)(vT + k * 144 + (seg * 16 + i) * 2) = vp[(size_t)i * 512];
    }
    if (seg == 0) DEC[(size_t)ch * 128 + k] = __expf(tot);
    __syncthreads();
    const int vb = wid >> 1;
#pragma unroll
    for (int q = 0; q < 2; ++q) {
        const int kb = (wid & 1) * 2 + q;
        f32x16 acc;
#pragma unroll
        for (int i = 0; i < 16; ++i) acc[i] = 0.f;
        lds_mma<4>(acc, vT + vb * 32 * 144, 144, kdT + kb * 32 * 144, 144, r, h);
        float* lp = LT + (size_t)ch * 16384 + (size_t)(vb * 32 + 4 * h) * 128 + kb * 32 + r;
#pragma unroll
        for (int i = 0; i < 16; ++i) lp[(size_t)((i & 3) + 8 * (i >> 2)) * 128] = acc[i];
    }
    __syncthreads();
}

DI void hgrn_b3(LAS unsigned char* lds, int ch, const float* GG, const bf16* HQ, const bf16* HK, const bf16* HV, const bf16* HGT, const float* LT, const float* onorm, bf16* HO) {
    constexpr int RS = 272;
    int tid_o = threadIdx.x; asm volatile("" : "+v"(tid_o)); const int tid = tid_o, wid = __builtin_amdgcn_readfirstlane(tid >> 6), lane = tid & 63, r = lane & 31, h = lane >> 5;
    const int bh = ch >> 6, c = ch & 63, b = bh >> 2, hd = bh & 3;
    const size_t t0 = (size_t)b * SEQ + c * 64;
    LAS unsigned char* qG = lds;
    LAS unsigned char* q1 = qG + 64 * RS;
    LAS unsigned char* kA0 = q1 + 32 * RS;
    LAS unsigned char* kA1 = kA0 + 32 * RS;
    LAS unsigned char* ST = kA1 + 64 * RS;
    LAS unsigned char* vT = ST + 128 * RS;
    LAS unsigned char* Am = vT + 128 * 144;
    {
        const int k8 = tid & 15;
        const float* g31p = GG + (t0 + 31) * 512 + hd * 128 + k8 * 8;
        const f32x4 ga = *(const f32x4*)g31p, gb = *(const f32x4*)(g31p + 4);
        const float g31[8] = {ga.x, ga.y, ga.z, ga.w, gb.x, gb.y, gb.z, gb.w};
#pragma unroll
        for (int pass = 0; pass < 2; ++pass) {
            const int t = (tid >> 4) + 32 * pass;
            const size_t off = (t0 + t) * 512 + hd * 128 + k8 * 8;
            const f32x4 a = *(const f32x4*)(GG + off), bq = *(const f32x4*)(GG + off + 4);
            const float G[8] = {a.x, a.y, a.z, a.w, bq.x, bq.y, bq.z, bq.w};
            float q[8], kk[8], o1[8], o2[8], o3[8];
            unpk8(*(const u32x4*)(HQ + off), q); unpk8(*(const u32x4*)(HK + off), kk);
#pragma unroll
            for (int e = 0; e < 8; ++e) o1[e] = q[e] * __expf(G[e]);
            *(LAS u32x4*)(qG + t * RS + k8 * 16) = pk8(o1);
            if (pass == 0) {
#pragma unroll
                for (int e = 0; e < 8; ++e) { o2[e] = kk[e] * __expf(fminf(-G[e], 80.f)); o3[e] = kk[e] * __expf(g31[e] - G[e]); }
                *(LAS u32x4*)(kA0 + t * RS + k8 * 16) = pk8(o2);
                *(LAS u32x4*)(kA1 + t * RS + k8 * 16) = pk8(o3);
            } else {
#pragma unroll
                for (int e = 0; e < 8; ++e) { o2[e] = q[e] * __expf(G[e] - g31[e]); o3[e] = kk[e] * __expf(fminf(g31[e] - G[e], 80.f)); }
                *(LAS u32x4*)(q1 + (t - 32) * RS + k8 * 16) = pk8(o2);
                *(LAS u32x4*)(kA1 + t * RS + k8 * 16) = pk8(o3);
            }
        }
        const float* lp = LT + (size_t)ch * 16384;
#pragma unroll
        for (int p = 0; p < 4; ++p) {
            const int idx = tid + 512 * p, v = idx >> 4, kk8 = idx & 15;
            const f32x4 a = *(const f32x4*)(lp + v * 128 + kk8 * 8), bq = *(const f32x4*)(lp + v * 128 + kk8 * 8 + 4);
            const float sv[8] = {a.x, a.y, a.z, a.w, bq.x, bq.y, bq.z, bq.w};
            *(LAS u32x4*)(ST + v * RS + kk8 * 16) = pk8(sv);
        }
        const int v = tid & 127, seg = tid >> 7;
        const bf16* vp = HV + (t0 + seg * 16) * 512 + hd * 128 + v;
#pragma unroll
        for (int i = 0; i < 16; ++i) *(LAS bf16*)(vT + v * 144 + (seg * 16 + i) * 2) = vp[(size_t)i * 512];
    }
    __syncthreads();
    if (wid < 3) {
        f32x16 a;
#pragma unroll
        for (int i = 0; i < 16; ++i) a[i] = 0.f;
        const int tb = wid == 0 ? 0 : 1, sb = wid == 2 ? 1 : 0;
        if (wid == 0) lds_mma<8>(a, qG, RS, kA0, RS, r, h);
        else lds_mma<8>(a, q1, RS, kA1 + sb * 32 * RS, RS, r, h);
#pragma unroll
        for (int i = 0; i < 16; ++i) { const int tl = (i & 3) + 8 * (i >> 2) + 4 * h; float val = a[i]; if (tb == sb && r > tl) val = 0.f;
            *(LAS bf16*)(Am + (tb * 32 + tl) * 144 + (sb * 32 + r) * 2) = f2bf(val); }
    } else if (wid == 3) {
#pragma unroll
        for (int i = 0; i < 16; ++i) { const int tl = (i & 3) + 8 * (i >> 2) + 4 * h; *(LAS bf16*)(Am + tl * 144 + (32 + r) * 2) = (bf16)0; }
    }
    __syncthreads();
    f32x16 acc;
#pragma unroll
    for (int i = 0; i < 16; ++i) acc[i] = 0.f;
    const int tb = wid >> 2, vb = wid & 3;
    lds_mma<8>(acc, qG + tb * 32 * RS, RS, ST + vb * 32 * RS, RS, r, h);
    lds_mma<4>(acc, Am + tb * 32 * 144, 144, vT + vb * 32 * 144, 144, r, h);
    __syncthreads();
    LAS float* Ost = (LAS float*)ST;
#pragma unroll
    for (int i = 0; i < 16; ++i) Ost[(tb * 32 + (i & 3) + 8 * (i >> 2) + 4 * h) * 132 + vb * 32 + r] = acc[i];
    __syncthreads();
    {
        const int t = tid >> 3, part = tid & 7;
        float ov[16]; float ss = 0.f;
#pragma unroll
        for (int q4 = 0; q4 < 4; ++q4) { const f32x4 x = *(const LAS f32x4*)(Ost + t * 132 + part * 16 + q4 * 4); ov[4 * q4] = x.x; ov[4 * q4 + 1] = x.y; ov[4 * q4 + 2] = x.z; ov[4 * q4 + 3] = x.w; }
#pragma unroll
        for (int e = 0; e < 16; ++e) ss += ov[e] * ov[e];
        ss += __shfl_xor(ss, 1); ss += __shfl_xor(ss, 2); ss += __shfl_xor(ss, 4);
        const float rs = rsqrtf(ss * (1.0f / 128.0f) + EPS);
        const size_t off = (t0 + t) * 512 + hd * 128 + part * 16;
        float gt[16];
        unpk8(*(const u32x4*)(HGT + off), gt); unpk8(*(const u32x4*)(HGT + off + 8), gt + 8);
#pragma unroll
        for (int e = 0; e < 16; ++e) ov[e] = ov[e] * rs * onorm[part * 16 + e] * gt[e];
        *(u32x4*)(HO + off) = pk8(ov); *(u32x4*)(HO + off + 8) = pk8(ov + 8);
    }
    __syncthreads();
}

DI int dest_row(int mode, int n) {
    if (mode == 0) return n;
    if (mode == 1) { const int j = n < DFF ? n : n - DFF; return (j >> 7) * 256 + (n < DFF ? 0 : 128) + (j & 127); }
    if (mode == 2) { if (n < 640) return n; if (n < 672) { const int j = n - 640; return 640 + (j < 16 ? 2 * j : 2 * (j - 16) + 1); } if (n < 3232) return 768 + (n - 672); return 3328 + (n - 3232); }
    const int hd = n / 96, w = n - hd * 96; if (w < 64) return n; const int j = w - 64; return hd * 96 + 64 + (j < 16 ? 2 * j : 2 * (j - 16) + 1);
}
DI void conv_item(const float* W, int K, int N, bf16* WT, const float* gain, int mode, int row_off, LAS float* scr, int item, int lane) {
    const int nblk = N / 32, kb = item / nblk, nb = item - kb * nblk, k0 = 64 * kb, n0 = 32 * nb;
#pragma unroll 8
    for (int i = 0; i < 32; ++i) { const int kk = 2 * i + (lane >> 5); scr[kk * 33 + (lane & 31)] = W[(size_t)(k0 + kk) * N + n0 + (lane & 31)]; }
    asm volatile("s_waitcnt lgkmcnt(0)" ::: "memory");
    const int c = lane & 7;
    float gn[8];
#pragma unroll
    for (int e = 0; e < 8; ++e) gn[e] = gain ? gain[k0 + 8 * c + e] : 1.0f;
#pragma unroll
    for (int j = 0; j < 4; ++j) { const int n = (lane >> 3) + 8 * j; const LAS float* s = scr + (8 * c) * 33 + n;
        float v[8];
#pragma unroll
        for (int e = 0; e < 8; ++e) v[e] = s[e * 33] * gn[e];
        *(u32x4*)(WT + (size_t)(row_off + dest_row(mode, n0 + n)) * K + k0 + 8 * c) = pk8(v); }
    asm volatile("s_waitcnt lgkmcnt(0)" ::: "memory");
}

struct Args { const void* in[25]; float* out; unsigned char* ws; int ph_lo, ph_hi; };
typedef const __attribute__((address_space(4))) unsigned long long* ka_t;
DI unsigned long long KA(int i) { ka_t p = (ka_t)__builtin_amdgcn_kernarg_segment_ptr(); asm volatile("" : "+s"(p)); return p[i]; }
#define KIN(i) ((const float*)KA(i))
#define KOUT ((float*)KA(25))
#define KWS ((unsigned char*)KA(26))

DI void conv_layer(int l, LAS unsigned char* lds) {
    int tid_o = threadIdx.x; asm volatile("" : "+v"(tid_o)); const int tid = tid_o, wave = __builtin_amdgcn_readfirstlane(tid >> 6), lane = tid & 63;
    LAS float* scr = (LAS float*)(lds + wave * 16384);
    const int gw = blockIdx.x * NWAVES + wave, NGW = gridDim.x * NWAVES;
    unsigned char* ws = KWS;
    const float* f1n = KIN(3) + l * 1024; const float* w1i = KIN(4) + (size_t)l * 1024 * 5632; const float* w1o = KIN(5) + (size_t)l * 2816 * 1024;
    const float* mxn = KIN(6) + l * 1024; const float* win = KIN(7) + (size_t)l * 1024 * DIN;
    const float* qln = KIN(8) + l * 384; const float* kvn = KIN(9) + l * 256;
    const float* wuq = KIN(10) + (size_t)l * 384 * 768; const float* wuk = KIN(11) + (size_t)l * 256 * 512; const float* wuv = KIN(12) + (size_t)l * 256 * 512;
    const float* womla = KIN(13) + (size_t)l * 512 * 1024; const float* wohg = KIN(16) + (size_t)l * 512 * 1024;
    const float* memn = KIN(17) + l * 1024; const float* wmkv = KIN(18) + (size_t)l * 1024 * 1024; const float* womem = KIN(19) + (size_t)l * 512 * 1024;
    const float* wout = KIN(20) + (size_t)l * 1024 * 1024;
    const float* f2n = KIN(21) + l * 1024; const float* w2i = KIN(22) + (size_t)l * 1024 * 5632; const float* w2o = KIN(23) + (size_t)l * 2816 * 1024;
    constexpr int I_FI = 16 * 176, I_FO = 44 * 32, I_WIN = 16 * 197, I_UQ = 6 * 24, I_UK = 4 * 16, I_WO = 8 * 32, I_SQ = 16 * 32;
    constexpr int NITEMS = 2 * I_FI + 2 * I_FO + I_WIN + I_UQ + 2 * I_UK + 3 * I_WO + 2 * I_SQ;
    for (int it = gw; it < NITEMS; it += NGW) {
        int r = it;
        if (r < I_FI) { conv_item(w1i, 1024, 5632, (bf16*)(ws + WT_W1IN), f1n, 1, 0, scr, r, lane); continue; } r -= I_FI;
        if (r < I_FI) { conv_item(w2i, 1024, 5632, (bf16*)(ws + WT_W2IN), f2n, 1, 0, scr, r, lane); continue; } r -= I_FI;
        if (r < I_FO) { conv_item(w1o, 2816, 1024, (bf16*)(ws + WT_W1OUT), nullptr, 0, 0, scr, r, lane); continue; } r -= I_FO;
        if (r < I_FO) { conv_item(w2o, 2816, 1024, (bf16*)(ws + WT_W2OUT), nullptr, 0, 0, scr, r, lane); continue; } r -= I_FO;
        if (r < I_WIN) { conv_item(win, 1024, DIN, (bf16*)(ws + WT_WIN), mxn, 2, 0, scr, r, lane); continue; } r -= I_WIN;
        if (r < I_UQ) { conv_item(wuq, 384, 768, (bf16*)(ws + WT_WUQ), qln, 3, 0, scr, r, lane); continue; } r -= I_UQ;
        if (r < I_UK) { conv_item(wuk, 256, 512, (bf16*)(ws + WT_WUKV), kvn, 0, 0, scr, r, lane); continue; } r -= I_UK;
        if (r < I_UK) { conv_item(wuv, 256, 512, (bf16*)(ws + WT_WUKV), kvn, 0, 512, scr, r, lane); continue; } r -= I_UK;
        if (r < I_WO) { conv_item(womla, 512, 1024, (bf16*)(ws + WT_WOMLA), nullptr, 0, 0, scr, r, lane); continue; } r -= I_WO;
        if (r < I_WO) { conv_item(wohg, 512, 1024, (bf16*)(ws + WT_WOHG), nullptr, 0, 0, scr, r, lane); continue; } r -= I_WO;
        if (r < I_WO) { conv_item(womem, 512, 1024, (bf16*)(ws + WT_WOMEM), nullptr, 0, 0, scr, r, lane); continue; } r -= I_WO;
        if (r < I_SQ) { conv_item(wmkv, 1024, 1024, (bf16*)(ws + WT_WMEMKV), memn, 0, 0, scr, r, lane); continue; } r -= I_SQ;
        conv_item(wout, 1024, 1024, (bf16*)(ws + WT_WOUT), nullptr, 0, 0, scr, r, lane);
    }
    u32x4* pad = (u32x4*)(ws + WT_WIN + (size_t)672 * 1024 * 2);
    for (int i = blockIdx.x * NTHREADS + tid; i < 96 * 1024 * 2 / 16; i += gridDim.x * NTHREADS) pad[i] = (u32x4){0, 0, 0, 0};
}

DI void prep_phase() {
    int tid_o = threadIdx.x; asm volatile("" : "+v"(tid_o)); const int tid = tid_o, wave = __builtin_amdgcn_readfirstlane(tid >> 6), lane = tid & 63;
    const int gw = blockIdx.x * NWAVES + wave, NGW = gridDim.x * NWAVES;
    unsigned char* ws = KWS; float* xout = KOUT;
    const float* x = KIN(0); const float* mem = KIN(1); const int* pos = (const int*)KA(2);
    bf16* XB = (bf16*)(ws + WS_XB); float* SSQ = (float*)(ws + WS_SSQ);
    for (int m = gw; m < T; m += NGW) {
        const f32x4* xr = (const f32x4*)(x + (size_t)m * D) + lane; f32x4* orow = (f32x4*)(xout + (size_t)m * D) + lane; u32x2* xb = (u32x2*)(XB + (size_t)m * D) + lane;
        float s = 0.f;
#pragma unroll
        for (int j = 0; j < 4; ++j) { const f32x4 v = xr[64 * j]; orow[64 * j] = v; s += (v.x * v.x + v.y * v.y) + (v.z * v.z + v.w * v.w); u32x2 w; w.x = pk2(v.x, v.y); w.y = pk2(v.z, v.w); xb[64 * j] = w; }
        s = wave_sum(s);
        if (lane < 16) SSQ[(size_t)m * 16 + lane] = lane == 0 ? s : 0.f;
    }
    bf16* MEMB = (bf16*)(ws + WS_MEMB); float* MRS = (float*)(ws + WS_MEMRSTD);
    for (int m = gw; m < 1024; m += NGW) {
        const f32x4* xr = (const f32x4*)(mem + (size_t)m * D) + lane; u32x2* xb = (u32x2*)(MEMB + (size_t)m * D) + lane;
        float s = 0.f;
#pragma unroll
        for (int j = 0; j < 4; ++j) { const f32x4 v = xr[64 * j]; s += (v.x * v.x + v.y * v.y) + (v.z * v.z + v.w * v.w); u32x2 w; w.x = pk2(v.x, v.y); w.y = pk2(v.z, v.w); xb[64 * j] = w; }
        s = wave_sum(s);
        if (lane == 0) MRS[m] = rsqrtf(s * (1.0f / 1024.0f) + EPS);
    }
    float* COS = (float*)(ws + WS_COS); float* SIN = (float*)(ws + WS_SIN);
    for (int i = blockIdx.x * NTHREADS + tid; i < T * 16; i += gridDim.x * NTHREADS) {
        const int row = i >> 4, fi = i & 15;
        const float invf = exp2f(-13.287712379549449f * (float)fi * (1.0f / 16.0f));
        const float ang = (float)pos[row] * invf;
        const float kq = rintf(ang * 0.15915494309189535f);
        float rr = fmaf(-kq, 6.28125f, ang); rr = fmaf(-kq, 1.9353071795864769e-3f, rr);
        COS[i] = __cosf(rr); SIN[i] = __sinf(rr);
    }
    const float* hlb = KIN(14); float* LBS = (float*)(ws + WS_LBS);
    for (int i = blockIdx.x * NTHREADS + tid; i < 512; i += gridDim.x * NTHREADS) {
        const float a0 = hlb[i], a1 = hlb[512 + i], a2 = hlb[1024 + i], a3 = hlb[1536 + i];
        const float mx = fmaxf(fmaxf(a0, a1), fmaxf(a2, a3));
        const float e0 = __expf(a0 - mx), e1 = __expf(a1 - mx), e2 = __expf(a2 - mx), e3 = __expf(a3 - mx), inv = 1.0f / (e0 + e1 + e2 + e3);
        LBS[i] = 0.f; LBS[512 + i] = e1 * inv; LBS[1024 + i] = (e1 + e2) * inv; LBS[1536 + i] = (e1 + e2 + e3) * inv;
    }
}

__global__ void __launch_bounds__(NTHREADS, 2) fwd_kernel(Args A_unused) {
    extern __shared__ __attribute__((aligned(16))) unsigned char lds_raw[];
    LAS unsigned char* lds = (LAS unsigned char*)lds_raw;
    cg::grid_group grid = cg::this_grid();
    int ph = 0;
    int lo, hi; { const unsigned long long w = KA(27); lo = (int)(unsigned)w; hi = (int)(unsigned)(w >> 32); }
#define RUN (ph >= lo && ph < hi)
#define SEAM do { if (ph >= lo && ph + 1 < hi) grid.sync(); ++ph; } while (0)
#define WSP(T_, name, off) T_* name = (T_*)(ws + (off))

    if (RUN) { prep_phase(); }
    ++ph;
    for (int l = 0; l < DEPTH; ++l) {
#ifndef SKIP_CONV
        if (RUN) { conv_layer(l, lds); __syncthreads(); }
#endif
        SEAM;
#ifndef SKIP_G1
        if (RUN) { unsigned char* ws = KWS; EpiSwiglu E{(bf16*)(ws + WS_H), (const float*)(ws + WS_SSQ)}; run_gemm(lds, (const bf16*)(ws + WS_XB), (const bf16*)(ws + WT_W1IN), T, 5632, 1024, 0, E); }
#endif
        SEAM;
#ifndef SKIP_G2
        if (RUN) { unsigned char* ws = KWS; EpiResid E{KOUT, (bf16*)(ws + WS_XB), (float*)(ws + WS_SSQ), 0.5f}; run_gemm(lds, (const bf16*)(ws + WS_H), (const bf16*)(ws + WT_W1OUT), T, 1024, DFF, 0, E); }
#endif
        SEAM;
#ifndef SKIP_WIN
        if (RUN) { unsigned char* ws = KWS;
            EpiWin E{(const float*)(ws + WS_SSQ), (const float*)(ws + WS_LBS) + l * 512, (const float*)(ws + WS_COS), (const float*)(ws + WS_SIN),
                     (bf16*)(ws + WS_CQ), (bf16*)(ws + WS_CKV), (bf16*)(ws + WS_KC), (bf16*)(ws + WS_HQ), (bf16*)(ws + WS_HK), (bf16*)(ws + WS_HV), (bf16*)(ws + WS_HGT), (bf16*)(ws + WS_MQ), (bf16*)(ws + WS_GATES),
                     (float*)(ws + WS_GG), (float*)(ws + WS_SSQQ), (float*)(ws + WS_SSQKV)};
            run_gemm(lds, (const bf16*)(ws + WS_XB), (const bf16*)(ws + WT_WIN), T, NIN, 1024, 0, E); }
#endif
        SEAM;
        if (RUN) {
#ifndef SKIP_G4
            { unsigned char* ws = KWS; EpiQ E{(bf16*)(ws + WS_Q)}; run_gemm(lds, (const bf16*)(ws + WS_CQ), (const bf16*)(ws + WT_WUQ), T, 768, 384, 0, E); }
            { unsigned char* ws = KWS; EpiKV E{(bf16*)(ws + WS_KC), (bf16*)(ws + WS_VT), (const float*)(ws + WS_SSQKV)}; run_gemm(lds, (const bf16*)(ws + WS_CKV), (const bf16*)(ws + WT_WUKV), T, 1024, 256, 64, E); }
            { unsigned char* ws = KWS; EpiMemKV E{(bf16*)(ws + WS_MK), (bf16*)(ws + WS_MVT), (const float*)(ws + WS_MEMRSTD)}; run_gemm(lds, (const bf16*)(ws + WS_MEMB), (const bf16*)(ws + WT_WMEMKV), 1024, 1024, 1024, 192, E); }
#endif
#ifndef SKIP_B1
            { unsigned char* ws = KWS; const int G = (int)gridDim.x;
              for (int ch = (int)blockIdx.x; ch < 1024; ch += G) hgrn_b1(lds, ch, (float*)(ws + WS_GG), (const bf16*)(ws + WS_HK), (const bf16*)(ws + WS_HV), (float*)(ws + WS_LT), (float*)(ws + WS_DEC)); }
#endif
        }
        SEAM;
        if (RUN) {
            unsigned char* ws = KWS; int tid_o = threadIdx.x; asm volatile("" : "+v"(tid_o)); const int G = (int)gridDim.x, bid = (int)blockIdx.x, tid = tid_o;
#ifndef SKIP_MLA
            for (int it = bid; it < 256; it += G) {
                const int bh = it >> 3, pr = it & 7, b = bh >> 3, hd = bh & 7;
#pragma unroll 1
                for (int half = 0; half < 2; ++half) {
                    const int qb = half == 0 ? 15 - pr : pr;
                    const size_t row0 = (size_t)b * SEQ + qb * 256;
                    attn_item<96, 64, true>(lds, (const bf16*)(ws + WS_Q) + row0 * 768 + hd * 96, 768, (const bf16*)(ws + WS_KC) + (size_t)bh * SEQ * 96, (const bf16*)(ws + WS_VT) + (size_t)bh * 64 * SEQ, SEQ,
                                            (bf16*)(ws + WS_AO) + row0 * 512 + hd * 64, 512, qb * 256, SEQ, (const float*)(ws + WS_SSQQ) + row0 * 16, (const float*)(ws + WS_COS) + row0 * 16, (const float*)(ws + WS_SIN) + row0 * 16);
                }
            }
#endif
            float* LT = (float*)(ws + WS_LT); const float* DEC = (const float*)(ws + WS_DEC);
            for (int gt = bid * NTHREADS + tid; gt < 16 * 16384; gt += G * NTHREADS) {
                const int bh = gt >> 14, e = gt & 16383, k = e & 127;
                float* lp = LT + (size_t)bh * 64 * 16384 + e; const float* dp = DEC + (size_t)bh * 64 * 128 + k;
                float run = 0.f;
#pragma unroll 8
                for (int c = 0; c < 64; ++c) { const float tmp = lp[(size_t)c * 16384], d = dp[c * 128]; lp[(size_t)c * 16384] = run; run = d * run + tmp; }
            }
        }
        SEAM;
        if (RUN) {
            unsigned char* ws = KWS; const int G = (int)gridDim.x, bid = (int)blockIdx.x;
#ifndef SKIP_XATT
            for (int it = bid; it < 256; it += G) {
                const int b = it >> 6, hd = (it >> 4) & 3, qb = it & 15;
                const size_t row0 = (size_t)b * SEQ + qb * 256;
                attn_item<128, 128, false>(lds, (const bf16*)(ws + WS_MQ) + row0 * 512 + hd * 128, 512, (const bf16*)(ws + WS_MK) + (size_t)(b * 4 + hd) * 256 * 128, (const bf16*)(ws + WS_MVT) + (size_t)(b * 4 + hd) * 128 * 256, 256,
                                           (bf16*)(ws + WS_MO) + row0 * 512 + hd * 128, 512, 0, 256, nullptr, nullptr, nullptr);
            }
#endif
#ifndef SKIP_B3
            const float* onorm = KIN(15) + l * 128;
            for (int ch = bid; ch < 1024; ch += G) hgrn_b3(lds, ch, (const float*)(ws + WS_GG), (const bf16*)(ws + WS_HQ), (const bf16*)(ws + WS_HK), (const bf16*)(ws + WS_HV), (const bf16*)(ws + WS_HGT), (const float*)(ws + WS_LT), onorm, (bf16*)(ws + WS_HO));
#endif
        }
        SEAM;
#ifndef SKIP_G7
        if (RUN) {
            { unsigned char* ws = KWS; EpiBranch E{(bf16*)(ws + WS_MERGED), (const bf16*)(ws + WS_GATES), 1}; run_gemm(lds, (const bf16*)(ws + WS_AO), (const bf16*)(ws + WT_WOMLA), T, 1024, 512, 0, E); }
            { unsigned char* ws = KWS; EpiBranch E{(bf16*)(ws + WS_MERGED), (const bf16*)(ws + WS_GATES) + (size_t)T * 1024, 0}; run_gemm(lds, (const bf16*)(ws + WS_HO), (const bf16*)(ws + WT_WOHG), T, 1024, 512, 0, E); }
            { unsigned char* ws = KWS; EpiBranch E{(bf16*)(ws + WS_MERGED), (const bf16*)(ws + WS_GATES) + (size_t)2 * T * 1024, 0}; run_gemm(lds, (const bf16*)(ws + WS_MO), (const bf16*)(ws + WT_WOMEM), T, 1024, 512, 0, E); }
        }
#endif
        SEAM;
#ifndef SKIP_G8
        if (RUN) { unsigned char* ws = KWS; EpiResid E{KOUT, (bf16*)(ws + WS_XB), (float*)(ws + WS_SSQ), 1.0f}; run_gemm(lds, (const bf16*)(ws + WS_MERGED), (const bf16*)(ws + WT_WOUT), T, 1024, 1024, 0, E); }
#endif
        SEAM;
#ifndef SKIP_G9
        if (RUN) { unsigned char* ws = KWS; EpiSwiglu E{(bf16*)(ws + WS_H), (const float*)(ws + WS_SSQ)}; run_gemm(lds, (const bf16*)(ws + WS_XB), (const bf16*)(ws + WT_W2IN), T, 5632, 1024, 0, E); }
#endif
        SEAM;
#ifndef SKIP_G10
        if (RUN) { unsigned char* ws = KWS; EpiResid E{KOUT, (bf16*)(ws + WS_XB), (float*)(ws + WS_SSQ), 0.5f}; run_gemm(lds, (const bf16*)(ws + WS_H), (const bf16*)(ws + WT_W2OUT), T, 1024, DFF, 0, E); }
#endif
        SEAM;
    }
    if (RUN) {
        unsigned char* ws = KWS; float* X = KOUT; const float* SSQ = (const float*)(ws + WS_SSQ);
        int tid_o = threadIdx.x; asm volatile("" : "+v"(tid_o)); const int tid = tid_o, wave = __builtin_amdgcn_readfirstlane(tid >> 6), lane = tid & 63, G = (int)gridDim.x;
        const float* fg = KIN(24);
        for (int m = (int)blockIdx.x * NWAVES + wave; m < T; m += G * NWAVES) {
            const float rs = rsqrtf(sum16(SSQ + (size_t)m * 16) * (1.0f / 1024.0f) + EPS);
            f32x4* xr = (f32x4*)(X + (size_t)m * D) + lane; const f32x4* gr = (const f32x4*)fg + lane;
#pragma unroll
            for (int j = 0; j < 4; ++j) { f32x4 v = xr[64 * j]; const f32x4 g = gr[64 * j]; v = v * rs * g; xr[64 * j] = v; }
        }
    }
#undef RUN
#undef SEAM
}

constexpr int N_PHASES = 1 + DEPTH * 11 + 1;

extern "C" void kernel_launch(void* const* d_in, const int* in_sizes, int n_in, void* d_out, int out_size, void* d_ws, size_t ws_size, hipStream_t stream) {
    static int grid = 0;
    if (grid == 0) {
        if (n_in != 25 || out_size != T * D || ws_size < WS_END) { fprintf(stderr, "kernel_launch: unexpected shapes (n_in %d out %d ws %zu need %zu)\n", n_in, out_size, ws_size, (size_t)WS_END); grid = -1; return; }
        int dev = 0, cus = 0, per_cu = 0;
        hipGetDevice(&dev);
        hipDeviceGetAttribute(&cus, hipDeviceAttributeMultiprocessorCount, dev);
        if (hipFuncSetAttribute((const void*)fwd_kernel, hipFuncAttributeMaxDynamicSharedMemorySize, LDS_BYTES) != hipSuccess) { fprintf(stderr, "kernel_launch: hipFuncSetAttribute failed\n"); grid = -1; return; }
        if (hipOccupancyMaxActiveBlocksPerMultiprocessor(&per_cu, (const void*)fwd_kernel, NTHREADS, LDS_BYTES) != hipSuccess || per_cu < 1) { fprintf(stderr, "kernel_launch: occupancy query says %d\n", per_cu); per_cu = 1; }
        (void)hipGetLastError();
        grid = cus * 1;
        if (grid <= 0) grid = 256;
    }
    if (grid < 0) return;
    Args a{};
    for (int i = 0; i < 25; ++i) a.in[i] = d_in[i];
    a.out = (float*)d_out; a.ws = (unsigned char*)d_ws; a.ph_lo = 0; a.ph_hi = N_PHASES;
    void* args[] = {&a};
    hipError_t e = hipLaunchCooperativeKernel((const void*)fwd_kernel, dim3(grid), dim3(NTHREADS), args, LDS_BYTES, stream);
    if (e != hipSuccess) fprintf(stderr, "cooperative launch failed: %s (grid %d)\n", hipGetErrorString(e), grid);
}
```

```cpp
#include <hip/hip_runtime.h>
#include <hip/hip_cooperative_groups.h>
#include <cstdio>
#include <cstdint>
namespace cg = cooperative_groups;
#define DI __device__ __forceinline__
namespace pg8 {
#define PG8_LAS __attribute__((address_space(3)))
typedef unsigned short bf16_t;
typedef short bf16x8 __attribute__((ext_vector_type(8)));
typedef float f32x4 __attribute__((ext_vector_type(4)));
typedef unsigned u32x4 __attribute__((ext_vector_type(4)));
constexpr int BM = 256, BK = 64, HALF = 128, HTB = HALF * BK * 2  , STAGE_BYTES = 8 * HTB, NXCD = 8, WGM = 8;

__host__ __device__ __forceinline__ int lds_byte(int r, int c) { const int st = (r >> 4) * 2 + (c >> 5), rr = r & 15, cc = c & 31, ob = rr * 64 + cc * 2; return st * 1024 + (ob ^ (((ob >> 9) & 1) << 5)); }
__host__ __device__ __forceinline__ void stage_rc(int b, int& R, int& C) { const int st = b / 1024, sb = b % 1024, swz = sb ^ (((sb >> 9) & 1) << 5); R = (st >> 1) * 16 + swz / 64; C = (st & 1) * 32 + (swz % 64) / 2; }
__host__ __device__ __forceinline__ int perm32(int rho) { const int n = rho >> 4, i = rho & 15; return 8 * (i >> 2) + 4 * n + (i & 3); }

struct Unit { int pm, pn; };
struct Gemm { const bf16_t* A; const bf16_t* Bt; int M, N, K; };

struct StaticOrder {
    int nM, nN, nwg, G, c;
    __host__ __device__ void init(int M, int N, int G_, int c_) { nM = M / BM; nN = N / BM; nwg = nM * nN; G = G_; c = c_; }
    __host__ __device__ bool next(int i, Unit& u) const {
        const long L = (long)i * G + c; if (L >= nwg) return false;
        int wgid = (int)L; { const int q = nwg / NXCD, r = nwg % NXCD, xcd = wgid % NXCD, off = wgid / NXCD; wgid = (xcd < r ? xcd * (q + 1) : r * (q + 1) + (xcd - r) * q) + off; }
        const int nig = WGM * nN, gid = wgid / nig, fm = gid * WGM, gsz = (nM - fm) < WGM ? (nM - fm) : WGM;
        u.pm = fm + ((wgid % nig) % gsz); u.pn = (wgid % nig) / gsz; return true;
    }
    __device__ __forceinline__ void a_ready(const Unit&) const {}
    __device__ __forceinline__ void done(const Unit&) const {}
};
template <class Epi, class Sched, bool ALIGN_EPI = false, bool SP2 = false>
__device__ __forceinline__ void gemm_phase(PG8_LAS unsigned char* lds, const Gemm g, const Sched& S, const Epi& E) {
    int tid_o = threadIdx.x; asm volatile("" : "+v"(tid_o));
    const int tid = tid_o, wid = __builtin_amdgcn_readfirstlane(tid >> 6), lane = tid & 63, wr = wid >> 2, wc = wid & 3, fr = lane & 15, fq = lane >> 4;
    const int K = g.K, nt = K / BK;
    unsigned voffA[2], voffB[2];
#pragma unroll
    for (int i = 0; i < 2; ++i) { int R, C; stage_rc(tid * 16 + i * 8192, R, C); const int Rb = Epi::PERM ? ((R & ~31) + perm32(R & 31)) : R;
        voffA[i] = (unsigned)(R * K + C) * 2u; voffB[i] = (unsigned)(Rb * K + C) * 2u; }
    const size_t kstep = (size_t)(BK * 2);
    const size_t hstep = (size_t)HALF * K * 2;
    const size_t tstep = 2 * hstep;
    const unsigned ldsw = (unsigned)wid * 1024u;
    const int aoff = lds_byte(wr * 64 + fr, fq * 8), boff = lds_byte(wc * 32 + fr, fq * 8);
#define PG8_SA(b, h) (((b) * 2 + (h)) * HTB)
#define PG8_SB(b, h) ((4 + (b) * 2 + (h)) * HTB)
#define PG8_STAGE(bufoff, gbase, voff) do { _Pragma("unroll") for (int _i = 0; _i < 2; ++_i) \
        __builtin_amdgcn_global_load_lds((const unsigned*)((const char*)(gbase) + (voff)[_i]), (PG8_LAS unsigned*)(lds + (bufoff) + ldsw + _i * 8192), 16, 0, 0); } while (0)
#define PG8_LDA(dst, b, h) do { _Pragma("unroll") for (int m = 0; m < 4; ++m) _Pragma("unroll") for (int k = 0; k < 2; ++k) dst[m][k] = *(const PG8_LAS bf16x8*)(lds + PG8_SA(b, h) + aoff + m * 2048 + k * 1024); } while (0)
#define PG8_LDB(dst, b, h) do { _Pragma("unroll") for (int n = 0; n < 2; ++n) _Pragma("unroll") for (int k = 0; k < 2; ++k) dst[n][k] = *(const PG8_LAS bf16x8*)(lds + PG8_SB(b, h) + boff + n * 2048 + k * 1024); } while (0)
#define PG8_MMA(ai, bj, At, Bt) do { __builtin_amdgcn_s_setprio(1); _Pragma("unroll") for (int m = 0; m < 4; ++m) _Pragma("unroll") for (int n = 0; n < 2; ++n) _Pragma("unroll") for (int k = 0; k < 2; ++k) \
        acc[ai][bj][m][n] = __builtin_amdgcn_mfma_f32_16x16x32_bf16(Bt[n][k], At[m][k], acc[ai][bj][m][n], 0, 0, 0); __builtin_amdgcn_s_setprio(0); } while (0)
#define PG8_WAIT_V(n) asm volatile("s_waitcnt vmcnt(" #n ")" ::: "memory")
#define PG8_WAIT_L(n) asm volatile("s_waitcnt lgkmcnt(" #n ")" ::: "memory")
#define PG8_BAR __builtin_amdgcn_s_barrier()
#define PG8_SCHED __builtin_amdgcn_sched_barrier(0)
    Unit cur, nxt; int ui = 0;
    if (!S.next(0, cur)) return;
    f32x4 acc[2][2][4][2];
#pragma unroll
    for (int a = 0; a < 2; ++a)
#pragma unroll
        for (int b = 0; b < 2; ++b)
#pragma unroll
            for (int m = 0; m < 4; ++m)
#pragma unroll
                for (int n = 0; n < 2; ++n) acc[a][b][m][n] = (f32x4){0.f, 0.f, 0.f, 0.f};
    bf16x8 At[4][2], B0[2][2], B1[2][2];
    const char* cA = (const char*)g.A + (size_t)cur.pm * tstep; const char* cB = (const char*)g.Bt + (size_t)cur.pn * tstep;
    S.a_ready(cur);
    if constexpr (SP2) {
        PG8_STAGE(PG8_SB(0, 0), cB, voffB); PG8_STAGE(PG8_SB(0, 1), cB + hstep, voffB); PG8_STAGE(PG8_SA(0, 0), cA, voffA); PG8_STAGE(PG8_SA(0, 1), cA + hstep, voffA);
        if (wr == 1) PG8_BAR;
        PG8_WAIT_V(2); PG8_BAR;
        PG8_STAGE(PG8_SB(1, 0), cB + kstep, voffB); PG8_STAGE(PG8_SA(1, 0), cA + kstep, voffA); PG8_STAGE(PG8_SB(1, 1), cB + hstep + kstep, voffB);
        PG8_WAIT_V(6); PG8_BAR;
    } else {
        PG8_STAGE(PG8_SB(0, 0), cB, voffB); PG8_STAGE(PG8_SA(0, 0), cA, voffA); PG8_STAGE(PG8_SB(0, 1), cB + hstep, voffB); PG8_STAGE(PG8_SA(0, 1), cA + hstep, voffA);
        if (wr == 1) PG8_BAR;
        PG8_WAIT_V(4); PG8_BAR;
        PG8_STAGE(PG8_SB(1, 0), cB + kstep, voffB); PG8_STAGE(PG8_SA(1, 0), cA + kstep, voffA); PG8_STAGE(PG8_SB(1, 1), cB + hstep + kstep, voffB);
        PG8_WAIT_V(6); PG8_BAR;
    }
    for (;;) {
        const bool has_next = S.next(ui + 1, nxt);
        const char* nA = has_next ? (const char*)g.A + (size_t)nxt.pm * tstep : cA; const char* nB = has_next ? (const char*)g.Bt + (size_t)nxt.pn * tstep : cB;
        for (int t = 0; t < nt; t += 2) {
            const bool last = (t == nt - 2);
            const char* a1 = cA + (size_t)(t + 1) * kstep;
            const char* a2 = last ? nA : cA + (size_t)(t + 2) * kstep; const char* b2 = last ? nB : cB + (size_t)(t + 2) * kstep;
            const char* a3 = a2 + kstep; const char* b3 = b2 + kstep;
            if (last && has_next) S.a_ready(nxt);
            if constexpr (SP2) {
            PG8_LDB(B0, 0, 0); PG8_LDB(B1, 0, 1); PG8_SCHED; PG8_LDA(At, 0, 0); PG8_STAGE(PG8_SA(1, 1), a1 + hstep, voffA);
            PG8_WAIT_V(8); PG8_WAIT_L(0); PG8_BAR; PG8_MMA(0, 0, At, B0); PG8_MMA(0, 1, At, B1); PG8_BAR; PG8_SCHED;
            PG8_LDA(At, 0, 1); PG8_STAGE(PG8_SB(0, 0), b2, voffB); PG8_STAGE(PG8_SB(0, 1), b2 + hstep, voffB); PG8_STAGE(PG8_SA(0, 0), a2, voffA);
            PG8_WAIT_V(8); PG8_WAIT_L(0); PG8_BAR; PG8_MMA(1, 0, At, B0); PG8_MMA(1, 1, At, B1); PG8_BAR; PG8_SCHED;
            PG8_LDB(B0, 1, 0); PG8_LDB(B1, 1, 1); PG8_SCHED; PG8_LDA(At, 1, 0); PG8_STAGE(PG8_SA(0, 1), a2 + hstep, voffA);
            PG8_WAIT_V(8); PG8_WAIT_L(0); PG8_BAR; PG8_MMA(0, 0, At, B0); PG8_MMA(0, 1, At, B1); PG8_BAR; PG8_SCHED;
            PG8_LDA(At, 1, 1); PG8_STAGE(PG8_SB(1, 0), b3, voffB); PG8_STAGE(PG8_SB(1, 1), b3 + hstep, voffB); PG8_STAGE(PG8_SA(1, 0), a3, voffA);
            PG8_WAIT_V(8); PG8_WAIT_L(0); PG8_BAR; PG8_MMA(1, 0, At, B0); PG8_MMA(1, 1, At, B1); PG8_BAR; PG8_SCHED;
            } else {
            PG8_LDB(B0, 0, 0); PG8_SCHED; PG8_LDA(At, 0, 0); PG8_STAGE(PG8_SA(1, 1), a1 + hstep, voffA);
            PG8_WAIT_L(8); PG8_BAR; PG8_WAIT_L(0); PG8_MMA(0, 0, At, B0); PG8_BAR; PG8_SCHED;
            PG8_LDB(B1, 0, 1); PG8_STAGE(PG8_SB(0, 0), b2, voffB);
            PG8_BAR; PG8_WAIT_L(0); PG8_MMA(0, 1, At, B1); PG8_BAR;
            PG8_LDA(At, 0, 1); PG8_STAGE(PG8_SA(0, 0), a2, voffA);
            PG8_BAR; PG8_WAIT_L(0); PG8_MMA(1, 0, At, B0); PG8_BAR; PG8_SCHED;
            PG8_STAGE(PG8_SB(0, 1), b2 + hstep, voffB);
            PG8_WAIT_V(6); PG8_BAR; PG8_MMA(1, 1, At, B1); PG8_BAR;
            PG8_LDB(B0, 1, 0); PG8_SCHED; PG8_LDA(At, 1, 0); PG8_STAGE(PG8_SA(0, 1), a2 + hstep, voffA);
            PG8_WAIT_L(8); PG8_BAR; PG8_WAIT_L(0); PG8_MMA(0, 0, At, B0); PG8_BAR; PG8_SCHED;
            PG8_LDB(B1, 1, 1); PG8_STAGE(PG8_SB(1, 0), b3, voffB);
            PG8_BAR; PG8_WAIT_L(0); PG8_MMA(0, 1, At, B1); PG8_BAR;
            PG8_LDA(At, 1, 1); PG8_STAGE(PG8_SA(1, 0), a3, voffA);
            PG8_BAR; PG8_WAIT_L(0); PG8_MMA(1, 0, At, B0); PG8_BAR; PG8_SCHED;
            PG8_STAGE(PG8_SB(1, 1), b3 + hstep, voffB);
            PG8_WAIT_V(6); PG8_BAR; PG8_MMA(1, 1, At, B1); PG8_BAR;
            }
        }
        if constexpr (ALIGN_EPI) { if (wr == 0) PG8_BAR; }
        if constexpr (!Epi::AFTER_DRAIN) { E(acc, cur, wr, wc, fr, fq); S.done(cur); }
        if (!has_next) break;
#pragma unroll
        for (int a = 0; a < 2; ++a)
#pragma unroll
            for (int b = 0; b < 2; ++b)
#pragma unroll
                for (int m = 0; m < 4; ++m)
#pragma unroll
                    for (int n = 0; n < 2; ++n) acc[a][b][m][n] = (f32x4){0.f, 0.f, 0.f, 0.f};
        cur = nxt; cA = nA; cB = nB; ++ui;
        if constexpr (ALIGN_EPI) { if (wr == 1) PG8_BAR; }
    }
    PG8_WAIT_V(0);
    if constexpr (!ALIGN_EPI) { if (wr == 0) PG8_BAR; }
    PG8_BAR;
    if constexpr (Epi::AFTER_DRAIN) { E.fused(acc, cur, wr, wc, fr, fq, lds, wid, lane); S.done(cur); }
#undef PG8_SA
#undef PG8_SB
#undef PG8_STAGE
#undef PG8_LDA
#undef PG8_LDB
#undef PG8_MMA
#undef PG8_WAIT_V
#undef PG8_WAIT_L
#undef PG8_BAR
#undef PG8_SCHED
}
}

typedef unsigned short bf16;
#define LAS __attribute__((address_space(3)))
#define GAS __attribute__((address_space(1)))
typedef float f32x4 __attribute__((ext_vector_type(4)));
typedef float f32x16 __attribute__((ext_vector_type(16)));
typedef float f32x2_t __attribute__((ext_vector_type(2)));
typedef __bf16 bf16x2_t __attribute__((ext_vector_type(2)));
typedef short bf16x8 __attribute__((ext_vector_type(8)));
typedef short s16x4 __attribute__((ext_vector_type(4)));
typedef unsigned u32x4 __attribute__((ext_vector_type(4)));
typedef unsigned u32x2 __attribute__((ext_vector_type(2)));

constexpr int T = 16384, D = 1024, SEQ = 4096, NBATCH = 4, DFF = 2816, DEPTH = 4, NIN = 6400, DIN = 6304;
constexpr int NTHREADS = 512, NWAVES = 8;
constexpr float EPS = 1e-6f;
constexpr float QSCALE_MLA = 0.14724498f;
constexpr float QSCALE_MEM = 0.12751743f;

constexpr size_t MiB = 1u << 20;
constexpr size_t WT_W1IN = 0;
constexpr size_t WT_W1OUT = WT_W1IN + (size_t)5632 * 1024 * 2;
constexpr size_t WT_WIN = WT_W1OUT + (size_t)1024 * 2816 * 2;
constexpr size_t WT_WUQ = WT_WIN + (size_t)NIN * 1024 * 2;
constexpr size_t WT_WUKV = WT_WUQ + (size_t)768 * 384 * 2;
constexpr size_t WT_WOMLA = WT_WUKV + (size_t)1024 * 256 * 2;
constexpr size_t WT_WOHG = WT_WOMLA + (size_t)1024 * 512 * 2;
constexpr size_t WT_WOMEM = WT_WOHG + (size_t)1024 * 512 * 2;
constexpr size_t WT_WMEMKV = WT_WOMEM + (size_t)1024 * 512 * 2;
constexpr size_t WT_WOUT = WT_WMEMKV + (size_t)1024 * 1024 * 2;
constexpr size_t WT_W2IN = WT_WOUT + (size_t)1024 * 1024 * 2;
constexpr size_t WT_W2OUT = WT_W2IN + (size_t)5632 * 1024 * 2;
constexpr size_t WT_END = WT_W2OUT + (size_t)1024 * 2816 * 2;
static_assert(WT_END <= 54 * MiB, "weights");
constexpr size_t WS_XB = 54 * MiB;
constexpr size_t WS_SSQ = WS_XB + 32 * MiB;
constexpr size_t WS_SSQQ = WS_SSQ + 1 * MiB;
constexpr size_t WS_SSQKV = WS_SSQQ + 1 * MiB;
constexpr size_t WS_COS = WS_SSQKV + 1 * MiB;
constexpr size_t WS_SIN = WS_COS + 1 * MiB;
constexpr size_t WS_LBS = WS_SIN + 1 * MiB;
constexpr size_t WS_MEMB = WS_LBS + 65536;
constexpr size_t WS_MEMRSTD = WS_MEMB + 2 * MiB;
constexpr size_t WS_MK = WS_MEMRSTD + 65536;
constexpr size_t WS_MVT = WS_MK + 1 * MiB;
constexpr size_t WS_DEC = WS_MVT + 1 * MiB;
constexpr size_t WS_MIX = WS_DEC + 1 * MiB;
constexpr size_t WS_CQ = WS_MIX;
constexpr size_t WS_CKV = WS_CQ + 12 * MiB;
constexpr size_t WS_KR = WS_CKV + 8 * MiB;
constexpr size_t WS_HQ = WS_KR + 1 * MiB;
constexpr size_t WS_GG = WS_HQ + 16 * MiB;
constexpr size_t WS_HK = WS_GG + 32 * MiB;
constexpr size_t WS_HV = WS_HK + 16 * MiB;
constexpr size_t WS_HGT = WS_HV + 16 * MiB;
constexpr size_t WS_MQ = WS_HGT + 16 * MiB;
constexpr size_t WS_GATES = WS_MQ + 16 * MiB;
constexpr size_t WS_Q = WS_GATES + 96 * MiB;
constexpr size_t WS_KC = WS_Q + 24 * MiB;
constexpr size_t WS_VT = WS_KC + 24 * MiB;
constexpr size_t WS_LT = WS_VT + 16 * MiB;
constexpr size_t WS_AO = WS_LT + 64 * MiB;
constexpr size_t WS_CTL = WS_AO + 16 * MiB;
constexpr size_t CTL_BYTES = 16384;
constexpr size_t WS_END = WS_CTL + 65536;
constexpr size_t WS_HO = WS_CQ;
constexpr size_t WS_MERGED = WS_GG;
constexpr size_t WS_MO = WS_Q;
constexpr size_t WS_H = WS_MIX;
static_assert(WS_H + (size_t)T * DFF * 2 <= WS_END, "h overlay");

constexpr int LDS_BYTES = 147456;
#ifndef REP_CONV
#define REP_CONV 1
#endif
#ifndef REP_P1
#define REP_P1 1
#endif
#ifndef REP_P3
#define REP_P3 1
#endif
#ifndef REP_MLA
#define REP_MLA 1
#endif
#ifndef REP_P6
#define REP_P6 1
#endif

DI unsigned pk2(float lo, float hi) { f32x2_t v = {lo, hi}; bf16x2_t b = __builtin_convertvector(v, bf16x2_t); return __builtin_bit_cast(unsigned, b); }
DI u32x4 pk8(const float* v) { u32x4 w; w.x = pk2(v[0], v[1]); w.y = pk2(v[2], v[3]); w.z = pk2(v[4], v[5]); w.w = pk2(v[6], v[7]); return w; }
DI float bflo(unsigned w) { return __uint_as_float(w << 16); }
DI float bfhi(unsigned w) { return __uint_as_float(w & 0xffff0000u); }
DI void unpk8(u32x4 w, float* v) { v[0] = bflo(w.x); v[1] = bfhi(w.x); v[2] = bflo(w.y); v[3] = bfhi(w.y); v[4] = bflo(w.z); v[5] = bfhi(w.z); v[6] = bflo(w.w); v[7] = bfhi(w.w); }
DI float bf2f(bf16 b) { return __uint_as_float(((unsigned)b) << 16); }
DI bf16 f2bf(float f) { return (bf16)(pk2(f, 0.f) & 0xffffu); }
DI float sigmoidf_(float z) { return __builtin_amdgcn_rcpf(1.0f + __expf(-z)); }
DI float wave_sum(float v) {
#pragma unroll
    for (int o = 1; o < 64; o <<= 1) v += __shfl_xor(v, o);
    return v;
}
DI float rowsum_q(const float* p, int fq, int nq) {
    float s = 0.f;
    if (fq < nq) { const f32x4 a = *(const f32x4*)(p + 4 * fq); s = (a.x + a.y) + (a.z + a.w); }
    s += __shfl_xor(s, 16); s += __shfl_xor(s, 32);
    return s;
}
DI void rstd8(const float* ssq, int stride, int nq, float inv_n, float post, int rowb, int fq, float (&rs)[8]) {
    f32x4 q[8];
#pragma unroll
    for (int i = 0; i < 8; ++i) q[i] = *(const f32x4*)(ssq + (size_t)(rowb + (i >> 2) * 128 + (i & 3) * 16) * stride + 4 * fq);
    const float keep = fq < nq ? 1.0f : 0.0f;
#pragma unroll
    for (int i = 0; i < 8; ++i) { float t = ((q[i].x + q[i].y) + (q[i].z + q[i].w)) * keep; t += __shfl_xor(t, 16); t += __shfl_xor(t, 32); rs[i] = __builtin_amdgcn_rsqf(t * inv_n + EPS) * post; }
}
DI float sum16(const float* p) {
    const f32x4 a = *(const f32x4*)p, b = *(const f32x4*)(p + 4), c = *(const f32x4*)(p + 8), d = *(const f32x4*)(p + 12);
    return ((a.x + a.y) + (a.z + a.w)) + ((b.x + b.y) + (b.z + b.w)) + ((c.x + c.y) + (c.z + c.w)) + ((d.x + d.y) + (d.z + d.w));
}

using pg8::Unit;
#define EPI_ARGS const f32x4 (&acc)[2][2][4][2], const Unit& u, int wr, int wc, int fr_in, int fq_in
#define EPI_OPAQUE int fr = fr_in, fq = fq_in; asm volatile("" : "+v"(fr), "+v"(fq));

struct EpiSwiglu {
    static constexpr bool PERM = true, AFTER_DRAIN = false;
    bf16* H; const float* ssq;
    DI void operator()(EPI_ARGS) const {
        EPI_OPAQUE
        const int rowb = u.pm * 256 + wr * 64 + fr;
        float rs[8]; rstd8(ssq, 16, 4, 1.0f / 1024.0f, 1.0f, rowb, fq, rs);
#pragma unroll
        for (int ai = 0; ai < 2; ++ai)
#pragma unroll
            for (int m = 0; m < 4; ++m) {
                const int row = rowb + ai * 128 + m * 16;
                const float r1 = rs[ai * 4 + m];
                float o[8];
#pragma unroll
                for (int n = 0; n < 2; ++n)
#pragma unroll
                    for (int j = 0; j < 4; ++j) { const float a = acc[ai][0][m][n][j] * r1, b = acc[ai][1][m][n][j] * r1; o[4 * n + j] = a * b * __builtin_amdgcn_rcpf(1.0f + __expf(-a)); }
                *(u32x4*)(H + (size_t)row * DFF + u.pn * 128 + 32 * wc + 8 * fq) = pk8(o);
            }
    }
};

struct EpiResid {
    static constexpr bool PERM = true, AFTER_DRAIN = false;
    float* X; bf16* XB; float* ssq; float scale;
    DI void operator()(EPI_ARGS) const {
        EPI_OPAQUE
        const int rowb = u.pm * 256 + wr * 64 + fr, colb = u.pn * 256 + 32 * wc + 8 * fq;
#pragma unroll
        for (int ai = 0; ai < 2; ++ai) {
            f32x4 xv[4][2][2];
#pragma unroll
            for (int m = 0; m < 4; ++m)
#pragma unroll
                for (int bj = 0; bj < 2; ++bj) { const float* xp = X + (size_t)(rowb + ai * 128 + m * 16) * D + colb + 128 * bj; xv[m][bj][0] = *(const f32x4*)xp; xv[m][bj][1] = *(const f32x4*)(xp + 4); }
#pragma unroll
            for (int m = 0; m < 4; ++m) {
                const int row = rowb + ai * 128 + m * 16;
                float ss = 0.f;
#pragma unroll
                for (int bj = 0; bj < 2; ++bj) {
                    const size_t off = (size_t)row * D + colb + 128 * bj;
                    const f32x4 x0 = xv[m][bj][0] + scale * acc[ai][bj][m][0], x1 = xv[m][bj][1] + scale * acc[ai][bj][m][1];
                    *(f32x4*)(X + off) = x0; *(f32x4*)(X + off + 4) = x1;
                    float o[8] = {x0.x, x0.y, x0.z, x0.w, x1.x, x1.y, x1.z, x1.w};
                    *(u32x4*)(XB + off) = pk8(o);
#pragma unroll
                    for (int e = 0; e < 8; ++e) ss += o[e] * o[e];
                }
                ss += __shfl_xor(ss, 16); ss += __shfl_xor(ss, 32);
                if (fq == 0) ssq[(size_t)row * 16 + u.pn * 4 + wc] = ss;
            }
        }
    }
};

struct EpiWin {
    static constexpr bool PERM = true, AFTER_DRAIN = false;
    const float* ssq; const float* lbs  ; const float* cosT; const float* sinT;
    bf16 *CQ, *CKV, *KC, *HQ, *HK, *HV, *HGT, *MQ, *GATES; float *GG, *SSQQ, *SSQKV;
    DI void operator()(EPI_ARGS) const {
        EPI_OPAQUE
        const int rowb = u.pm * 256 + wr * 64 + fr;
        float rs8[8]; rstd8(ssq, 16, 4, 1.0f / 1024.0f, 1.0f, rowb, fq, rs8);
#pragma unroll
        for (int ai = 0; ai < 2; ++ai)
#pragma unroll
            for (int m = 0; m < 4; ++m) {
                const int row = rowb + ai * 128 + m * 16;
                const float rs = rs8[ai * 4 + m];
#pragma unroll
                for (int bj = 0; bj < 2; ++bj) {
                    const int hh = 2 * u.pn + bj, cw = 32 * wc + 8 * fq;
                    float v[8];
#pragma unroll
                    for (int n = 0; n < 2; ++n)
#pragma unroll
                        for (int j = 0; j < 4; ++j) v[4 * n + j] = acc[ai][bj][m][n][j] * rs;
                    if (hh < 5) {
                        float ss = 0.f;
#pragma unroll
                        for (int e = 0; e < 8; ++e) ss += v[e] * v[e];
                        ss += __shfl_xor(ss, 16); ss += __shfl_xor(ss, 32);
                        if (hh < 3) { *(u32x4*)(CQ + (size_t)row * 384 + hh * 128 + cw) = pk8(v); if (fq == 0) SSQQ[(size_t)row * 16 + hh * 4 + wc] = ss; }
                        else { *(u32x4*)(CKV + (size_t)row * 256 + (hh - 3) * 128 + cw) = pk8(v); if (fq == 0) SSQKV[(size_t)row * 8 + (hh - 3) * 4 + wc] = ss; }
                    } else if (hh == 5) {
                        if (wc == 0) {
                            const f32x4 c = *(const f32x4*)(cosT + (size_t)row * 16 + 4 * fq), s = *(const f32x4*)(sinT + (size_t)row * 16 + 4 * fq);
                            u32x4 o;
                            o.x = pk2(v[0] * c.x - v[1] * s.x, v[1] * c.x + v[0] * s.x); o.y = pk2(v[2] * c.y - v[3] * s.y, v[3] * c.y + v[2] * s.y);
                            o.z = pk2(v[4] * c.z - v[5] * s.z, v[5] * c.z + v[4] * s.z); o.w = pk2(v[6] * c.w - v[7] * s.w, v[7] * c.w + v[6] * s.w);
                            bf16* kp = KC + ((size_t)(row >> 12) * 8 * SEQ + (row & 4095)) * 96 + 64 + 8 * fq;
#pragma unroll
                            for (int hd = 0; hd < 8; ++hd) *(u32x4*)(kp + (size_t)hd * SEQ * 96) = o;
                        }
                    } else if (hh < 10) {
#pragma unroll
                        for (int e = 0; e < 8; ++e) v[e] = v[e] * sigmoidf_(v[e]);
                        *(u32x4*)(HQ + (size_t)row * 512 + (hh - 6) * 128 + cw) = pk8(v);
                    } else if (hh < 14) {
                        const int c0 = (hh - 10) * 128 + cw;
                        const f32x4 l0 = *(const f32x4*)(lbs + c0), l1 = *(const f32x4*)(lbs + c0 + 4);
                        const float lb[8] = {l0.x, l0.y, l0.z, l0.w, l1.x, l1.y, l1.z, l1.w};
                        float g[8], k[8];
#pragma unroll
                        for (int e = 0; e < 8; ++e) { const float z = fminf(fmaxf(v[e], -60.f), 60.f); const float sg = __builtin_amdgcn_rcpf(1.0f + __expf(-z));
                            g[e] = __logf(lb[e] + (1.0f - lb[e]) * sg); k[e] = (1.0f - lb[e]) * __builtin_amdgcn_rcpf(1.0f + __expf(z)); }
                        *(f32x4*)(GG + (size_t)row * 512 + c0) = (f32x4){g[0], g[1], g[2], g[3]}; *(f32x4*)(GG + (size_t)row * 512 + c0 + 4) = (f32x4){g[4], g[5], g[6], g[7]};
                        *(u32x4*)(HK + (size_t)row * 512 + c0) = pk8(k);
                    } else if (hh < 18) {
                        *(u32x4*)(HV + (size_t)row * 512 + (hh - 14) * 128 + cw) = pk8(v);
                    } else if (hh < 22) {
#pragma unroll
                        for (int e = 0; e < 8; ++e) v[e] = v[e] * sigmoidf_(v[e]);
                        *(u32x4*)(HGT + (size_t)row * 512 + (hh - 18) * 128 + cw) = pk8(v);
                    } else if (hh < 26) {
#pragma unroll
                        for (int e = 0; e < 8; ++e) v[e] *= QSCALE_MEM;
                        *(u32x4*)(MQ + (size_t)row * 512 + (hh - 22) * 128 + cw) = pk8(v);
                    } else {
                        const int c0 = (hh - 26) * 128 + cw, br = c0 >> 10, cc = c0 & 1023;
#pragma unroll
                        for (int e = 0; e < 8; ++e) v[e] = sigmoidf_(v[e]);
                        *(u32x4*)(GATES + ((size_t)br * T + row) * 1024 + cc) = pk8(v);
                    }
                }
            }
    }
};

struct EpiQ {
    static constexpr bool PERM = true, AFTER_DRAIN = false;
    bf16* Q;
    DI void operator()(EPI_ARGS) const {
        EPI_OPAQUE
#pragma unroll
        for (int ai = 0; ai < 2; ++ai)
#pragma unroll
            for (int m = 0; m < 4; ++m) {
                const int row = u.pm * 256 + ai * 128 + wr * 64 + m * 16 + fr;
#pragma unroll
                for (int bj = 0; bj < 2; ++bj) {
                    float v[8];
#pragma unroll
                    for (int n = 0; n < 2; ++n)
#pragma unroll
                        for (int j = 0; j < 4; ++j) v[4 * n + j] = acc[ai][bj][m][n][j];
                    *(u32x4*)(Q + (size_t)row * 768 + u.pn * 256 + 128 * bj + 32 * wc + 8 * fq) = pk8(v);
                }
            }
    }
};

struct EpiKV {
    static constexpr bool PERM = true, AFTER_DRAIN = false;
    bf16* KC; bf16* VT; const float* ssqkv;
    DI void operator()(EPI_ARGS) const {
        EPI_OPAQUE
        float rs8[8]; rstd8(ssqkv, 8, 2, 1.0f / 256.0f, 1.0f, u.pm * 256 + wr * 64 + fr, fq, rs8);
#pragma unroll
        for (int ai = 0; ai < 2; ++ai)
#pragma unroll
            for (int m = 0; m < 4; ++m) {
                const int row = u.pm * 256 + ai * 128 + wr * 64 + m * 16 + fr, b = row >> 12, s = row & 4095;
                const float rs = rs8[ai * 4 + m];
#pragma unroll
                for (int bj = 0; bj < 2; ++bj) {
                    const int c0 = u.pn * 256 + 128 * bj + 32 * wc + 8 * fq;
                    float v[8];
#pragma unroll
                    for (int n = 0; n < 2; ++n)
#pragma unroll
                        for (int j = 0; j < 4; ++j) v[4 * n + j] = acc[ai][bj][m][n][j] * rs;
                    if (c0 < 512) {
                        const int hd = c0 >> 6, d = c0 & 63;
                        bf16* kp = KC + ((size_t)(b * 8 + hd) * SEQ + s) * 96;
                        *(u32x4*)(kp + d) = pk8(v);
                    } else {
                        const int c = c0 - 512, hd = c >> 6, dv = c & 63;
                        bf16* vp = VT + ((size_t)(b * 8 + hd) * 64 + dv) * SEQ + s;
#pragma unroll
                        for (int e = 0; e < 8; ++e) vp[(size_t)e * SEQ] = f2bf(v[e]);
                    }
                }
            }
    }
};

struct EpiMemKV {
    static constexpr bool PERM = true, AFTER_DRAIN = false;
    bf16* MK; bf16* MVT; const float* rstd;
    DI void operator()(EPI_ARGS) const {
        EPI_OPAQUE
#pragma unroll
        for (int ai = 0; ai < 2; ++ai)
#pragma unroll
            for (int m = 0; m < 4; ++m) {
                const int row = u.pm * 256 + ai * 128 + wr * 64 + m * 16 + fr, b = row >> 8, mm = row & 255;
                const float rs = rstd[row];
#pragma unroll
                for (int bj = 0; bj < 2; ++bj) {
                    const int c0 = u.pn * 256 + 128 * bj + 32 * wc + 8 * fq;
                    float v[8];
#pragma unroll
                    for (int n = 0; n < 2; ++n)
#pragma unroll
                        for (int j = 0; j < 4; ++j) v[4 * n + j] = acc[ai][bj][m][n][j] * rs;
                    if (c0 < 512) { const int hd = c0 >> 7, d = c0 & 127; *(u32x4*)(MK + ((size_t)(b * 4 + hd) * 256 + mm) * 128 + d) = pk8(v); }
                    else { const int c = c0 - 512, hd = c >> 7, dv = c & 127; bf16* vp = MVT + ((size_t)(b * 4 + hd) * 128 + dv) * 256 + mm;
#pragma unroll
                        for (int e = 0; e < 8; ++e) vp[(size_t)e * 256] = f2bf(v[e]); }
                }
            }
    }
};

struct EpiBranch {
    static constexpr bool PERM = true, AFTER_DRAIN = false;
    bf16* MG; const bf16* gate; int first;
    DI void operator()(EPI_ARGS) const {
        EPI_OPAQUE
        const int rowb = u.pm * 256 + wr * 64 + fr, colb = u.pn * 256 + 32 * wc + 8 * fq;
#pragma unroll
        for (int ai = 0; ai < 2; ++ai) {
            u32x4 gv[4][2], pv[4][2];
#pragma unroll
            for (int m = 0; m < 4; ++m)
#pragma unroll
                for (int bj = 0; bj < 2; ++bj) { const size_t off = (size_t)(rowb + ai * 128 + m * 16) * 1024 + colb + 128 * bj;
                    gv[m][bj] = *(const u32x4*)(gate + off); pv[m][bj] = (u32x4){0, 0, 0, 0}; if (!first) pv[m][bj] = *(const u32x4*)(MG + off); }
#pragma unroll
            for (int m = 0; m < 4; ++m)
#pragma unroll
                for (int bj = 0; bj < 2; ++bj) {
                    const size_t off = (size_t)(rowb + ai * 128 + m * 16) * 1024 + colb + 128 * bj;
                    float g[8], o[8];
                    unpk8(gv[m][bj], g); unpk8(pv[m][bj], o);
#pragma unroll
                    for (int n = 0; n < 2; ++n)
#pragma unroll
                        for (int j = 0; j < 4; ++j) o[4 * n + j] += g[4 * n + j] * acc[ai][bj][m][n][j];
                    *(u32x4*)(MG + off) = pk8(o);
                }
        }
    }
};

template <class Epi> DI void run_gemm(LAS unsigned char* lds, const bf16* A, const bf16* Bt, int M, int N, int K, int rot, const Epi& E) {
    int Kv = K, Nv = N, Mv = M; asm volatile("" : "+s"(Kv), "+s"(Nv), "+s"(Mv));
    pg8::Gemm g{A, Bt, Mv, Nv, Kv}; pg8::StaticOrder S; const int G = (int)gridDim.x;
    S.init(Mv, Nv, G, (int)((blockIdx.x + (unsigned)G - (unsigned)rot) % (unsigned)G));
    pg8::gemm_phase<Epi, pg8::StaticOrder, true, true>(lds, g, S, E);
}

#define MFMA32(a, b, c) __builtin_amdgcn_mfma_f32_32x32x16_bf16((a), (b), (c), 0, 0, 0)
template <int DQK, int DV, bool CAUSAL>
DI void attn_item(LAS unsigned char* lds, const bf16* Qp, int qstride, const bf16* Kp, const bf16* VTp, int vt_stride, bf16* Op, int ostride, int q0, int nkeys,
                  const float* ssqq, const float* cosT, const float* sinT) {
    constexpr int KROW = DQK * 2 + 16, VROW = 144, KBYTES = 64 * KROW, VBYTES = DV * VROW, BUF = KBYTES + VBYTES;
    constexpr int NCK = 64 * DQK / 8, NCV = DV * 8, KS = DQK / 16, NDB = DV / 32;
    constexpr int CPR = DQK / 8;
    int tid_o = threadIdx.x; asm volatile("" : "+v"(tid_o)); const int tid = tid_o, wid = __builtin_amdgcn_readfirstlane(tid >> 6), lane = tid & 63, r = lane & 31, h = lane >> 5;
    const int ntiles = CAUSAL ? (q0 + 256) / 64 : nkeys / 64;
    const int qlo = q0 + wid * 32;
    bf16x8 qf[KS];
    { const bf16* qr = Qp + (size_t)(wid * 32 + r) * qstride + 8 * h;
#pragma unroll
      for (int ks = 0; ks < KS; ++ks) qf[ks] = *(const bf16x8*)(qr + 16 * ks);
      if (CAUSAL) {
          const float* sp = ssqq + (size_t)(wid * 32 + r) * 16;
          const f32x4 a = *(const f32x4*)sp, b = *(const f32x4*)(sp + 4), c = *(const f32x4*)(sp + 8);
          const float rs = rsqrtf((((a.x + a.y) + (a.z + a.w)) + ((b.x + b.y) + (b.z + b.w)) + ((c.x + c.y) + (c.z + c.w))) * (1.0f / 384.0f) + EPS) * QSCALE_MLA;
#pragma unroll
          for (int ks = 0; ks < KS; ++ks) {
              float v[8]; unpk8(__builtin_bit_cast(u32x4, qf[ks]), v);
              if (ks >= 4) {
                  const int i0 = 8 * (ks - 4) + 4 * h;
                  const f32x4 cs = *(const f32x4*)(cosT + (size_t)(wid * 32 + r) * 16 + i0), sn = *(const f32x4*)(sinT + (size_t)(wid * 32 + r) * 16 + i0);
                  const float t0 = v[0], t1 = v[1], t2 = v[2], t3 = v[3], t4 = v[4], t5 = v[5], t6 = v[6], t7 = v[7];
                  v[0] = t0 * cs.x - t1 * sn.x; v[1] = t1 * cs.x + t0 * sn.x; v[2] = t2 * cs.y - t3 * sn.y; v[3] = t3 * cs.y + t2 * sn.y;
                  v[4] = t4 * cs.z - t5 * sn.z; v[5] = t5 * cs.z + t4 * sn.z; v[6] = t6 * cs.w - t7 * sn.w; v[7] = t7 * cs.w + t6 * sn.w;
              }
#pragma unroll
              for (int e = 0; e < 8; ++e) v[e] *= rs;
              qf[ks] = __builtin_bit_cast(bf16x8, pk8(v));
          }
      } }
    f32x16 o[NDB];
#pragma unroll
    for (int db = 0; db < NDB; ++db)
#pragma unroll
        for (int i = 0; i < 16; ++i) o[db][i] = 0.f;
    float mrun = -1e30f, lrun = 0.f;
    const int kc0 = tid, kc1 = tid + 512; const bool k1on = kc1 < NCK;
    const int kr0 = kc0 / CPR, kcc0 = kc0 % CPR, kr1 = kc1 / CPR, kcc1 = kc1 % CPR;
    const int vc0 = tid, vc1 = tid + 512; const bool v1on = vc1 < NCV;
    u32x4 pk0, pk1 = {0, 0, 0, 0}, pv0, pv1 = {0, 0, 0, 0};
    const GAS u32x4* Kg = (const GAS u32x4*)Kp;
#define ATT_GLOAD(t_) do { pk0 = Kg[(size_t)(t_) * NCK + kc0]; if (k1on) pk1 = Kg[(size_t)(t_) * NCK + kc1]; \
        pv0 = *(const GAS u32x4*)(VTp + (size_t)(vc0 >> 3) * vt_stride + (t_) * 64 + (vc0 & 7) * 8); \
        if (v1on) pv1 = *(const GAS u32x4*)(VTp + (size_t)(vc1 >> 3) * vt_stride + (t_) * 64 + (vc1 & 7) * 8); } while (0)
#define ATT_LSTORE(buf_) do { LAS unsigned char* kb_ = lds + (buf_) * BUF; LAS unsigned char* vb_ = kb_ + KBYTES; \
        *(LAS u32x4*)(kb_ + kr0 * KROW + kcc0 * 16) = pk0; if (k1on) *(LAS u32x4*)(kb_ + kr1 * KROW + kcc1 * 16) = pk1; \
        *(LAS u32x4*)(vb_ + (vc0 >> 3) * VROW + (vc0 & 7) * 16) = pv0; if (v1on) *(LAS u32x4*)(vb_ + (vc1 >> 3) * VROW + (vc1 & 7) * 16) = pv1; } while (0)
    ATT_GLOAD(0); ATT_LSTORE(0);
    __syncthreads();
    for (int t = 0; t < ntiles; ++t) {
        const bool more = t + 1 < ntiles;
        if (more) ATT_GLOAD(t + 1);
        const bool active = !CAUSAL || (64 * t <= qlo + 31);
        if (active) {
            LAS unsigned char* kb = lds + (t & 1) * BUF; LAS unsigned char* vb = kb + KBYTES;
            f32x16 s0, s1;
#pragma unroll
            for (int i = 0; i < 16; ++i) { s0[i] = 0.f; s1[i] = 0.f; }
#pragma unroll
            for (int ks = 0; ks < KS; ++ks) {
                const bf16x8 k0 = *(const LAS bf16x8*)(kb + r * KROW + 32 * ks + 16 * h);
                const bf16x8 k1 = *(const LAS bf16x8*)(kb + (32 + r) * KROW + 32 * ks + 16 * h);
                s0 = MFMA32(k0, qf[ks], s0); s1 = MFMA32(k1, qf[ks], s1);
            }
            if (CAUSAL && (64 * t + 63 > qlo)) {
                const int qpos = qlo + r, kbase = 64 * t + 4 * h;
#pragma unroll
                for (int i = 0; i < 16; ++i) { const int key = kbase + (i & 3) + 8 * (i >> 2);
                    if (key > qpos) s0[i] = -1e30f; if (key + 32 > qpos) s1[i] = -1e30f; }
            }
            float mx = s0[0];
#pragma unroll
            for (int i = 1; i < 16; ++i) mx = fmaxf(mx, s0[i]);
#pragma unroll
            for (int i = 0; i < 16; ++i) mx = fmaxf(mx, s1[i]);
            mx = fmaxf(mx, __shfl_xor(mx, 32));
            const float mnew = fmaxf(mrun, mx), alpha = __builtin_amdgcn_exp2f(mrun - mnew);
            mrun = mnew;
            float ps = 0.f;
#pragma unroll
            for (int i = 0; i < 16; ++i) { s0[i] = __builtin_amdgcn_exp2f(s0[i] - mnew); s1[i] = __builtin_amdgcn_exp2f(s1[i] - mnew); ps += s0[i] + s1[i]; }
            lrun = lrun * alpha + ps;
#pragma unroll
            for (int db = 0; db < NDB; ++db)
#pragma unroll
                for (int i = 0; i < 16; ++i) o[db][i] *= alpha;
#pragma unroll
            for (int kb2 = 0; kb2 < 2; ++kb2)
#pragma unroll
                for (int s = 0; s < 2; ++s) {
                    u32x4 pw;
                    if (kb2 == 0) { pw.x = pk2(s0[8 * s], s0[8 * s + 1]); pw.y = pk2(s0[8 * s + 2], s0[8 * s + 3]); pw.z = pk2(s0[8 * s + 4], s0[8 * s + 5]); pw.w = pk2(s0[8 * s + 6], s0[8 * s + 7]); }
                    else { pw.x = pk2(s1[8 * s], s1[8 * s + 1]); pw.y = pk2(s1[8 * s + 2], s1[8 * s + 3]); pw.z = pk2(s1[8 * s + 4], s1[8 * s + 5]); pw.w = pk2(s1[8 * s + 6], s1[8 * s + 7]); }
                    const bf16x8 pf = __builtin_bit_cast(bf16x8, pw);
                    const int koff = (32 * kb2 + 16 * s + 4 * h) * 2;
#pragma unroll
                    for (int db = 0; db < NDB; ++db) {
                        const u32x2 lo = *(const LAS u32x2*)(vb + (32 * db + r) * VROW + koff), hi = *(const LAS u32x2*)(vb + (32 * db + r) * VROW + koff + 16);
                        u32x4 vw; vw.x = lo.x; vw.y = lo.y; vw.z = hi.x; vw.w = hi.y;
                        o[db] = MFMA32(__builtin_bit_cast(bf16x8, vw), pf, o[db]);
                    }
                }
        }
        if (more) ATT_LSTORE((t + 1) & 1);
        __syncthreads();
    }
    const float ltot = lrun + __shfl_xor(lrun, 32), inv = 1.0f / ltot;
    bf16* orow = Op + (size_t)(wid * 32 + r) * ostride + 4 * h;
#pragma unroll
    for (int db = 0; db < NDB; ++db)
#pragma unroll
        for (int g = 0; g < 4; ++g) {
            u32x2 w; w.x = pk2(o[db][4 * g] * inv, o[db][4 * g + 1] * inv); w.y = pk2(o[db][4 * g + 2] * inv, o[db][4 * g + 3] * inv);
            *(u32x2*)(orow + 32 * db + 8 * g) = w;
        }
}

template <int KSTEPS> DI void lds_mma(f32x16& c, const LAS unsigned char* A, int astride, const LAS unsigned char* Bt, int bstride, int r, int h) {
#pragma unroll
    for (int s = 0; s < KSTEPS; ++s) {
        const bf16x8 a = *(const LAS bf16x8*)(A + r * astride + 32 * s + 16 * h);
        const bf16x8 b = *(const LAS bf16x8*)(Bt + r * bstride + 32 * s + 16 * h);
        c = MFMA32(a, b, c);
    }
}

DI void hgrn_b1(LAS unsigned char* lds, int ch, float* GG, const bf16* HK, const bf16* HV, float* LT, float* DEC) {
    int tid_o = threadIdx.x; asm volatile("" : "+v"(tid_o)); const int tid = tid_o, wid = __builtin_amdgcn_readfirstlane(tid >> 6), lane = tid & 63, r = lane & 31, h = lane >> 5;
    const int bh = ch >> 6, c = ch & 63, b = bh >> 2, hd = bh & 3;
    const size_t t0 = (size_t)b * SEQ + c * 64;
    const int k = tid & 127, seg = tid >> 7;
    LAS float* segsum = (LAS float*)lds;
    LAS unsigned char* kdT = lds + 2048;
    LAS unsigned char* vT = kdT + 128 * 144;
    float g[16]; float run = 0.f;
    float* gp = GG + (t0 + seg * 16) * 512 + hd * 128 + k;
#pragma unroll
    for (int i = 0; i < 16; ++i) { run += gp[(size_t)i * 512]; g[i] = run; }
    segsum[seg * 128 + k] = run;
    __syncthreads();
    float off = 0.f, tot = 0.f;
#pragma unroll
    for (int s = 0; s < 4; ++s) { const float v = segsum[s * 128 + k]; if (s < seg) off += v; tot += v; }
    const bf16* kp = HK + (t0 + seg * 16) * 512 + hd * 128 + k;
    const bf16* vp = HV + (t0 + seg * 16) * 512 + hd * 128 + k;
#pragma unroll
    for (int i = 0; i < 16; ++i) {
        const float G = g[i] + off; gp[(size_t)i * 512] = G;
        const float kd = bf2f(kp[(size_t)i * 512]) * __expf(tot - G);
        *(LAS bf16*)(kdT + k * 144 + (seg * 16 + i) * 2) = f2bf(kd);
        *(LAS bf16*)(vT + k * 144 + (seg * 16 + i) * 2) = vp[(size_t)i * 512];
    }
    if (seg == 0) DEC[(size_t)ch * 128 + k] = __expf(tot);
    __syncthreads();
    const int vb = wid >> 1;
#pragma unroll
    for (int q = 0; q < 2; ++q) {
        const int kb = (wid & 1) * 2 + q;
        f32x16 acc;
#pragma unroll
        for (int i = 0; i < 16; ++i) acc[i] = 0.f;
        lds_mma<4>(acc, vT + vb * 32 * 144, 144, kdT + kb * 32 * 144, 144, r, h);
        float* lp = LT + (size_t)ch * 16384 + (size_t)(vb * 32 + 4 * h) * 128 + kb * 32 + r;
#pragma unroll
        for (int i = 0; i < 16; ++i) lp[(size_t)((i & 3) + 8 * (i >> 2)) * 128] = acc[i];
    }
    __syncthreads();
}

DI void hgrn_b3(LAS unsigned char* lds, int ch, const float* GG, const bf16* HQ, const bf16* HK, const bf16* HV, const bf16* HGT, const float* LT, const float* onorm, bf16* HO) {
    constexpr int RS = 272;
    int tid_o = threadIdx.x; asm volatile("" : "+v"(tid_o)); const int tid = tid_o, wid = __builtin_amdgcn_readfirstlane(tid >> 6), lane = tid & 63, r = lane & 31, h = lane >> 5;
    const int bh = ch >> 6, c = ch & 63, b = bh >> 2, hd = bh & 3;
    const size_t t0 = (size_t)b * SEQ + c * 64;
    LAS unsigned char* qG = lds;
    LAS unsigned char* q1 = qG + 64 * RS;
    LAS unsigned char* kA0 = q1 + 32 * RS;
    LAS unsigned char* kA1 = kA0 + 32 * RS;
    LAS unsigned char* ST = kA1 + 64 * RS;
    LAS unsigned char* vT = ST + 128 * RS;
    LAS unsigned char* Am = vT + 128 * 144;
    {
        const int k8 = tid & 15;
        const float* g31p = GG + (t0 + 31) * 512 + hd * 128 + k8 * 8;
        const f32x4 ga = *(const f32x4*)g31p, gb = *(const f32x4*)(g31p + 4);
        const float g31[8] = {ga.x, ga.y, ga.z, ga.w, gb.x, gb.y, gb.z, gb.w};
#pragma unroll
        for (int pass = 0; pass < 2; ++pass) {
            const int t = (tid >> 4) + 32 * pass;
            const size_t off = (t0 + t) * 512 + hd * 128 + k8 * 8;
            const f32x4 a = *(const f32x4*)(GG + off), bq = *(const f32x4*)(GG + off + 4);
            const float G[8] = {a.x, a.y, a.z, a.w, bq.x, bq.y, bq.z, bq.w};
            float q[8], kk[8], o1[8], o2[8], o3[8];
            unpk8(*(const u32x4*)(HQ + off), q); unpk8(*(const u32x4*)(HK + off), kk);
#pragma unroll
            for (int e = 0; e < 8; ++e) o1[e] = q[e] * __expf(G[e]);
            *(LAS u32x4*)(qG + t * RS + k8 * 16) = pk8(o1);
            if (pass == 0) {
#pragma unroll
                for (int e = 0; e < 8; ++e) { o2[e] = kk[e] * __expf(fminf(-G[e], 80.f)); o3[e] = kk[e] * __expf(g31[e] - G[e]); }
                *(LAS u32x4*)(kA0 + t * RS + k8 * 16) = pk8(o2);
                *(LAS u32x4*)(kA1 + t * RS + k8 * 16) = pk8(o3);
            } else {
#pragma unroll
                for (int e = 0; e < 8; ++e) { o2[e] = q[e] * __expf(G[e] - g31[e]); o3[e] = kk[e] * __expf(fminf(g31[e] - G[e], 80.f)); }
                *(LAS u32x4*)(q1 + (t - 32) * RS + k8 * 16) = pk8(o2);
                *(LAS u32x4*)(kA1 + t * RS + k8 * 16) = pk8(o3);
            }
        }
        const float* lp = LT + (size_t)ch * 16384;
#pragma unroll
        for (int p = 0; p < 4; ++p) {
            const int idx = tid + 512 * p, v = idx >> 4, kk8 = idx & 15;
            const f32x4 a = *(const f32x4*)(lp + v * 128 + kk8 * 8), bq = *(const f32x4*)(lp + v * 128 + kk8 * 8 + 4);
            const float sv[8] = {a.x, a.y, a.z, a.w, bq.x, bq.y, bq.z, bq.w};
            *(LAS u32x4*)(ST + v * RS + kk8 * 16) = pk8(sv);
        }
        const int v = tid & 127, seg = tid >> 7;
        const bf16* vp = HV + (t0 + seg * 16) * 512 + hd * 128 + v;
#pragma unroll
        for (int i = 0; i < 16; ++i) *(LAS bf16*)(vT + v * 144 + (seg * 16 + i) * 2) = vp[(size_t)i * 512];
    }
    __syncthreads();
    if (wid < 3) {
        f32x16 a;
#pragma unroll
        for (int i = 0; i < 16; ++i) a[i] = 0.f;
        const int tb = wid == 0 ? 0 : 1, sb = wid == 2 ? 1 : 0;
        if (wid == 0) lds_mma<8>(a, qG, RS, kA0, RS, r, h);
        else lds_mma<8>(a, q1, RS, kA1 + sb * 32 * RS, RS, r, h);
#pragma unroll
        for (int i = 0; i < 16; ++i) { const int tl = (i & 3) + 8 * (i >> 2) + 4 * h; float val = a[i]; if (tb == sb && r > tl) val = 0.f;
            *(LAS bf16*)(Am + (tb * 32 + tl) * 144 + (sb * 32 + r) * 2) = f2bf(val); }
    } else if (wid == 3) {
#pragma unroll
        for (int i = 0; i < 16; ++i) { const int tl = (i & 3) + 8 * (i >> 2) + 4 * h; *(LAS bf16*)(Am + tl * 144 + (32 + r) * 2) = (bf16)0; }
    }
    __syncthreads();
    f32x16 acc;
#pragma unroll
    for (int i = 0; i < 16; ++i) acc[i] = 0.f;
    const int tb = wid >> 2, vb = wid & 3;
    lds_mma<8>(acc, qG + tb * 32 * RS, RS, ST + vb * 32 * RS, RS, r, h);
    lds_mma<4>(acc, Am + tb * 32 * 144, 144, vT + vb * 32 * 144, 144, r, h);
    __syncthreads();
    LAS float* Ost = (LAS float*)ST;
#pragma unroll
    for (int i = 0; i < 16; ++i) Ost[(tb * 32 + (i & 3) + 8 * (i >> 2) + 4 * h) * 132 + vb * 32 + r] = acc[i];
    __syncthreads();
    {
        const int t = tid >> 3, part = tid & 7;
        float ov[16]; float ss = 0.f;
#pragma unroll
        for (int q4 = 0; q4 < 4; ++q4) { const f32x4 x = *(const LAS f32x4*)(Ost + t * 132 + part * 16 + q4 * 4); ov[4 * q4] = x.x; ov[4 * q4 + 1] = x.y; ov[4 * q4 + 2] = x.z; ov[4 * q4 + 3] = x.w; }
#pragma unroll
        for (int e = 0; e < 16; ++e) ss += ov[e] * ov[e];
        ss += __shfl_xor(ss, 1); ss += __shfl_xor(ss, 2); ss += __shfl_xor(ss, 4);
        const float rs = rsqrtf(ss * (1.0f / 128.0f) + EPS);
        const size_t off = (t0 + t) * 512 + hd * 128 + part * 16;
        float gt[16];
        unpk8(*(const u32x4*)(HGT + off), gt); unpk8(*(const u32x4*)(HGT + off + 8), gt + 8);
#pragma unroll
        for (int e = 0; e < 16; ++e) ov[e] = ov[e] * rs * onorm[part * 16 + e] * gt[e];
        *(u32x4*)(HO + off) = pk8(ov); *(u32x4*)(HO + off + 8) = pk8(ov + 8);
    }
    __syncthreads();
}

DI int dest_row(int mode, int n) {
    if (mode == 0) return n;
    if (mode == 1) { const int j = n < DFF ? n : n - DFF; return (j >> 7) * 256 + (n < DFF ? 0 : 128) + (j & 127); }
    if (mode == 2) { if (n < 640) return n; if (n < 672) { const int j = n - 640; return 640 + (j < 16 ? 2 * j : 2 * (j - 16) + 1); } if (n < 3232) return 768 + (n - 672); return 3328 + (n - 3232); }
    const int hd = n / 96, w = n - hd * 96; if (w < 64) return n; const int j = w - 64; return hd * 96 + 64 + (j < 16 ? 2 * j : 2 * (j - 16) + 1);
}
DI void conv_item(const float* W, int K, int N, bf16* WT, const float* gain, int mode, int row_off, LAS float* scr, int item, int lane) {
    const int nblk = N / 32, kb = item / nblk, nb = item - kb * nblk, k0 = 64 * kb, n0 = 32 * nb;
#pragma unroll 8
    for (int i = 0; i < 32; ++i) { const int kk = 2 * i + (lane >> 5); scr[kk * 33 + (lane & 31)] = W[(size_t)(k0 + kk) * N + n0 + (lane & 31)]; }
    asm volatile("s_waitcnt lgkmcnt(0)" ::: "memory");
    const int c = lane & 7;
    float gn[8];
#pragma unroll
    for (int e = 0; e < 8; ++e) gn[e] = gain ? gain[k0 + 8 * c + e] : 1.0f;
#pragma unroll
    for (int j = 0; j < 4; ++j) { const int n = (lane >> 3) + 8 * j; const LAS float* s = scr + (8 * c) * 33 + n;
        float v[8];
#pragma unroll
        for (int e = 0; e < 8; ++e) v[e] = s[e * 33] * gn[e];
        *(u32x4*)(WT + (size_t)(row_off + dest_row(mode, n0 + n)) * K + k0 + 8 * c) = pk8(v); }
    asm volatile("s_waitcnt lgkmcnt(0)" ::: "memory");
}

#define XB_TMO      128
#define XB_XCNT(j)  (256  + 64 * (j))
#define XB_XSUB(j)  (1280 + 64 * (j))
#define XB_XGEN(j)  (2304 + 64 * (j))
#define XB_TOP      3328
#define XB_TOPGEN   3392
#define XCD_BAR_WORDS 3456
#define XB_SPIN_CAP (1u << 18)
static_assert(XCD_BAR_WORDS * 4 <= CTL_BYTES, "barrier words inside the memset region");
DI unsigned xb_ld(unsigned* p)              { return __hip_atomic_load(p, __ATOMIC_RELAXED, __HIP_MEMORY_SCOPE_AGENT); }
DI unsigned xb_add(unsigned* p, unsigned v) { return __hip_atomic_fetch_add(p, v, __ATOMIC_RELAXED, __HIP_MEMORY_SCOPE_AGENT); }
DI unsigned xb_xcc_id() { return (unsigned)__builtin_amdgcn_s_getreg((3 << 11) | 20) & 0xFu; }
#define XB_SPIN(cond, bar) do { unsigned _sp = 0; while (cond) { __builtin_amdgcn_s_sleep(1); \
    if ((++_sp & 255u) == 0u) { if (xb_ld(&(bar)[XB_TMO])) break; if (_sp > XB_SPIN_CAP) { atomicAdd(&(bar)[XB_TMO], 1u); break; } } } } while (0)
struct XcdBarrier { unsigned* bar; unsigned x; volatile LAS unsigned* st; };
DI void xcd_barrier_complete(unsigned* bar, unsigned x, unsigned& nloc, unsigned& nx) {
    const unsigned G = gridDim.x * gridDim.y * gridDim.z;
    unsigned sum, cnt, mine, sp = 0u;
    for (;;) {
        sum = 0u; cnt = 0u; mine = 0u;
#pragma unroll
        for (unsigned j = 0; j < 16; ++j) { const unsigned c = xb_ld(&bar[XB_XCNT(j)]); sum += c; cnt += (c > 0u) ? 1u : 0u; mine = (j == x) ? c : mine; }
        if (sum == G) break;
        __builtin_amdgcn_s_sleep(1);
        if ((++sp & 255u) == 0u) { if (xb_ld(&bar[XB_TMO])) break; if (sp > XB_SPIN_CAP) { atomicAdd(&bar[XB_TMO], 1u); break; } }
    }
    nloc = mine > 0u ? mine : 1u; nx = cnt > 0u ? cnt : 1u;
}
DI void xcd_barrier(const XcdBarrier& b) {
    asm volatile("s_waitcnt vmcnt(0)" ::: "memory");
    __syncthreads();
    if (threadIdx.x == 0) {
        unsigned* bar = b.bar;
        __builtin_amdgcn_s_waitcnt(0);
        unsigned nloc = b.st[0], nx = b.st[1];
        if (nloc == 0u) { xcd_barrier_complete(bar, b.x, nloc, nx); b.st[0] = nloc; b.st[1] = nx; }
        const unsigned old = xb_add(&bar[XB_XSUB(b.x)], 1u);
        const unsigned gen = old / nloc;
        if (old + 1u == (gen + 1u) * nloc) {
            __builtin_amdgcn_fence(__ATOMIC_RELEASE, "agent");
            asm volatile("s_waitcnt vmcnt(0)" ::: "memory");
            const unsigned og = xb_add(&bar[XB_TOP], 1u);
            const unsigned tg = og / nx;
            if (og + 1u == (tg + 1u) * nx) xb_add(&bar[XB_TOPGEN], 1u);
            else XB_SPIN(xb_ld(&bar[XB_TOPGEN]) == tg, bar);
            __builtin_amdgcn_fence(__ATOMIC_ACQUIRE, "agent");
            xb_add(&bar[XB_XGEN(b.x)], 1u);
            asm volatile("s_waitcnt vmcnt(0)" ::: "memory");
        } else {
            XB_SPIN(xb_ld(&bar[XB_XGEN(b.x)]) == gen, bar);
            __builtin_amdgcn_fence(__ATOMIC_ACQUIRE, "agent");
            asm volatile("s_waitcnt vmcnt(0)" ::: "memory");
        }
    }
    __syncthreads();
}

struct Args { const void* in[25]; float* out; unsigned char* ws; int ph_lo, ph_hi; };
typedef const __attribute__((address_space(4))) unsigned long long* ka_t;
DI unsigned long long KA(int i) { ka_t p = (ka_t)__builtin_amdgcn_kernarg_segment_ptr(); asm volatile("" : "+s"(p)); return p[i]; }
#define KIN(i) ((const float*)KA(i))
#define KOUT ((float*)KA(25))
#define KWS ((unsigned char*)KA(26))

DI void conv_layer(int l, LAS unsigned char* lds) {
    int tid_o = threadIdx.x; asm volatile("" : "+v"(tid_o)); const int tid = tid_o, wave = __builtin_amdgcn_readfirstlane(tid >> 6), lane = tid & 63;
    LAS float* scr = (LAS float*)(lds + wave * 16384);
    const int gw = blockIdx.x * NWAVES + wave, NGW = gridDim.x * NWAVES;
    unsigned char* ws = KWS;
    const float* f1n = KIN(3) + l * 1024; const float* w1i = KIN(4) + (size_t)l * 1024 * 5632; const float* w1o = KIN(5) + (size_t)l * 2816 * 1024;
    const float* mxn = KIN(6) + l * 1024; const float* win = KIN(7) + (size_t)l * 1024 * DIN;
    const float* qln = KIN(8) + l * 384; const float* kvn = KIN(9) + l * 256;
    const float* wuq = KIN(10) + (size_t)l * 384 * 768; const float* wuk = KIN(11) + (size_t)l * 256 * 512; const float* wuv = KIN(12) + (size_t)l * 256 * 512;
    const float* womla = KIN(13) + (size_t)l * 512 * 1024; const float* wohg = KIN(16) + (size_t)l * 512 * 1024;
    const float* memn = KIN(17) + l * 1024; const float* wmkv = KIN(18) + (size_t)l * 1024 * 1024; const float* womem = KIN(19) + (size_t)l * 512 * 1024;
    const float* wout = KIN(20) + (size_t)l * 1024 * 1024;
    const float* f2n = KIN(21) + l * 1024; const float* w2i = KIN(22) + (size_t)l * 1024 * 5632; const float* w2o = KIN(23) + (size_t)l * 2816 * 1024;
    constexpr int I_FI = 16 * 176, I_FO = 44 * 32, I_WIN = 16 * 197, I_UQ = 6 * 24, I_UK = 4 * 16, I_WO = 8 * 32, I_SQ = 16 * 32;
    constexpr int NITEMS = 2 * I_FI + 2 * I_FO + I_WIN + I_UQ + 2 * I_UK + 3 * I_WO + 2 * I_SQ;
    for (int it = gw; it < NITEMS; it += NGW) {
        int r = it;
        if (r < I_FI) { conv_item(w1i, 1024, 5632, (bf16*)(ws + WT_W1IN), f1n, 1, 0, scr, r, lane); continue; } r -= I_FI;
        if (r < I_FI) { conv_item(w2i, 1024, 5632, (bf16*)(ws + WT_W2IN), f2n, 1, 0, scr, r, lane); continue; } r -= I_FI;
        if (r < I_FO) { conv_item(w1o, 2816, 1024, (bf16*)(ws + WT_W1OUT), nullptr, 0, 0, scr, r, lane); continue; } r -= I_FO;
        if (r < I_FO) { conv_item(w2o, 2816, 1024, (bf16*)(ws + WT_W2OUT), nullptr, 0, 0, scr, r, lane); continue; } r -= I_FO;
        if (r < I_WIN) { conv_item(win, 1024, DIN, (bf16*)(ws + WT_WIN), mxn, 2, 0, scr, r, lane); continue; } r -= I_WIN;
        if (r < I_UQ) { conv_item(wuq, 384, 768, (bf16*)(ws + WT_WUQ), qln, 3, 0, scr, r, lane); continue; } r -= I_UQ;
        if (r < I_UK) { conv_item(wuk, 256, 512, (bf16*)(ws + WT_WUKV), kvn, 0, 0, scr, r, lane); continue; } r -= I_UK;
        if (r < I_UK) { conv_item(wuv, 256, 512, (bf16*)(ws + WT_WUKV), kvn, 0, 512, scr, r, lane); continue; } r -= I_UK;
        if (r < I_WO) { conv_item(womla, 512, 1024, (bf16*)(ws + WT_WOMLA), nullptr, 0, 0, scr, r, lane); continue; } r -= I_WO;
        if (r < I_WO) { conv_item(wohg, 512, 1024, (bf16*)(ws + WT_WOHG), nullptr, 0, 0, scr, r, lane); continue; } r -= I_WO;
        if (r < I_WO) { conv_item(womem, 512, 1024, (bf16*)(ws + WT_WOMEM), nullptr, 0, 0, scr, r, lane); continue; } r -= I_WO;
        if (r < I_SQ) { conv_item(wmkv, 1024, 1024, (bf16*)(ws + WT_WMEMKV), memn, 0, 0, scr, r, lane); continue; } r -= I_SQ;
        conv_item(wout, 1024, 1024, (bf16*)(ws + WT_WOUT), nullptr, 0, 0, scr, r, lane);
    }
    u32x4* pad = (u32x4*)(ws + WT_WIN + (size_t)672 * 1024 * 2);
    for (int i = blockIdx.x * NTHREADS + tid; i < 96 * 1024 * 2 / 16; i += gridDim.x * NTHREADS) pad[i] = (u32x4){0, 0, 0, 0};
}

DI void prep_phase() {
    int tid_o = threadIdx.x; asm volatile("" : "+v"(tid_o)); const int tid = tid_o, wave = __builtin_amdgcn_readfirstlane(tid >> 6), lane = tid & 63;
    const int gw = blockIdx.x * NWAVES + wave, NGW = gridDim.x * NWAVES;
    unsigned char* ws = KWS; float* xout = KOUT;
    const float* x = KIN(0); const float* mem = KIN(1); const int* pos = (const int*)KA(2);
    bf16* XB = (bf16*)(ws + WS_XB); float* SSQ = (float*)(ws + WS_SSQ);
    for (int m = gw; m < T; m += NGW) {
        const f32x4* xr = (const f32x4*)(x + (size_t)m * D) + lane; f32x4* orow = (f32x4*)(xout + (size_t)m * D) + lane; u32x2* xb = (u32x2*)(XB + (size_t)m * D) + lane;
        float s = 0.f;
#pragma unroll
        for (int j = 0; j < 4; ++j) { const f32x4 v = xr[64 * j]; orow[64 * j] = v; s += (v.x * v.x + v.y * v.y) + (v.z * v.z + v.w * v.w); u32x2 w; w.x = pk2(v.x, v.y); w.y = pk2(v.z, v.w); xb[64 * j] = w; }
        s = wave_sum(s);
        if (lane < 16) SSQ[(size_t)m * 16 + lane] = lane == 0 ? s : 0.f;
    }
    bf16* MEMB = (bf16*)(ws + WS_MEMB); float* MRS = (float*)(ws + WS_MEMRSTD);
    for (int m = gw; m < 1024; m += NGW) {
        const f32x4* xr = (const f32x4*)(mem + (size_t)m * D) + lane; u32x2* xb = (u32x2*)(MEMB + (size_t)m * D) + lane;
        float s = 0.f;
#pragma unroll
        for (int j = 0; j < 4; ++j) { const f32x4 v = xr[64 * j]; s += (v.x * v.x + v.y * v.y) + (v.z * v.z + v.w * v.w); u32x2 w; w.x = pk2(v.x, v.y); w.y = pk2(v.z, v.w); xb[64 * j] = w; }
        s = wave_sum(s);
        if (lane == 0) MRS[m] = rsqrtf(s * (1.0f / 1024.0f) + EPS);
    }
    float* COS = (float*)(ws + WS_COS); float* SIN = (float*)(ws + WS_SIN);
    for (int i = blockIdx.x * NTHREADS + tid; i < T * 16; i += gridDim.x * NTHREADS) {
        const int row = i >> 4, fi = i & 15;
        const float invf = exp2f(-13.287712379549449f * (float)fi * (1.0f / 16.0f));
        const float ang = (float)pos[row] * invf;
        const float kq = rintf(ang * 0.15915494309189535f);
        float rr = fmaf(-kq, 6.28125f, ang); rr = fmaf(-kq, 1.9353071795864769e-3f, rr);
        COS[i] = __cosf(rr); SIN[i] = __sinf(rr);
    }
    const float* hlb = KIN(14); float* LBS = (float*)(ws + WS_LBS);
    for (int i = blockIdx.x * NTHREADS + tid; i < 512; i += gridDim.x * NTHREADS) {
        const float a0 = hlb[i], a1 = hlb[512 + i], a2 = hlb[1024 + i], a3 = hlb[1536 + i];
        const float mx = fmaxf(fmaxf(a0, a1), fmaxf(a2, a3));
        const float e0 = __expf(a0 - mx), e1 = __expf(a1 - mx), e2 = __expf(a2 - mx), e3 = __expf(a3 - mx), inv = 1.0f / (e0 + e1 + e2 + e3);
        LBS[i] = 0.f; LBS[512 + i] = e1 * inv; LBS[1024 + i] = (e1 + e2) * inv; LBS[1536 + i] = (e1 + e2 + e3) * inv;
    }
}

__global__ void __launch_bounds__(NTHREADS, 2) fwd_kernel(Args A_unused) {
    extern __shared__ __attribute__((aligned(16))) unsigned char lds_raw[];
    LAS unsigned char* lds = (LAS unsigned char*)lds_raw;
    cg::grid_group grid = cg::this_grid();
    int ph = 0;
    int lo, hi; { const unsigned long long w = KA(27); lo = (int)(unsigned)w; hi = (int)(unsigned)(w >> 32); }
#define RUN (ph >= lo && ph < hi)
    volatile LAS unsigned* bst = (volatile LAS unsigned*)(lds + 131072 + 512);
    if (threadIdx.x < 2) bst[threadIdx.x] = 0u;
    __syncthreads();
    if (threadIdx.x == 0) (void)xb_add(&((unsigned*)(KWS + WS_CTL))[XB_XCNT(xb_xcc_id())], 1u);
#define SEAM do { if (ph >= lo && ph + 1 < hi) { if (ph == 1) grid.sync(); else { XcdBarrier xb_; xb_.bar = (unsigned*)(KWS + WS_CTL); xb_.x = xb_xcc_id(); xb_.st = bst; xcd_barrier(xb_); } } ++ph; } while (0)
#define WSP(T_, name, off) T_* name = (T_*)(ws + (off))
#define REPEAT(n_) for (int rep_ = 0; rep_ < (n_); ++rep_, ((rep_ < (n_)) ? grid.sync() : (void)0))

    if (RUN) { prep_phase(); }
    ++ph;
    for (int l = 0; l < DEPTH; ++l) {
#ifndef SKIP_CONV
        if (RUN) REPEAT(REP_CONV) { conv_layer(l, lds); __syncthreads(); }
#endif
        SEAM;
#ifndef SKIP_G1
        if (RUN) REPEAT(REP_P1) { unsigned char* ws = KWS; EpiSwiglu E{(bf16*)(ws + WS_H), (const float*)(ws + WS_SSQ)}; run_gemm(lds, (const bf16*)(ws + WS_XB), (const bf16*)(ws + WT_W1IN), T, 5632, 1024, 0, E); }
#endif
        SEAM;
#ifndef SKIP_G2
        if (RUN) { unsigned char* ws = KWS; EpiResid E{KOUT, (bf16*)(ws + WS_XB), (float*)(ws + WS_SSQ), 0.5f}; run_gemm(lds, (const bf16*)(ws + WS_H), (const bf16*)(ws + WT_W1OUT), T, 1024, DFF, 0, E); }
#endif
        SEAM;
#ifndef SKIP_WIN
        if (RUN) REPEAT(REP_P3) { unsigned char* ws = KWS;
            EpiWin E{(const float*)(ws + WS_SSQ), (const float*)(ws + WS_LBS) + l * 512, (const float*)(ws + WS_COS), (const float*)(ws + WS_SIN),
                     (bf16*)(ws + WS_CQ), (bf16*)(ws + WS_CKV), (bf16*)(ws + WS_KC), (bf16*)(ws + WS_HQ), (bf16*)(ws + WS_HK), (bf16*)(ws + WS_HV), (bf16*)(ws + WS_HGT), (bf16*)(ws + WS_MQ), (bf16*)(ws + WS_GATES),
                     (float*)(ws + WS_GG), (float*)(ws + WS_SSQQ), (float*)(ws + WS_SSQKV)};
            run_gemm(lds, (const bf16*)(ws + WS_XB), (const bf16*)(ws + WT_WIN), T, NIN, 1024, 0, E); }
#endif
        SEAM;
        if (RUN) {
#ifndef SKIP_G4
            { unsigned char* ws = KWS; EpiQ E{(bf16*)(ws + WS_Q)}; run_gemm(lds, (const bf16*)(ws + WS_CQ), (const bf16*)(ws + WT_WUQ), T, 768, 384, 0, E); }
            { unsigned char* ws = KWS; EpiKV E{(bf16*)(ws + WS_KC), (bf16*)(ws + WS_VT), (const float*)(ws + WS_SSQKV)}; run_gemm(lds, (const bf16*)(ws + WS_CKV), (const bf16*)(ws + WT_WUKV), T, 1024, 256, 64, E); }
            { unsigned char* ws = KWS; EpiMemKV E{(bf16*)(ws + WS_MK), (bf16*)(ws + WS_MVT), (const float*)(ws + WS_MEMRSTD)}; run_gemm(lds, (const bf16*)(ws + WS_MEMB), (const bf16*)(ws + WT_WMEMKV), 1024, 1024, 1024, 192, E); }
#endif
#ifndef SKIP_B1
            { unsigned char* ws = KWS; const int G = (int)gridDim.x;
              for (int ch = (int)blockIdx.x; ch < 1024; ch += G) hgrn_b1(lds, ch, (float*)(ws + WS_GG), (const bf16*)(ws + WS_HK), (const bf16*)(ws + WS_HV), (float*)(ws + WS_LT), (float*)(ws + WS_DEC)); }
#endif
        }
        SEAM;
        if (RUN) {
            unsigned char* ws = KWS; int tid_o = threadIdx.x; asm volatile("" : "+v"(tid_o)); const int G = (int)gridDim.x, bid = (int)blockIdx.x, tid = tid_o;
#ifndef SKIP_MLA
            REPEAT(REP_MLA) for (int it = bid; it < 256; it += G) {
                const int bh = it >> 3, pr = it & 7, b = bh >> 3, hd = bh & 7;
#pragma unroll 1
                for (int half = 0; half < 2; ++half) {
                    const int qb = half == 0 ? 15 - pr : pr;
                    const size_t row0 = (size_t)b * SEQ + qb * 256;
                    attn_item<96, 64, true>(lds, (const bf16*)(ws + WS_Q) + row0 * 768 + hd * 96, 768, (const bf16*)(ws + WS_KC) + (size_t)bh * SEQ * 96, (const bf16*)(ws + WS_VT) + (size_t)bh * 64 * SEQ, SEQ,
                                            (bf16*)(ws + WS_AO) + row0 * 512 + hd * 64, 512, qb * 256, SEQ, (const float*)(ws + WS_SSQQ) + row0 * 16, (const float*)(ws + WS_COS) + row0 * 16, (const float*)(ws + WS_SIN) + row0 * 16);
                }
            }
#endif
            float* LT = (float*)(ws + WS_LT); const float* DEC = (const float*)(ws + WS_DEC);
            for (int gt = bid * NTHREADS + tid; gt < 16 * 16384; gt += G * NTHREADS) {
                const int bh = gt >> 14, e = gt & 16383, k = e & 127;
                float* lp = LT + (size_t)bh * 64 * 16384 + e; const float* dp = DEC + (size_t)bh * 64 * 128 + k;
                float run = 0.f;
#pragma unroll 8
                for (int c = 0; c < 64; ++c) { const float tmp = lp[(size_t)c * 16384], d = dp[c * 128]; lp[(size_t)c * 16384] = run; run = d * run + tmp; }
            }
        }
        SEAM;
        if (RUN) REPEAT(REP_P6) {
            unsigned char* ws = KWS; const int G = (int)gridDim.x, bid = (int)blockIdx.x;
#ifndef SKIP_XATT
            for (int it = bid; it < 256; it += G) {
                const int b = it >> 6, hd = (it >> 4) & 3, qb = it & 15;
                const size_t row0 = (size_t)b * SEQ + qb * 256;
                attn_item<128, 128, false>(lds, (const bf16*)(ws + WS_MQ) + row0 * 512 + hd * 128, 512, (const bf16*)(ws + WS_MK) + (size_t)(b * 4 + hd) * 256 * 128, (const bf16*)(ws + WS_MVT) + (size_t)(b * 4 + hd) * 128 * 256, 256,
                                           (bf16*)(ws + WS_MO) + row0 * 512 + hd * 128, 512, 0, 256, nullptr, nullptr, nullptr);
            }
#endif
#ifndef SKIP_B3
            const float* onorm = KIN(15) + l * 128;
            for (int ch = bid; ch < 1024; ch += G) hgrn_b3(lds, ch, (const float*)(ws + WS_GG), (const bf16*)(ws + WS_HQ), (const bf16*)(ws + WS_HK), (const bf16*)(ws + WS_HV), (const bf16*)(ws + WS_HGT), (const float*)(ws + WS_LT), onorm, (bf16*)(ws + WS_HO));
#endif
        }
        SEAM;
#ifndef SKIP_G7
        if (RUN) {
            { unsigned char* ws = KWS; EpiBranch E{(bf16*)(ws + WS_MERGED), (const bf16*)(ws + WS_GATES), 1}; run_gemm(lds, (const bf16*)(ws + WS_AO), (const bf16*)(ws + WT_WOMLA), T, 1024, 512, 0, E); }
            { unsigned char* ws = KWS; EpiBranch E{(bf16*)(ws + WS_MERGED), (const bf16*)(ws + WS_GATES) + (size_t)T * 1024, 0}; run_gemm(lds, (const bf16*)(ws + WS_HO), (const bf16*)(ws + WT_WOHG), T, 1024, 512, 0, E); }
            { unsigned char* ws = KWS; EpiBranch E{(bf16*)(ws + WS_MERGED), (const bf16*)(ws + WS_GATES) + (size_t)2 * T * 1024, 0}; run_gemm(lds, (const bf16*)(ws + WS_MO), (const bf16*)(ws + WT_WOMEM), T, 1024, 512, 0, E); }
        }
#endif
        SEAM;
#ifndef SKIP_G8
        if (RUN) { unsigned char* ws = KWS; EpiResid E{KOUT, (bf16*)(ws + WS_XB), (float*)(ws + WS_SSQ), 1.0f}; run_gemm(lds, (const bf16*)(ws + WS_MERGED), (const bf16*)(ws + WT_WOUT), T, 1024, 1024, 0, E); }
#endif
        SEAM;
#ifndef SKIP_G9
        if (RUN) { unsigned char* ws = KWS; EpiSwiglu E{(bf16*)(ws + WS_H), (const float*)(ws + WS_SSQ)}; run_gemm(lds, (const bf16*)(ws + WS_XB), (const bf16*)(ws + WT_W2IN), T, 5632, 1024, 0, E); }
#endif
        SEAM;
#ifndef SKIP_G10
        if (RUN) { unsigned char* ws = KWS; EpiResid E{KOUT, (bf16*)(ws + WS_XB), (float*)(ws + WS_SSQ), 0.5f}; run_gemm(lds, (const bf16*)(ws + WS_H), (const bf16*)(ws + WT_W2OUT), T, 1024, DFF, 0, E); }
#endif
        SEAM;
    }
    if (RUN) {
        unsigned char* ws = KWS; float* X = KOUT; const float* SSQ = (const float*)(ws + WS_SSQ);
        int tid_o = threadIdx.x; asm volatile("" : "+v"(tid_o)); const int tid = tid_o, wave = __builtin_amdgcn_readfirstlane(tid >> 6), lane = tid & 63, G = (int)gridDim.x;
        const float* fg = KIN(24);
        for (int m = (int)blockIdx.x * NWAVES + wave; m < T; m += G * NWAVES) {
            const float rs = rsqrtf(sum16(SSQ + (size_t)m * 16) * (1.0f / 1024.0f) + EPS);
            f32x4* xr = (f32x4*)(X + (size_t)m * D) + lane; const f32x4* gr = (const f32x4*)fg + lane;
#pragma unroll
            for (int j = 0; j < 4; ++j) { f32x4 v = xr[64 * j]; const f32x4 g = gr[64 * j]; v = v * rs * g; xr[64 * j] = v; }
        }
    }
#undef RUN
#undef SEAM
}

constexpr int N_PHASES = 1 + DEPTH * 11 + 1;

extern "C" void kernel_launch(void* const* d_in, const int* in_sizes, int n_in, void* d_out, int out_size, void* d_ws, size_t ws_size, hipStream_t stream) {
    static int grid = 0;
    if (grid == 0) {
        if (n_in != 25 || out_size != T * D || ws_size < WS_END) { fprintf(stderr, "kernel_launch: unexpected shapes (n_in %d out %d ws %zu need %zu)\n", n_in, out_size, ws_size, (size_t)WS_END); grid = -1; return; }
        int dev = 0, cus = 0, per_cu = 0;
        hipGetDevice(&dev);
        hipDeviceGetAttribute(&cus, hipDeviceAttributeMultiprocessorCount, dev);
        if (hipFuncSetAttribute((const void*)fwd_kernel, hipFuncAttributeMaxDynamicSharedMemorySize, LDS_BYTES) != hipSuccess) { fprintf(stderr, "kernel_launch: hipFuncSetAttribute failed\n"); grid = -1; return; }
        if (hipOccupancyMaxActiveBlocksPerMultiprocessor(&per_cu, (const void*)fwd_kernel, NTHREADS, LDS_BYTES) != hipSuccess || per_cu < 1) { fprintf(stderr, "kernel_launch: occupancy query says %d\n", per_cu); per_cu = 1; }
        (void)hipGetLastError();
        grid = cus * 1;
        if (grid <= 0) grid = 256;
    }
    if (grid < 0) return;
    if (hipMemsetAsync((char*)d_ws + WS_CTL, 0, CTL_BYTES, stream) != hipSuccess) { fprintf(stderr, "kernel_launch: memset of the barrier words failed\n"); return; }
    Args a{};
    for (int i = 0; i < 25; ++i) a.in[i] = d_in[i];
    a.out = (float*)d_out; a.ws = (unsigned char*)d_ws; a.ph_lo = 0; a.ph_hi = N_PHASES;
    void* args[] = {&a};
    hipError_t e = hipLaunchCooperativeKernel((const void*)fwd_kernel, dim3(grid), dim3(NTHREADS), args, LDS_BYTES, stream);
    if (e != hipSuccess) fprintf(stderr, "cooperative launch failed: %s (grid %d)\n", hipGetErrorString(e), grid);
}
```

```cpp
#include <hip/hip_runtime.h>
#include <hip/hip_cooperative_groups.h>
#include <cstdio>
#include <cstdint>
namespace cg = cooperative_groups;
#define DI __device__ __forceinline__
namespace pg8 {
#define PG8_LAS __attribute__((address_space(3)))
typedef unsigned short bf16_t;
typedef short bf16x8 __attribute__((ext_vector_type(8)));
typedef float f32x4 __attribute__((ext_vector_type(4)));
typedef unsigned u32x4 __attribute__((ext_vector_type(4)));
constexpr int BM = 256, BK = 64, HALF = 128, HTB = HALF * BK * 2  , STAGE_BYTES = 8 * HTB, NXCD = 8, WGM = 8;

__host__ __device__ __forceinline__ int lds_byte(int r, int c) { const int st = (r >> 4) * 2 + (c >> 5), rr = r & 15, cc = c & 31, ob = rr * 64 + cc * 2; return st * 1024 + (ob ^ (((ob >> 9) & 1) << 5)); }
__host__ __device__ __forceinline__ void stage_rc(int b, int& R, int& C) { const int st = b / 1024, sb = b % 1024, swz = sb ^ (((sb >> 9) & 1) << 5); R = (st >> 1) * 16 + swz / 64; C = (st & 1) * 32 + (swz % 64) / 2; }
__host__ __device__ __forceinline__ int perm32(int rho) { const int n = rho >> 4, i = rho & 15; return 8 * (i >> 2) + 4 * n + (i & 3); }

struct Unit { int pm, pn; };
struct Gemm { const bf16_t* A; const bf16_t* Bt; int M, N, K; };

struct StaticOrder {
    int nM, nN, nwg, G, c;
    __host__ __device__ void init(int M, int N, int G_, int c_) { nM = M / BM; nN = N / BM; nwg = nM * nN; G = G_; c = c_; }
    __host__ __device__ bool next(int i, Unit& u) const {
        const long L = (long)i * G + c; if (L >= nwg) return false;
        int wgid = (int)L; { const int q = nwg / NXCD, r = nwg % NXCD, xcd = wgid % NXCD, off = wgid / NXCD; wgid = (xcd < r ? xcd * (q + 1) : r * (q + 1) + (xcd - r) * q) + off; }
        const int nig = WGM * nN, gid = wgid / nig, fm = gid * WGM, gsz = (nM - fm) < WGM ? (nM - fm) : WGM;
        u.pm = fm + ((wgid % nig) % gsz); u.pn = (wgid % nig) / gsz; return true;
    }
    __device__ __forceinline__ void a_ready(const Unit&) const {}
    __device__ __forceinline__ void done(const Unit&) const {}
};
template <class Epi, class Sched, bool ALIGN_EPI = false, bool SP2 = false>
__device__ __forceinline__ void gemm_phase(PG8_LAS unsigned char* lds, const Gemm g, const Sched& S, const Epi& E) {
    int tid_o = threadIdx.x; asm volatile("" : "+v"(tid_o));
    const int tid = tid_o, wid = __builtin_amdgcn_readfirstlane(tid >> 6), lane = tid & 63, wr = wid >> 2, wc = wid & 3, fr = lane & 15, fq = lane >> 4;
    const int K = g.K, nt = K / BK;
    unsigned voffA[2], voffB[2];
#pragma unroll
    for (int i = 0; i < 2; ++i) { int R, C; stage_rc(tid * 16 + i * 8192, R, C); const int Rb = Epi::PERM ? ((R & ~31) + perm32(R & 31)) : R;
        voffA[i] = (unsigned)(R * K + C) * 2u; voffB[i] = (unsigned)(Rb * K + C) * 2u; }
    const size_t kstep = (size_t)(BK * 2);
    const size_t hstep = (size_t)HALF * K * 2;
    const size_t tstep = 2 * hstep;
    const unsigned ldsw = (unsigned)wid * 1024u;
    const int aoff = lds_byte(wr * 64 + fr, fq * 8), boff = lds_byte(wc * 32 + fr, fq * 8);
#define PG8_SA(b, h) (((b) * 2 + (h)) * HTB)
#define PG8_SB(b, h) ((4 + (b) * 2 + (h)) * HTB)
#define PG8_STAGE(bufoff, gbase, voff) do { _Pragma("unroll") for (int _i = 0; _i < 2; ++_i) \
        __builtin_amdgcn_global_load_lds((const unsigned*)((const char*)(gbase) + (voff)[_i]), (PG8_LAS unsigned*)(lds + (bufoff) + ldsw + _i * 8192), 16, 0, 0); } while (0)
#define PG8_LDA(dst, b, h) do { _Pragma("unroll") for (int m = 0; m < 4; ++m) _Pragma("unroll") for (int k = 0; k < 2; ++k) dst[m][k] = *(const PG8_LAS bf16x8*)(lds + PG8_SA(b, h) + aoff + m * 2048 + k * 1024); } while (0)
#define PG8_LDB(dst, b, h) do { _Pragma("unroll") for (int n = 0; n < 2; ++n) _Pragma("unroll") for (int k = 0; k < 2; ++k) dst[n][k] = *(const PG8_LAS bf16x8*)(lds + PG8_SB(b, h) + boff + n * 2048 + k * 1024); } while (0)
#define PG8_MMA(ai, bj, At, Bt) do { __builtin_amdgcn_s_setprio(1); _Pragma("unroll") for (int m = 0; m < 4; ++m) _Pragma("unroll") for (int n = 0; n < 2; ++n) _Pragma("unroll") for (int k = 0; k < 2; ++k) \
        acc[ai][bj][m][n] = __builtin_amdgcn_mfma_f32_16x16x32_bf16(Bt[n][k], At[m][k], acc[ai][bj][m][n], 0, 0, 0); __builtin_amdgcn_s_setprio(0); } while (0)
#define PG8_WAIT_V(n) asm volatile("s_waitcnt vmcnt(" #n ")" ::: "memory")
#define PG8_WAIT_L(n) asm volatile("s_waitcnt lgkmcnt(" #n ")" ::: "memory")
#define PG8_BAR __builtin_amdgcn_s_barrier()
#define PG8_SCHED __builtin_amdgcn_sched_barrier(0)
    Unit cur, nxt; int ui = 0;
    if (!S.next(0, cur)) return;
    f32x4 acc[2][2][4][2];
#pragma unroll
    for (int a = 0; a < 2; ++a)
#pragma unroll
        for (int b = 0; b < 2; ++b)
#pragma unroll
            for (int m = 0; m < 4; ++m)
#pragma unroll
                for (int n = 0; n < 2; ++n) acc[a][b][m][n] = (f32x4){0.f, 0.f, 0.f, 0.f};
    bf16x8 At[4][2], B0[2][2], B1[2][2];
    const char* cA = (const char*)g.A + (size_t)cur.pm * tstep; const char* cB = (const char*)g.Bt + (size_t)cur.pn * tstep;
    S.a_ready(cur);
    if constexpr (SP2) {
        PG8_STAGE(PG8_SB(0, 0), cB, voffB); PG8_STAGE(PG8_SB(0, 1), cB + hstep, voffB); PG8_STAGE(PG8_SA(0, 0), cA, voffA); PG8_STAGE(PG8_SA(0, 1), cA + hstep, voffA);
        if (wr == 1) PG8_BAR;
        PG8_WAIT_V(2); PG8_BAR;
        PG8_STAGE(PG8_SB(1, 0), cB + kstep, voffB); PG8_STAGE(PG8_SA(1, 0), cA + kstep, voffA); PG8_STAGE(PG8_SB(1, 1), cB + hstep + kstep, voffB);
        PG8_WAIT_V(6); PG8_BAR;
    } else {
        PG8_STAGE(PG8_SB(0, 0), cB, voffB); PG8_STAGE(PG8_SA(0, 0), cA, voffA); PG8_STAGE(PG8_SB(0, 1), cB + hstep, voffB); PG8_STAGE(PG8_SA(0, 1), cA + hstep, voffA);
        if (wr == 1) PG8_BAR;
        PG8_WAIT_V(4); PG8_BAR;
        PG8_STAGE(PG8_SB(1, 0), cB + kstep, voffB); PG8_STAGE(PG8_SA(1, 0), cA + kstep, voffA); PG8_STAGE(PG8_SB(1, 1), cB + hstep + kstep, voffB);
        PG8_WAIT_V(6); PG8_BAR;
    }
    for (;;) {
        const bool has_next = S.next(ui + 1, nxt);
        const char* nA = has_next ? (const char*)g.A + (size_t)nxt.pm * tstep : cA; const char* nB = has_next ? (const char*)g.Bt + (size_t)nxt.pn * tstep : cB;
        for (int t = 0; t < nt; t += 2) {
            const bool last = (t == nt - 2);
            const char* a1 = cA + (size_t)(t + 1) * kstep;
            const char* a2 = last ? nA : cA + (size_t)(t + 2) * kstep; const char* b2 = last ? nB : cB + (size_t)(t + 2) * kstep;
            const char* a3 = a2 + kstep; const char* b3 = b2 + kstep;
            if (last && has_next) S.a_ready(nxt);
            if constexpr (SP2) {
            PG8_LDB(B0, 0, 0); PG8_LDB(B1, 0, 1); PG8_SCHED; PG8_LDA(At, 0, 0); PG8_STAGE(PG8_SA(1, 1), a1 + hstep, voffA);
            PG8_WAIT_V(8); PG8_WAIT_L(0); PG8_BAR; PG8_MMA(0, 0, At, B0); PG8_MMA(0, 1, At, B1); PG8_BAR; PG8_SCHED;
            PG8_LDA(At, 0, 1); PG8_STAGE(PG8_SB(0, 0), b2, voffB); PG8_STAGE(PG8_SB(0, 1), b2 + hstep, voffB); PG8_STAGE(PG8_SA(0, 0), a2, voffA);
            PG8_WAIT_V(8); PG8_WAIT_L(0); PG8_BAR; PG8_MMA(1, 0, At, B0); PG8_MMA(1, 1, At, B1); PG8_BAR; PG8_SCHED;
            PG8_LDB(B0, 1, 0); PG8_LDB(B1, 1, 1); PG8_SCHED; PG8_LDA(At, 1, 0); PG8_STAGE(PG8_SA(0, 1), a2 + hstep, voffA);
            PG8_WAIT_V(8); PG8_WAIT_L(0); PG8_BAR; PG8_MMA(0, 0, At, B0); PG8_MMA(0, 1, At, B1); PG8_BAR; PG8_SCHED;
            PG8_LDA(At, 1, 1); PG8_STAGE(PG8_SB(1, 0), b3, voffB); PG8_STAGE(PG8_SB(1, 1), b3 + hstep, voffB); PG8_STAGE(PG8_SA(1, 0), a3, voffA);
            PG8_WAIT_V(8); PG8_WAIT_L(0); PG8_BAR; PG8_MMA(1, 0, At, B0); PG8_MMA(1, 1, At, B1); PG8_BAR; PG8_SCHED;
            } else {
            PG8_LDB(B0, 0, 0); PG8_SCHED; PG8_LDA(At, 0, 0); PG8_STAGE(PG8_SA(1, 1), a1 + hstep, voffA);
            PG8_WAIT_L(8); PG8_BAR; PG8_WAIT_L(0); PG8_MMA(0, 0, At, B0); PG8_BAR; PG8_SCHED;
            PG8_LDB(B1, 0, 1); PG8_STAGE(PG8_SB(0, 0), b2, voffB);
            PG8_BAR; PG8_WAIT_L(0); PG8_MMA(0, 1, At, B1); PG8_BAR;
            PG8_LDA(At, 0, 1); PG8_STAGE(PG8_SA(0, 0), a2, voffA);
            PG8_BAR; PG8_WAIT_L(0); PG8_MMA(1, 0, At, B0); PG8_BAR; PG8_SCHED;
            PG8_STAGE(PG8_SB(0, 1), b2 + hstep, voffB);
            PG8_WAIT_V(6); PG8_BAR; PG8_MMA(1, 1, At, B1); PG8_BAR;
            PG8_LDB(B0, 1, 0); PG8_SCHED; PG8_LDA(At, 1, 0); PG8_STAGE(PG8_SA(0, 1), a2 + hstep, voffA);
            PG8_WAIT_L(8); PG8_BAR; PG8_WAIT_L(0); PG8_MMA(0, 0, At, B0); PG8_BAR; PG8_SCHED;
            PG8_LDB(B1, 1, 1); PG8_STAGE(PG8_SB(1, 0), b3, voffB);
            PG8_BAR; PG8_WAIT_L(0); PG8_MMA(0, 1, At, B1); PG8_BAR;
            PG8_LDA(At, 1, 1); PG8_STAGE(PG8_SA(1, 0), a3, voffA);
            PG8_BAR; PG8_WAIT_L(0); PG8_MMA(1, 0, At, B0); PG8_BAR; PG8_SCHED;
            PG8_STAGE(PG8_SB(1, 1), b3 + hstep, voffB);
            PG8_WAIT_V(6); PG8_BAR; PG8_MMA(1, 1, At, B1); PG8_BAR;
            }
        }
        if constexpr (ALIGN_EPI) { if (wr == 0) PG8_BAR; }
        if constexpr (!Epi::AFTER_DRAIN) { E(acc, cur, wr, wc, fr, fq); S.done(cur); }
        if (!has_next) break;
#pragma unroll
        for (int a = 0; a < 2; ++a)
#pragma unroll
            for (int b = 0; b < 2; ++b)
#pragma unroll
                for (int m = 0; m < 4; ++m)
#pragma unroll
                    for (int n = 0; n < 2; ++n) acc[a][b][m][n] = (f32x4){0.f, 0.f, 0.f, 0.f};
        cur = nxt; cA = nA; cB = nB; ++ui;
        if constexpr (ALIGN_EPI) { if (wr == 1) PG8_BAR; }
    }
    PG8_WAIT_V(0);
    if constexpr (!ALIGN_EPI) { if (wr == 0) PG8_BAR; }
    PG8_BAR;
    if constexpr (Epi::AFTER_DRAIN) { E.fused(acc, cur, wr, wc, fr, fq, lds, wid, lane); S.done(cur); }
#undef PG8_SA
#undef PG8_SB
#undef PG8_STAGE
#undef PG8_LDA
#undef PG8_LDB
#undef PG8_MMA
#undef PG8_WAIT_V
#undef PG8_WAIT_L
#undef PG8_BAR
#undef PG8_SCHED
}
}

typedef unsigned short bf16;
#define LAS __attribute__((address_space(3)))
#define GAS __attribute__((address_space(1)))
typedef float f32x4 __attribute__((ext_vector_type(4)));
typedef float f32x16 __attribute__((ext_vector_type(16)));
typedef float f32x2_t __attribute__((ext_vector_type(2)));
typedef __bf16 bf16x2_t __attribute__((ext_vector_type(2)));
typedef short bf16x8 __attribute__((ext_vector_type(8)));
typedef short s16x4 __attribute__((ext_vector_type(4)));
typedef unsigned u32x4 __attribute__((ext_vector_type(4)));
typedef unsigned u32x2 __attribute__((ext_vector_type(2)));

constexpr int T = 16384, D = 1024, SEQ = 4096, NBATCH = 4, DFF = 2816, DEPTH = 4, NIN = 6400, DIN = 6304;
constexpr int NTHREADS = 512, NWAVES = 8;
constexpr float EPS = 1e-6f;
constexpr float QSCALE_MLA = 0.14724498f;
constexpr float QSCALE_MEM = 0.12751743f;

constexpr size_t MiB = 1u << 20;
constexpr size_t WT_W1IN = 0;
constexpr size_t WT_W1OUT = WT_W1IN + (size_t)5632 * 1024 * 2;
constexpr size_t WT_WIN = WT_W1OUT + (size_t)1024 * 2816 * 2;
constexpr size_t WT_WUQ = WT_WIN + (size_t)NIN * 1024 * 2;
constexpr size_t WT_WUKV = WT_WUQ + (size_t)768 * 384 * 2;
constexpr size_t WT_WOMLA = WT_WUKV + (size_t)1024 * 256 * 2;
constexpr size_t WT_WOHG = WT_WOMLA + (size_t)1024 * 512 * 2;
constexpr size_t WT_WOMEM = WT_WOHG + (size_t)1024 * 512 * 2;
constexpr size_t WT_WMEMKV = WT_WOMEM + (size_t)1024 * 512 * 2;
constexpr size_t WT_WOUT = WT_WMEMKV + (size_t)4 * 1024 * 1024 * 2;
constexpr size_t WT_W2IN = WT_WOUT + (size_t)1024 * 1024 * 2;
constexpr size_t WT_W2OUT = WT_W2IN + (size_t)5632 * 1024 * 2;
constexpr size_t WT_END = WT_W2OUT + (size_t)1024 * 2816 * 2;
static_assert(WT_END <= 60 * MiB, "weights");
constexpr size_t WS_XB = 60 * MiB;
constexpr size_t WS_SSQ = WS_XB + 32 * MiB;
constexpr size_t WS_SSQQ = WS_SSQ + 1 * MiB;
constexpr size_t WS_SSQKV = WS_SSQQ + 1 * MiB;
constexpr size_t WS_COS = WS_SSQKV + 1 * MiB;
constexpr size_t WS_SIN = WS_COS + 1 * MiB;
constexpr size_t WS_LBS = WS_SIN + 1 * MiB;
constexpr size_t WS_MEMB = WS_LBS + 65536;
constexpr size_t WS_MEMRSTD = WS_MEMB + 2 * MiB;
constexpr size_t WS_MK = WS_MEMRSTD + 65536;
constexpr size_t WS_MVT = WS_MK + 4 * MiB;
constexpr size_t WS_DEC = WS_MVT + 4 * MiB;
constexpr size_t WS_MIX = WS_DEC + 1 * MiB;
constexpr size_t WS_CQ = WS_MIX;
constexpr size_t WS_CKV = WS_CQ + 12 * MiB;
constexpr size_t WS_KR = WS_CKV + 8 * MiB;
constexpr size_t WS_HQ = WS_KR + 1 * MiB;
constexpr size_t WS_GG = WS_HQ + 16 * MiB;
constexpr size_t WS_HK = WS_GG + 32 * MiB;
constexpr size_t WS_HV = WS_HK + 16 * MiB;
constexpr size_t WS_HGT = WS_HV + 16 * MiB;
constexpr size_t WS_MQ = WS_HGT + 16 * MiB;
constexpr size_t WS_GATES = WS_MQ + 16 * MiB;
constexpr size_t WS_Q = WS_GATES + 96 * MiB;
constexpr size_t WS_KC = WS_Q + 24 * MiB;
constexpr size_t WS_VT = WS_KC + 24 * MiB;
constexpr size_t WS_LT = WS_VT + 16 * MiB;
constexpr size_t WS_AO = WS_LT + 64 * MiB;
constexpr size_t WS_CTL = WS_AO + 16 * MiB;
constexpr size_t CTL_BYTES = 16384;
constexpr size_t WS_END = WS_CTL + 65536;
constexpr size_t WS_HO = WS_CQ;
constexpr size_t WS_MERGED = WS_GG;
constexpr size_t WS_MO = WS_Q;
constexpr size_t WS_H = WS_MIX;
static_assert(WS_H + (size_t)T * DFF * 2 <= WS_END, "h overlay");

constexpr int LDS_BYTES = 147456;
#ifndef REP_CONV
#define REP_CONV 1
#endif
#ifndef REP_P1
#define REP_P1 1
#endif
#ifndef REP_P3
#define REP_P3 1
#endif
#ifndef REP_MLA
#define REP_MLA 1
#endif
#ifndef REP_P6
#define REP_P6 1
#endif

DI unsigned pk2(float lo, float hi) { f32x2_t v = {lo, hi}; bf16x2_t b = __builtin_convertvector(v, bf16x2_t); return __builtin_bit_cast(unsigned, b); }
DI u32x4 pk8(const float* v) { u32x4 w; w.x = pk2(v[0], v[1]); w.y = pk2(v[2], v[3]); w.z = pk2(v[4], v[5]); w.w = pk2(v[6], v[7]); return w; }
DI float bflo(unsigned w) { return __uint_as_float(w << 16); }
DI float bfhi(unsigned w) { return __uint_as_float(w & 0xffff0000u); }
DI void unpk8(u32x4 w, float* v) { v[0] = bflo(w.x); v[1] = bfhi(w.x); v[2] = bflo(w.y); v[3] = bfhi(w.y); v[4] = bflo(w.z); v[5] = bfhi(w.z); v[6] = bflo(w.w); v[7] = bfhi(w.w); }
DI float bf2f(bf16 b) { return __uint_as_float(((unsigned)b) << 16); }
DI bf16 f2bf(float f) { return (bf16)(pk2(f, 0.f) & 0xffffu); }
DI float sigmoidf_(float z) { return __builtin_amdgcn_rcpf(1.0f + __expf(-z)); }
DI float wave_sum(float v) {
#pragma unroll
    for (int o = 1; o < 64; o <<= 1) v += __shfl_xor(v, o);
    return v;
}
DI float rowsum_q(const float* p, int fq, int nq) {
    float s = 0.f;
    if (fq < nq) { const f32x4 a = *(const f32x4*)(p + 4 * fq); s = (a.x + a.y) + (a.z + a.w); }
    s += __shfl_xor(s, 16); s += __shfl_xor(s, 32);
    return s;
}
DI void rstd8(const float* ssq, int stride, int nq, float inv_n, float post, int rowb, int fq, float (&rs)[8]) {
    f32x4 q[8];
#pragma unroll
    for (int i = 0; i < 8; ++i) q[i] = *(const f32x4*)(ssq + (size_t)(rowb + (i >> 2) * 128 + (i & 3) * 16) * stride + 4 * fq);
    const float keep = fq < nq ? 1.0f : 0.0f;
#pragma unroll
    for (int i = 0; i < 8; ++i) { float t = ((q[i].x + q[i].y) + (q[i].z + q[i].w)) * keep; t += __shfl_xor(t, 16); t += __shfl_xor(t, 32); rs[i] = __builtin_amdgcn_rsqf(t * inv_n + EPS) * post; }
}
DI float sum16(const float* p) {
    const f32x4 a = *(const f32x4*)p, b = *(const f32x4*)(p + 4), c = *(const f32x4*)(p + 8), d = *(const f32x4*)(p + 12);
    return ((a.x + a.y) + (a.z + a.w)) + ((b.x + b.y) + (b.z + b.w)) + ((c.x + c.y) + (c.z + c.w)) + ((d.x + d.y) + (d.z + d.w));
}

using pg8::Unit;
#define EPI_ARGS const f32x4 (&acc)[2][2][4][2], const Unit& u, int wr, int wc, int fr_in, int fq_in
#define EPI_OPAQUE int fr = fr_in, fq = fq_in; asm volatile("" : "+v"(fr), "+v"(fq));

struct EpiSwiglu {
    static constexpr bool PERM = true, AFTER_DRAIN = false;
    bf16* H; const float* ssq;
    DI void operator()(EPI_ARGS) const {
        EPI_OPAQUE
        const int rowb = u.pm * 256 + wr * 64 + fr;
        float rs[8]; rstd8(ssq, 16, 4, 1.0f / 1024.0f, 1.0f, rowb, fq, rs);
#pragma unroll
        for (int ai = 0; ai < 2; ++ai)
#pragma unroll
            for (int m = 0; m < 4; ++m) {
                const int row = rowb + ai * 128 + m * 16;
                const float r1 = rs[ai * 4 + m];
                float o[8];
#pragma unroll
                for (int n = 0; n < 2; ++n)
#pragma unroll
                    for (int j = 0; j < 4; ++j) { const float a = acc[ai][0][m][n][j] * r1, b = acc[ai][1][m][n][j] * r1; o[4 * n + j] = a * b * __builtin_amdgcn_rcpf(1.0f + __expf(-a)); }
                *(u32x4*)(H + (size_t)row * DFF + u.pn * 128 + 32 * wc + 8 * fq) = pk8(o);
            }
    }
};

struct EpiResid {
    static constexpr bool PERM = true, AFTER_DRAIN = false;
    float* X; bf16* XB; float* ssq; float scale;
    DI void operator()(EPI_ARGS) const {
        EPI_OPAQUE
        const int rowb = u.pm * 256 + wr * 64 + fr, colb = u.pn * 256 + 32 * wc + 8 * fq;
#pragma unroll
        for (int ai = 0; ai < 2; ++ai) {
            f32x4 xv[4][2][2];
#pragma unroll
            for (int m = 0; m < 4; ++m)
#pragma unroll
                for (int bj = 0; bj < 2; ++bj) { const float* xp = X + (size_t)(rowb + ai * 128 + m * 16) * D + colb + 128 * bj; xv[m][bj][0] = *(const f32x4*)xp; xv[m][bj][1] = *(const f32x4*)(xp + 4); }
#pragma unroll
            for (int m = 0; m < 4; ++m) {
                const int row = rowb + ai * 128 + m * 16;
                float ss = 0.f;
#pragma unroll
                for (int bj = 0; bj < 2; ++bj) {
                    const size_t off = (size_t)row * D + colb + 128 * bj;
                    const f32x4 x0 = xv[m][bj][0] + scale * acc[ai][bj][m][0], x1 = xv[m][bj][1] + scale * acc[ai][bj][m][1];
                    *(f32x4*)(X + off) = x0; *(f32x4*)(X + off + 4) = x1;
                    float o[8] = {x0.x, x0.y, x0.z, x0.w, x1.x, x1.y, x1.z, x1.w};
                    *(u32x4*)(XB + off) = pk8(o);
#pragma unroll
                    for (int e = 0; e < 8; ++e) ss += o[e] * o[e];
                }
                ss += __shfl_xor(ss, 16); ss += __shfl_xor(ss, 32);
                if (fq == 0) ssq[(size_t)row * 16 + u.pn * 4 + wc] = ss;
            }
        }
    }
};

struct EpiWin {
    static constexpr bool PERM = true, AFTER_DRAIN = false;
    unsigned char* ws; const float* lbs  ;
    DI void operator()(EPI_ARGS) const {
        EPI_OPAQUE
        const float* ssq = (const float*)(ws + WS_SSQ); const float* cosT = (const float*)(ws + WS_COS); const float* sinT = (const float*)(ws + WS_SIN);
        bf16* CQ = (bf16*)(ws + WS_CQ); bf16* CKV = (bf16*)(ws + WS_CKV); bf16* KC = (bf16*)(ws + WS_KC); bf16* HQ = (bf16*)(ws + WS_HQ); bf16* HK = (bf16*)(ws + WS_HK); bf16* HV = (bf16*)(ws + WS_HV);
        bf16* HGT = (bf16*)(ws + WS_HGT); bf16* MQ = (bf16*)(ws + WS_MQ); bf16* GATES = (bf16*)(ws + WS_GATES); float* GG = (float*)(ws + WS_GG); float* SSQQ = (float*)(ws + WS_SSQQ); float* SSQKV = (float*)(ws + WS_SSQKV);
        const int rowb = u.pm * 256 + wr * 64 + fr;
        float rs8[8]; rstd8(ssq, 16, 4, 1.0f / 1024.0f, 1.0f, rowb, fq, rs8);
#pragma unroll
        for (int ai = 0; ai < 2; ++ai)
#pragma unroll
            for (int m = 0; m < 4; ++m) {
                const int row = rowb + ai * 128 + m * 16;
                const float rs = rs8[ai * 4 + m];
#pragma unroll
                for (int bj = 0; bj < 2; ++bj) {
                    const int hh = 2 * u.pn + bj, cw = 32 * wc + 8 * fq;
                    float v[8];
#pragma unroll
                    for (int n = 0; n < 2; ++n)
#pragma unroll
                        for (int j = 0; j < 4; ++j) v[4 * n + j] = acc[ai][bj][m][n][j] * rs;
                    if (hh < 5) {
                        float ss = 0.f;
#pragma unroll
                        for (int e = 0; e < 8; ++e) ss += v[e] * v[e];
                        ss += __shfl_xor(ss, 16); ss += __shfl_xor(ss, 32);
                        if (hh < 3) { *(u32x4*)(CQ + (size_t)row * 384 + hh * 128 + cw) = pk8(v); if (fq == 0) SSQQ[(size_t)row * 16 + hh * 4 + wc] = ss; }
                        else { *(u32x4*)(CKV + (size_t)row * 256 + (hh - 3) * 128 + cw) = pk8(v); if (fq == 0) SSQKV[(size_t)row * 8 + (hh - 3) * 4 + wc] = ss; }
                    } else if (hh == 5) {
                        if (wc == 0) {
                            const f32x4 c = *(const f32x4*)(cosT + (size_t)row * 16 + 4 * fq), s = *(const f32x4*)(sinT + (size_t)row * 16 + 4 * fq);
                            u32x4 o;
                            o.x = pk2(v[0] * c.x - v[1] * s.x, v[1] * c.x + v[0] * s.x); o.y = pk2(v[2] * c.y - v[3] * s.y, v[3] * c.y + v[2] * s.y);
                            o.z = pk2(v[4] * c.z - v[5] * s.z, v[5] * c.z + v[4] * s.z); o.w = pk2(v[6] * c.w - v[7] * s.w, v[7] * c.w + v[6] * s.w);
                            bf16* kp = KC + ((size_t)(row >> 12) * 8 * SEQ + (row & 4095)) * 96 + 64 + 8 * fq;
#pragma unroll
                            for (int hd = 0; hd < 8; ++hd) *(u32x4*)(kp + (size_t)hd * SEQ * 96) = o;
                        }
                    } else if (hh < 10) {
#pragma unroll
                        for (int e = 0; e < 8; ++e) v[e] = v[e] * sigmoidf_(v[e]);
                        *(u32x4*)(HQ + (size_t)row * 512 + (hh - 6) * 128 + cw) = pk8(v);
                    } else if (hh < 14) {
                        const int c0 = (hh - 10) * 128 + cw;
                        const f32x4 l0 = *(const f32x4*)(lbs + c0), l1 = *(const f32x4*)(lbs + c0 + 4);
                        const float lb[8] = {l0.x, l0.y, l0.z, l0.w, l1.x, l1.y, l1.z, l1.w};
                        float g[8], k[8];
#pragma unroll
                        for (int e = 0; e < 8; ++e) { const float z = fminf(fmaxf(v[e], -60.f), 60.f); const float sg = __builtin_amdgcn_rcpf(1.0f + __expf(-z));
                            g[e] = __logf(lb[e] + (1.0f - lb[e]) * sg); k[e] = (1.0f - lb[e]) * __builtin_amdgcn_rcpf(1.0f + __expf(z)); }
                        *(f32x4*)(GG + (size_t)row * 512 + c0) = (f32x4){g[0], g[1], g[2], g[3]}; *(f32x4*)(GG + (size_t)row * 512 + c0 + 4) = (f32x4){g[4], g[5], g[6], g[7]};
                        *(u32x4*)(HK + (size_t)row * 512 + c0) = pk8(k);
                    } else if (hh < 18) {
                        *(u32x4*)(HV + (size_t)row * 512 + (hh - 14) * 128 + cw) = pk8(v);
                    } else if (hh < 22) {
#pragma unroll
                        for (int e = 0; e < 8; ++e) v[e] = v[e] * sigmoidf_(v[e]);
                        *(u32x4*)(HGT + (size_t)row * 512 + (hh - 18) * 128 + cw) = pk8(v);
                    } else if (hh < 26) {
#pragma unroll
                        for (int e = 0; e < 8; ++e) v[e] *= QSCALE_MEM;
                        *(u32x4*)(MQ + (size_t)row * 512 + (hh - 22) * 128 + cw) = pk8(v);
                    } else {
                        const int c0 = (hh - 26) * 128 + cw, br = c0 >> 10, cc = c0 & 1023;
#pragma unroll
                        for (int e = 0; e < 8; ++e) v[e] = sigmoidf_(v[e]);
                        *(u32x4*)(GATES + ((size_t)br * T + row) * 1024 + cc) = pk8(v);
                    }
                }
            }
    }
};

struct EpiQ {
    static constexpr bool PERM = true, AFTER_DRAIN = false;
    bf16* Q;
    DI void operator()(EPI_ARGS) const {
        EPI_OPAQUE
#pragma unroll
        for (int ai = 0; ai < 2; ++ai)
#pragma unroll
            for (int m = 0; m < 4; ++m) {
                const int row = u.pm * 256 + ai * 128 + wr * 64 + m * 16 + fr;
#pragma unroll
                for (int bj = 0; bj < 2; ++bj) {
                    float v[8];
#pragma unroll
                    for (int n = 0; n < 2; ++n)
#pragma unroll
                        for (int j = 0; j < 4; ++j) v[4 * n + j] = acc[ai][bj][m][n][j];
                    *(u32x4*)(Q + (size_t)row * 768 + u.pn * 256 + 128 * bj + 32 * wc + 8 * fq) = pk8(v);
                }
            }
    }
};

struct EpiKV {
    static constexpr bool PERM = true, AFTER_DRAIN = false;
    bf16* KC; bf16* VT; const float* ssqkv;
    DI void operator()(EPI_ARGS) const {
        EPI_OPAQUE
        float rs8[8]; rstd8(ssqkv, 8, 2, 1.0f / 256.0f, 1.0f, u.pm * 256 + wr * 64 + fr, fq, rs8);
#pragma unroll
        for (int ai = 0; ai < 2; ++ai)
#pragma unroll
            for (int m = 0; m < 4; ++m) {
                const int row = u.pm * 256 + ai * 128 + wr * 64 + m * 16 + fr, b = row >> 12, s = row & 4095;
                const float rs = rs8[ai * 4 + m];
#pragma unroll
                for (int bj = 0; bj < 2; ++bj) {
                    const int c0 = u.pn * 256 + 128 * bj + 32 * wc + 8 * fq;
                    float v[8];
#pragma unroll
                    for (int n = 0; n < 2; ++n)
#pragma unroll
                        for (int j = 0; j < 4; ++j) v[4 * n + j] = acc[ai][bj][m][n][j] * rs;
                    if (c0 < 512) {
                        const int hd = c0 >> 6, d = c0 & 63;
                        bf16* kp = KC + ((size_t)(b * 8 + hd) * SEQ + s) * 96;
                        *(u32x4*)(kp + d) = pk8(v);
                    } else {
                        const int c = c0 - 512, hd = c >> 6, dv = c & 63;
                        bf16* vp = VT + ((size_t)(b * 8 + hd) * 64 + dv) * SEQ + s;
#pragma unroll
                        for (int e = 0; e < 8; ++e) vp[(size_t)e * SEQ] = f2bf(v[e]);
                    }
                }
            }
    }
};

struct EpiMemKV {
    static constexpr bool PERM = true, AFTER_DRAIN = false;
    bf16* MK; bf16* MVT; const float* rstd;
    DI void operator()(EPI_ARGS) const {
        EPI_OPAQUE
#pragma unroll
        for (int ai = 0; ai < 2; ++ai)
#pragma unroll
            for (int m = 0; m < 4; ++m) {
                const int row = u.pm * 256 + ai * 128 + wr * 64 + m * 16 + fr, b = row >> 8, mm = row & 255;
                const float rs = rstd[row];
#pragma unroll
                for (int bj = 0; bj < 2; ++bj) {
                    const int c0 = u.pn * 256 + 128 * bj + 32 * wc + 8 * fq;
                    float v[8];
#pragma unroll
                    for (int n = 0; n < 2; ++n)
#pragma unroll
                        for (int j = 0; j < 4; ++j) v[4 * n + j] = acc[ai][bj][m][n][j] * rs;
                    if (c0 < 512) { const int hd = c0 >> 7, d = c0 & 127; *(u32x4*)(MK + ((size_t)(b * 4 + hd) * 256 + mm) * 128 + d) = pk8(v); }
                    else { const int c = c0 - 512, hd = c >> 7, dv = c & 127; bf16* vp = MVT + ((size_t)(b * 4 + hd) * 128 + dv) * 256 + mm;
#pragma unroll
                        for (int e = 0; e < 8; ++e) vp[(size_t)e * 256] = f2bf(v[e]); }
                }
            }
    }
};

struct EpiBranch {
    static constexpr bool PERM = true, AFTER_DRAIN = false;
    bf16* MG; const bf16* gate; int first;
    DI void operator()(EPI_ARGS) const {
        EPI_OPAQUE
        const int rowb = u.pm * 256 + wr * 64 + fr, colb = u.pn * 256 + 32 * wc + 8 * fq;
#pragma unroll
        for (int ai = 0; ai < 2; ++ai) {
            u32x4 gv[4][2], pv[4][2];
#pragma unroll
            for (int m = 0; m < 4; ++m)
#pragma unroll
                for (int bj = 0; bj < 2; ++bj) { const size_t off = (size_t)(rowb + ai * 128 + m * 16) * 1024 + colb + 128 * bj;
                    gv[m][bj] = *(const u32x4*)(gate + off); pv[m][bj] = (u32x4){0, 0, 0, 0}; if (!first) pv[m][bj] = *(const u32x4*)(MG + off); }
#pragma unroll
            for (int m = 0; m < 4; ++m)
#pragma unroll
                for (int bj = 0; bj < 2; ++bj) {
                    const size_t off = (size_t)(rowb + ai * 128 + m * 16) * 1024 + colb + 128 * bj;
                    float g[8], o[8];
                    unpk8(gv[m][bj], g); unpk8(pv[m][bj], o);
#pragma unroll
                    for (int n = 0; n < 2; ++n)
#pragma unroll
                        for (int j = 0; j < 4; ++j) o[4 * n + j] += g[4 * n + j] * acc[ai][bj][m][n][j];
                    *(u32x4*)(MG + off) = pk8(o);
                }
        }
    }
};

template <class Epi> DI void run_gemm(LAS unsigned char* lds, const bf16* A, const bf16* Bt, int M, int N, int K, int rot, const Epi& E) {
    int Kv = K, Nv = N, Mv = M; asm volatile("" : "+s"(Kv), "+s"(Nv), "+s"(Mv));
    pg8::Gemm g{A, Bt, Mv, Nv, Kv}; pg8::StaticOrder S; const int G = (int)gridDim.x;
    S.init(Mv, Nv, G, (int)((blockIdx.x + (unsigned)G - (unsigned)rot) % (unsigned)G));
    pg8::gemm_phase<Epi, pg8::StaticOrder, true, true>(lds, g, S, E);
}

#define MFMA32(a, b, c) __builtin_amdgcn_mfma_f32_32x32x16_bf16((a), (b), (c), 0, 0, 0)
template <int DQK, int DV, bool CAUSAL>
DI void attn_item(LAS unsigned char* lds, const bf16* Qp, int qstride, const bf16* Kp, const bf16* VTp, int vt_stride, bf16* Op, int ostride, int q0, int nkeys,
                  const float* ssqq, const float* cosT, const float* sinT) {
    constexpr int KROW = DQK * 2 + 16, VROW = 144, KBYTES = 64 * KROW, VBYTES = DV * VROW, BUF = KBYTES + VBYTES;
    constexpr int NCK = 64 * DQK / 8, NCV = DV * 8, KS = DQK / 16, NDB = DV / 32;
    constexpr int CPR = DQK / 8;
    int tid_o = threadIdx.x; asm volatile("" : "+v"(tid_o)); const int tid = tid_o, wid = __builtin_amdgcn_readfirstlane(tid >> 6), lane = tid & 63, r = lane & 31, h = lane >> 5;
    const int ntiles = CAUSAL ? (q0 + 256) / 64 : nkeys / 64;
    const int qlo = q0 + wid * 32;
    bf16x8 qf[KS];
    { const bf16* qr = Qp + (size_t)(wid * 32 + r) * qstride + 8 * h;
#pragma unroll
      for (int ks = 0; ks < KS; ++ks) qf[ks] = *(const bf16x8*)(qr + 16 * ks);
      if (CAUSAL) {
          const float* sp = ssqq + (size_t)(wid * 32 + r) * 16;
          const f32x4 a = *(const f32x4*)sp, b = *(const f32x4*)(sp + 4), c = *(const f32x4*)(sp + 8);
          const float rs = rsqrtf((((a.x + a.y) + (a.z + a.w)) + ((b.x + b.y) + (b.z + b.w)) + ((c.x + c.y) + (c.z + c.w))) * (1.0f / 384.0f) + EPS) * QSCALE_MLA;
#pragma unroll
          for (int ks = 0; ks < KS; ++ks) {
              float v[8]; unpk8(__builtin_bit_cast(u32x4, qf[ks]), v);
              if (ks >= 4) {
                  const int i0 = 8 * (ks - 4) + 4 * h;
                  const f32x4 cs = *(const f32x4*)(cosT + (size_t)(wid * 32 + r) * 16 + i0), sn = *(const f32x4*)(sinT + (size_t)(wid * 32 + r) * 16 + i0);
                  const float t0 = v[0], t1 = v[1], t2 = v[2], t3 = v[3], t4 = v[4], t5 = v[5], t6 = v[6], t7 = v[7];
                  v[0] = t0 * cs.x - t1 * sn.x; v[1] = t1 * cs.x + t0 * sn.x; v[2] = t2 * cs.y - t3 * sn.y; v[3] = t3 * cs.y + t2 * sn.y;
                  v[4] = t4 * cs.z - t5 * sn.z; v[5] = t5 * cs.z + t4 * sn.z; v[6] = t6 * cs.w - t7 * sn.w; v[7] = t7 * cs.w + t6 * sn.w;
              }
#pragma unroll
              for (int e = 0; e < 8; ++e) v[e] *= rs;
              qf[ks] = __builtin_bit_cast(bf16x8, pk8(v));
          }
      } }
    f32x16 o[NDB];
#pragma unroll
    for (int db = 0; db < NDB; ++db)
#pragma unroll
        for (int i = 0; i < 16; ++i) o[db][i] = 0.f;
    float mrun = -1e30f, lrun = 0.f;
    const int kc0 = tid, kc1 = tid + 512; const bool k1on = kc1 < NCK;
    const int kr0 = kc0 / CPR, kcc0 = kc0 % CPR, kr1 = kc1 / CPR, kcc1 = kc1 % CPR;
    const int vc0 = tid, vc1 = tid + 512; const bool v1on = vc1 < NCV;
    u32x4 pk0, pk1 = {0, 0, 0, 0}, pv0, pv1 = {0, 0, 0, 0};
    const GAS u32x4* Kg = (const GAS u32x4*)Kp;
#define ATT_GLOAD(t_) do { pk0 = Kg[(size_t)(t_) * NCK + kc0]; if (k1on) pk1 = Kg[(size_t)(t_) * NCK + kc1]; \
        pv0 = *(const GAS u32x4*)(VTp + (size_t)(vc0 >> 3) * vt_stride + (t_) * 64 + (vc0 & 7) * 8); \
        if (v1on) pv1 = *(const GAS u32x4*)(VTp + (size_t)(vc1 >> 3) * vt_stride + (t_) * 64 + (vc1 & 7) * 8); } while (0)
#define ATT_LSTORE(buf_) do { LAS unsigned char* kb_ = lds + (buf_) * BUF; LAS unsigned char* vb_ = kb_ + KBYTES; \
        *(LAS u32x4*)(kb_ + kr0 * KROW + kcc0 * 16) = pk0; if (k1on) *(LAS u32x4*)(kb_ + kr1 * KROW + kcc1 * 16) = pk1; \
        *(LAS u32x4*)(vb_ + (vc0 >> 3) * VROW + (vc0 & 7) * 16) = pv0; if (v1on) *(LAS u32x4*)(vb_ + (vc1 >> 3) * VROW + (vc1 & 7) * 16) = pv1; } while (0)
    ATT_GLOAD(0); ATT_LSTORE(0);
    __syncthreads();
    for (int t = 0; t < ntiles; ++t) {
        const bool more = t + 1 < ntiles;
        if (more) ATT_GLOAD(t + 1);
        const bool active = !CAUSAL || (64 * t <= qlo + 31);
        if (active) {
            LAS unsigned char* kb = lds + (t & 1) * BUF; LAS unsigned char* vb = kb + KBYTES;
            f32x16 s0, s1;
#pragma unroll
            for (int i = 0; i < 16; ++i) { s0[i] = 0.f; s1[i] = 0.f; }
#pragma unroll
            for (int ks = 0; ks < KS; ++ks) {
                const bf16x8 k0 = *(const LAS bf16x8*)(kb + r * KROW + 32 * ks + 16 * h);
                const bf16x8 k1 = *(const LAS bf16x8*)(kb + (32 + r) * KROW + 32 * ks + 16 * h);
                s0 = MFMA32(k0, qf[ks], s0); s1 = MFMA32(k1, qf[ks], s1);
            }
            if (CAUSAL && (64 * t + 63 > qlo)) {
                const int qpos = qlo + r, kbase = 64 * t + 4 * h;
#pragma unroll
                for (int i = 0; i < 16; ++i) { const int key = kbase + (i & 3) + 8 * (i >> 2);
                    if (key > qpos) s0[i] = -1e30f; if (key + 32 > qpos) s1[i] = -1e30f; }
            }
            float mx = s0[0];
#pragma unroll
            for (int i = 1; i < 16; ++i) mx = fmaxf(mx, s0[i]);
#pragma unroll
            for (int i = 0; i < 16; ++i) mx = fmaxf(mx, s1[i]);
            mx = fmaxf(mx, __shfl_xor(mx, 32));
            const float mnew = fmaxf(mrun, mx), alpha = __builtin_amdgcn_exp2f(mrun - mnew);
            mrun = mnew;
            float ps = 0.f;
#pragma unroll
            for (int i = 0; i < 16; ++i) { s0[i] = __builtin_amdgcn_exp2f(s0[i] - mnew); s1[i] = __builtin_amdgcn_exp2f(s1[i] - mnew); ps += s0[i] + s1[i]; }
            lrun = lrun * alpha + ps;
#pragma unroll
            for (int db = 0; db < NDB; ++db)
#pragma unroll
                for (int i = 0; i < 16; ++i) o[db][i] *= alpha;
#pragma unroll
            for (int kb2 = 0; kb2 < 2; ++kb2)
#pragma unroll
                for (int s = 0; s < 2; ++s) {
                    u32x4 pw;
                    if (kb2 == 0) { pw.x = pk2(s0[8 * s], s0[8 * s + 1]); pw.y = pk2(s0[8 * s + 2], s0[8 * s + 3]); pw.z = pk2(s0[8 * s + 4], s0[8 * s + 5]); pw.w = pk2(s0[8 * s + 6], s0[8 * s + 7]); }
                    else { pw.x = pk2(s1[8 * s], s1[8 * s + 1]); pw.y = pk2(s1[8 * s + 2], s1[8 * s + 3]); pw.z = pk2(s1[8 * s + 4], s1[8 * s + 5]); pw.w = pk2(s1[8 * s + 6], s1[8 * s + 7]); }
                    const bf16x8 pf = __builtin_bit_cast(bf16x8, pw);
                    const int koff = (32 * kb2 + 16 * s + 4 * h) * 2;
#pragma unroll
                    for (int db = 0; db < NDB; ++db) {
                        const u32x2 lo = *(const LAS u32x2*)(vb + (32 * db + r) * VROW + koff), hi = *(const LAS u32x2*)(vb + (32 * db + r) * VROW + koff + 16);
                        u32x4 vw; vw.x = lo.x; vw.y = lo.y; vw.z = hi.x; vw.w = hi.y;
                        o[db] = MFMA32(__builtin_bit_cast(bf16x8, vw), pf, o[db]);
                    }
                }
        }
        if (more) ATT_LSTORE((t + 1) & 1);
        __syncthreads();
    }
    const float ltot = lrun + __shfl_xor(lrun, 32), inv = 1.0f / ltot;
    bf16* orow = Op + (size_t)(wid * 32 + r) * ostride + 4 * h;
#pragma unroll
    for (int db = 0; db < NDB; ++db)
#pragma unroll
        for (int g = 0; g < 4; ++g) {
            u32x2 w; w.x = pk2(o[db][4 * g] * inv, o[db][4 * g + 1] * inv); w.y = pk2(o[db][4 * g + 2] * inv, o[db][4 * g + 3] * inv);
            *(u32x2*)(orow + 32 * db + 8 * g) = w;
        }
}

template <int KSTEPS> DI void lds_mma(f32x16& c, const LAS unsigned char* A, int astride, const LAS unsigned char* Bt, int bstride, int r, int h) {
#pragma unroll
    for (int s = 0; s < KSTEPS; ++s) {
        const bf16x8 a = *(const LAS bf16x8*)(A + r * astride + 32 * s + 16 * h);
        const bf16x8 b = *(const LAS bf16x8*)(Bt + r * bstride + 32 * s + 16 * h);
        c = MFMA32(a, b, c);
    }
}

DI void hgrn_b1(LAS unsigned char* lds, int ch, float* GG, const bf16* HK, const bf16* HV, float* LT, float* DEC) {
    int tid_o = threadIdx.x; asm volatile("" : "+v"(tid_o)); const int tid = tid_o, wid = __builtin_amdgcn_readfirstlane(tid >> 6), lane = tid & 63, r = lane & 31, h = lane >> 5;
    const int bh = ch >> 6, c = ch & 63, b = bh >> 2, hd = bh & 3;
    const size_t t0 = (size_t)b * SEQ + c * 64;
    const int k = tid & 127, seg = tid >> 7;
    LAS float* segsum = (LAS float*)lds;
    LAS unsigned char* kdT = lds + 2048;
    LAS unsigned char* vT = kdT + 128 * 144;
    float g[16]; float run = 0.f;
    float* gp = GG + (t0 + seg * 16) * 512 + hd * 128 + k;
#pragma unroll
    for (int i = 0; i < 16; ++i) { run += gp[(size_t)i * 512]; g[i] = run; }
    segsum[seg * 128 + k] = run;
    __syncthreads();
    float off = 0.f, tot = 0.f;
#pragma unroll
    for (int s = 0; s < 4; ++s) { const float v = segsum[s * 128 + k]; if (s < seg) off += v; tot += v; }
    const bf16* kp = HK + (t0 + seg * 16) * 512 + hd * 128 + k;
    const bf16* vp = HV + (t0 + seg * 16) * 512 + hd * 128 + k;
#pragma unroll
    for (int i = 0; i < 16; ++i) {
        const float G = g[i] + off; gp[(size_t)i * 512] = G;
        const float kd = bf2f(kp[(size_t)i * 512]) * __expf(tot - G);
        *(LAS bf16*)(kdT + k * 144 + (seg * 16 + i) * 2) = f2bf(kd);
        *(LAS bf16*)(vT + k * 144 + (seg * 16 + i) * 2) = vp[(size_t)i * 512];
    }
    if (seg == 0) DEC[(size_t)ch * 128 + k] = __expf(tot);
    __syncthreads();
    const int vb = wid >> 1;
#pragma unroll
    for (int q = 0; q < 2; ++q) {
        const int kb = (wid & 1) * 2 + q;
        f32x16 acc;
#pragma unroll
        for (int i = 0; i < 16; ++i) acc[i] = 0.f;
        lds_mma<4>(acc, vT + vb * 32 * 144, 144, kdT + kb * 32 * 144, 144, r, h);
        float* lp = LT + (size_t)ch * 16384 + (size_t)(vb * 32 + 4 * h) * 128 + kb * 32 + r;
#pragma unroll
        for (int i = 0; i < 16; ++i) lp[(size_t)((i & 3) + 8 * (i >> 2)) * 128] = acc[i];
    }
    __syncthreads();
}

DI void hgrn_b3(LAS unsigned char* lds, int ch, const float* GG, const bf16* HQ, const bf16* HK, const bf16* HV, const bf16* HGT, const float* LT, const float* onorm, bf16* HO) {
    constexpr int RS = 272;
    int tid_o = threadIdx.x; asm volatile("" : "+v"(tid_o)); const int tid = tid_o, wid = __builtin_amdgcn_readfirstlane(tid >> 6), lane = tid & 63, r = lane & 31, h = lane >> 5;
    const int bh = ch >> 6, c = ch & 63, b = bh >> 2, hd = bh & 3;
    const size_t t0 = (size_t)b * SEQ + c * 64;
    LAS unsigned char* qG = lds;
    LAS unsigned char* q1 = qG + 64 * RS;
    LAS unsigned char* kA0 = q1 + 32 * RS;
    LAS unsigned char* kA1 = kA0 + 32 * RS;
    LAS unsigned char* ST = kA1 + 64 * RS;
    LAS unsigned char* vT = ST + 128 * RS;
    LAS unsigned char* Am = vT + 128 * 144;
    {
        const int k8 = tid & 15;
        const float* g31p = GG + (t0 + 31) * 512 + hd * 128 + k8 * 8;
        const f32x4 ga = *(const f32x4*)g31p, gb = *(const f32x4*)(g31p + 4);
        const float g31[8] = {ga.x, ga.y, ga.z, ga.w, gb.x, gb.y, gb.z, gb.w};
#pragma unroll
        for (int pass = 0; pass < 2; ++pass) {
            const int t = (tid >> 4) + 32 * pass;
            const size_t off = (t0 + t) * 512 + hd * 128 + k8 * 8;
            const f32x4 a = *(const f32x4*)(GG + off), bq = *(const f32x4*)(GG + off + 4);
            const float G[8] = {a.x, a.y, a.z, a.w, bq.x, bq.y, bq.z, bq.w};
            float q[8], kk[8], o1[8], o2[8], o3[8];
            unpk8(*(const u32x4*)(HQ + off), q); unpk8(*(const u32x4*)(HK + off), kk);
#pragma unroll
            for (int e = 0; e < 8; ++e) o1[e] = q[e] * __expf(G[e]);
            *(LAS u32x4*)(qG + t * RS + k8 * 16) = pk8(o1);
            if (pass == 0) {
#pragma unroll
                for (int e = 0; e < 8; ++e) { o2[e] = kk[e] * __expf(fminf(-G[e], 80.f)); o3[e] = kk[e] * __expf(g31[e] - G[e]); }
                *(LAS u32x4*)(kA0 + t * RS + k8 * 16) = pk8(o2);
                *(LAS u32x4*)(kA1 + t * RS + k8 * 16) = pk8(o3);
            } else {
#pragma unroll
                for (int e = 0; e < 8; ++e) { o2[e] = q[e] * __expf(G[e] - g31[e]); o3[e] = kk[e] * __expf(fminf(g31[e] - G[e], 80.f)); }
                *(LAS u32x4*)(q1 + (t - 32) * RS + k8 * 16) = pk8(o2);
                *(LAS u32x4*)(kA1 + t * RS + k8 * 16) = pk8(o3);
            }
        }
        const float* lp = LT + (size_t)ch * 16384;
#pragma unroll
        for (int p = 0; p < 4; ++p) {
            const int idx = tid + 512 * p, v = idx >> 4, kk8 = idx & 15;
            const f32x4 a = *(const f32x4*)(lp + v * 128 + kk8 * 8), bq = *(const f32x4*)(lp + v * 128 + kk8 * 8 + 4);
            const float sv[8] = {a.x, a.y, a.z, a.w, bq.x, bq.y, bq.z, bq.w};
            *(LAS u32x4*)(ST + v * RS + kk8 * 16) = pk8(sv);
        }
        const int v = tid & 127, seg = tid >> 7;
        const bf16* vp = HV + (t0 + seg * 16) * 512 + hd * 128 + v;
#pragma unroll
        for (int i = 0; i < 16; ++i) *(LAS bf16*)(vT + v * 144 + (seg * 16 + i) * 2) = vp[(size_t)i * 512];
    }
    __syncthreads();
    if (wid < 3) {
        f32x16 a;
#pragma unroll
        for (int i = 0; i < 16; ++i) a[i] = 0.f;
        const int tb = wid == 0 ? 0 : 1, sb = wid == 2 ? 1 : 0;
        if (wid == 0) lds_mma<8>(a, qG, RS, kA0, RS, r, h);
        else lds_mma<8>(a, q1, RS, kA1 + sb * 32 * RS, RS, r, h);
#pragma unroll
        for (int i = 0; i < 16; ++i) { const int tl = (i & 3) + 8 * (i >> 2) + 4 * h; float val = a[i]; if (tb == sb && r > tl) val = 0.f;
            *(LAS bf16*)(Am + (tb * 32 + tl) * 144 + (sb * 32 + r) * 2) = f2bf(val); }
    } else if (wid == 3) {
#pragma unroll
        for (int i = 0; i < 16; ++i) { const int tl = (i & 3) + 8 * (i >> 2) + 4 * h; *(LAS bf16*)(Am + tl * 144 + (32 + r) * 2) = (bf16)0; }
    }
    __syncthreads();
    f32x16 acc;
#pragma unroll
    for (int i = 0; i < 16; ++i) acc[i] = 0.f;
    const int tb = wid >> 2, vb = wid & 3;
    lds_mma<8>(acc, qG + tb * 32 * RS, RS, ST + vb * 32 * RS, RS, r, h);
    lds_mma<4>(acc, Am + tb * 32 * 144, 144, vT + vb * 32 * 144, 144, r, h);
    __syncthreads();
    LAS float* Ost = (LAS float*)ST;
#pragma unroll
    for (int i = 0; i < 16; ++i) Ost[(tb * 32 + (i & 3) + 8 * (i >> 2) + 4 * h) * 132 + vb * 32 + r] = acc[i];
    __syncthreads();
    {
        const int t = tid >> 3, part = tid & 7;
        float ov[16]; float ss = 0.f;
#pragma unroll
        for (int q4 = 0; q4 < 4; ++q4) { const f32x4 x = *(const LAS f32x4*)(Ost + t * 132 + part * 16 + q4 * 4); ov[4 * q4] = x.x; ov[4 * q4 + 1] = x.y; ov[4 * q4 + 2] = x.z; ov[4 * q4 + 3] = x.w; }
#pragma unroll
        for (int e = 0; e < 16; ++e) ss += ov[e] * ov[e];
        ss += __shfl_xor(ss, 1); ss += __shfl_xor(ss, 2); ss += __shfl_xor(ss, 4);
        const float rs = rsqrtf(ss * (1.0f / 128.0f) + EPS);
        const size_t off = (t0 + t) * 512 + hd * 128 + part * 16;
        float gt[16];
        unpk8(*(const u32x4*)(HGT + off), gt); unpk8(*(const u32x4*)(HGT + off + 8), gt + 8);
#pragma unroll
        for (int e = 0; e < 16; ++e) ov[e] = ov[e] * rs * onorm[part * 16 + e] * gt[e];
        *(u32x4*)(HO + off) = pk8(ov); *(u32x4*)(HO + off + 8) = pk8(ov + 8);
    }
    __syncthreads();
}

DI int dest_row(int mode, int n) {
    if (mode == 0) return n;
    if (mode == 1) { const int j = n < DFF ? n : n - DFF; return (j >> 7) * 256 + (n < DFF ? 0 : 128) + (j & 127); }
    if (mode == 2) { if (n < 640) return n; if (n < 672) { const int j = n - 640; return 640 + (j < 16 ? 2 * j : 2 * (j - 16) + 1); } if (n < 3232) return 768 + (n - 672); return 3328 + (n - 3232); }
    const int hd = n / 96, w = n - hd * 96; if (w < 64) return n; const int j = w - 64; return hd * 96 + 64 + (j < 16 ? 2 * j : 2 * (j - 16) + 1);
}
DI void conv_item(const float* W, int K, int N, bf16* WT, const float* gain, int mode, int row_off, LAS float* scr, int item, int lane) {
    const int nblk = N / 32, kb = item / nblk, nb = item - kb * nblk, k0 = 64 * kb, n0 = 32 * nb;
    float wv[32];
    const float* wp = W + (size_t)(k0 + (lane >> 5)) * N + n0 + (lane & 31);
#pragma unroll
    for (int i = 0; i < 32; ++i) wv[i] = __builtin_nontemporal_load(wp + (size_t)(2 * i) * N);
#pragma unroll
    for (int i = 0; i < 32; ++i) scr[(2 * i + (lane >> 5)) * 33 + (lane & 31)] = wv[i];
    asm volatile("s_waitcnt lgkmcnt(0)" ::: "memory");
    const int c = lane & 7;
    float gn[8];
#pragma unroll
    for (int e = 0; e < 8; ++e) gn[e] = gain ? gain[k0 + 8 * c + e] : 1.0f;
#pragma unroll
    for (int j = 0; j < 4; ++j) { const int n = (lane >> 3) + 8 * j; const LAS float* s = scr + (8 * c) * 33 + n;
        float v[8];
#pragma unroll
        for (int e = 0; e < 8; ++e) v[e] = s[e * 33] * gn[e];
        *(u32x4*)(WT + (size_t)(row_off + dest_row(mode, n0 + n)) * K + k0 + 8 * c) = pk8(v); }
    asm volatile("s_waitcnt lgkmcnt(0)" ::: "memory");
}

#define XB_TMO      128
#define XB_XCNT(j)  (256  + 64 * (j))
#define XB_XSUB(j)  (1280 + 64 * (j))
#define XB_XGEN(j)  (2304 + 64 * (j))
#define XB_TOP      3328
#define XB_TOPGEN   3392
#define XCD_BAR_WORDS 3456
#define XB_SPIN_CAP (1u << 18)
static_assert(XCD_BAR_WORDS * 4 <= CTL_BYTES, "barrier words inside the memset region");
DI unsigned xb_ld(unsigned* p)              { return __hip_atomic_load(p, __ATOMIC_RELAXED, __HIP_MEMORY_SCOPE_AGENT); }
DI unsigned xb_add(unsigned* p, unsigned v) { return __hip_atomic_fetch_add(p, v, __ATOMIC_RELAXED, __HIP_MEMORY_SCOPE_AGENT); }
DI unsigned xb_xcc_id() { return (unsigned)__builtin_amdgcn_s_getreg((3 << 11) | 20) & 0xFu; }
#define XB_SPIN(cond, bar) do { unsigned _sp = 0; while (cond) { __builtin_amdgcn_s_sleep(1); \
    if ((++_sp & 255u) == 0u) { if (xb_ld(&(bar)[XB_TMO])) break; if (_sp > XB_SPIN_CAP) { atomicAdd(&(bar)[XB_TMO], 1u); break; } } } } while (0)
struct XcdBarrier { unsigned* bar; unsigned x; volatile LAS unsigned* st; };
DI void xcd_barrier_complete(unsigned* bar, unsigned x, unsigned& nloc, unsigned& nx) {
    const unsigned G = gridDim.x * gridDim.y * gridDim.z;
    unsigned sum, cnt, mine, sp = 0u;
    for (;;) {
        sum = 0u; cnt = 0u; mine = 0u;
#pragma unroll
        for (unsigned j = 0; j < 16; ++j) { const unsigned c = xb_ld(&bar[XB_XCNT(j)]); sum += c; cnt += (c > 0u) ? 1u : 0u; mine = (j == x) ? c : mine; }
        if (sum == G) break;
        __builtin_amdgcn_s_sleep(1);
        if ((++sp & 255u) == 0u) { if (xb_ld(&bar[XB_TMO])) break; if (sp > XB_SPIN_CAP) { atomicAdd(&bar[XB_TMO], 1u); break; } }
    }
    nloc = mine > 0u ? mine : 1u; nx = cnt > 0u ? cnt : 1u;
}
DI void xcd_barrier(const XcdBarrier& b) {
    asm volatile("s_waitcnt vmcnt(0)" ::: "memory");
    __syncthreads();
    if (threadIdx.x == 0) {
        unsigned* bar = b.bar;
        __builtin_amdgcn_s_waitcnt(0);
        unsigned nloc = b.st[0], nx = b.st[1];
        if (nloc == 0u) { xcd_barrier_complete(bar, b.x, nloc, nx); b.st[0] = nloc; b.st[1] = nx; }
        const unsigned old = xb_add(&bar[XB_XSUB(b.x)], 1u);
        const unsigned gen = old / nloc;
        if (old + 1u == (gen + 1u) * nloc) {
            __builtin_amdgcn_fence(__ATOMIC_RELEASE, "agent");
            asm volatile("s_waitcnt vmcnt(0)" ::: "memory");
            const unsigned og = xb_add(&bar[XB_TOP], 1u);
            const unsigned tg = og / nx;
            if (og + 1u == (tg + 1u) * nx) xb_add(&bar[XB_TOPGEN], 1u);
            else XB_SPIN(xb_ld(&bar[XB_TOPGEN]) == tg, bar);
            __builtin_amdgcn_fence(__ATOMIC_ACQUIRE, "agent");
            xb_add(&bar[XB_XGEN(b.x)], 1u);
            asm volatile("s_waitcnt vmcnt(0)" ::: "memory");
        } else {
            XB_SPIN(xb_ld(&bar[XB_XGEN(b.x)]) == gen, bar);
            __builtin_amdgcn_fence(__ATOMIC_ACQUIRE, "agent");
            asm volatile("s_waitcnt vmcnt(0)" ::: "memory");
        }
    }
    __syncthreads();
}

struct Args { const void* in[25]; float* out; unsigned char* ws; int ph_lo, ph_hi; };
typedef const __attribute__((address_space(4))) unsigned long long* ka_t;
DI unsigned long long KA(int i) { ka_t p = (ka_t)__builtin_amdgcn_kernarg_segment_ptr(); asm volatile("" : "+s"(p)); return p[i]; }
#define KIN(i) ((const float*)KA(i))
#define KOUT ((float*)KA(25))
#define KWS ((unsigned char*)KA(26))

DI void conv_set(int mask, int l, int bpart, int nbparts, LAS unsigned char* lds) {
    int tid_o = threadIdx.x; asm volatile("" : "+v"(tid_o)); const int tid = tid_o, wave = __builtin_amdgcn_readfirstlane(tid >> 6), lane = tid & 63;
    const int part = bpart * NWAVES + wave, nparts = nbparts * NWAVES, tpart = bpart * NTHREADS + tid, ntparts = nbparts * NTHREADS;
    LAS float* scr = (LAS float*)(lds + wave * 16384);
    unsigned char* ws = KWS;
    constexpr int I_FI = 16 * 176, I_FO = 44 * 32, I_WIN = 16 * 197, I_UQ = 6 * 24, I_UK = 4 * 16, I_WO = 8 * 32, I_SQ = 16 * 32;
    if (mask & 1) {
        const float* f1n = KIN(3) + l * 1024; const float* w1i = KIN(4) + (size_t)l * 1024 * 5632; const float* w1o = KIN(5) + (size_t)l * 2816 * 1024;
        for (int it = part; it < I_FI + I_FO; it += nparts) {
            if (it < I_FI) conv_item(w1i, 1024, 5632, (bf16*)(ws + WT_W1IN), f1n, 1, 0, scr, it, lane);
            else conv_item(w1o, 2816, 1024, (bf16*)(ws + WT_W1OUT), nullptr, 0, 0, scr, it - I_FI, lane);
        }
    }
    if (mask & 4) {
        const float* f2n = KIN(21) + l * 1024; const float* w2i = KIN(22) + (size_t)l * 1024 * 5632; const float* w2o = KIN(23) + (size_t)l * 2816 * 1024;
        for (int it = part; it < I_FI + I_FO; it += nparts) {
            if (it < I_FI) conv_item(w2i, 1024, 5632, (bf16*)(ws + WT_W2IN), f2n, 1, 0, scr, it, lane);
            else conv_item(w2o, 2816, 1024, (bf16*)(ws + WT_W2OUT), nullptr, 0, 0, scr, it - I_FI, lane);
        }
    }
    if (mask & 2) {
        const float* mxn = KIN(6) + l * 1024; const float* win = KIN(7) + (size_t)l * 1024 * DIN;
        for (int it = part; it < I_WIN; it += nparts) conv_item(win, 1024, DIN, (bf16*)(ws + WT_WIN), mxn, 2, 0, scr, it, lane);
        u32x4* pad = (u32x4*)(ws + WT_WIN + (size_t)672 * 1024 * 2);
        for (int i = tpart; i < 96 * 1024 * 2 / 16; i += ntparts) pad[i] = (u32x4){0, 0, 0, 0};
    }
    if (mask & 8) {
        const float* qln = KIN(8) + l * 384; const float* kvn = KIN(9) + l * 256;
        const float* wuq = KIN(10) + (size_t)l * 384 * 768; const float* wuk = KIN(11) + (size_t)l * 256 * 512; const float* wuv = KIN(12) + (size_t)l * 256 * 512;
        const float* womla = KIN(13) + (size_t)l * 512 * 1024; const float* wohg = KIN(16) + (size_t)l * 512 * 1024; const float* womem = KIN(19) + (size_t)l * 512 * 1024;
        const float* wout = KIN(20) + (size_t)l * 1024 * 1024;
        constexpr int NIT = I_UQ + 2 * I_UK + 3 * I_WO + I_SQ;
        for (int it = part; it < NIT; it += nparts) {
            int r = it;
            if (r < I_UQ) { conv_item(wuq, 384, 768, (bf16*)(ws + WT_WUQ), qln, 3, 0, scr, r, lane); continue; } r -= I_UQ;
            if (r < I_UK) { conv_item(wuk, 256, 512, (bf16*)(ws + WT_WUKV), kvn, 0, 0, scr, r, lane); continue; } r -= I_UK;
            if (r < I_UK) { conv_item(wuv, 256, 512, (bf16*)(ws + WT_WUKV), kvn, 0, 512, scr, r, lane); continue; } r -= I_UK;
            if (r < I_WO) { conv_item(womla, 512, 1024, (bf16*)(ws + WT_WOMLA), nullptr, 0, 0, scr, r, lane); continue; } r -= I_WO;
            if (r < I_WO) { conv_item(wohg, 512, 1024, (bf16*)(ws + WT_WOHG), nullptr, 0, 0, scr, r, lane); continue; } r -= I_WO;
            if (r < I_WO) { conv_item(womem, 512, 1024, (bf16*)(ws + WT_WOMEM), nullptr, 0, 0, scr, r, lane); continue; } r -= I_WO;
            conv_item(wout, 1024, 1024, (bf16*)(ws + WT_WOUT), nullptr, 0, 0, scr, r, lane);
        }
    }
    if (mask & 16) {
        const float* memn = KIN(17); const float* wmkv = KIN(18);
        for (int it = part; it < 4 * I_SQ; it += nparts) { const int ll = it / I_SQ, r = it - ll * I_SQ;
            conv_item(wmkv + (size_t)ll * 1024 * 1024, 1024, 1024, (bf16*)(ws + WT_WMEMKV) + (size_t)ll * 1024 * 1024, memn + ll * 1024, 0, 0, scr, r, lane); }
    }
    __syncthreads();
}
DI void conv_tail(int mask, int l, int nwg, LAS unsigned char* lds) {
    const int G = (int)gridDim.x, rem = nwg % G, c = (int)blockIdx.x;
    if (c < rem) return;
    conv_set(mask, l, c - rem, G - rem, lds);
}

DI void prep_phase() {
    int tid_o = threadIdx.x; asm volatile("" : "+v"(tid_o)); const int tid = tid_o, wave = __builtin_amdgcn_readfirstlane(tid >> 6), lane = tid & 63;
    const int gw = blockIdx.x * NWAVES + wave, NGW = gridDim.x * NWAVES;
    unsigned char* ws = KWS; float* xout = KOUT;
    const float* x = KIN(0); const float* mem = KIN(1); const int* pos = (const int*)KA(2);
    bf16* XB = (bf16*)(ws + WS_XB); float* SSQ = (float*)(ws + WS_SSQ);
    for (int m = gw; m < T; m += NGW) {
        const f32x4* xr = (const f32x4*)(x + (size_t)m * D) + lane; f32x4* orow = (f32x4*)(xout + (size_t)m * D) + lane; u32x2* xb = (u32x2*)(XB + (size_t)m * D) + lane;
        float s = 0.f;
#pragma unroll
        for (int j = 0; j < 4; ++j) { const f32x4 v = xr[64 * j]; orow[64 * j] = v; s += (v.x * v.x + v.y * v.y) + (v.z * v.z + v.w * v.w); u32x2 w; w.x = pk2(v.x, v.y); w.y = pk2(v.z, v.w); xb[64 * j] = w; }
        s = wave_sum(s);
        if (lane < 16) SSQ[(size_t)m * 16 + lane] = lane == 0 ? s : 0.f;
    }
    bf16* MEMB = (bf16*)(ws + WS_MEMB); float* MRS = (float*)(ws + WS_MEMRSTD);
    for (int m = gw; m < 1024; m += NGW) {
        const f32x4* xr = (const f32x4*)(mem + (size_t)m * D) + lane; u32x2* xb = (u32x2*)(MEMB + (size_t)m * D) + lane;
        float s = 0.f;
#pragma unroll
        for (int j = 0; j < 4; ++j) { const f32x4 v = xr[64 * j]; s += (v.x * v.x + v.y * v.y) + (v.z * v.z + v.w * v.w); u32x2 w; w.x = pk2(v.x, v.y); w.y = pk2(v.z, v.w); xb[64 * j] = w; }
        s = wave_sum(s);
        if (lane == 0) MRS[m] = rsqrtf(s * (1.0f / 1024.0f) + EPS);
    }
    float* COS = (float*)(ws + WS_COS); float* SIN = (float*)(ws + WS_SIN);
    for (int i = blockIdx.x * NTHREADS + tid; i < T * 16; i += gridDim.x * NTHREADS) {
        const int row = i >> 4, fi = i & 15;
        const float invf = exp2f(-13.287712379549449f * (float)fi * (1.0f / 16.0f));
        const float ang = (float)pos[row] * invf;
        const float kq = rintf(ang * 0.15915494309189535f);
        float rr = fmaf(-kq, 6.28125f, ang); rr = fmaf(-kq, 1.9353071795864769e-3f, rr);
        COS[i] = __cosf(rr); SIN[i] = __sinf(rr);
    }
    const float* hlb = KIN(14); float* LBS = (float*)(ws + WS_LBS);
    for (int i = blockIdx.x * NTHREADS + tid; i < 512; i += gridDim.x * NTHREADS) {
        const float a0 = hlb[i], a1 = hlb[512 + i], a2 = hlb[1024 + i], a3 = hlb[1536 + i];
        const float mx = fmaxf(fmaxf(a0, a1), fmaxf(a2, a3));
        const float e0 = __expf(a0 - mx), e1 = __expf(a1 - mx), e2 = __expf(a2 - mx), e3 = __expf(a3 - mx), inv = 1.0f / (e0 + e1 + e2 + e3);
        LBS[i] = 0.f; LBS[512 + i] = e1 * inv; LBS[1024 + i] = (e1 + e2) * inv; LBS[1536 + i] = (e1 + e2 + e3) * inv;
    }
}

__global__ void __launch_bounds__(NTHREADS, 2) fwd_kernel(Args A_unused) {
    extern __shared__ __attribute__((aligned(16))) unsigned char lds_raw[];
    LAS unsigned char* lds = (LAS unsigned char*)lds_raw;
    cg::grid_group grid = cg::this_grid();
    int ph = 0;
    int lo, hi; { const unsigned long long w = KA(27); lo = (int)(unsigned)w; hi = (int)(unsigned)(w >> 32); }
#define RUN (ph >= lo && ph < hi)
    volatile LAS unsigned* bst = (volatile LAS unsigned*)(lds + 131072 + 512);
    if (threadIdx.x < 2) bst[threadIdx.x] = 0u;
    __syncthreads();
    if (threadIdx.x == 0) (void)xb_add(&((unsigned*)(KWS + WS_CTL))[XB_XCNT(xb_xcc_id())], 1u);
#define SEAM do { if (ph >= lo && ph + 1 < hi) { if (ph == 1) grid.sync(); else { XcdBarrier xb_; xb_.bar = (unsigned*)(KWS + WS_CTL); xb_.x = xb_xcc_id(); xb_.st = bst; xcd_barrier(xb_); } } ++ph; } while (0)
#define WSP(T_, name, off) T_* name = (T_*)(ws + (off))
#define REPEAT(n_) for (int rep_ = 0; rep_ < (n_); ++rep_, ((rep_ < (n_)) ? grid.sync() : (void)0))

    if (RUN) { prep_phase(); }
    ++ph;
    for (int l = 0; l < DEPTH; ++l) {
        if (l == 0) {
            if (RUN) conv_set(1 | 2 | 16, 0, (int)blockIdx.x, (int)gridDim.x, lds);
            SEAM;
        }
#ifndef SKIP_G1
        if (RUN) REPEAT(REP_P1) { unsigned char* ws = KWS; EpiSwiglu E{(bf16*)(ws + WS_H), (const float*)(ws + WS_SSQ)}; run_gemm(lds, (const bf16*)(ws + WS_XB), (const bf16*)(ws + WT_W1IN), T, 5632, 1024, 0, E);
            if (l == 0) {
                const int rem = (64 * 22) % (int)gridDim.x;
#pragma unroll 1
                for (int ll = 0; ll < DEPTH; ++ll) { unsigned char* ws2 = KWS; EpiMemKV E2{(bf16*)(ws2 + WS_MK) + (size_t)ll * 16 * 256 * 128, (bf16*)(ws2 + WS_MVT) + (size_t)ll * 16 * 128 * 256, (const float*)(ws2 + WS_MEMRSTD)};
                    run_gemm(lds, (const bf16*)(ws2 + WS_MEMB), (const bf16*)(ws2 + WT_WMEMKV) + (size_t)ll * 1024 * 1024, 1024, 1024, 1024, (rem + 16 * ll) % (int)gridDim.x, E2); }
            } else conv_tail(2, l, 64 * 22, lds);
        }
#endif
        SEAM;
#ifndef SKIP_G2
        if (RUN) { unsigned char* ws = KWS; EpiResid E{KOUT, (bf16*)(ws + WS_XB), (float*)(ws + WS_SSQ), 0.5f}; run_gemm(lds, (const bf16*)(ws + WS_H), (const bf16*)(ws + WT_W1OUT), T, 1024, DFF, 0, E); }
#endif
        SEAM;
#ifndef SKIP_WIN
        if (RUN) REPEAT(REP_P3) { unsigned char* ws = KWS;
            EpiWin E{ws, (const float*)(ws + WS_LBS) + l * 512};
            run_gemm(lds, (const bf16*)(ws + WS_XB), (const bf16*)(ws + WT_WIN), T, NIN, 1024, 0, E);
            conv_tail(4 | 8, l, 64 * 25, lds); }
#endif
        SEAM;
        if (RUN) {
#ifndef SKIP_G4
            { unsigned char* ws = KWS; EpiQ E{(bf16*)(ws + WS_Q)}; run_gemm(lds, (const bf16*)(ws + WS_CQ), (const bf16*)(ws + WT_WUQ), T, 768, 384, 0, E); }
            { unsigned char* ws = KWS; EpiKV E{(bf16*)(ws + WS_KC), (bf16*)(ws + WS_VT), (const float*)(ws + WS_SSQKV)}; run_gemm(lds, (const bf16*)(ws + WS_CKV), (const bf16*)(ws + WT_WUKV), T, 1024, 256, 64, E); }
#endif
#ifndef SKIP_B1
            { unsigned char* ws = KWS; const int G = (int)gridDim.x;
              for (int ch = (int)blockIdx.x; ch < 1024; ch += G) hgrn_b1(lds, ch, (float*)(ws + WS_GG), (const bf16*)(ws + WS_HK), (const bf16*)(ws + WS_HV), (float*)(ws + WS_LT), (float*)(ws + WS_DEC)); }
#endif
        }
        SEAM;
        if (RUN) {
            unsigned char* ws = KWS; int tid_o = threadIdx.x; asm volatile("" : "+v"(tid_o)); const int G = (int)gridDim.x, bid = (int)blockIdx.x, tid = tid_o;
#ifndef SKIP_MLA
            REPEAT(REP_MLA) for (int it = bid; it < 256; it += G) {
                const int bh = it >> 3, pr = it & 7, b = bh >> 3, hd = bh & 7;
#pragma unroll 1
                for (int half = 0; half < 2; ++half) {
                    const int qb = half == 0 ? 15 - pr : pr;
                    const size_t row0 = (size_t)b * SEQ + qb * 256;
                    attn_item<96, 64, true>(lds, (const bf16*)(ws + WS_Q) + row0 * 768 + hd * 96, 768, (const bf16*)(ws + WS_KC) + (size_t)bh * SEQ * 96, (const bf16*)(ws + WS_VT) + (size_t)bh * 64 * SEQ, SEQ,
                                            (bf16*)(ws + WS_AO) + row0 * 512 + hd * 64, 512, qb * 256, SEQ, (const float*)(ws + WS_SSQQ) + row0 * 16, (const float*)(ws + WS_COS) + row0 * 16, (const float*)(ws + WS_SIN) + row0 * 16);
                }
            }
#endif
            float* LT = (float*)(ws + WS_LT); const float* DEC = (const float*)(ws + WS_DEC);
            for (int gt = bid * NTHREADS + tid; gt < 16 * 16384; gt += G * NTHREADS) {
                const int bh = gt >> 14, e = gt & 16383, k = e & 127;
                float* lp = LT + (size_t)bh * 64 * 16384 + e; const float* dp = DEC + (size_t)bh * 64 * 128 + k;
                float run = 0.f;
#pragma unroll 8
                for (int c = 0; c < 64; ++c) { const float tmp = lp[(size_t)c * 16384], d = dp[c * 128]; lp[(size_t)c * 16384] = run; run = d * run + tmp; }
            }
        }
        SEAM;
        if (RUN) REPEAT(REP_P6) {
            unsigned char* ws = KWS; const int G = (int)gridDim.x, bid = (int)blockIdx.x;
#ifndef SKIP_XATT
            for (int it = bid; it < 256; it += G) {
                const int b = it >> 6, hd = (it >> 4) & 3, qb = it & 15;
                const size_t row0 = (size_t)b * SEQ + qb * 256;
                attn_item<128, 128, false>(lds, (const bf16*)(ws + WS_MQ) + row0 * 512 + hd * 128, 512, (const bf16*)(ws + WS_MK) + (size_t)(l * 16 + b * 4 + hd) * 256 * 128, (const bf16*)(ws + WS_MVT) + (size_t)(l * 16 + b * 4 + hd) * 128 * 256, 256,
                                           (bf16*)(ws + WS_MO) + row0 * 512 + hd * 128, 512, 0, 256, nullptr, nullptr, nullptr);
            }
#endif
#ifndef SKIP_B3
            const float* onorm = KIN(15) + l * 128;
            for (int ch = bid; ch < 1024; ch += G) hgrn_b3(lds, ch, (const float*)(ws + WS_GG), (const bf16*)(ws + WS_HQ), (const bf16*)(ws + WS_HK), (const bf16*)(ws + WS_HV), (const bf16*)(ws + WS_HGT), (const float*)(ws + WS_LT), onorm, (bf16*)(ws + WS_HO));
#endif
        }
        SEAM;
#ifndef SKIP_G7
        if (RUN) {
            { unsigned char* ws = KWS; EpiBranch E{(bf16*)(ws + WS_MERGED), (const bf16*)(ws + WS_GATES), 1}; run_gemm(lds, (const bf16*)(ws + WS_AO), (const bf16*)(ws + WT_WOMLA), T, 1024, 512, 0, E); }
            { unsigned char* ws = KWS; EpiBranch E{(bf16*)(ws + WS_MERGED), (const bf16*)(ws + WS_GATES) + (size_t)T * 1024, 0}; run_gemm(lds, (const bf16*)(ws + WS_HO), (const bf16*)(ws + WT_WOHG), T, 1024, 512, 0, E); }
            { unsigned char* ws = KWS; EpiBranch E{(bf16*)(ws + WS_MERGED), (const bf16*)(ws + WS_GATES) + (size_t)2 * T * 1024, 0}; run_gemm(lds, (const bf16*)(ws + WS_MO), (const bf16*)(ws + WT_WOMEM), T, 1024, 512, 0, E); }
        }
#endif
        SEAM;
#ifndef SKIP_G8
        if (RUN) { unsigned char* ws = KWS; EpiResid E{KOUT, (bf16*)(ws + WS_XB), (float*)(ws + WS_SSQ), 1.0f}; run_gemm(lds, (const bf16*)(ws + WS_MERGED), (const bf16*)(ws + WT_WOUT), T, 1024, 1024, 0, E); }
#endif
        SEAM;
#ifndef SKIP_G9
        if (RUN) { unsigned char* ws = KWS; EpiSwiglu E{(bf16*)(ws + WS_H), (const float*)(ws + WS_SSQ)}; run_gemm(lds, (const bf16*)(ws + WS_XB), (const bf16*)(ws + WT_W2IN), T, 5632, 1024, 0, E);
            if (l + 1 < DEPTH) conv_tail(1, l + 1, 64 * 22, lds); }
#endif
        SEAM;
#ifndef SKIP_G10
        if (RUN) { unsigned char* ws = KWS; EpiResid E{KOUT, (bf16*)(ws + WS_XB), (float*)(ws + WS_SSQ), 0.5f}; run_gemm(lds, (const bf16*)(ws + WS_H), (const bf16*)(ws + WT_W2OUT), T, 1024, DFF, 0, E); }
#endif
        SEAM;
    }
    if (RUN) {
        unsigned char* ws = KWS; float* X = KOUT; const float* SSQ = (const float*)(ws + WS_SSQ);
        int tid_o = threadIdx.x; asm volatile("" : "+v"(tid_o)); const int tid = tid_o, wave = __builtin_amdgcn_readfirstlane(tid >> 6), lane = tid & 63, G = (int)gridDim.x;
        const float* fg = KIN(24);
        for (int m = (int)blockIdx.x * NWAVES + wave; m < T; m += G * NWAVES) {
            const float rs = rsqrtf(sum16(SSQ + (size_t)m * 16) * (1.0f / 1024.0f) + EPS);
            f32x4* xr = (f32x4*)(X + (size_t)m * D) + lane; const f32x4* gr = (const f32x4*)fg + lane;
#pragma unroll
            for (int j = 0; j < 4; ++j) { f32x4 v = xr[64 * j]; const f32x4 g = gr[64 * j]; v = v * rs * g; xr[64 * j] = v; }
        }
    }
#undef RUN
#undef SEAM
}

constexpr int N_PHASES = 1 + 1 + DEPTH * 10 + 1;

extern "C" void kernel_launch(void* const* d_in, const int* in_sizes, int n_in, void* d_out, int out_size, void* d_ws, size_t ws_size, hipStream_t stream) {
    static int grid = 0;
    if (grid == 0) {
        if (n_in != 25 || out_size != T * D || ws_size < WS_END) { fprintf(stderr, "kernel_launch: unexpected shapes (n_in %d out %d ws %zu need %zu)\n", n_in, out_size, ws_size, (size_t)WS_END); grid = -1; return; }
        int dev = 0, cus = 0, per_cu = 0;
        hipGetDevice(&dev);
        hipDeviceGetAttribute(&cus, hipDeviceAttributeMultiprocessorCount, dev);
        if (hipFuncSetAttribute((const void*)fwd_kernel, hipFuncAttributeMaxDynamicSharedMemorySize, LDS_BYTES) != hipSuccess) { fprintf(stderr, "kernel_launch: hipFuncSetAttribute failed\n"); grid = -1; return; }
        if (hipOccupancyMaxActiveBlocksPerMultiprocessor(&per_cu, (const void*)fwd_kernel, NTHREADS, LDS_BYTES) != hipSuccess || per_cu < 1) { fprintf(stderr, "kernel_launch: occupancy query says %d\n", per_cu); per_cu = 1; }
        (void)hipGetLastError();
        grid = cus * 1;
        if (grid <= 0) grid = 256;
    }
    if (grid < 0) return;
    if (hipMemsetAsync((char*)d_ws + WS_CTL, 0, CTL_BYTES, stream) != hipSuccess) { fprintf(stderr, "kernel_launch: memset of the barrier words failed\n"); return; }
    Args a{};
    for (int i = 0; i < 25; ++i) a.in[i] = d_in[i];
    a.out = (float*)d_out; a.ws = (unsigned char*)d_ws; a.ph_lo = 0; a.ph_hi = N_PHASES;
    void* args[] = {&a};
    hipError_t e = hipLaunchCooperativeKernel((const void*)fwd_kernel, dim3(grid), dim3(NTHREADS), args, LDS_BYTES, stream);
    if (e != hipSuccess) fprintf(stderr, "cooperative launch failed: %s (grid %d)\n", hipGetErrorString(e), grid);
}
```

```cpp
#include <hip/hip_runtime.h>
#include <hip/hip_cooperative_groups.h>
#include <cstdio>
#include <cstdint>
namespace cg = cooperative_groups;
#define DI __device__ __forceinline__
namespace pg8 {
#define PG8_LAS __attribute__((address_space(3)))
typedef unsigned short bf16_t;
typedef short bf16x8 __attribute__((ext_vector_type(8)));
typedef float f32x4 __attribute__((ext_vector_type(4)));
typedef unsigned u32x4 __attribute__((ext_vector_type(4)));
constexpr int BM = 256, BK = 64, HALF = 128, HTB = HALF * BK * 2  , STAGE_BYTES = 8 * HTB, NXCD = 8, WGM = 8;

__host__ __device__ __forceinline__ int lds_byte(int r, int c) { const int st = (r >> 4) * 2 + (c >> 5), rr = r & 15, cc = c & 31, ob = rr * 64 + cc * 2; return st * 1024 + (ob ^ (((ob >> 9) & 1) << 5)); }
__host__ __device__ __forceinline__ void stage_rc(int b, int& R, int& C) { const int st = b / 1024, sb = b % 1024, swz = sb ^ (((sb >> 9) & 1) << 5); R = (st >> 1) * 16 + swz / 64; C = (st & 1) * 32 + (swz % 64) / 2; }
__host__ __device__ __forceinline__ int perm32(int rho) { const int n = rho >> 4, i = rho & 15; return 8 * (i >> 2) + 4 * n + (i & 3); }

struct Unit { int pm, pn, seg; };
struct Gemm { const bf16_t* A; const bf16_t* Bt; int M, N, K; };

struct StaticOrder {
    int nM, nN, nwg, G, c;
    __host__ __device__ void init(int M, int N, int G_, int c_) { nM = M / BM; nN = N / BM; nwg = nM * nN; G = G_; c = c_; }
    __host__ __device__ bool next(int i, Unit& u) const {
        const long L = (long)i * G + c; if (L >= nwg) return false;
        int wgid = (int)L; { const int q = nwg / NXCD, r = nwg % NXCD, xcd = wgid % NXCD, off = wgid / NXCD; wgid = (xcd < r ? xcd * (q + 1) : r * (q + 1) + (xcd - r) * q) + off; }
        const int nig = WGM * nN, gid = wgid / nig, fm = gid * WGM, gsz = (nM - fm) < WGM ? (nM - fm) : WGM;
        u.pm = fm + ((wgid % nig) % gsz); u.pn = (wgid % nig) / gsz; u.seg = 0; return true;
    }
    __device__ __forceinline__ const char* a_ptr(const Gemm& g, const Unit&) const { return (const char*)g.A; }
    __device__ __forceinline__ const char* b_ptr(const Gemm& g, const Unit&) const { return (const char*)g.Bt; }
    __device__ __forceinline__ void a_ready(const Unit&) const {}
    __device__ __forceinline__ void done(const Unit&) const {}
};
template <class Epi, class Sched, bool ALIGN_EPI = false, bool SP2 = false>
__device__ __forceinline__ void gemm_phase(PG8_LAS unsigned char* lds, const Gemm g, const Sched& S, const Epi& E) {
    int tid_o = threadIdx.x; asm volatile("" : "+v"(tid_o));
    const int tid = tid_o, wid = __builtin_amdgcn_readfirstlane(tid >> 6), lane = tid & 63, wr = wid >> 2, wc = wid & 3, fr = lane & 15, fq = lane >> 4;
    const int K = g.K, nt = K / BK;
    unsigned voffA[2], voffB[2];
#pragma unroll
    for (int i = 0; i < 2; ++i) { int R, C; stage_rc(tid * 16 + i * 8192, R, C); const int Rb = Epi::PERM ? ((R & ~31) + perm32(R & 31)) : R;
        voffA[i] = (unsigned)(R * K + C) * 2u; voffB[i] = (unsigned)(Rb * K + C) * 2u; }
    const size_t kstep = (size_t)(BK * 2);
    const size_t hstep = (size_t)HALF * K * 2;
    const size_t tstep = 2 * hstep;
    const unsigned ldsw = (unsigned)wid * 1024u;
    const int aoff = lds_byte(wr * 64 + fr, fq * 8), boff = lds_byte(wc * 32 + fr, fq * 8);
#define PG8_SA(b, h) (((b) * 2 + (h)) * HTB)
#define PG8_SB(b, h) ((4 + (b) * 2 + (h)) * HTB)
#define PG8_STAGE(bufoff, gbase, voff) do { _Pragma("unroll") for (int _i = 0; _i < 2; ++_i) \
        __builtin_amdgcn_global_load_lds((const unsigned*)((const char*)(gbase) + (voff)[_i]), (PG8_LAS unsigned*)(lds + (bufoff) + ldsw + _i * 8192), 16, 0, 0); } while (0)
#define PG8_LDA(dst, b, h) do { _Pragma("unroll") for (int m = 0; m < 4; ++m) _Pragma("unroll") for (int k = 0; k < 2; ++k) dst[m][k] = *(const PG8_LAS bf16x8*)(lds + PG8_SA(b, h) + aoff + m * 2048 + k * 1024); } while (0)
#define PG8_LDB(dst, b, h) do { _Pragma("unroll") for (int n = 0; n < 2; ++n) _Pragma("unroll") for (int k = 0; k < 2; ++k) dst[n][k] = *(const PG8_LAS bf16x8*)(lds + PG8_SB(b, h) + boff + n * 2048 + k * 1024); } while (0)
#define PG8_MMA(ai, bj, At, Bt) do { __builtin_amdgcn_s_setprio(1); _Pragma("unroll") for (int m = 0; m < 4; ++m) _Pragma("unroll") for (int n = 0; n < 2; ++n) _Pragma("unroll") for (int k = 0; k < 2; ++k) \
        acc[ai][bj][m][n] = __builtin_amdgcn_mfma_f32_16x16x32_bf16(Bt[n][k], At[m][k], acc[ai][bj][m][n], 0, 0, 0); __builtin_amdgcn_s_setprio(0); } while (0)
#define PG8_WAIT_V(n) asm volatile("s_waitcnt vmcnt(" #n ")" ::: "memory")
#define PG8_WAIT_L(n) asm volatile("s_waitcnt lgkmcnt(" #n ")" ::: "memory")
#define PG8_BAR __builtin_amdgcn_s_barrier()
#define PG8_SCHED __builtin_amdgcn_sched_barrier(0)
    Unit cur, nxt; int ui = 0;
    if (!S.next(0, cur)) return;
    f32x4 acc[2][2][4][2];
#pragma unroll
    for (int a = 0; a < 2; ++a)
#pragma unroll
        for (int b = 0; b < 2; ++b)
#pragma unroll
            for (int m = 0; m < 4; ++m)
#pragma unroll
                for (int n = 0; n < 2; ++n) acc[a][b][m][n] = (f32x4){0.f, 0.f, 0.f, 0.f};
    bf16x8 At[4][2], B0[2][2], B1[2][2];
    const char* cA = S.a_ptr(g, cur) + (size_t)cur.pm * tstep; const char* cB = S.b_ptr(g, cur) + (size_t)cur.pn * tstep;
    S.a_ready(cur);
    if constexpr (SP2) {
        PG8_STAGE(PG8_SB(0, 0), cB, voffB); PG8_STAGE(PG8_SB(0, 1), cB + hstep, voffB); PG8_STAGE(PG8_SA(0, 0), cA, voffA); PG8_STAGE(PG8_SA(0, 1), cA + hstep, voffA);
        if (wr == 1) PG8_BAR;
        PG8_WAIT_V(2); PG8_BAR;
        PG8_STAGE(PG8_SB(1, 0), cB + kstep, voffB); PG8_STAGE(PG8_SA(1, 0), cA + kstep, voffA); PG8_STAGE(PG8_SB(1, 1), cB + hstep + kstep, voffB);
        PG8_WAIT_V(6); PG8_BAR;
    } else {
        PG8_STAGE(PG8_SB(0, 0), cB, voffB); PG8_STAGE(PG8_SA(0, 0), cA, voffA); PG8_STAGE(PG8_SB(0, 1), cB + hstep, voffB); PG8_STAGE(PG8_SA(0, 1), cA + hstep, voffA);
        if (wr == 1) PG8_BAR;
        PG8_WAIT_V(4); PG8_BAR;
        PG8_STAGE(PG8_SB(1, 0), cB + kstep, voffB); PG8_STAGE(PG8_SA(1, 0), cA + kstep, voffA); PG8_STAGE(PG8_SB(1, 1), cB + hstep + kstep, voffB);
        PG8_WAIT_V(6); PG8_BAR;
    }
    for (;;) {
        const bool has_next = S.next(ui + 1, nxt);
        const char* nA = has_next ? S.a_ptr(g, nxt) + (size_t)nxt.pm * tstep : cA; const char* nB = has_next ? S.b_ptr(g, nxt) + (size_t)nxt.pn * tstep : cB;
        for (int t = 0; t < nt; t += 2) {
            const bool last = (t == nt - 2);
            const char* a1 = cA + (size_t)(t + 1) * kstep;
            const char* a2 = last ? nA : cA + (size_t)(t + 2) * kstep; const char* b2 = last ? nB : cB + (size_t)(t + 2) * kstep;
            const char* a3 = a2 + kstep; const char* b3 = b2 + kstep;
            if (last && has_next) S.a_ready(nxt);
            if constexpr (SP2) {
            PG8_LDB(B0, 0, 0); PG8_LDB(B1, 0, 1); PG8_SCHED; PG8_LDA(At, 0, 0); PG8_STAGE(PG8_SA(1, 1), a1 + hstep, voffA);
            PG8_WAIT_V(8); PG8_WAIT_L(0); PG8_BAR; PG8_MMA(0, 0, At, B0); PG8_MMA(0, 1, At, B1); PG8_BAR; PG8_SCHED;
            PG8_LDA(At, 0, 1); PG8_STAGE(PG8_SB(0, 0), b2, voffB); PG8_STAGE(PG8_SB(0, 1), b2 + hstep, voffB); PG8_STAGE(PG8_SA(0, 0), a2, voffA);
            PG8_WAIT_V(8); PG8_WAIT_L(0); PG8_BAR; PG8_MMA(1, 0, At, B0); PG8_MMA(1, 1, At, B1); PG8_BAR; PG8_SCHED;
            PG8_LDB(B0, 1, 0); PG8_LDB(B1, 1, 1); PG8_SCHED; PG8_LDA(At, 1, 0); PG8_STAGE(PG8_SA(0, 1), a2 + hstep, voffA);
            PG8_WAIT_V(8); PG8_WAIT_L(0); PG8_BAR; PG8_MMA(0, 0, At, B0); PG8_MMA(0, 1, At, B1); PG8_BAR; PG8_SCHED;
            PG8_LDA(At, 1, 1); PG8_STAGE(PG8_SB(1, 0), b3, voffB); PG8_STAGE(PG8_SB(1, 1), b3 + hstep, voffB); PG8_STAGE(PG8_SA(1, 0), a3, voffA);
            PG8_WAIT_V(8); PG8_WAIT_L(0); PG8_BAR; PG8_MMA(1, 0, At, B0); PG8_MMA(1, 1, At, B1); PG8_BAR; PG8_SCHED;
            } else {
            PG8_LDB(B0, 0, 0); PG8_SCHED; PG8_LDA(At, 0, 0); PG8_STAGE(PG8_SA(1, 1), a1 + hstep, voffA);
            PG8_WAIT_L(8); PG8_BAR; PG8_WAIT_L(0); PG8_MMA(0, 0, At, B0); PG8_BAR; PG8_SCHED;
            PG8_LDB(B1, 0, 1); PG8_STAGE(PG8_SB(0, 0), b2, voffB);
            PG8_BAR; PG8_WAIT_L(0); PG8_MMA(0, 1, At, B1); PG8_BAR;
            PG8_LDA(At, 0, 1); PG8_STAGE(PG8_SA(0, 0), a2, voffA);
            PG8_BAR; PG8_WAIT_L(0); PG8_MMA(1, 0, At, B0); PG8_BAR; PG8_SCHED;
            PG8_STAGE(PG8_SB(0, 1), b2 + hstep, voffB);
            PG8_WAIT_V(6); PG8_BAR; PG8_MMA(1, 1, At, B1); PG8_BAR;
            PG8_LDB(B0, 1, 0); PG8_SCHED; PG8_LDA(At, 1, 0); PG8_STAGE(PG8_SA(0, 1), a2 + hstep, voffA);
            PG8_WAIT_L(8); PG8_BAR; PG8_WAIT_L(0); PG8_MMA(0, 0, At, B0); PG8_BAR; PG8_SCHED;
            PG8_LDB(B1, 1, 1); PG8_STAGE(PG8_SB(1, 0), b3, voffB);
            PG8_BAR; PG8_WAIT_L(0); PG8_MMA(0, 1, At, B1); PG8_BAR;
            PG8_LDA(At, 1, 1); PG8_STAGE(PG8_SA(1, 0), a3, voffA);
            PG8_BAR; PG8_WAIT_L(0); PG8_MMA(1, 0, At, B0); PG8_BAR; PG8_SCHED;
            PG8_STAGE(PG8_SB(1, 1), b3 + hstep, voffB);
            PG8_WAIT_V(6); PG8_BAR; PG8_MMA(1, 1, At, B1); PG8_BAR;
            }
        }
        if constexpr (ALIGN_EPI) { if (wr == 0) PG8_BAR; }
        if constexpr (!Epi::AFTER_DRAIN) { E(acc, cur, wr, wc, fr, fq); S.done(cur); }
        if (!has_next) break;
        if (!E.keep_acc(cur))
#pragma unroll
        for (int a = 0; a < 2; ++a)
#pragma unroll
            for (int b = 0; b < 2; ++b)
#pragma unroll
                for (int m = 0; m < 4; ++m)
#pragma unroll
                    for (int n = 0; n < 2; ++n) acc[a][b][m][n] = (f32x4){0.f, 0.f, 0.f, 0.f};
        cur = nxt; cA = nA; cB = nB; ++ui;
        if constexpr (ALIGN_EPI) { if (wr == 1) PG8_BAR; }
    }
    PG8_WAIT_V(0);
    if constexpr (!ALIGN_EPI) { if (wr == 0) PG8_BAR; }
    PG8_BAR;
    if constexpr (Epi::AFTER_DRAIN) { E.fused(acc, cur, wr, wc, fr, fq, lds, wid, lane); S.done(cur); }
#undef PG8_SA
#undef PG8_SB
#undef PG8_STAGE
#undef PG8_LDA
#undef PG8_LDB
#undef PG8_MMA
#undef PG8_WAIT_V
#undef PG8_WAIT_L
#undef PG8_BAR
#undef PG8_SCHED
}
}

typedef unsigned short bf16;
#define LAS __attribute__((address_space(3)))
#define GAS __attribute__((address_space(1)))
typedef float f32x4 __attribute__((ext_vector_type(4)));
typedef float f32x16 __attribute__((ext_vector_type(16)));
typedef float f32x2_t __attribute__((ext_vector_type(2)));
typedef __bf16 bf16x2_t __attribute__((ext_vector_type(2)));
typedef short bf16x8 __attribute__((ext_vector_type(8)));
typedef short s16x4 __attribute__((ext_vector_type(4)));
typedef unsigned u32x4 __attribute__((ext_vector_type(4)));
typedef unsigned u32x2 __attribute__((ext_vector_type(2)));

constexpr int T = 16384, D = 1024, SEQ = 4096, NBATCH = 4, DFF = 2816, DEPTH = 4, NIN = 6400, DIN = 6304;
constexpr int NTHREADS = 512, NWAVES = 8;
constexpr float EPS = 1e-6f;
constexpr float QSCALE_MLA = 0.14724498f;
constexpr float QSCALE_MEM = 0.12751743f;

constexpr size_t MiB = 1u << 20;
constexpr size_t WT_W1IN = 0;
constexpr size_t WT_W1OUT = WT_W1IN + (size_t)5632 * 1024 * 2;
constexpr size_t WT_WIN = WT_W1OUT + (size_t)1024 * 2816 * 2;
constexpr size_t WT_WUQ = WT_WIN + (size_t)NIN * 1024 * 2;
constexpr size_t WT_WUKV = WT_WUQ + (size_t)768 * 384 * 2;
constexpr size_t WT_WOMLA = WT_WUKV + (size_t)1024 * 256 * 2;
constexpr size_t WT_WOHG = WT_WOMLA + (size_t)1024 * 512 * 2;
constexpr size_t WT_WOMEM = WT_WOHG + (size_t)1024 * 512 * 2;
constexpr size_t WT_WMEMKV = WT_WOMEM + (size_t)1024 * 512 * 2;
constexpr size_t WT_WOUT = WT_WMEMKV + (size_t)4 * 1024 * 1024 * 2;
constexpr size_t WT_W2IN = WT_WOUT + (size_t)1024 * 1024 * 2;
constexpr size_t WT_W2OUT = WT_W2IN + (size_t)5632 * 1024 * 2;
constexpr size_t WT_END = WT_W2OUT + (size_t)1024 * 2816 * 2;
static_assert(WT_END <= 60 * MiB, "weights");
constexpr size_t WS_XB = 60 * MiB;
constexpr size_t WS_SSQ = WS_XB + 32 * MiB;
constexpr size_t WS_SSQQ = WS_SSQ + 1 * MiB;
constexpr size_t WS_SSQKV = WS_SSQQ + 1 * MiB;
constexpr size_t WS_COS = WS_SSQKV + 1 * MiB;
constexpr size_t WS_SIN = WS_COS + 1 * MiB;
constexpr size_t WS_LBS = WS_SIN + 1 * MiB;
constexpr size_t WS_MEMB = WS_LBS + 65536;
constexpr size_t WS_MEMRSTD = WS_MEMB + 2 * MiB;
constexpr size_t WS_MK = WS_MEMRSTD + 65536;
constexpr size_t WS_MVT = WS_MK + 4 * MiB;
constexpr size_t WS_DEC = WS_MVT + 4 * MiB;
constexpr size_t WS_MIX = WS_DEC + 1 * MiB;
constexpr size_t WS_CQ = WS_MIX;
constexpr size_t WS_CKV = WS_CQ + 12 * MiB;
constexpr size_t WS_KR = WS_CKV + 8 * MiB;
constexpr size_t WS_HQ = WS_KR + 1 * MiB;
constexpr size_t WS_GG = WS_HQ + 16 * MiB;
constexpr size_t WS_HK = WS_GG + 32 * MiB;
constexpr size_t WS_HV = WS_HK + 16 * MiB;
constexpr size_t WS_HGT = WS_HV + 16 * MiB;
constexpr size_t WS_MQ = WS_HGT + 16 * MiB;
constexpr size_t WS_GATES = WS_MQ + 16 * MiB;
constexpr size_t WS_Q = WS_GATES + 96 * MiB;
constexpr size_t WS_KC = WS_Q + 24 * MiB;
constexpr size_t WS_VT = WS_KC + 24 * MiB;
constexpr size_t WS_LT = WS_VT + 16 * MiB;
constexpr size_t WS_AO = WS_LT + 64 * MiB;
constexpr size_t WS_CTL = WS_AO + 16 * MiB;
constexpr size_t CTL_BYTES = 16384;
constexpr size_t WS_END = WS_CTL + 65536;
constexpr size_t WS_HO = WS_CQ;
constexpr size_t WS_MERGED = WS_GG;
constexpr size_t WS_MO = WS_Q;
constexpr size_t WS_H = WS_MIX;
static_assert(WS_H + (size_t)T * DFF * 2 <= WS_END, "h overlay");

constexpr int LDS_BYTES = 147456;
#ifndef REP_CONV
#define REP_CONV 1
#endif
#ifndef REP_P1
#define REP_P1 1
#endif
#ifndef REP_P3
#define REP_P3 1
#endif
#ifndef REP_MLA
#define REP_MLA 1
#endif
#ifndef REP_P6
#define REP_P6 1
#endif
#ifndef REP_P7
#define REP_P7 1
#endif
#ifndef REP_P4G
#define REP_P4G 1
#endif

DI unsigned pk2(float lo, float hi) { f32x2_t v = {lo, hi}; bf16x2_t b = __builtin_convertvector(v, bf16x2_t); return __builtin_bit_cast(unsigned, b); }
DI u32x4 pk8(const float* v) { u32x4 w; w.x = pk2(v[0], v[1]); w.y = pk2(v[2], v[3]); w.z = pk2(v[4], v[5]); w.w = pk2(v[6], v[7]); return w; }
DI float bflo(unsigned w) { return __uint_as_float(w << 16); }
DI float bfhi(unsigned w) { return __uint_as_float(w & 0xffff0000u); }
DI void unpk8(u32x4 w, float* v) { v[0] = bflo(w.x); v[1] = bfhi(w.x); v[2] = bflo(w.y); v[3] = bfhi(w.y); v[4] = bflo(w.z); v[5] = bfhi(w.z); v[6] = bflo(w.w); v[7] = bfhi(w.w); }
DI float bf2f(bf16 b) { return __uint_as_float(((unsigned)b) << 16); }
DI bf16 f2bf(float f) { return (bf16)(pk2(f, 0.f) & 0xffffu); }
DI float sigmoidf_(float z) { return __builtin_amdgcn_rcpf(1.0f + __expf(-z)); }
DI float wave_sum(float v) {
#pragma unroll
    for (int o = 1; o < 64; o <<= 1) v += __shfl_xor(v, o);
    return v;
}
DI float rowsum_q(const float* p, int fq, int nq) {
    float s = 0.f;
    if (fq < nq) { const f32x4 a = *(const f32x4*)(p + 4 * fq); s = (a.x + a.y) + (a.z + a.w); }
    s += __shfl_xor(s, 16); s += __shfl_xor(s, 32);
    return s;
}
DI void rstd8(const float* ssq, int stride, int nq, float inv_n, float post, int rowb, int fq, float (&rs)[8]) {
    f32x4 q[8];
#pragma unroll
    for (int i = 0; i < 8; ++i) q[i] = *(const f32x4*)(ssq + (size_t)(rowb + (i >> 2) * 128 + (i & 3) * 16) * stride + 4 * fq);
    const float keep = fq < nq ? 1.0f : 0.0f;
#pragma unroll
    for (int i = 0; i < 8; ++i) { float t = ((q[i].x + q[i].y) + (q[i].z + q[i].w)) * keep; t += __shfl_xor(t, 16); t += __shfl_xor(t, 32); rs[i] = __builtin_amdgcn_rsqf(t * inv_n + EPS) * post; }
}
DI float sum16(const float* p) {
    const f32x4 a = *(const f32x4*)p, b = *(const f32x4*)(p + 4), c = *(const f32x4*)(p + 8), d = *(const f32x4*)(p + 12);
    return ((a.x + a.y) + (a.z + a.w)) + ((b.x + b.y) + (b.z + b.w)) + ((c.x + c.y) + (c.z + c.w)) + ((d.x + d.y) + (d.z + d.w));
}

using pg8::Unit;
#define EPI_ARGS const f32x4 (&acc)[2][2][4][2], const Unit& u, int wr, int wc, int fr_in, int fq_in
#define EPI_OPAQUE int fr = fr_in, fq = fq_in; asm volatile("" : "+v"(fr), "+v"(fq));

struct EpiSwiglu {
    static constexpr bool PERM = true, AFTER_DRAIN = false;
    DI bool keep_acc(const Unit&) const { return false; }
    bf16* H; const float* ssq;
    DI void operator()(EPI_ARGS) const {
        EPI_OPAQUE
        const int rowb = u.pm * 256 + wr * 64 + fr;
        float rs[8]; rstd8(ssq, 16, 4, 1.0f / 1024.0f, 1.0f, rowb, fq, rs);
#pragma unroll
        for (int ai = 0; ai < 2; ++ai)
#pragma unroll
            for (int m = 0; m < 4; ++m) {
                const int row = rowb + ai * 128 + m * 16;
                const float r1 = rs[ai * 4 + m];
                float o[8];
#pragma unroll
                for (int n = 0; n < 2; ++n)
#pragma unroll
                    for (int j = 0; j < 4; ++j) { const float a = acc[ai][0][m][n][j] * r1, b = acc[ai][1][m][n][j] * r1; o[4 * n + j] = a * b * __builtin_amdgcn_rcpf(1.0f + __expf(-a)); }
                *(u32x4*)(H + (size_t)row * DFF + u.pn * 128 + 32 * wc + 8 * fq) = pk8(o);
            }
    }
};

struct EpiNull {
    static constexpr bool PERM = true, AFTER_DRAIN = false;
    DI bool keep_acc(const Unit&) const { return false; }
    bf16* H;
    DI void operator()(EPI_ARGS) const {
        float t = 0.f;
#pragma unroll
        for (int ai = 0; ai < 2; ++ai)
#pragma unroll
            for (int bj = 0; bj < 2; ++bj)
#pragma unroll
                for (int m = 0; m < 4; ++m)
#pragma unroll
                    for (int n = 0; n < 2; ++n) t += acc[ai][bj][m][n][0] + acc[ai][bj][m][n][1] + acc[ai][bj][m][n][2] + acc[ai][bj][m][n][3];
        if (t == 12345.678f) H[0] = 0;
    }
};

struct EpiResid {
    static constexpr bool PERM = true, AFTER_DRAIN = false;
    DI bool keep_acc(const Unit&) const { return false; }
    float* X; bf16* XB; float* ssq; float scale;
    DI void operator()(EPI_ARGS) const {
        EPI_OPAQUE
        const int rowb = u.pm * 256 + wr * 64 + fr, colb = u.pn * 256 + 32 * wc + 8 * fq;
#pragma unroll
        for (int ai = 0; ai < 2; ++ai) {
            f32x4 xv[4][2][2];
#pragma unroll
            for (int m = 0; m < 4; ++m)
#pragma unroll
                for (int bj = 0; bj < 2; ++bj) { const float* xp = X + (size_t)(rowb + ai * 128 + m * 16) * D + colb + 128 * bj; xv[m][bj][0] = *(const f32x4*)xp; xv[m][bj][1] = *(const f32x4*)(xp + 4); }
#pragma unroll
            for (int m = 0; m < 4; ++m) {
                const int row = rowb + ai * 128 + m * 16;
                float ss = 0.f;
#pragma unroll
                for (int bj = 0; bj < 2; ++bj) {
                    const size_t off = (size_t)row * D + colb + 128 * bj;
                    const f32x4 x0 = xv[m][bj][0] + scale * acc[ai][bj][m][0], x1 = xv[m][bj][1] + scale * acc[ai][bj][m][1];
                    *(f32x4*)(X + off) = x0; *(f32x4*)(X + off + 4) = x1;
                    float o[8] = {x0.x, x0.y, x0.z, x0.w, x1.x, x1.y, x1.z, x1.w};
                    *(u32x4*)(XB + off) = pk8(o);
#pragma unroll
                    for (int e = 0; e < 8; ++e) ss += o[e] * o[e];
                }
                ss += __shfl_xor(ss, 16); ss += __shfl_xor(ss, 32);
                if (fq == 0) ssq[(size_t)row * 16 + u.pn * 4 + wc] = ss;
            }
        }
    }
};

struct EpiWin {
    static constexpr bool PERM = true, AFTER_DRAIN = false;
    DI bool keep_acc(const Unit&) const { return false; }
    unsigned char* ws; const float* lbs  ;
    DI void operator()(EPI_ARGS) const {
        EPI_OPAQUE
        const float* ssq = (const float*)(ws + WS_SSQ); const float* cosT = (const float*)(ws + WS_COS); const float* sinT = (const float*)(ws + WS_SIN);
        bf16* CQ = (bf16*)(ws + WS_CQ); bf16* CKV = (bf16*)(ws + WS_CKV); bf16* KC = (bf16*)(ws + WS_KC); bf16* HQ = (bf16*)(ws + WS_HQ); bf16* HK = (bf16*)(ws + WS_HK); bf16* HV = (bf16*)(ws + WS_HV);
        bf16* HGT = (bf16*)(ws + WS_HGT); bf16* MQ = (bf16*)(ws + WS_MQ); bf16* GATES = (bf16*)(ws + WS_GATES); float* GG = (float*)(ws + WS_GG); float* SSQQ = (float*)(ws + WS_SSQQ); float* SSQKV = (float*)(ws + WS_SSQKV);
        const int rowb = u.pm * 256 + wr * 64 + fr;
        float rs8[8]; rstd8(ssq, 16, 4, 1.0f / 1024.0f, 1.0f, rowb, fq, rs8);
#pragma unroll
        for (int ai = 0; ai < 2; ++ai)
#pragma unroll
            for (int m = 0; m < 4; ++m) {
                const int row = rowb + ai * 128 + m * 16;
                const float rs = rs8[ai * 4 + m];
#pragma unroll
                for (int bj = 0; bj < 2; ++bj) {
                    const int hh = 2 * u.pn + bj, cw = 32 * wc + 8 * fq;
                    float v[8];
#pragma unroll
                    for (int n = 0; n < 2; ++n)
#pragma unroll
                        for (int j = 0; j < 4; ++j) v[4 * n + j] = acc[ai][bj][m][n][j] * rs;
                    if (hh < 5) {
                        float ss = 0.f;
#pragma unroll
                        for (int e = 0; e < 8; ++e) ss += v[e] * v[e];
                        ss += __shfl_xor(ss, 16); ss += __shfl_xor(ss, 32);
                        if (hh < 3) { *(u32x4*)(CQ + (size_t)row * 384 + hh * 128 + cw) = pk8(v); if (fq == 0) SSQQ[(size_t)row * 16 + hh * 4 + wc] = ss; }
                        else { *(u32x4*)(CKV + (size_t)row * 256 + (hh - 3) * 128 + cw) = pk8(v); if (fq == 0) SSQKV[(size_t)row * 8 + (hh - 3) * 4 + wc] = ss; }
                    } else if (hh == 5) {
                        if (wc == 0) {
                            const f32x4 c = *(const f32x4*)(cosT + (size_t)row * 16 + 4 * fq), s = *(const f32x4*)(sinT + (size_t)row * 16 + 4 * fq);
                            u32x4 o;
                            o.x = pk2(v[0] * c.x - v[1] * s.x, v[1] * c.x + v[0] * s.x); o.y = pk2(v[2] * c.y - v[3] * s.y, v[3] * c.y + v[2] * s.y);
                            o.z = pk2(v[4] * c.z - v[5] * s.z, v[5] * c.z + v[4] * s.z); o.w = pk2(v[6] * c.w - v[7] * s.w, v[7] * c.w + v[6] * s.w);
                            bf16* kp = KC + ((size_t)(row >> 12) * 8 * SEQ + (row & 4095)) * 96 + 64 + 8 * fq;
#pragma unroll
                            for (int hd = 0; hd < 8; ++hd) *(u32x4*)(kp + (size_t)hd * SEQ * 96) = o;
                        }
                    } else if (hh < 10) {
#pragma unroll
                        for (int e = 0; e < 8; ++e) v[e] = v[e] * sigmoidf_(v[e]);
                        *(u32x4*)(HQ + (size_t)row * 512 + (hh - 6) * 128 + cw) = pk8(v);
                    } else if (hh < 14) {
                        const int c0 = (hh - 10) * 128 + cw;
                        const f32x4 l0 = *(const f32x4*)(lbs + c0), l1 = *(const f32x4*)(lbs + c0 + 4);
                        const float lb[8] = {l0.x, l0.y, l0.z, l0.w, l1.x, l1.y, l1.z, l1.w};
                        float g[8], k[8];
#pragma unroll
                        for (int e = 0; e < 8; ++e) { const float z = fminf(fmaxf(v[e], -60.f), 60.f); const float sg = __builtin_amdgcn_rcpf(1.0f + __expf(-z));
                            g[e] = __logf(lb[e] + (1.0f - lb[e]) * sg); k[e] = (1.0f - lb[e]) * __builtin_amdgcn_rcpf(1.0f + __expf(z)); }
                        *(f32x4*)(GG + (size_t)row * 512 + c0) = (f32x4){g[0], g[1], g[2], g[3]}; *(f32x4*)(GG + (size_t)row * 512 + c0 + 4) = (f32x4){g[4], g[5], g[6], g[7]};
                        *(u32x4*)(HK + (size_t)row * 512 + c0) = pk8(k);
                    } else if (hh < 18) {
                        *(u32x4*)(HV + (size_t)row * 512 + (hh - 14) * 128 + cw) = pk8(v);
                    } else if (hh < 22) {
#pragma unroll
                        for (int e = 0; e < 8; ++e) v[e] = v[e] * sigmoidf_(v[e]);
                        *(u32x4*)(HGT + (size_t)row * 512 + (hh - 18) * 128 + cw) = pk8(v);
                    } else if (hh < 26) {
#pragma unroll
                        for (int e = 0; e < 8; ++e) v[e] *= QSCALE_MEM;
                        *(u32x4*)(MQ + (size_t)row * 512 + (hh - 22) * 128 + cw) = pk8(v);
                    } else {
                        const int c0 = (hh - 26) * 128 + cw, br = c0 >> 10, cc = c0 & 1023;
#pragma unroll
                        for (int e = 0; e < 8; ++e) v[e] = sigmoidf_(v[e]);
                        *(u32x4*)(GATES + ((size_t)br * T + row) * 1024 + cc) = pk8(v);
                    }
                }
            }
    }
};

struct EpiQ {
    static constexpr bool PERM = true, AFTER_DRAIN = false;
    DI bool keep_acc(const Unit&) const { return false; }
    bf16* Q;
    DI void operator()(EPI_ARGS) const {
        EPI_OPAQUE
#pragma unroll
        for (int ai = 0; ai < 2; ++ai)
#pragma unroll
            for (int m = 0; m < 4; ++m) {
                const int row = u.pm * 256 + ai * 128 + wr * 64 + m * 16 + fr;
#pragma unroll
                for (int bj = 0; bj < 2; ++bj) {
                    float v[8];
#pragma unroll
                    for (int n = 0; n < 2; ++n)
#pragma unroll
                        for (int j = 0; j < 4; ++j) v[4 * n + j] = acc[ai][bj][m][n][j];
                    *(u32x4*)(Q + (size_t)row * 768 + u.pn * 256 + 128 * bj + 32 * wc + 8 * fq) = pk8(v);
                }
            }
    }
};

struct EpiKV {
    static constexpr bool PERM = true, AFTER_DRAIN = false;
    DI bool keep_acc(const Unit&) const { return false; }
    bf16* KC; bf16* VT; const float* ssqkv;
    DI void operator()(EPI_ARGS) const {
        EPI_OPAQUE
        float rs8[8]; rstd8(ssqkv, 8, 2, 1.0f / 256.0f, 1.0f, u.pm * 256 + wr * 64 + fr, fq, rs8);
#pragma unroll
        for (int ai = 0; ai < 2; ++ai)
#pragma unroll
            for (int m = 0; m < 4; ++m) {
                const int row = u.pm * 256 + ai * 128 + wr * 64 + m * 16 + fr, b = row >> 12, s = row & 4095;
                const float rs = rs8[ai * 4 + m];
#pragma unroll
                for (int bj = 0; bj < 2; ++bj) {
                    const int c0 = u.pn * 256 + 128 * bj + 32 * wc + 8 * fq;
                    float v[8];
#pragma unroll
                    for (int n = 0; n < 2; ++n)
#pragma unroll
                        for (int j = 0; j < 4; ++j) v[4 * n + j] = acc[ai][bj][m][n][j] * rs;
                    if (c0 < 512) {
                        const int hd = c0 >> 6, d = c0 & 63;
                        bf16* kp = KC + ((size_t)(b * 8 + hd) * SEQ + s) * 96;
                        *(u32x4*)(kp + d) = pk8(v);
                    } else {
                        const int c = c0 - 512, hd = c >> 6, dv = c & 63;
                        bf16* vp = VT + ((size_t)(b * 8 + hd) * 64 + dv) * SEQ + s;
#pragma unroll
                        for (int e = 0; e < 8; ++e) vp[(size_t)e * SEQ] = f2bf(v[e]);
                    }
                }
            }
    }
};

struct EpiMemKV {
    static constexpr bool PERM = true, AFTER_DRAIN = false;
    DI bool keep_acc(const Unit&) const { return false; }
    bf16* MK; bf16* MVT; const float* rstd;
    DI void operator()(EPI_ARGS) const {
        EPI_OPAQUE
#pragma unroll
        for (int ai = 0; ai < 2; ++ai)
#pragma unroll
            for (int m = 0; m < 4; ++m) {
                const int row = u.pm * 256 + ai * 128 + wr * 64 + m * 16 + fr, b = row >> 8, mm = row & 255;
                const float rs = rstd[row];
#pragma unroll
                for (int bj = 0; bj < 2; ++bj) {
                    const int c0 = u.pn * 256 + 128 * bj + 32 * wc + 8 * fq;
                    float v[8];
#pragma unroll
                    for (int n = 0; n < 2; ++n)
#pragma unroll
                        for (int j = 0; j < 4; ++j) v[4 * n + j] = acc[ai][bj][m][n][j] * rs;
                    if (c0 < 512) { const int hd = c0 >> 7, d = c0 & 127; *(u32x4*)(MK + ((size_t)(b * 4 + hd) * 256 + mm) * 128 + d) = pk8(v); }
                    else { const int c = c0 - 512, hd = c >> 7, dv = c & 127; bf16* vp = MVT + ((size_t)(b * 4 + hd) * 128 + dv) * 256 + mm;
#pragma unroll
                        for (int e = 0; e < 8; ++e) vp[(size_t)e * 256] = f2bf(v[e]); }
                }
            }
    }
};

struct EpiBranch {
    static constexpr bool PERM = true, AFTER_DRAIN = false;
    DI bool keep_acc(const Unit&) const { return false; }
    bf16* MG; const bf16* gate; int first;
    DI void operator()(EPI_ARGS) const {
        EPI_OPAQUE
        const int rowb = u.pm * 256 + wr * 64 + fr, colb = u.pn * 256 + 32 * wc + 8 * fq;
#pragma unroll
        for (int ai = 0; ai < 2; ++ai) {
            u32x4 gv[4][2], pv[4][2];
#pragma unroll
            for (int m = 0; m < 4; ++m)
#pragma unroll
                for (int bj = 0; bj < 2; ++bj) { const size_t off = (size_t)(rowb + ai * 128 + m * 16) * 1024 + colb + 128 * bj;
                    gv[m][bj] = *(const u32x4*)(gate + off); pv[m][bj] = (u32x4){0, 0, 0, 0}; if (!first) pv[m][bj] = *(const u32x4*)(MG + off); }
#pragma unroll
            for (int m = 0; m < 4; ++m)
#pragma unroll
                for (int bj = 0; bj < 2; ++bj) {
                    const size_t off = (size_t)(rowb + ai * 128 + m * 16) * 1024 + colb + 128 * bj;
                    float g[8], o[8];
                    unpk8(gv[m][bj], g); unpk8(pv[m][bj], o);
#pragma unroll
                    for (int n = 0; n < 2; ++n)
#pragma unroll
                        for (int j = 0; j < 4; ++j) o[4 * n + j] += g[4 * n + j] * acc[ai][bj][m][n][j];
                    *(u32x4*)(MG + off) = pk8(o);
                }
        }
    }
};

struct EpiBranch3 {
    static constexpr bool PERM = true, AFTER_DRAIN = false;
    bf16* MG; const bf16* gates;
    DI bool keep_acc(const Unit& u) const { return u.seg < 2; }
    DI void operator()(f32x4 (&acc)[2][2][4][2], const Unit& u, int wr, int wc, int fr_in, int fq_in) const {
        EPI_OPAQUE
        const int rowb = u.pm * 256 + wr * 64 + fr, colb = u.pn * 256 + 32 * wc + 8 * fq, seg = u.seg;
        const bf16* gcur = gates + (size_t)seg * T * 1024; const bf16* gnxt = gates + (size_t)(seg < 2 ? seg + 1 : seg) * T * 1024;
#pragma unroll
        for (int ai = 0; ai < 2; ++ai) {
            u32x4 gv[4][2], nv[4][2];
#pragma unroll
            for (int m = 0; m < 4; ++m)
#pragma unroll
                for (int bj = 0; bj < 2; ++bj) { const size_t off = (size_t)(rowb + ai * 128 + m * 16) * 1024 + colb + 128 * bj; gv[m][bj] = *(const u32x4*)(gcur + off); nv[m][bj] = *(const u32x4*)(gnxt + off); }
#pragma unroll
            for (int m = 0; m < 4; ++m)
#pragma unroll
                for (int bj = 0; bj < 2; ++bj) {
                    float g[8], gn[8];
                    unpk8(gv[m][bj], g); unpk8(nv[m][bj], gn);
                    if (seg < 2) {
#pragma unroll
                        for (int n = 0; n < 2; ++n)
#pragma unroll
                            for (int j = 0; j < 4; ++j) acc[ai][bj][m][n][j] *= g[4 * n + j] * __builtin_amdgcn_rcpf(fmaxf(gn[4 * n + j], 1e-30f));
                    } else {
                        float o[8];
#pragma unroll
                        for (int n = 0; n < 2; ++n)
#pragma unroll
                            for (int j = 0; j < 4; ++j) o[4 * n + j] = acc[ai][bj][m][n][j] * g[4 * n + j];
                        *(u32x4*)(MG + (size_t)(rowb + ai * 128 + m * 16) * 1024 + colb + 128 * bj) = pk8(o);
                    }
                }
        }
    }
};
struct SegOrder3 : pg8::StaticOrder {
    const char* wsb;
    DI bool next(int i, Unit& u) const { const int base = i / 3; if (!pg8::StaticOrder::next(base, u)) return false; u.seg = i - 3 * base; return true; }
    DI const char* a_ptr(const pg8::Gemm&, const Unit& u) const {
        const long long off = (long long)WS_AO + (long long)(u.seg == 1) * ((long long)WS_HO - (long long)WS_AO) + (long long)(u.seg == 2) * ((long long)WS_MO - (long long)WS_AO);
        return wsb + off; }
    DI const char* b_ptr(const pg8::Gemm& g, const Unit& u) const { return (const char*)g.Bt + (size_t)u.seg * ((size_t)1024 * 512 * 2); }
};

template <class Epi> DI void run_gemm(LAS unsigned char* lds, const bf16* A, const bf16* Bt, int M, int N, int K, int rot, const Epi& E) {
    int Kv = K, Nv = N, Mv = M; asm volatile("" : "+s"(Kv), "+s"(Nv), "+s"(Mv));
    pg8::Gemm g{A, Bt, Mv, Nv, Kv}; pg8::StaticOrder S; const int G = (int)gridDim.x;
    S.init(Mv, Nv, G, (int)((blockIdx.x + (unsigned)G - (unsigned)rot) % (unsigned)G));
    pg8::gemm_phase<Epi, pg8::StaticOrder, true, true>(lds, g, S, E);
}

#define MFMA32(a, b, c) __builtin_amdgcn_mfma_f32_32x32x16_bf16((a), (b), (c), 0, 0, 0)
template <int DQK, int DV, bool CAUSAL>
DI void attn_tile(const LAS unsigned char* kb, const LAS unsigned char* vb, const bf16x8 (&qf)[DQK / 16], f32x16 (&o)[DV / 32], float& mrun, float& lrun, int t, int qlo, int r, int h) {
    constexpr int KROW = DQK * 2 + 16, VROW = 144, KS = DQK / 16, NDB = DV / 32;
    f32x16 s0, s1;
    const float negm = -mrun;
#pragma unroll
    for (int i = 0; i < 16; ++i) { s0[i] = negm; s1[i] = negm; }
#pragma unroll
    for (int ks = 0; ks < KS; ++ks) {
        const bf16x8 k0 = *(const LAS bf16x8*)(kb + r * KROW + 32 * ks + 16 * h);
        const bf16x8 k1 = *(const LAS bf16x8*)(kb + (32 + r) * KROW + 32 * ks + 16 * h);
        s0 = MFMA32(k0, qf[ks], s0); s1 = MFMA32(k1, qf[ks], s1);
    }
    if (CAUSAL && (64 * t + 63 > qlo)) {
        const int qpos = qlo + r, kbase = 64 * t + 4 * h;
#pragma unroll
        for (int i = 0; i < 16; ++i) { const int key = kbase + (i & 3) + 8 * (i >> 2);
            if (key > qpos) s0[i] = -1e30f; if (key + 32 > qpos) s1[i] = -1e30f; }
    }
    float mx = fmaxf(s0[0], s1[0]);
#pragma unroll
    for (int i = 1; i < 16; ++i) mx = fmaxf(mx, fmaxf(s0[i], s1[i]));
    mx = fmaxf(mx, __shfl_xor(mx, 32));
    if (__builtin_amdgcn_ballot_w64(mx > 8.0f) != 0ull) {
        const float delta = fmaxf(mx, 0.f), alpha = __builtin_amdgcn_exp2f(-delta);
        mrun += delta; lrun *= alpha;
#pragma unroll
        for (int i = 0; i < 16; ++i) { s0[i] -= delta; s1[i] -= delta; }
#pragma unroll
        for (int db = 0; db < NDB; ++db)
#pragma unroll
            for (int i = 0; i < 16; ++i) o[db][i] *= alpha;
    }
    float ps = 0.f;
#pragma unroll
    for (int i = 0; i < 16; ++i) { s0[i] = __builtin_amdgcn_exp2f(s0[i]); s1[i] = __builtin_amdgcn_exp2f(s1[i]); ps += s0[i] + s1[i]; }
    lrun += ps;
#pragma unroll
    for (int kb2 = 0; kb2 < 2; ++kb2)
#pragma unroll
        for (int s = 0; s < 2; ++s) {
            u32x4 pw;
            if (kb2 == 0) { pw.x = pk2(s0[8 * s], s0[8 * s + 1]); pw.y = pk2(s0[8 * s + 2], s0[8 * s + 3]); pw.z = pk2(s0[8 * s + 4], s0[8 * s + 5]); pw.w = pk2(s0[8 * s + 6], s0[8 * s + 7]); }
            else { pw.x = pk2(s1[8 * s], s1[8 * s + 1]); pw.y = pk2(s1[8 * s + 2], s1[8 * s + 3]); pw.z = pk2(s1[8 * s + 4], s1[8 * s + 5]); pw.w = pk2(s1[8 * s + 6], s1[8 * s + 7]); }
            const bf16x8 pf = __builtin_bit_cast(bf16x8, pw);
            const int koff = (32 * kb2 + 16 * s + 4 * h) * 2;
#pragma unroll
            for (int db = 0; db < NDB; ++db) {
                const u32x2 lo = *(const LAS u32x2*)(vb + (32 * db + r) * VROW + koff), hi = *(const LAS u32x2*)(vb + (32 * db + r) * VROW + koff + 16);
                u32x4 vw; vw.x = lo.x; vw.y = lo.y; vw.z = hi.x; vw.w = hi.y;
                o[db] = MFMA32(__builtin_bit_cast(bf16x8, vw), pf, o[db]);
            }
        }
}

template <int DQK, int DV, bool CAUSAL>
DI void attn_item(LAS unsigned char* lds, const bf16* Qp, int qstride, const bf16* Kp, const bf16* VTp, int vt_stride, bf16* Op, int ostride, int q0, int nkeys,
                  const float* ssqq, const float* cosT, const float* sinT) {
    constexpr int KROW = DQK * 2 + 16, VROW = 144, KBYTES = 64 * KROW, VBYTES = DV * VROW, BUF = KBYTES + VBYTES;
    constexpr int NCK = 64 * DQK / 8, NCV = DV * 8, KS = DQK / 16, NDB = DV / 32;
    constexpr int CPR = DQK / 8;
    int tid_o = threadIdx.x; asm volatile("" : "+v"(tid_o)); const int tid = tid_o, wid = __builtin_amdgcn_readfirstlane(tid >> 6), lane = tid & 63, r = lane & 31, h = lane >> 5;
    const int ntiles = CAUSAL ? (q0 + 256) / 64 : nkeys / 64;
    const int qlo = q0 + wid * 32;
    bf16x8 qf[KS];
    { const bf16* qr = Qp + (size_t)(wid * 32 + r) * qstride + 8 * h;
#pragma unroll
      for (int ks = 0; ks < KS; ++ks) qf[ks] = *(const bf16x8*)(qr + 16 * ks);
      if (CAUSAL) {
          const float* sp = ssqq + (size_t)(wid * 32 + r) * 16;
          const f32x4 a = *(const f32x4*)sp, b = *(const f32x4*)(sp + 4), c = *(const f32x4*)(sp + 8);
          const float rs = rsqrtf((((a.x + a.y) + (a.z + a.w)) + ((b.x + b.y) + (b.z + b.w)) + ((c.x + c.y) + (c.z + c.w))) * (1.0f / 384.0f) + EPS) * QSCALE_MLA;
#pragma unroll
          for (int ks = 0; ks < KS; ++ks) {
              float v[8]; unpk8(__builtin_bit_cast(u32x4, qf[ks]), v);
              if (ks >= 4) {
                  const int i0 = 8 * (ks - 4) + 4 * h;
                  const f32x4 cs = *(const f32x4*)(cosT + (size_t)(wid * 32 + r) * 16 + i0), sn = *(const f32x4*)(sinT + (size_t)(wid * 32 + r) * 16 + i0);
                  const float t0 = v[0], t1 = v[1], t2 = v[2], t3 = v[3], t4 = v[4], t5 = v[5], t6 = v[6], t7 = v[7];
                  v[0] = t0 * cs.x - t1 * sn.x; v[1] = t1 * cs.x + t0 * sn.x; v[2] = t2 * cs.y - t3 * sn.y; v[3] = t3 * cs.y + t2 * sn.y;
                  v[4] = t4 * cs.z - t5 * sn.z; v[5] = t5 * cs.z + t4 * sn.z; v[6] = t6 * cs.w - t7 * sn.w; v[7] = t7 * cs.w + t6 * sn.w;
              }
#pragma unroll
              for (int e = 0; e < 8; ++e) v[e] *= rs;
              qf[ks] = __builtin_bit_cast(bf16x8, pk8(v));
          }
      } }
    f32x16 o[NDB];
#pragma unroll
    for (int db = 0; db < NDB; ++db)
#pragma unroll
        for (int i = 0; i < 16; ++i) o[db][i] = 0.f;
    float mrun = 0.f, lrun = 0.f;
    const int kc0 = tid, kc1 = tid + 512; const bool k1on = kc1 < NCK;
    const int kr0 = kc0 / CPR, kcc0 = kc0 % CPR, kr1 = kc1 / CPR, kcc1 = kc1 % CPR;
    const int vc0 = tid, vc1 = tid + 512; const bool v1on = vc1 < NCV;
    const GAS u32x4* Kg = (const GAS u32x4*)Kp;
    u32x4 ak0, ak1 = {0, 0, 0, 0}, av0, av1 = {0, 0, 0, 0}, bk0, bk1 = {0, 0, 0, 0}, bv0, bv1 = {0, 0, 0, 0};
#define ATT_GLOAD(P, t_) do { P##k0 = Kg[(size_t)(t_) * NCK + kc0]; if (k1on) P##k1 = Kg[(size_t)(t_) * NCK + kc1]; \
        P##v0 = *(const GAS u32x4*)(VTp + (size_t)(vc0 >> 3) * vt_stride + (t_) * 64 + (vc0 & 7) * 8); \
        if (v1on) P##v1 = *(const GAS u32x4*)(VTp + (size_t)(vc1 >> 3) * vt_stride + (t_) * 64 + (vc1 & 7) * 8); } while (0)
#define ATT_LSTORE(P, buf_) do { LAS unsigned char* kb_ = lds + (buf_) * BUF; LAS unsigned char* vb_ = kb_ + KBYTES; \
        *(LAS u32x4*)(kb_ + kr0 * KROW + kcc0 * 16) = P##k0; if (k1on) *(LAS u32x4*)(kb_ + kr1 * KROW + kcc1 * 16) = P##k1; \
        *(LAS u32x4*)(vb_ + (vc0 >> 3) * VROW + (vc0 & 7) * 16) = P##v0; if (v1on) *(LAS u32x4*)(vb_ + (vc1 >> 3) * VROW + (vc1 & 7) * 16) = P##v1; } while (0)
    ATT_GLOAD(a, 0); ATT_LSTORE(a, 0);
    if (ntiles > 1) ATT_GLOAD(a, 1);
    __syncthreads();
    for (int t = 0; t < ntiles; t += 2) {
        if (t + 2 < ntiles) ATT_GLOAD(b, t + 2);
        if (!CAUSAL || (64 * t <= qlo + 31)) attn_tile<DQK, DV, CAUSAL>(lds, lds + KBYTES, qf, o, mrun, lrun, t, qlo, r, h);
        if (t + 1 < ntiles) ATT_LSTORE(a, 1);
        __syncthreads();
        if (t + 1 < ntiles) {
            if (t + 3 < ntiles) ATT_GLOAD(a, t + 3);
            if (!CAUSAL || (64 * (t + 1) <= qlo + 31)) attn_tile<DQK, DV, CAUSAL>(lds + BUF, lds + BUF + KBYTES, qf, o, mrun, lrun, t + 1, qlo, r, h);
            if (t + 2 < ntiles) ATT_LSTORE(b, 0);
            __syncthreads();
        }
    }
#undef ATT_GLOAD
#undef ATT_LSTORE
    const float ltot = lrun + __shfl_xor(lrun, 32), inv = 1.0f / ltot;
    bf16* orow = Op + (size_t)(wid * 32 + r) * ostride + 4 * h;
#pragma unroll
    for (int db = 0; db < NDB; ++db)
#pragma unroll
        for (int g = 0; g < 4; ++g) {
            u32x2 w; w.x = pk2(o[db][4 * g] * inv, o[db][4 * g + 1] * inv); w.y = pk2(o[db][4 * g + 2] * inv, o[db][4 * g + 3] * inv);
            *(u32x2*)(orow + 32 * db + 8 * g) = w;
        }
}

template <int KSTEPS> DI void lds_mma(f32x16& c, const LAS unsigned char* A, int astride, const LAS unsigned char* Bt, int bstride, int r, int h) {
#pragma unroll
    for (int s = 0; s < KSTEPS; ++s) {
        const bf16x8 a = *(const LAS bf16x8*)(A + r * astride + 32 * s + 16 * h);
        const bf16x8 b = *(const LAS bf16x8*)(Bt + r * bstride + 32 * s + 16 * h);
        c = MFMA32(a, b, c);
    }
}

DI void hgrn_b1(LAS unsigned char* lds, int ch, float* GG, const bf16* HK, const bf16* HV, bf16* LT, float* DEC) {
    int tid_o = threadIdx.x; asm volatile("" : "+v"(tid_o)); const int tid = tid_o, wid = __builtin_amdgcn_readfirstlane(tid >> 6), lane = tid & 63, r = lane & 31, h = lane >> 5;
    const int bh = ch >> 6, c = ch & 63, b = bh >> 2, hd = bh & 3;
    const size_t t0 = (size_t)b * SEQ + c * 64;
    const int k = tid & 127, seg = tid >> 7;
    LAS float* segsum = (LAS float*)lds;
    LAS unsigned char* kdT = lds + 2048;
    LAS unsigned char* vT = kdT + 128 * 144;
    float g[16]; float run = 0.f;
    float* gp = GG + (t0 + seg * 16) * 512 + hd * 128 + k;
#pragma unroll
    for (int i = 0; i < 16; ++i) { run += gp[(size_t)i * 512]; g[i] = run; }
    segsum[seg * 128 + k] = run;
    __syncthreads();
    float off = 0.f, tot = 0.f;
#pragma unroll
    for (int s = 0; s < 4; ++s) { const float v = segsum[s * 128 + k]; if (s < seg) off += v; tot += v; }
    const bf16* kp = HK + (t0 + seg * 16) * 512 + hd * 128 + k;
    const bf16* vp = HV + (t0 + seg * 16) * 512 + hd * 128 + k;
#pragma unroll
    for (int i = 0; i < 16; ++i) {
        const float G = g[i] + off; gp[(size_t)i * 512] = G;
        const float kd = bf2f(kp[(size_t)i * 512]) * __expf(tot - G);
        *(LAS bf16*)(kdT + k * 144 + (seg * 16 + i) * 2) = f2bf(kd);
        *(LAS bf16*)(vT + k * 144 + (seg * 16 + i) * 2) = vp[(size_t)i * 512];
    }
    if (seg == 0) DEC[(size_t)ch * 128 + k] = __expf(tot);
    __syncthreads();
    const int vb = wid >> 1;
#pragma unroll
    for (int q = 0; q < 2; ++q) {
        const int kb = (wid & 1) * 2 + q;
        f32x16 acc;
#pragma unroll
        for (int i = 0; i < 16; ++i) acc[i] = 0.f;
        lds_mma<4>(acc, vT + vb * 32 * 144, 144, kdT + kb * 32 * 144, 144, r, h);
        bf16* lp = LT + (size_t)ch * 16384 + (size_t)(vb * 32 + 4 * h) * 128 + kb * 32 + r;
#pragma unroll
        for (int i = 0; i < 16; ++i) lp[(size_t)((i & 3) + 8 * (i >> 2)) * 128] = f2bf(acc[i]);
    }
    __syncthreads();
}

DI void hgrn_b3(LAS unsigned char* lds, int ch, const float* GG, const bf16* HQ, const bf16* HK, const bf16* HV, const bf16* HGT, const bf16* LT, const float* onorm, bf16* HO) {
    constexpr int RS = 272;
    int tid_o = threadIdx.x; asm volatile("" : "+v"(tid_o)); const int tid = tid_o, wid = __builtin_amdgcn_readfirstlane(tid >> 6), lane = tid & 63, r = lane & 31, h = lane >> 5;
    const int bh = ch >> 6, c = ch & 63, b = bh >> 2, hd = bh & 3;
    const size_t t0 = (size_t)b * SEQ + c * 64;
    LAS unsigned char* qG = lds;
    LAS unsigned char* q1 = qG + 64 * RS;
    LAS unsigned char* kA0 = q1 + 32 * RS;
    LAS unsigned char* kA1 = kA0 + 32 * RS;
    LAS unsigned char* ST = kA1 + 64 * RS;
    LAS unsigned char* vT = ST + 128 * RS;
    LAS unsigned char* Am = vT + 128 * 144;
    {
        const int k8 = tid & 15;
        const float* g31p = GG + (t0 + 31) * 512 + hd * 128 + k8 * 8;
        const f32x4 ga = *(const f32x4*)g31p, gb = *(const f32x4*)(g31p + 4);
        const float g31[8] = {ga.x, ga.y, ga.z, ga.w, gb.x, gb.y, gb.z, gb.w};
#pragma unroll
        for (int pass = 0; pass < 2; ++pass) {
            const int t = (tid >> 4) + 32 * pass;
            const size_t off = (t0 + t) * 512 + hd * 128 + k8 * 8;
            const f32x4 a = *(const f32x4*)(GG + off), bq = *(const f32x4*)(GG + off + 4);
            const float G[8] = {a.x, a.y, a.z, a.w, bq.x, bq.y, bq.z, bq.w};
            float q[8], kk[8], o1[8], o2[8], o3[8];
            unpk8(*(const u32x4*)(HQ + off), q); unpk8(*(const u32x4*)(HK + off), kk);
#pragma unroll
            for (int e = 0; e < 8; ++e) o1[e] = q[e] * __expf(G[e]);
            *(LAS u32x4*)(qG + t * RS + k8 * 16) = pk8(o1);
            if (pass == 0) {
#pragma unroll
                for (int e = 0; e < 8; ++e) { o2[e] = kk[e] * __expf(fminf(-G[e], 80.f)); o3[e] = kk[e] * __expf(g31[e] - G[e]); }
                *(LAS u32x4*)(kA0 + t * RS + k8 * 16) = pk8(o2);
                *(LAS u32x4*)(kA1 + t * RS + k8 * 16) = pk8(o3);
            } else {
#pragma unroll
                for (int e = 0; e < 8; ++e) { o2[e] = q[e] * __expf(G[e] - g31[e]); o3[e] = kk[e] * __expf(fminf(g31[e] - G[e], 80.f)); }
                *(LAS u32x4*)(q1 + (t - 32) * RS + k8 * 16) = pk8(o2);
                *(LAS u32x4*)(kA1 + t * RS + k8 * 16) = pk8(o3);
            }
        }
        const bf16* lp = LT + (size_t)ch * 16384;
#pragma unroll
        for (int p = 0; p < 4; ++p) {
            const int idx = tid + 512 * p, v = idx >> 4, kk8 = idx & 15;
            *(LAS u32x4*)(ST + v * RS + kk8 * 16) = *(const u32x4*)(lp + v * 128 + kk8 * 8);
        }
        const int v = tid & 127, seg = tid >> 7;
        const bf16* vp = HV + (t0 + seg * 16) * 512 + hd * 128 + v;
#pragma unroll
        for (int i = 0; i < 16; ++i) *(LAS bf16*)(vT + v * 144 + (seg * 16 + i) * 2) = vp[(size_t)i * 512];
    }
    __syncthreads();
    if (wid < 3) {
        f32x16 a;
#pragma unroll
        for (int i = 0; i < 16; ++i) a[i] = 0.f;
        const int tb = wid == 0 ? 0 : 1, sb = wid == 2 ? 1 : 0;
        if (wid == 0) lds_mma<8>(a, qG, RS, kA0, RS, r, h);
        else lds_mma<8>(a, q1, RS, kA1 + sb * 32 * RS, RS, r, h);
#pragma unroll
        for (int i = 0; i < 16; ++i) { const int tl = (i & 3) + 8 * (i >> 2) + 4 * h; float val = a[i]; if (tb == sb && r > tl) val = 0.f;
            *(LAS bf16*)(Am + (tb * 32 + tl) * 144 + (sb * 32 + r) * 2) = f2bf(val); }
    } else if (wid == 3) {
#pragma unroll
        for (int i = 0; i < 16; ++i) { const int tl = (i & 3) + 8 * (i >> 2) + 4 * h; *(LAS bf16*)(Am + tl * 144 + (32 + r) * 2) = (bf16)0; }
    }
    __syncthreads();
    f32x16 acc;
#pragma unroll
    for (int i = 0; i < 16; ++i) acc[i] = 0.f;
    const int tb = wid >> 2, vb = wid & 3;
    lds_mma<8>(acc, qG + tb * 32 * RS, RS, ST + vb * 32 * RS, RS, r, h);
    lds_mma<4>(acc, Am + tb * 32 * 144, 144, vT + vb * 32 * 144, 144, r, h);
    __syncthreads();
    LAS float* Ost = (LAS float*)ST;
#pragma unroll
    for (int i = 0; i < 16; ++i) Ost[(tb * 32 + (i & 3) + 8 * (i >> 2) + 4 * h) * 132 + vb * 32 + r] = acc[i];
    __syncthreads();
    {
        const int t = tid >> 3, part = tid & 7;
        float ov[16]; float ss = 0.f;
#pragma unroll
        for (int q4 = 0; q4 < 4; ++q4) { const f32x4 x = *(const LAS f32x4*)(Ost + t * 132 + part * 16 + q4 * 4); ov[4 * q4] = x.x; ov[4 * q4 + 1] = x.y; ov[4 * q4 + 2] = x.z; ov[4 * q4 + 3] = x.w; }
#pragma unroll
        for (int e = 0; e < 16; ++e) ss += ov[e] * ov[e];
        ss += __shfl_xor(ss, 1); ss += __shfl_xor(ss, 2); ss += __shfl_xor(ss, 4);
        const float rs = rsqrtf(ss * (1.0f / 128.0f) + EPS);
        const size_t off = (t0 + t) * 512 + hd * 128 + part * 16;
        float gt[16];
        unpk8(*(const u32x4*)(HGT + off), gt); unpk8(*(const u32x4*)(HGT + off + 8), gt + 8);
#pragma unroll
        for (int e = 0; e < 16; ++e) ov[e] = ov[e] * rs * onorm[part * 16 + e] * gt[e];
        *(u32x4*)(HO + off) = pk8(ov); *(u32x4*)(HO + off + 8) = pk8(ov + 8);
    }
    __syncthreads();
}

DI int dest_row(int mode, int n) {
    if (mode == 0) return n;
    if (mode == 1) { const int j = n < DFF ? n : n - DFF; return (j >> 7) * 256 + (n < DFF ? 0 : 128) + (j & 127); }
    if (mode == 2) { if (n < 640) return n; if (n < 672) { const int j = n - 640; return 640 + (j < 16 ? 2 * j : 2 * (j - 16) + 1); } if (n < 3232) return 768 + (n - 672); return 3328 + (n - 3232); }
    const int hd = n / 96, w = n - hd * 96; if (w < 64) return n; const int j = w - 64; return hd * 96 + 64 + (j < 16 ? 2 * j : 2 * (j - 16) + 1);
}
DI void conv_item(const float* W, int K, int N, bf16* WT, const float* gain, int mode, int row_off, LAS float* scr, int item, int lane) {
    const int nblk = N / 32, kb = item / nblk, nb = item - kb * nblk, k0 = 64 * kb, n0 = 32 * nb;
    float wv[32];
    const float* wp = W + (size_t)(k0 + (lane >> 5)) * N + n0 + (lane & 31);
#pragma unroll
    for (int i = 0; i < 32; ++i) wv[i] = __builtin_nontemporal_load(wp + (size_t)(2 * i) * N);
#pragma unroll
    for (int i = 0; i < 32; ++i) scr[(2 * i + (lane >> 5)) * 33 + (lane & 31)] = wv[i];
    asm volatile("s_waitcnt lgkmcnt(0)" ::: "memory");
    const int c = lane & 7;
    float gn[8];
#pragma unroll
    for (int e = 0; e < 8; ++e) gn[e] = gain ? gain[k0 + 8 * c + e] : 1.0f;
#pragma unroll
    for (int j = 0; j < 4; ++j) { const int n = (lane >> 3) + 8 * j; const LAS float* s = scr + (8 * c) * 33 + n;
        float v[8];
#pragma unroll
        for (int e = 0; e < 8; ++e) v[e] = s[e * 33] * gn[e];
        *(u32x4*)(WT + (size_t)(row_off + dest_row(mode, n0 + n)) * K + k0 + 8 * c) = pk8(v); }
    asm volatile("s_waitcnt lgkmcnt(0)" ::: "memory");
}

#define XB_TMO      128
#define XB_XCNT(j)  (256  + 64 * (j))
#define XB_XSUB(j)  (1280 + 64 * (j))
#define XB_XGEN(j)  (2304 + 64 * (j))
#define XB_TOP      3328
#define XB_TOPGEN   3392
#define XCD_BAR_WORDS 3456
#define XB_SPIN_CAP (1u << 18)
static_assert(XCD_BAR_WORDS * 4 <= CTL_BYTES, "barrier words inside the memset region");
DI unsigned xb_ld(unsigned* p)              { return __hip_atomic_load(p, __ATOMIC_RELAXED, __HIP_MEMORY_SCOPE_AGENT); }
DI unsigned xb_add(unsigned* p, unsigned v) { return __hip_atomic_fetch_add(p, v, __ATOMIC_RELAXED, __HIP_MEMORY_SCOPE_AGENT); }
DI unsigned xb_xcc_id() { return (unsigned)__builtin_amdgcn_s_getreg((3 << 11) | 20) & 0xFu; }
#define XB_SPIN(cond, bar) do { unsigned _sp = 0; while (cond) { __builtin_amdgcn_s_sleep(1); \
    if ((++_sp & 255u) == 0u) { if (xb_ld(&(bar)[XB_TMO])) break; if (_sp > XB_SPIN_CAP) { atomicAdd(&(bar)[XB_TMO], 1u); break; } } } } while (0)
struct XcdBarrier { unsigned* bar; unsigned x; volatile LAS unsigned* st; };
DI void xcd_barrier_complete(unsigned* bar, unsigned x, unsigned& nloc, unsigned& nx) {
    const unsigned G = gridDim.x * gridDim.y * gridDim.z;
    unsigned sum, cnt, mine, sp = 0u;
    for (;;) {
        sum = 0u; cnt = 0u; mine = 0u;
#pragma unroll
        for (unsigned j = 0; j < 16; ++j) { const unsigned c = xb_ld(&bar[XB_XCNT(j)]); sum += c; cnt += (c > 0u) ? 1u : 0u; mine = (j == x) ? c : mine; }
        if (sum == G) break;
        __builtin_amdgcn_s_sleep(1);
        if ((++sp & 255u) == 0u) { if (xb_ld(&bar[XB_TMO])) break; if (sp > XB_SPIN_CAP) { atomicAdd(&bar[XB_TMO], 1u); break; } }
    }
    nloc = mine > 0u ? mine : 1u; nx = cnt > 0u ? cnt : 1u;
}
DI void xcd_barrier(const XcdBarrier& b) {
    asm volatile("s_waitcnt vmcnt(0)" ::: "memory");
    __syncthreads();
    if (threadIdx.x == 0) {
        unsigned* bar = b.bar;
        __builtin_amdgcn_s_waitcnt(0);
        unsigned nloc = b.st[0], nx = b.st[1];
        if (nloc == 0u) { xcd_barrier_complete(bar, b.x, nloc, nx); b.st[0] = nloc; b.st[1] = nx; }
        const unsigned old = xb_add(&bar[XB_XSUB(b.x)], 1u);
        const unsigned gen = old / nloc;
        if (old + 1u == (gen + 1u) * nloc) {
            __builtin_amdgcn_fence(__ATOMIC_RELEASE, "agent");
            asm volatile("s_waitcnt vmcnt(0)" ::: "memory");
            const unsigned og = xb_add(&bar[XB_TOP], 1u);
            const unsigned tg = og / nx;
            if (og + 1u == (tg + 1u) * nx) xb_add(&bar[XB_TOPGEN], 1u);
            else XB_SPIN(xb_ld(&bar[XB_TOPGEN]) == tg, bar);
            __builtin_amdgcn_fence(__ATOMIC_ACQUIRE, "agent");
            xb_add(&bar[XB_XGEN(b.x)], 1u);
            asm volatile("s_waitcnt vmcnt(0)" ::: "memory");
        } else {
            XB_SPIN(xb_ld(&bar[XB_XGEN(b.x)]) == gen, bar);
            __builtin_amdgcn_fence(__ATOMIC_ACQUIRE, "agent");
            asm volatile("s_waitcnt vmcnt(0)" ::: "memory");
        }
    }
    __syncthreads();
}

struct Args { const void* in[25]; float* out; unsigned char* ws; int ph_lo, ph_hi; };
typedef const __attribute__((address_space(4))) unsigned long long* ka_t;
DI unsigned long long KA(int i) { ka_t p = (ka_t)__builtin_amdgcn_kernarg_segment_ptr(); asm volatile("" : "+s"(p)); return p[i]; }
#define KIN(i) ((const float*)KA(i))
#define KOUT ((float*)KA(25))
#define KWS ((unsigned char*)KA(26))

DI void conv_set(int mask, int l, int bpart, int nbparts, LAS unsigned char* lds) {
    int tid_o = threadIdx.x; asm volatile("" : "+v"(tid_o)); const int tid = tid_o, wave = __builtin_amdgcn_readfirstlane(tid >> 6), lane = tid & 63;
    const int part = bpart * NWAVES + wave, nparts = nbparts * NWAVES, tpart = bpart * NTHREADS + tid, ntparts = nbparts * NTHREADS;
    LAS float* scr = (LAS float*)(lds + wave * 16384);
    unsigned char* ws = KWS;
    constexpr int I_FI = 16 * 176, I_FO = 44 * 32, I_WIN = 16 * 197, I_UQ = 6 * 24, I_UK = 4 * 16, I_WO = 8 * 32, I_SQ = 16 * 32;
    if (mask & 1) {
        const float* f1n = KIN(3) + l * 1024; const float* w1i = KIN(4) + (size_t)l * 1024 * 5632; const float* w1o = KIN(5) + (size_t)l * 2816 * 1024;
        for (int it = part; it < I_FI + I_FO; it += nparts) {
            if (it < I_FI) conv_item(w1i, 1024, 5632, (bf16*)(ws + WT_W1IN), f1n, 1, 0, scr, it, lane);
            else conv_item(w1o, 2816, 1024, (bf16*)(ws + WT_W1OUT), nullptr, 0, 0, scr, it - I_FI, lane);
        }
    }
    if (mask & 4) {
        const float* f2n = KIN(21) + l * 1024; const float* w2i = KIN(22) + (size_t)l * 1024 * 5632; const float* w2o = KIN(23) + (size_t)l * 2816 * 1024;
        for (int it = part; it < I_FI + I_FO; it += nparts) {
            if (it < I_FI) conv_item(w2i, 1024, 5632, (bf16*)(ws + WT_W2IN), f2n, 1, 0, scr, it, lane);
            else conv_item(w2o, 2816, 1024, (bf16*)(ws + WT_W2OUT), nullptr, 0, 0, scr, it - I_FI, lane);
        }
    }
    if (mask & 2) {
        const float* mxn = KIN(6) + l * 1024; const float* win = KIN(7) + (size_t)l * 1024 * DIN;
        for (int it = part; it < I_WIN; it += nparts) conv_item(win, 1024, DIN, (bf16*)(ws + WT_WIN), mxn, 2, 0, scr, it, lane);
        u32x4* pad = (u32x4*)(ws + WT_WIN + (size_t)672 * 1024 * 2);
        unsigned zz = 0u; asm volatile("" : "+v"(zz));
        for (int i = tpart; i < 96 * 1024 * 2 / 16; i += ntparts) pad[i] = (u32x4){zz, zz, zz, zz};
    }
    if (mask & 8) {
        const float* qln = KIN(8) + l * 384; const float* kvn = KIN(9) + l * 256;
        const float* wuq = KIN(10) + (size_t)l * 384 * 768; const float* wuk = KIN(11) + (size_t)l * 256 * 512; const float* wuv = KIN(12) + (size_t)l * 256 * 512;
        const float* womla = KIN(13) + (size_t)l * 512 * 1024; const float* wohg = KIN(16) + (size_t)l * 512 * 1024; const float* womem = KIN(19) + (size_t)l * 512 * 1024;
        const float* wout = KIN(20) + (size_t)l * 1024 * 1024;
        constexpr int NIT = I_UQ + 2 * I_UK + 3 * I_WO + I_SQ;
        for (int it = part; it < NIT; it += nparts) {
            int r = it;
            if (r < I_UQ) { conv_item(wuq, 384, 768, (bf16*)(ws + WT_WUQ), qln, 3, 0, scr, r, lane); continue; } r -= I_UQ;
            if (r < I_UK) { conv_item(wuk, 256, 512, (bf16*)(ws + WT_WUKV), kvn, 0, 0, scr, r, lane); continue; } r -= I_UK;
            if (r < I_UK) { conv_item(wuv, 256, 512, (bf16*)(ws + WT_WUKV), kvn, 0, 512, scr, r, lane); continue; } r -= I_UK;
            if (r < I_WO) { conv_item(womla, 512, 1024, (bf16*)(ws + WT_WOMLA), nullptr, 0, 0, scr, r, lane); continue; } r -= I_WO;
            if (r < I_WO) { conv_item(wohg, 512, 1024, (bf16*)(ws + WT_WOHG), nullptr, 0, 0, scr, r, lane); continue; } r -= I_WO;
            if (r < I_WO) { conv_item(womem, 512, 1024, (bf16*)(ws + WT_WOMEM), nullptr, 0, 0, scr, r, lane); continue; } r -= I_WO;
            conv_item(wout, 1024, 1024, (bf16*)(ws + WT_WOUT), nullptr, 0, 0, scr, r, lane);
        }
    }
    if (mask & 16) {
        const float* memn = KIN(17); const float* wmkv = KIN(18);
        for (int it = part; it < 4 * I_SQ; it += nparts) { const int ll = it / I_SQ, r = it - ll * I_SQ;
            conv_item(wmkv + (size_t)ll * 1024 * 1024, 1024, 1024, (bf16*)(ws + WT_WMEMKV) + (size_t)ll * 1024 * 1024, memn + ll * 1024, 0, 0, scr, r, lane); }
    }
    __syncthreads();
}
DI void conv_tail(int mask, int l, int nwg, LAS unsigned char* lds) {
    const int G = (int)gridDim.x, rem = nwg % G, c = (int)blockIdx.x;
    if (c < rem) return;
    conv_set(mask, l, c - rem, G - rem, lds);
}

DI void prep_phase() {
    int tid_o = threadIdx.x; asm volatile("" : "+v"(tid_o)); const int tid = tid_o, wave = __builtin_amdgcn_readfirstlane(tid >> 6), lane = tid & 63;
    const int gw = blockIdx.x * NWAVES + wave, NGW = gridDim.x * NWAVES;
    unsigned char* ws = KWS; float* xout = KOUT;
    const float* x = KIN(0); const float* mem = KIN(1); const int* pos = (const int*)KA(2);
    bf16* XB = (bf16*)(ws + WS_XB); float* SSQ = (float*)(ws + WS_SSQ);
    for (int m = gw; m < T; m += NGW) {
        const f32x4* xr = (const f32x4*)(x + (size_t)m * D) + lane; f32x4* orow = (f32x4*)(xout + (size_t)m * D) + lane; u32x2* xb = (u32x2*)(XB + (size_t)m * D) + lane;
        float s = 0.f;
#pragma unroll
        for (int j = 0; j < 4; ++j) { const f32x4 v = xr[64 * j]; orow[64 * j] = v; s += (v.x * v.x + v.y * v.y) + (v.z * v.z + v.w * v.w); u32x2 w; w.x = pk2(v.x, v.y); w.y = pk2(v.z, v.w); xb[64 * j] = w; }
        s = wave_sum(s);
        if (lane < 16) SSQ[(size_t)m * 16 + lane] = lane == 0 ? s : 0.f;
    }
    bf16* MEMB = (bf16*)(ws + WS_MEMB); float* MRS = (float*)(ws + WS_MEMRSTD);
    for (int m = gw; m < 1024; m += NGW) {
        const f32x4* xr = (const f32x4*)(mem + (size_t)m * D) + lane; u32x2* xb = (u32x2*)(MEMB + (size_t)m * D) + lane;
        float s = 0.f;
#pragma unroll
        for (int j = 0; j < 4; ++j) { const f32x4 v = xr[64 * j]; s += (v.x * v.x + v.y * v.y) + (v.z * v.z + v.w * v.w); u32x2 w; w.x = pk2(v.x, v.y); w.y = pk2(v.z, v.w); xb[64 * j] = w; }
        s = wave_sum(s);
        if (lane == 0) MRS[m] = rsqrtf(s * (1.0f / 1024.0f) + EPS);
    }
    float* COS = (float*)(ws + WS_COS); float* SIN = (float*)(ws + WS_SIN);
    for (int i = blockIdx.x * NTHREADS + tid; i < T * 16; i += gridDim.x * NTHREADS) {
        const int row = i >> 4, fi = i & 15;
        const float invf = exp2f(-13.287712379549449f * (float)fi * (1.0f / 16.0f));
        const float ang = (float)pos[row] * invf;
        const float kq = rintf(ang * 0.15915494309189535f);
        float rr = fmaf(-kq, 6.28125f, ang); rr = fmaf(-kq, 1.9353071795864769e-3f, rr);
        COS[i] = __cosf(rr); SIN[i] = __sinf(rr);
    }
    const float* hlb = KIN(14); float* LBS = (float*)(ws + WS_LBS);
    for (int i = blockIdx.x * NTHREADS + tid; i < 512; i += gridDim.x * NTHREADS) {
        const float a0 = hlb[i], a1 = hlb[512 + i], a2 = hlb[1024 + i], a3 = hlb[1536 + i];
        const float mx = fmaxf(fmaxf(a0, a1), fmaxf(a2, a3));
        const float e0 = __expf(a0 - mx), e1 = __expf(a1 - mx), e2 = __expf(a2 - mx), e3 = __expf(a3 - mx), inv = 1.0f / (e0 + e1 + e2 + e3);
        LBS[i] = 0.f; LBS[512 + i] = e1 * inv; LBS[1024 + i] = (e1 + e2) * inv; LBS[1536 + i] = (e1 + e2 + e3) * inv;
    }
}

__global__ void __launch_bounds__(NTHREADS, 2) fwd_kernel(Args A_unused) {
    extern __shared__ __attribute__((aligned(16))) unsigned char lds_raw[];
    LAS unsigned char* lds = (LAS unsigned char*)lds_raw;
    cg::grid_group grid = cg::this_grid();
    int ph = 0;
    int lo, hi; { const unsigned long long w = KA(27); lo = (int)(unsigned)w; hi = (int)(unsigned)(w >> 32); }
#define RUN (ph >= lo && ph < hi)
    volatile LAS unsigned* bst = (volatile LAS unsigned*)(lds + 131072 + 512);
    if (threadIdx.x < 2) bst[threadIdx.x] = 0u;
    __syncthreads();
    if (threadIdx.x == 0) (void)xb_add(&((unsigned*)(KWS + WS_CTL))[XB_XCNT(xb_xcc_id())], 1u);
#define SEAM do { if (ph >= lo && ph + 1 < hi) { if (ph == 1) grid.sync(); else { XcdBarrier xb_; xb_.bar = (unsigned*)(KWS + WS_CTL); xb_.x = xb_xcc_id(); xb_.st = bst; xcd_barrier(xb_); } } ++ph; } while (0)
#define WSP(T_, name, off) T_* name = (T_*)(ws + (off))
#define REPEAT(n_) for (int rep_ = 0; rep_ < (n_); ++rep_, ((rep_ < (n_)) ? xcd_barrier(XcdBarrier{(unsigned*)(KWS + WS_CTL), xb_xcc_id(), bst}) : (void)0))

    if (RUN) { prep_phase(); }
    ++ph;
    for (int l = 0; l < DEPTH; ++l) {
        if (l == 0) {
            if (RUN) conv_set(1 | 2 | 16, 0, (int)blockIdx.x, (int)gridDim.x, lds);
            SEAM;
        }
#ifdef PROBE_NULL_P1
        if (RUN) { unsigned char* ws = KWS; EpiNull E{(bf16*)(ws + WS_H)}; run_gemm(lds, (const bf16*)(ws + WS_XB), (const bf16*)(ws + WT_W1IN), T, 5632, 1024, 0, E);
            XcdBarrier xb_; xb_.bar = (unsigned*)(KWS + WS_CTL); xb_.x = xb_xcc_id(); xb_.st = bst; xcd_barrier(xb_); }
#endif
#ifndef SKIP_G1
        if (RUN) REPEAT(REP_P1) { unsigned char* ws = KWS; EpiSwiglu E{(bf16*)(ws + WS_H), (const float*)(ws + WS_SSQ)}; run_gemm(lds, (const bf16*)(ws + WS_XB), (const bf16*)(ws + WT_W1IN), T, 5632, 1024, 0, E);
            if (l == 0) {
                const int rem = (64 * 22) % (int)gridDim.x;
#pragma unroll 1
                for (int ll = 0; ll < DEPTH; ++ll) { unsigned char* ws2 = KWS; EpiMemKV E2{(bf16*)(ws2 + WS_MK) + (size_t)ll * 16 * 256 * 128, (bf16*)(ws2 + WS_MVT) + (size_t)ll * 16 * 128 * 256, (const float*)(ws2 + WS_MEMRSTD)};
                    run_gemm(lds, (const bf16*)(ws2 + WS_MEMB), (const bf16*)(ws2 + WT_WMEMKV) + (size_t)ll * 1024 * 1024, 1024, 1024, 1024, (rem + 16 * ll) % (int)gridDim.x, E2); }
            } else conv_tail(2, l, 64 * 22, lds);
        }
#endif
        SEAM;
#ifndef SKIP_G2
        if (RUN) { unsigned char* ws = KWS; EpiResid E{KOUT, (bf16*)(ws + WS_XB), (float*)(ws + WS_SSQ), 0.5f}; run_gemm(lds, (const bf16*)(ws + WS_H), (const bf16*)(ws + WT_W1OUT), T, 1024, DFF, 0, E); }
#endif
        SEAM;
#ifndef SKIP_WIN
        if (RUN) REPEAT(REP_P3) { unsigned char* ws = KWS;
            EpiWin E{ws, (const float*)(ws + WS_LBS) + l * 512};
            run_gemm(lds, (const bf16*)(ws + WS_XB), (const bf16*)(ws + WT_WIN), T, NIN, 1024, 0, E);
            conv_tail(4 | 8, l, 64 * 25, lds); }
#endif
        SEAM;
        if (RUN) {
#ifndef SKIP_G4
            REPEAT(REP_P4G) {
            { unsigned char* ws = KWS; EpiQ E{(bf16*)(ws + WS_Q)}; run_gemm(lds, (const bf16*)(ws + WS_CQ), (const bf16*)(ws + WT_WUQ), T, 768, 384, 0, E); }
            { unsigned char* ws = KWS; EpiKV E{(bf16*)(ws + WS_KC), (bf16*)(ws + WS_VT), (const float*)(ws + WS_SSQKV)}; run_gemm(lds, (const bf16*)(ws + WS_CKV), (const bf16*)(ws + WT_WUKV), T, 1024, 256, 64, E); }
            }
#endif
#ifndef SKIP_B1
            { unsigned char* ws = KWS; const int G = (int)gridDim.x;
              for (int ch = (int)blockIdx.x; ch < 1024; ch += G) hgrn_b1(lds, ch, (float*)(ws + WS_GG), (const bf16*)(ws + WS_HK), (const bf16*)(ws + WS_HV), (bf16*)(ws + WS_LT), (float*)(ws + WS_DEC)); }
#endif
        }
        SEAM;
        if (RUN) {
            unsigned char* ws = KWS; int tid_o = threadIdx.x; asm volatile("" : "+v"(tid_o)); const int G = (int)gridDim.x, bid = (int)blockIdx.x, tid = tid_o;
#ifndef SKIP_MLA
            REPEAT(REP_MLA) for (int it = bid; it < 256; it += G) {
                const int bh = it >> 3, pr = it & 7, b = bh >> 3, hd = bh & 7;
#pragma unroll 1
                for (int half = 0; half < 2; ++half) {
                    const int qb = half == 0 ? 15 - pr : pr;
                    const size_t row0 = (size_t)b * SEQ + qb * 256;
                    attn_item<96, 64, true>(lds, (const bf16*)(ws + WS_Q) + row0 * 768 + hd * 96, 768, (const bf16*)(ws + WS_KC) + (size_t)bh * SEQ * 96, (const bf16*)(ws + WS_VT) + (size_t)bh * 64 * SEQ, SEQ,
                                            (bf16*)(ws + WS_AO) + row0 * 512 + hd * 64, 512, qb * 256, SEQ, (const float*)(ws + WS_SSQQ) + row0 * 16, (const float*)(ws + WS_COS) + row0 * 16, (const float*)(ws + WS_SIN) + row0 * 16);
                }
            }
#endif
            unsigned* LT2 = (unsigned*)(ws + WS_LT); const float* DEC = (const float*)(ws + WS_DEC);
            for (int gt = bid * NTHREADS + tid; gt < 16 * 8192; gt += G * NTHREADS) {
                const int bh = gt >> 13, e2 = gt & 8191, k = (e2 & 63) * 2;
                unsigned* lp = LT2 + (size_t)bh * 64 * 8192 + e2; const float* dp = DEC + (size_t)bh * 64 * 128 + k;
                float run0 = 0.f, run1 = 0.f;
#pragma unroll 8
                for (int c = 0; c < 64; ++c) { const unsigned tmp = lp[(size_t)c * 8192]; const f32x2_t d = *(const f32x2_t*)(dp + c * 128); lp[(size_t)c * 8192] = pk2(run0, run1); run0 = d.x * run0 + bflo(tmp); run1 = d.y * run1 + bfhi(tmp); }
            }
        }
        SEAM;
        if (RUN) REPEAT(REP_P6) {
            unsigned char* ws = KWS; const int G = (int)gridDim.x, bid = (int)blockIdx.x;
#ifndef SKIP_XATT
            for (int it = bid; it < 256; it += G) {
                const int b = it >> 6, hd = (it >> 4) & 3, qb = it & 15;
                const size_t row0 = (size_t)b * SEQ + qb * 256;
                attn_item<128, 128, false>(lds, (const bf16*)(ws + WS_MQ) + row0 * 512 + hd * 128, 512, (const bf16*)(ws + WS_MK) + (size_t)(l * 16 + b * 4 + hd) * 256 * 128, (const bf16*)(ws + WS_MVT) + (size_t)(l * 16 + b * 4 + hd) * 128 * 256, 256,
                                           (bf16*)(ws + WS_MO) + row0 * 512 + hd * 128, 512, 0, 256, nullptr, nullptr, nullptr);
            }
#endif
#ifndef SKIP_B3
            const float* onorm = KIN(15) + l * 128;
            for (int ch = bid; ch < 1024; ch += G) hgrn_b3(lds, ch, (const float*)(ws + WS_GG), (const bf16*)(ws + WS_HQ), (const bf16*)(ws + WS_HK), (const bf16*)(ws + WS_HV), (const bf16*)(ws + WS_HGT), (const bf16*)(ws + WS_LT), onorm, (bf16*)(ws + WS_HO));
#endif
        }
        SEAM;
#ifndef SKIP_G7
        if (RUN) REPEAT(REP_P7) {
            unsigned char* ws = KWS; EpiBranch3 E{(bf16*)(ws + WS_MERGED), (const bf16*)(ws + WS_GATES)};
            int Kv = 512, Nv = 1024, Mv = T; asm volatile("" : "+s"(Kv), "+s"(Nv), "+s"(Mv));
            pg8::Gemm g{(const bf16*)(ws + WS_AO), (const bf16*)(ws + WT_WOMLA), Mv, Nv, Kv};
            SegOrder3 S; S.init(Mv, Nv, (int)gridDim.x, (int)blockIdx.x); S.wsb = (const char*)ws;
            pg8::gemm_phase<EpiBranch3, SegOrder3, true, true>(lds, g, S, E);
        }
#endif
        SEAM;
#ifndef SKIP_G8
        if (RUN) { unsigned char* ws = KWS; EpiResid E{KOUT, (bf16*)(ws + WS_XB), (float*)(ws + WS_SSQ), 1.0f}; run_gemm(lds, (const bf16*)(ws + WS_MERGED), (const bf16*)(ws + WT_WOUT), T, 1024, 1024, 0, E); }
#endif
        SEAM;
#ifndef SKIP_G9
        if (RUN) { unsigned char* ws = KWS; EpiSwiglu E{(bf16*)(ws + WS_H), (const float*)(ws + WS_SSQ)}; run_gemm(lds, (const bf16*)(ws + WS_XB), (const bf16*)(ws + WT_W2IN), T, 5632, 1024, 0, E);
            if (l + 1 < DEPTH) conv_tail(1, l + 1, 64 * 22, lds); }
#endif
        SEAM;
#ifndef SKIP_G10
        if (RUN) { unsigned char* ws = KWS; EpiResid E{KOUT, (bf16*)(ws + WS_XB), (float*)(ws + WS_SSQ), 0.5f}; run_gemm(lds, (const bf16*)(ws + WS_H), (const bf16*)(ws + WT_W2OUT), T, 1024, DFF, 0, E); }
#endif
        SEAM;
    }
    if (RUN) {
        unsigned char* ws = KWS; float* X = KOUT; const float* SSQ = (const float*)(ws + WS_SSQ);
        int tid_o = threadIdx.x; asm volatile("" : "+v"(tid_o)); const int tid = tid_o, wave = __builtin_amdgcn_readfirstlane(tid >> 6), lane = tid & 63, G = (int)gridDim.x;
        const float* fg = KIN(24);
        for (int m = (int)blockIdx.x * NWAVES + wave; m < T; m += G * NWAVES) {
            const float rs = rsqrtf(sum16(SSQ + (size_t)m * 16) * (1.0f / 1024.0f) + EPS);
            f32x4* xr = (f32x4*)(X + (size_t)m * D) + lane; const f32x4* gr = (const f32x4*)fg + lane;
#pragma unroll
            for (int j = 0; j < 4; ++j) { f32x4 v = xr[64 * j]; const f32x4 g = gr[64 * j]; v = v * rs * g; xr[64 * j] = v; }
        }
    }
#undef RUN
#undef SEAM
}

constexpr int N_PHASES = 1 + 1 + DEPTH * 10 + 1;

extern "C" void kernel_launch(void* const* d_in, const int* in_sizes, int n_in, void* d_out, int out_size, void* d_ws, size_t ws_size, hipStream_t stream) {
    static int grid = 0;
    if (grid == 0) {
        if (n_in != 25 || out_size != T * D || ws_size < WS_END) { fprintf(stderr, "kernel_launch: unexpected shapes (n_in %d out %d ws %zu need %zu)\n", n_in, out_size, ws_size, (size_t)WS_END); grid = -1; return; }
        int dev = 0, cus = 0, per_cu = 0;
        hipGetDevice(&dev);
        hipDeviceGetAttribute(&cus, hipDeviceAttributeMultiprocessorCount, dev);
        if (hipFuncSetAttribute((const void*)fwd_kernel, hipFuncAttributeMaxDynamicSharedMemorySize, LDS_BYTES) != hipSuccess) { fprintf(stderr, "kernel_launch: hipFuncSetAttribute failed\n"); grid = -1; return; }
        if (hipOccupancyMaxActiveBlocksPerMultiprocessor(&per_cu, (const void*)fwd_kernel, NTHREADS, LDS_BYTES) != hipSuccess || per_cu < 1) { fprintf(stderr, "kernel_launch: occupancy query says %d\n", per_cu); per_cu = 1; }
        (void)hipGetLastError();
        grid = cus * 1;
        if (grid <= 0) grid = 256;
    }
    if (grid < 0) return;
    if (hipMemsetAsync((char*)d_ws + WS_CTL, 0, CTL_BYTES, stream) != hipSuccess) { fprintf(stderr, "kernel_launch: memset of the barrier words failed\n"); return; }
    Args a{};
    for (int i = 0; i < 25; ++i) a.in[i] = d_in[i];
    a.out = (float*)d_out; a.ws = (unsigned char*)d_ws; a.ph_lo = 0; a.ph_hi = N_PHASES;
    void* args[] = {&a};
    hipError_t e = hipLaunchCooperativeKernel((const void*)fwd_kernel, dim3(grid), dim3(NTHREADS), args, LDS_BYTES, stream);
    if (e != hipSuccess) fprintf(stderr, "cooperative launch failed: %s (grid %d)\n", hipGetErrorString(e), grid);
}
```

```cpp
#include <hip/hip_runtime.h>
#include <hip/hip_cooperative_groups.h>
#include <cstdio>
#include <cstdint>
namespace cg = cooperative_groups;
#define DI __device__ __forceinline__
namespace pg8 {
#define PG8_LAS __attribute__((address_space(3)))
typedef unsigned short bf16_t;
typedef short bf16x8 __attribute__((ext_vector_type(8)));
typedef float f32x4 __attribute__((ext_vector_type(4)));
typedef unsigned u32x4 __attribute__((ext_vector_type(4)));
constexpr int BM = 256, BK = 64, HALF = 128, HTB = HALF * BK * 2  , STAGE_BYTES = 8 * HTB, NXCD = 8, WGM = 8;

__host__ __device__ __forceinline__ int lds_byte(int r, int c) { const int st = (r >> 4) * 2 + (c >> 5), rr = r & 15, cc = c & 31, ob = rr * 64 + cc * 2; return st * 1024 + (ob ^ (((ob >> 9) & 1) << 5)); }
__host__ __device__ __forceinline__ void stage_rc(int b, int& R, int& C) { const int st = b / 1024, sb = b % 1024, swz = sb ^ (((sb >> 9) & 1) << 5); R = (st >> 1) * 16 + swz / 64; C = (st & 1) * 32 + (swz % 64) / 2; }
__host__ __device__ __forceinline__ int perm32(int rho) { const int n = rho >> 4, i = rho & 15; return 8 * (i >> 2) + 4 * n + (i & 3); }

struct Unit { int pm, pn, seg; };
struct Gemm { const bf16_t* A; const bf16_t* Bt; int M, N, K; };

struct StaticOrder {
    int nM, nN, nwg, G, c;
    __host__ __device__ void init(int M, int N, int G_, int c_) { nM = M / BM; nN = N / BM; nwg = nM * nN; G = G_; c = c_; }
    __host__ __device__ bool next(int i, Unit& u) const {
        const long L = (long)i * G + c; if (L >= nwg) return false;
        int wgid = (int)L; { const int q = nwg / NXCD, r = nwg % NXCD, xcd = wgid % NXCD, off = wgid / NXCD; wgid = (xcd < r ? xcd * (q + 1) : r * (q + 1) + (xcd - r) * q) + off; }
        const int nig = WGM * nN, gid = wgid / nig, fm = gid * WGM, gsz = (nM - fm) < WGM ? (nM - fm) : WGM;
        u.pm = fm + ((wgid % nig) % gsz); u.pn = (wgid % nig) / gsz; u.seg = 0; return true;
    }
    __device__ __forceinline__ const char* a_ptr(const Gemm& g, const Unit&) const { return (const char*)g.A; }
    __device__ __forceinline__ const char* b_ptr(const Gemm& g, const Unit&) const { return (const char*)g.Bt; }
    __device__ __forceinline__ void a_ready(const Unit&) const {}
    __device__ __forceinline__ void done(const Unit&) const {}
};
template <class Epi, class Sched, bool ALIGN_EPI = false, bool SP2 = false>
__device__ __forceinline__ void gemm_phase(PG8_LAS unsigned char* lds, const Gemm g, const Sched& S, const Epi& E) {
    int tid_o = threadIdx.x; asm volatile("" : "+v"(tid_o));
    const int tid = tid_o, wid = __builtin_amdgcn_readfirstlane(tid >> 6), lane = tid & 63, wr = wid >> 2, wc = wid & 3, fr = lane & 15, fq = lane >> 4;
    const int K = g.K, nt = K / BK;
    unsigned voffA[2], voffB[2];
#pragma unroll
    for (int i = 0; i < 2; ++i) { int R, C; stage_rc(tid * 16 + i * 8192, R, C); const int Rb = Epi::PERM ? ((R & ~31) + perm32(R & 31)) : R;
        voffA[i] = (unsigned)(R * K + C) * 2u; voffB[i] = (unsigned)(Rb * K + C) * 2u; }
    const size_t kstep = (size_t)(BK * 2);
    const size_t hstep = (size_t)HALF * K * 2;
    const size_t tstep = 2 * hstep;
    const unsigned ldsw = (unsigned)wid * 1024u;
    const int aoff = lds_byte(wr * 64 + fr, fq * 8), boff = lds_byte(wc * 32 + fr, fq * 8);
#define PG8_SA(b, h) (((b) * 2 + (h)) * HTB)
#define PG8_SB(b, h) ((4 + (b) * 2 + (h)) * HTB)
#define PG8_STAGE(bufoff, gbase, voff) do { _Pragma("unroll") for (int _i = 0; _i < 2; ++_i) \
        __builtin_amdgcn_global_load_lds((const unsigned*)((const char*)(gbase) + (voff)[_i]), (PG8_LAS unsigned*)(lds + (bufoff) + ldsw + _i * 8192), 16, 0, 0); } while (0)
#define PG8_LDA(dst, b, h) do { _Pragma("unroll") for (int m = 0; m < 4; ++m) _Pragma("unroll") for (int k = 0; k < 2; ++k) dst[m][k] = *(const PG8_LAS bf16x8*)(lds + PG8_SA(b, h) + aoff + m * 2048 + k * 1024); } while (0)
#define PG8_LDB(dst, b, h) do { _Pragma("unroll") for (int n = 0; n < 2; ++n) _Pragma("unroll") for (int k = 0; k < 2; ++k) dst[n][k] = *(const PG8_LAS bf16x8*)(lds + PG8_SB(b, h) + boff + n * 2048 + k * 1024); } while (0)
#define PG8_MMA(ai, bj, At, Bt) do { __builtin_amdgcn_s_setprio(1); _Pragma("unroll") for (int m = 0; m < 4; ++m) _Pragma("unroll") for (int n = 0; n < 2; ++n) _Pragma("unroll") for (int k = 0; k < 2; ++k) \
        acc[ai][bj][m][n] = __builtin_amdgcn_mfma_f32_16x16x32_bf16(Bt[n][k], At[m][k], acc[ai][bj][m][n], 0, 0, 0); __builtin_amdgcn_s_setprio(0); } while (0)
#define PG8_WAIT_V(n) asm volatile("s_waitcnt vmcnt(" #n ")" ::: "memory")
#define PG8_WAIT_L(n) asm volatile("s_waitcnt lgkmcnt(" #n ")" ::: "memory")
#define PG8_BAR __builtin_amdgcn_s_barrier()
#define PG8_SCHED __builtin_amdgcn_sched_barrier(0)
    Unit cur, nxt; int ui = 0;
    if (!S.next(0, cur)) return;
    f32x4 acc[2][2][4][2];
#pragma unroll
    for (int a = 0; a < 2; ++a)
#pragma unroll
        for (int b = 0; b < 2; ++b)
#pragma unroll
            for (int m = 0; m < 4; ++m)
#pragma unroll
                for (int n = 0; n < 2; ++n) acc[a][b][m][n] = (f32x4){0.f, 0.f, 0.f, 0.f};
    bf16x8 At[4][2], B0[2][2], B1[2][2];
    const char* cA = S.a_ptr(g, cur) + (size_t)cur.pm * tstep; const char* cB = S.b_ptr(g, cur) + (size_t)cur.pn * tstep;
    S.a_ready(cur);
    if constexpr (SP2) {
        PG8_STAGE(PG8_SB(0, 0), cB, voffB); PG8_STAGE(PG8_SB(0, 1), cB + hstep, voffB); PG8_STAGE(PG8_SA(0, 0), cA, voffA); PG8_STAGE(PG8_SA(0, 1), cA + hstep, voffA);
        if (wr == 1) PG8_BAR;
        PG8_WAIT_V(2); PG8_BAR;
        PG8_STAGE(PG8_SB(1, 0), cB + kstep, voffB); PG8_STAGE(PG8_SA(1, 0), cA + kstep, voffA); PG8_STAGE(PG8_SB(1, 1), cB + hstep + kstep, voffB);
        PG8_WAIT_V(6); PG8_BAR;
    } else {
        PG8_STAGE(PG8_SB(0, 0), cB, voffB); PG8_STAGE(PG8_SA(0, 0), cA, voffA); PG8_STAGE(PG8_SB(0, 1), cB + hstep, voffB); PG8_STAGE(PG8_SA(0, 1), cA + hstep, voffA);
        if (wr == 1) PG8_BAR;
        PG8_WAIT_V(4); PG8_BAR;
        PG8_STAGE(PG8_SB(1, 0), cB + kstep, voffB); PG8_STAGE(PG8_SA(1, 0), cA + kstep, voffA); PG8_STAGE(PG8_SB(1, 1), cB + hstep + kstep, voffB);
        PG8_WAIT_V(6); PG8_BAR;
    }
    for (;;) {
        const bool has_next = S.next(ui + 1, nxt);
        const char* nA = has_next ? S.a_ptr(g, nxt) + (size_t)nxt.pm * tstep : cA; const char* nB = has_next ? S.b_ptr(g, nxt) + (size_t)nxt.pn * tstep : cB;
        for (int t = 0; t < nt; t += 2) {
            const bool last = (t == nt - 2);
            const char* a1 = cA + (size_t)(t + 1) * kstep;
            const char* a2 = last ? nA : cA + (size_t)(t + 2) * kstep; const char* b2 = last ? nB : cB + (size_t)(t + 2) * kstep;
            const char* a3 = a2 + kstep; const char* b3 = b2 + kstep;
            if (last && has_next) S.a_ready(nxt);
            if constexpr (SP2) {
            PG8_LDB(B0, 0, 0); PG8_LDB(B1, 0, 1); PG8_SCHED; PG8_LDA(At, 0, 0); PG8_STAGE(PG8_SA(1, 1), a1 + hstep, voffA);
            PG8_WAIT_V(8); PG8_WAIT_L(0); PG8_BAR; PG8_MMA(0, 0, At, B0); PG8_MMA(0, 1, At, B1); PG8_BAR; PG8_SCHED;
            PG8_LDA(At, 0, 1); PG8_STAGE(PG8_SB(0, 0), b2, voffB); PG8_STAGE(PG8_SB(0, 1), b2 + hstep, voffB); PG8_STAGE(PG8_SA(0, 0), a2, voffA);
            PG8_WAIT_V(8); PG8_WAIT_L(0); PG8_BAR; PG8_MMA(1, 0, At, B0); PG8_MMA(1, 1, At, B1); PG8_BAR; PG8_SCHED;
            PG8_LDB(B0, 1, 0); PG8_LDB(B1, 1, 1); PG8_SCHED; PG8_LDA(At, 1, 0); PG8_STAGE(PG8_SA(0, 1), a2 + hstep, voffA);
            PG8_WAIT_V(8); PG8_WAIT_L(0); PG8_BAR; PG8_MMA(0, 0, At, B0); PG8_MMA(0, 1, At, B1); PG8_BAR; PG8_SCHED;
            PG8_LDA(At, 1, 1); PG8_STAGE(PG8_SB(1, 0), b3, voffB); PG8_STAGE(PG8_SB(1, 1), b3 + hstep, voffB); PG8_STAGE(PG8_SA(1, 0), a3, voffA);
            PG8_WAIT_V(8); PG8_WAIT_L(0); PG8_BAR; PG8_MMA(1, 0, At, B0); PG8_MMA(1, 1, At, B1); PG8_BAR; PG8_SCHED;
            } else {
            PG8_LDB(B0, 0, 0); PG8_SCHED; PG8_LDA(At, 0, 0); PG8_STAGE(PG8_SA(1, 1), a1 + hstep, voffA);
            PG8_WAIT_L(8); PG8_BAR; PG8_WAIT_L(0); PG8_MMA(0, 0, At, B0); PG8_BAR; PG8_SCHED;
            PG8_LDB(B1, 0, 1); PG8_STAGE(PG8_SB(0, 0), b2, voffB);
            PG8_BAR; PG8_WAIT_L(0); PG8_MMA(0, 1, At, B1); PG8_BAR;
            PG8_LDA(At, 0, 1); PG8_STAGE(PG8_SA(0, 0), a2, voffA);
            PG8_BAR; PG8_WAIT_L(0); PG8_MMA(1, 0, At, B0); PG8_BAR; PG8_SCHED;
            PG8_STAGE(PG8_SB(0, 1), b2 + hstep, voffB);
            PG8_WAIT_V(6); PG8_BAR; PG8_MMA(1, 1, At, B1); PG8_BAR;
            PG8_LDB(B0, 1, 0); PG8_SCHED; PG8_LDA(At, 1, 0); PG8_STAGE(PG8_SA(0, 1), a2 + hstep, voffA);
            PG8_WAIT_L(8); PG8_BAR; PG8_WAIT_L(0); PG8_MMA(0, 0, At, B0); PG8_BAR; PG8_SCHED;
            PG8_LDB(B1, 1, 1); PG8_STAGE(PG8_SB(1, 0), b3, voffB);
            PG8_BAR; PG8_WAIT_L(0); PG8_MMA(0, 1, At, B1); PG8_BAR;
            PG8_LDA(At, 1, 1); PG8_STAGE(PG8_SA(1, 0), a3, voffA);
            PG8_BAR; PG8_WAIT_L(0); PG8_MMA(1, 0, At, B0); PG8_BAR; PG8_SCHED;
            PG8_STAGE(PG8_SB(1, 1), b3 + hstep, voffB);
            PG8_WAIT_V(6); PG8_BAR; PG8_MMA(1, 1, At, B1); PG8_BAR;
            }
        }
        if constexpr (ALIGN_EPI) { if (wr == 0) PG8_BAR; }
        if constexpr (!Epi::AFTER_DRAIN) { E(acc, cur, wr, wc, fr, fq); S.done(cur); }
        if (!has_next) break;
        if (!E.keep_acc(cur))
#pragma unroll
        for (int a = 0; a < 2; ++a)
#pragma unroll
            for (int b = 0; b < 2; ++b)
#pragma unroll
                for (int m = 0; m < 4; ++m)
#pragma unroll
                    for (int n = 0; n < 2; ++n) acc[a][b][m][n] = (f32x4){0.f, 0.f, 0.f, 0.f};
        cur = nxt; cA = nA; cB = nB; ++ui;
        if constexpr (ALIGN_EPI) { if (wr == 1) PG8_BAR; }
    }
    PG8_WAIT_V(0);
    if constexpr (!ALIGN_EPI) { if (wr == 0) PG8_BAR; }
    PG8_BAR;
    if constexpr (Epi::AFTER_DRAIN) { E.fused(acc, cur, wr, wc, fr, fq, lds, wid, lane); S.done(cur); }
#undef PG8_SA
#undef PG8_SB
#undef PG8_STAGE
#undef PG8_LDA
#undef PG8_LDB
#undef PG8_MMA
#undef PG8_WAIT_V
#undef PG8_WAIT_L
#undef PG8_BAR
#undef PG8_SCHED
}
}

typedef unsigned short bf16;
#define LAS __attribute__((address_space(3)))
#define GAS __attribute__((address_space(1)))
typedef float f32x4 __attribute__((ext_vector_type(4)));
typedef float f32x16 __attribute__((ext_vector_type(16)));
typedef float f32x2_t __attribute__((ext_vector_type(2)));
typedef __bf16 bf16x2_t __attribute__((ext_vector_type(2)));
typedef short bf16x8 __attribute__((ext_vector_type(8)));
typedef short s16x4 __attribute__((ext_vector_type(4)));
typedef unsigned u32x4 __attribute__((ext_vector_type(4)));
typedef unsigned u32x2 __attribute__((ext_vector_type(2)));

constexpr int T = 16384, D = 1024, SEQ = 4096, NBATCH = 4, DFF = 2816, DEPTH = 4, NIN = 6400, DIN = 6304;
constexpr int NTHREADS = 512, NWAVES = 8;
constexpr float EPS = 1e-6f;
constexpr float QSCALE_MLA = 0.14724498f;
constexpr float QSCALE_MEM = 0.12751743f;

constexpr size_t MiB = 1u << 20;
constexpr size_t WT_W1IN = 0;
constexpr size_t WT_W1OUT = WT_W1IN + (size_t)5632 * 1024 * 2;
constexpr size_t WT_WIN = WT_W1OUT + (size_t)1024 * 2816 * 2;
constexpr size_t WT_WUQ = WT_WIN + (size_t)NIN * 1024 * 2;
constexpr size_t WT_WUKV = WT_WUQ + (size_t)768 * 384 * 2;
constexpr size_t WT_WOMLA = WT_WUKV + (size_t)1024 * 256 * 2;
constexpr size_t WT_WOHG = WT_WOMLA + (size_t)1024 * 512 * 2;
constexpr size_t WT_WOMEM = WT_WOHG + (size_t)1024 * 512 * 2;
constexpr size_t WT_WMEMKV = WT_WOMEM + (size_t)1024 * 512 * 2;
constexpr size_t WT_WOUT = WT_WMEMKV + (size_t)4 * 1024 * 1024 * 2;
constexpr size_t WT_W2IN = WT_WOUT + (size_t)1024 * 1024 * 2;
constexpr size_t WT_W2OUT = WT_W2IN + (size_t)5632 * 1024 * 2;
constexpr size_t WT_END = WT_W2OUT + (size_t)1024 * 2816 * 2;
static_assert(WT_END <= 60 * MiB, "weights");
constexpr size_t WS_XB = 60 * MiB;
constexpr size_t WS_SSQ = WS_XB + 32 * MiB;
constexpr size_t WS_SSQQ = WS_SSQ + 1 * MiB;
constexpr size_t WS_SSQKV = WS_SSQQ + 1 * MiB;
constexpr size_t WS_COS = WS_SSQKV + 1 * MiB;
constexpr size_t WS_SIN = WS_COS + 1 * MiB;
constexpr size_t WS_LBS = WS_SIN + 1 * MiB;
constexpr size_t WS_MEMB = WS_LBS + 65536;
constexpr size_t WS_MEMRSTD = WS_MEMB + 2 * MiB;
constexpr size_t WS_MK = WS_MEMRSTD + 65536;
constexpr size_t WS_MVT = WS_MK + 4 * MiB;
constexpr size_t WS_DEC = WS_MVT + 4 * MiB;
constexpr size_t WS_MIX = WS_DEC + 1 * MiB;
constexpr size_t WS_CQ = WS_MIX;
constexpr size_t WS_CKV = WS_CQ + 12 * MiB;
constexpr size_t WS_KR = WS_CKV + 8 * MiB;
constexpr size_t WS_HQ = WS_KR + 1 * MiB;
constexpr size_t WS_GG = WS_HQ + 16 * MiB;
constexpr size_t WS_HK = WS_GG + 32 * MiB;
constexpr size_t WS_HV = WS_HK + 16 * MiB;
constexpr size_t WS_HGT = WS_HV + 16 * MiB;
constexpr size_t WS_MQ = WS_HGT + 16 * MiB;
constexpr size_t WS_GATES = WS_MQ + 16 * MiB;
constexpr size_t WS_Q = WS_GATES + 96 * MiB;
constexpr size_t WS_KC = WS_Q + 24 * MiB;
constexpr size_t WS_VT = WS_KC + 24 * MiB;
constexpr size_t WS_LT = WS_VT + 16 * MiB;
constexpr size_t WS_AO = WS_LT + 64 * MiB;
constexpr size_t WS_CTL = WS_AO + 16 * MiB;
constexpr size_t CTL_BYTES = 16384;
constexpr size_t WS_END = WS_CTL + 65536;
constexpr size_t WS_HO = WS_CQ;
constexpr size_t WS_MERGED = WS_GG;
constexpr size_t WS_MO = WS_Q;
constexpr size_t WS_H = WS_MIX;
static_assert(WS_H + (size_t)T * DFF * 2 <= WS_END, "h overlay");

constexpr int LDS_BYTES = 147456;
#ifndef REP_CONV
#define REP_CONV 1
#endif
#ifndef REP_P1
#define REP_P1 1
#endif
#ifndef REP_P3
#define REP_P3 1
#endif
#ifndef REP_MLA
#define REP_MLA 1
#endif
#ifndef REP_P6
#define REP_P6 1
#endif
#ifndef REP_P7
#define REP_P7 1
#endif
#ifndef REP_P4G
#define REP_P4G 1
#endif

DI unsigned pk2(float lo, float hi) { f32x2_t v = {lo, hi}; bf16x2_t b = __builtin_convertvector(v, bf16x2_t); return __builtin_bit_cast(unsigned, b); }
DI u32x4 pk8(const float* v) { u32x4 w; w.x = pk2(v[0], v[1]); w.y = pk2(v[2], v[3]); w.z = pk2(v[4], v[5]); w.w = pk2(v[6], v[7]); return w; }
DI float bflo(unsigned w) { return __uint_as_float(w << 16); }
DI float bfhi(unsigned w) { return __uint_as_float(w & 0xffff0000u); }
DI void unpk8(u32x4 w, float* v) { v[0] = bflo(w.x); v[1] = bfhi(w.x); v[2] = bflo(w.y); v[3] = bfhi(w.y); v[4] = bflo(w.z); v[5] = bfhi(w.z); v[6] = bflo(w.w); v[7] = bfhi(w.w); }
DI float bf2f(bf16 b) { return __uint_as_float(((unsigned)b) << 16); }
DI bf16 f2bf(float f) { return (bf16)(pk2(f, 0.f) & 0xffffu); }
DI float sigmoidf_(float z) { return __builtin_amdgcn_rcpf(1.0f + __expf(-z)); }
DI float wave_sum(float v) {
#pragma unroll
    for (int o = 1; o < 64; o <<= 1) v += __shfl_xor(v, o);
    return v;
}
DI float rowsum_q(const float* p, int fq, int nq) {
    float s = 0.f;
    if (fq < nq) { const f32x4 a = *(const f32x4*)(p + 4 * fq); s = (a.x + a.y) + (a.z + a.w); }
    s += __shfl_xor(s, 16); s += __shfl_xor(s, 32);
    return s;
}
DI void rstd8(const float* ssq, int stride, int nq, float inv_n, float post, int rowb, int fq, float (&rs)[8]) {
    f32x4 q[8];
#pragma unroll
    for (int i = 0; i < 8; ++i) q[i] = *(const f32x4*)(ssq + (size_t)(rowb + (i >> 2) * 128 + (i & 3) * 16) * stride + 4 * fq);
    const float keep = fq < nq ? 1.0f : 0.0f;
#pragma unroll
    for (int i = 0; i < 8; ++i) { float t = ((q[i].x + q[i].y) + (q[i].z + q[i].w)) * keep; t += __shfl_xor(t, 16); t += __shfl_xor(t, 32); rs[i] = __builtin_amdgcn_rsqf(t * inv_n + EPS) * post; }
}
DI float sum16(const float* p) {
    const f32x4 a = *(const f32x4*)p, b = *(const f32x4*)(p + 4), c = *(const f32x4*)(p + 8), d = *(const f32x4*)(p + 12);
    return ((a.x + a.y) + (a.z + a.w)) + ((b.x + b.y) + (b.z + b.w)) + ((c.x + c.y) + (c.z + c.w)) + ((d.x + d.y) + (d.z + d.w));
}

using pg8::Unit;
#define EPI_ARGS const f32x4 (&acc)[2][2][4][2], const Unit& u, int wr, int wc, int fr_in, int fq_in
#define EPI_OPAQUE int fr = fr_in, fq = fq_in; asm volatile("" : "+v"(fr), "+v"(fq));

struct EpiSwiglu {
    static constexpr bool PERM = true, AFTER_DRAIN = false;
    DI bool keep_acc(const Unit&) const { return false; }
    bf16* H; const float* ssq;
    DI void operator()(EPI_ARGS) const {
        EPI_OPAQUE
        const int rowb = u.pm * 256 + wr * 64 + fr;
        float rs[8]; rstd8(ssq, 16, 4, 1.0f / 1024.0f, 1.0f, rowb, fq, rs);
#pragma unroll
        for (int ai = 0; ai < 2; ++ai)
#pragma unroll
            for (int m = 0; m < 4; ++m) {
                const int row = rowb + ai * 128 + m * 16;
                const float r1 = rs[ai * 4 + m];
                float o[8];
#pragma unroll
                for (int n = 0; n < 2; ++n)
#pragma unroll
                    for (int j = 0; j < 4; ++j) { const float a = acc[ai][0][m][n][j] * r1, b = acc[ai][1][m][n][j] * r1; o[4 * n + j] = a * b * __builtin_amdgcn_rcpf(1.0f + __expf(-a)); }
                *(u32x4*)(H + (size_t)row * DFF + u.pn * 128 + 32 * wc + 8 * fq) = pk8(o);
            }
    }
};

struct EpiNull {
    static constexpr bool PERM = true, AFTER_DRAIN = false;
    DI bool keep_acc(const Unit&) const { return false; }
    bf16* H;
    DI void operator()(EPI_ARGS) const {
        float t = 0.f;
#pragma unroll
        for (int ai = 0; ai < 2; ++ai)
#pragma unroll
            for (int bj = 0; bj < 2; ++bj)
#pragma unroll
                for (int m = 0; m < 4; ++m)
#pragma unroll
                    for (int n = 0; n < 2; ++n) t += acc[ai][bj][m][n][0] + acc[ai][bj][m][n][1] + acc[ai][bj][m][n][2] + acc[ai][bj][m][n][3];
        if (t == 12345.678f) H[0] = 0;
    }
};

struct EpiResid {
    static constexpr bool PERM = true, AFTER_DRAIN = false;
    DI bool keep_acc(const Unit&) const { return false; }
    bf16* XB; float* ssq; float scale;
    DI void operator()(EPI_ARGS) const {
        EPI_OPAQUE
        const int rowb = u.pm * 256 + wr * 64 + fr, colb = u.pn * 256 + 32 * wc + 8 * fq;
#pragma unroll
        for (int ai = 0; ai < 2; ++ai) {
            u32x4 xv[4][2];
#pragma unroll
            for (int m = 0; m < 4; ++m)
#pragma unroll
                for (int bj = 0; bj < 2; ++bj) xv[m][bj] = *(const u32x4*)(XB + (size_t)(rowb + ai * 128 + m * 16) * D + colb + 128 * bj);
#pragma unroll
            for (int m = 0; m < 4; ++m) {
                const int row = rowb + ai * 128 + m * 16;
                float ss = 0.f;
#pragma unroll
                for (int bj = 0; bj < 2; ++bj) {
                    float o[8]; unpk8(xv[m][bj], o);
#pragma unroll
                    for (int n = 0; n < 2; ++n)
#pragma unroll
                        for (int j = 0; j < 4; ++j) o[4 * n + j] += scale * acc[ai][bj][m][n][j];
                    const u32x4 w = pk8(o);
                    *(u32x4*)(XB + (size_t)row * D + colb + 128 * bj) = w;
                    float q[8]; unpk8(w, q);
#pragma unroll
                    for (int e = 0; e < 8; ++e) ss += q[e] * q[e];
                }
                ss += __shfl_xor(ss, 16); ss += __shfl_xor(ss, 32);
                if (fq == 0) ssq[(size_t)row * 16 + u.pn * 4 + wc] = ss;
            }
        }
    }
};

struct EpiWin {
    static constexpr bool PERM = true, AFTER_DRAIN = false;
    DI bool keep_acc(const Unit&) const { return false; }
    unsigned char* ws; const float* lbs  ;
    DI void operator()(EPI_ARGS) const {
        EPI_OPAQUE
        const float* ssq = (const float*)(ws + WS_SSQ); const float* cosT = (const float*)(ws + WS_COS); const float* sinT = (const float*)(ws + WS_SIN);
        bf16* CQ = (bf16*)(ws + WS_CQ); bf16* CKV = (bf16*)(ws + WS_CKV); bf16* KC = (bf16*)(ws + WS_KC); bf16* HQ = (bf16*)(ws + WS_HQ); bf16* HK = (bf16*)(ws + WS_HK); bf16* HV = (bf16*)(ws + WS_HV);
        bf16* HGT = (bf16*)(ws + WS_HGT); bf16* MQ = (bf16*)(ws + WS_MQ); bf16* GATES = (bf16*)(ws + WS_GATES); float* GG = (float*)(ws + WS_GG); float* SSQQ = (float*)(ws + WS_SSQQ); float* SSQKV = (float*)(ws + WS_SSQKV);
        const int rowb = u.pm * 256 + wr * 64 + fr;
        float rs8[8]; rstd8(ssq, 16, 4, 1.0f / 1024.0f, 1.0f, rowb, fq, rs8);
#pragma unroll
        for (int ai = 0; ai < 2; ++ai)
#pragma unroll
            for (int m = 0; m < 4; ++m) {
                const int row = rowb + ai * 128 + m * 16;
                const float rs = rs8[ai * 4 + m];
#pragma unroll
                for (int bj = 0; bj < 2; ++bj) {
                    const int hh = 2 * u.pn + bj, cw = 32 * wc + 8 * fq;
                    float v[8];
#pragma unroll
                    for (int n = 0; n < 2; ++n)
#pragma unroll
                        for (int j = 0; j < 4; ++j) v[4 * n + j] = acc[ai][bj][m][n][j] * rs;
                    if (hh < 5) {
                        float ss = 0.f;
#pragma unroll
                        for (int e = 0; e < 8; ++e) ss += v[e] * v[e];
                        ss += __shfl_xor(ss, 16); ss += __shfl_xor(ss, 32);
                        if (hh < 3) { *(u32x4*)(CQ + (size_t)row * 384 + hh * 128 + cw) = pk8(v); if (fq == 0) SSQQ[(size_t)row * 16 + hh * 4 + wc] = ss; }
                        else { *(u32x4*)(CKV + (size_t)row * 256 + (hh - 3) * 128 + cw) = pk8(v); if (fq == 0) SSQKV[(size_t)row * 8 + (hh - 3) * 4 + wc] = ss; }
                    } else if (hh == 5) {
                        if (wc == 0) {
                            const f32x4 c = *(const f32x4*)(cosT + (size_t)row * 16 + 4 * fq), s = *(const f32x4*)(sinT + (size_t)row * 16 + 4 * fq);
                            u32x4 o;
                            o.x = pk2(v[0] * c.x - v[1] * s.x, v[1] * c.x + v[0] * s.x); o.y = pk2(v[2] * c.y - v[3] * s.y, v[3] * c.y + v[2] * s.y);
                            o.z = pk2(v[4] * c.z - v[5] * s.z, v[5] * c.z + v[4] * s.z); o.w = pk2(v[6] * c.w - v[7] * s.w, v[7] * c.w + v[6] * s.w);
                            bf16* kp = KC + ((size_t)(row >> 12) * 8 * SEQ + (row & 4095)) * 96 + 64 + 8 * fq;
#pragma unroll
                            for (int hd = 0; hd < 8; ++hd) *(u32x4*)(kp + (size_t)hd * SEQ * 96) = o;
                        }
                    } else if (hh < 10) {
#pragma unroll
                        for (int e = 0; e < 8; ++e) v[e] = v[e] * sigmoidf_(v[e]);
                        *(u32x4*)(HQ + (size_t)row * 512 + (hh - 6) * 128 + cw) = pk8(v);
                    } else if (hh < 14) {
                        const int c0 = (hh - 10) * 128 + cw;
                        const f32x4 l0 = *(const f32x4*)(lbs + c0), l1 = *(const f32x4*)(lbs + c0 + 4);
                        const float lb[8] = {l0.x, l0.y, l0.z, l0.w, l1.x, l1.y, l1.z, l1.w};
                        float g[8], k[8];
#pragma unroll
                        for (int e = 0; e < 8; ++e) { const float z = fminf(fmaxf(v[e], -60.f), 60.f); const float sg = __builtin_amdgcn_rcpf(1.0f + __expf(-z));
                            g[e] = __logf(lb[e] + (1.0f - lb[e]) * sg); k[e] = (1.0f - lb[e]) * __builtin_amdgcn_rcpf(1.0f + __expf(z)); }
                        *(f32x4*)(GG + (size_t)row * 512 + c0) = (f32x4){g[0], g[1], g[2], g[3]}; *(f32x4*)(GG + (size_t)row * 512 + c0 + 4) = (f32x4){g[4], g[5], g[6], g[7]};
                        *(u32x4*)(HK + (size_t)row * 512 + c0) = pk8(k);
                    } else if (hh < 18) {
                        *(u32x4*)(HV + (size_t)row * 512 + (hh - 14) * 128 + cw) = pk8(v);
                    } else if (hh < 22) {
#pragma unroll
                        for (int e = 0; e < 8; ++e) v[e] = v[e] * sigmoidf_(v[e]);
                        *(u32x4*)(HGT + (size_t)row * 512 + (hh - 18) * 128 + cw) = pk8(v);
                    } else if (hh < 26) {
#pragma unroll
                        for (int e = 0; e < 8; ++e) v[e] *= QSCALE_MEM;
                        *(u32x4*)(MQ + (size_t)row * 512 + (hh - 22) * 128 + cw) = pk8(v);
                    } else {
                        const int c0 = (hh - 26) * 128 + cw, br = c0 >> 10, cc = c0 & 1023;
#pragma unroll
                        for (int e = 0; e < 8; ++e) v[e] = sigmoidf_(v[e]);
                        *(u32x4*)(GATES + ((size_t)br * T + row) * 1024 + cc) = pk8(v);
                    }
                }
            }
    }
};

struct EpiQ {
    static constexpr bool PERM = true, AFTER_DRAIN = false;
    DI bool keep_acc(const Unit&) const { return false; }
    bf16* Q;
    DI void operator()(EPI_ARGS) const {
        EPI_OPAQUE
#pragma unroll
        for (int ai = 0; ai < 2; ++ai)
#pragma unroll
            for (int m = 0; m < 4; ++m) {
                const int row = u.pm * 256 + ai * 128 + wr * 64 + m * 16 + fr;
#pragma unroll
                for (int bj = 0; bj < 2; ++bj) {
                    float v[8];
#pragma unroll
                    for (int n = 0; n < 2; ++n)
#pragma unroll
                        for (int j = 0; j < 4; ++j) v[4 * n + j] = acc[ai][bj][m][n][j];
                    *(u32x4*)(Q + (size_t)row * 768 + u.pn * 256 + 128 * bj + 32 * wc + 8 * fq) = pk8(v);
                }
            }
    }
};

struct EpiKV {
    static constexpr bool PERM = true, AFTER_DRAIN = false;
    DI bool keep_acc(const Unit&) const { return false; }
    bf16* KC; bf16* VT; const float* ssqkv;
    DI void operator()(EPI_ARGS) const {
        EPI_OPAQUE
        float rs8[8]; rstd8(ssqkv, 8, 2, 1.0f / 256.0f, 1.0f, u.pm * 256 + wr * 64 + fr, fq, rs8);
#pragma unroll
        for (int ai = 0; ai < 2; ++ai)
#pragma unroll
            for (int m = 0; m < 4; ++m) {
                const int row = u.pm * 256 + ai * 128 + wr * 64 + m * 16 + fr, b = row >> 12, s = row & 4095;
                const float rs = rs8[ai * 4 + m];
#pragma unroll
                for (int bj = 0; bj < 2; ++bj) {
                    const int c0 = u.pn * 256 + 128 * bj + 32 * wc + 8 * fq;
                    float v[8];
#pragma unroll
                    for (int n = 0; n < 2; ++n)
#pragma unroll
                        for (int j = 0; j < 4; ++j) v[4 * n + j] = acc[ai][bj][m][n][j] * rs;
                    if (c0 < 512) {
                        const int hd = c0 >> 6, d = c0 & 63;
                        bf16* kp = KC + ((size_t)(b * 8 + hd) * SEQ + s) * 96;
                        *(u32x4*)(kp + d) = pk8(v);
                    } else {
                        const int c = c0 - 512, hd = c >> 6, dv = c & 63;
                        bf16* vp = VT + ((size_t)(b * 8 + hd) * 64 + dv) * SEQ + s;
#pragma unroll
                        for (int e = 0; e < 8; ++e) vp[(size_t)e * SEQ] = f2bf(v[e]);
                    }
                }
            }
    }
};

struct EpiMemKV {
    static constexpr bool PERM = true, AFTER_DRAIN = false;
    DI bool keep_acc(const Unit&) const { return false; }
    bf16* MK; bf16* MVT; const float* rstd;
    DI void operator()(EPI_ARGS) const {
        EPI_OPAQUE
#pragma unroll
        for (int ai = 0; ai < 2; ++ai)
#pragma unroll
            for (int m = 0; m < 4; ++m) {
                const int row = u.pm * 256 + ai * 128 + wr * 64 + m * 16 + fr, b = row >> 8, mm = row & 255;
                const float rs = rstd[row];
#pragma unroll
                for (int bj = 0; bj < 2; ++bj) {
                    const int c0 = u.pn * 256 + 128 * bj + 32 * wc + 8 * fq;
                    float v[8];
#pragma unroll
                    for (int n = 0; n < 2; ++n)
#pragma unroll
                        for (int j = 0; j < 4; ++j) v[4 * n + j] = acc[ai][bj][m][n][j] * rs;
                    if (c0 < 512) { const int hd = c0 >> 7, d = c0 & 127; *(u32x4*)(MK + ((size_t)(b * 4 + hd) * 256 + mm) * 128 + d) = pk8(v); }
                    else { const int c = c0 - 512, hd = c >> 7, dv = c & 127; bf16* vp = MVT + ((size_t)(b * 4 + hd) * 128 + dv) * 256 + mm;
#pragma unroll
                        for (int e = 0; e < 8; ++e) vp[(size_t)e * 256] = f2bf(v[e]); }
                }
            }
    }
};

struct EpiBranch {
    static constexpr bool PERM = true, AFTER_DRAIN = false;
    DI bool keep_acc(const Unit&) const { return false; }
    bf16* MG; const bf16* gate; int first;
    DI void operator()(EPI_ARGS) const {
        EPI_OPAQUE
        const int rowb = u.pm * 256 + wr * 64 + fr, colb = u.pn * 256 + 32 * wc + 8 * fq;
#pragma unroll
        for (int ai = 0; ai < 2; ++ai) {
            u32x4 gv[4][2], pv[4][2];
#pragma unroll
            for (int m = 0; m < 4; ++m)
#pragma unroll
                for (int bj = 0; bj < 2; ++bj) { const size_t off = (size_t)(rowb + ai * 128 + m * 16) * 1024 + colb + 128 * bj;
                    gv[m][bj] = *(const u32x4*)(gate + off); pv[m][bj] = (u32x4){0, 0, 0, 0}; if (!first) pv[m][bj] = *(const u32x4*)(MG + off); }
#pragma unroll
            for (int m = 0; m < 4; ++m)
#pragma unroll
                for (int bj = 0; bj < 2; ++bj) {
                    const size_t off = (size_t)(rowb + ai * 128 + m * 16) * 1024 + colb + 128 * bj;
                    float g[8], o[8];
                    unpk8(gv[m][bj], g); unpk8(pv[m][bj], o);
#pragma unroll
                    for (int n = 0; n < 2; ++n)
#pragma unroll
                        for (int j = 0; j < 4; ++j) o[4 * n + j] += g[4 * n + j] * acc[ai][bj][m][n][j];
                    *(u32x4*)(MG + off) = pk8(o);
                }
        }
    }
};

struct EpiBranch3 {
    static constexpr bool PERM = true, AFTER_DRAIN = false;
    bf16* MG; const bf16* gates;
    DI bool keep_acc(const Unit& u) const { return u.seg < 2; }
    DI void operator()(f32x4 (&acc)[2][2][4][2], const Unit& u, int wr, int wc, int fr_in, int fq_in) const {
        EPI_OPAQUE
        const int rowb = u.pm * 256 + wr * 64 + fr, colb = u.pn * 256 + 32 * wc + 8 * fq, seg = u.seg;
        const bf16* gcur = gates + (size_t)seg * T * 1024; const bf16* gnxt = gates + (size_t)(seg < 2 ? seg + 1 : seg) * T * 1024;
#pragma unroll
        for (int ai = 0; ai < 2; ++ai) {
            u32x4 gv[4][2], nv[4][2];
#pragma unroll
            for (int m = 0; m < 4; ++m)
#pragma unroll
                for (int bj = 0; bj < 2; ++bj) { const size_t off = (size_t)(rowb + ai * 128 + m * 16) * 1024 + colb + 128 * bj; gv[m][bj] = *(const u32x4*)(gcur + off); nv[m][bj] = *(const u32x4*)(gnxt + off); }
#pragma unroll
            for (int m = 0; m < 4; ++m)
#pragma unroll
                for (int bj = 0; bj < 2; ++bj) {
                    float g[8], gn[8];
                    unpk8(gv[m][bj], g); unpk8(nv[m][bj], gn);
                    if (seg < 2) {
#pragma unroll
                        for (int n = 0; n < 2; ++n)
#pragma unroll
                            for (int j = 0; j < 4; ++j) acc[ai][bj][m][n][j] *= g[4 * n + j] * __builtin_amdgcn_rcpf(fmaxf(gn[4 * n + j], 1e-30f));
                    } else {
                        float o[8];
#pragma unroll
                        for (int n = 0; n < 2; ++n)
#pragma unroll
                            for (int j = 0; j < 4; ++j) o[4 * n + j] = acc[ai][bj][m][n][j] * g[4 * n + j];
                        *(u32x4*)(MG + (size_t)(rowb + ai * 128 + m * 16) * 1024 + colb + 128 * bj) = pk8(o);
                    }
                }
        }
    }
};
struct SegOrder3 : pg8::StaticOrder {
    const char* wsb;
    DI bool next(int i, Unit& u) const { const int base = i / 3; if (!pg8::StaticOrder::next(base, u)) return false; u.seg = i - 3 * base; return true; }
    DI const char* a_ptr(const pg8::Gemm&, const Unit& u) const {
        const long long off = (long long)WS_AO + (long long)(u.seg == 1) * ((long long)WS_HO - (long long)WS_AO) + (long long)(u.seg == 2) * ((long long)WS_MO - (long long)WS_AO);
        return wsb + off; }
    DI const char* b_ptr(const pg8::Gemm& g, const Unit& u) const { return (const char*)g.Bt + (size_t)u.seg * ((size_t)1024 * 512 * 2); }
};

template <class Epi> DI void run_gemm(LAS unsigned char* lds, const bf16* A, const bf16* Bt, int M, int N, int K, int rot, const Epi& E) {
    int Kv = K, Nv = N, Mv = M; asm volatile("" : "+s"(Kv), "+s"(Nv), "+s"(Mv));
    pg8::Gemm g{A, Bt, Mv, Nv, Kv}; pg8::StaticOrder S; const int G = (int)gridDim.x;
    S.init(Mv, Nv, G, (int)((blockIdx.x + (unsigned)G - (unsigned)rot) % (unsigned)G));
    pg8::gemm_phase<Epi, pg8::StaticOrder, true, true>(lds, g, S, E);
}

#define MFMA32(a, b, c) __builtin_amdgcn_mfma_f32_32x32x16_bf16((a), (b), (c), 0, 0, 0)
template <int DQK, int DV, bool CAUSAL>
DI void attn_tile(const LAS unsigned char* kb, const LAS unsigned char* vb, const bf16x8 (&qf)[DQK / 16], f32x16 (&o)[DV / 32], float& mrun, float& lrun, int t, int qlo, int r, int h) {
    constexpr int KROW = DQK * 2 + 16, VROW = 144, KS = DQK / 16, NDB = DV / 32;
    f32x16 s0, s1;
    const float negm = -mrun;
#pragma unroll
    for (int i = 0; i < 16; ++i) { s0[i] = negm; s1[i] = negm; }
#pragma unroll
    for (int ks = 0; ks < KS; ++ks) {
        const bf16x8 k0 = *(const LAS bf16x8*)(kb + r * KROW + 32 * ks + 16 * h);
        const bf16x8 k1 = *(const LAS bf16x8*)(kb + (32 + r) * KROW + 32 * ks + 16 * h);
        s0 = MFMA32(k0, qf[ks], s0); s1 = MFMA32(k1, qf[ks], s1);
    }
    if (CAUSAL && (64 * t + 63 > qlo)) {
        const int qpos = qlo + r, kbase = 64 * t + 4 * h;
#pragma unroll
        for (int i = 0; i < 16; ++i) { const int key = kbase + (i & 3) + 8 * (i >> 2);
            if (key > qpos) s0[i] = -1e30f; if (key + 32 > qpos) s1[i] = -1e30f; }
    }
    float mx = fmaxf(s0[0], s1[0]);
#pragma unroll
    for (int i = 1; i < 16; ++i) mx = fmaxf(mx, fmaxf(s0[i], s1[i]));
    mx = fmaxf(mx, __shfl_xor(mx, 32));
    if (__builtin_amdgcn_ballot_w64(mx > 8.0f) != 0ull) {
        const float delta = fmaxf(mx, 0.f), alpha = __builtin_amdgcn_exp2f(-delta);
        mrun += delta; lrun *= alpha;
#pragma unroll
        for (int i = 0; i < 16; ++i) { s0[i] -= delta; s1[i] -= delta; }
#pragma unroll
        for (int db = 0; db < NDB; ++db)
#pragma unroll
            for (int i = 0; i < 16; ++i) o[db][i] *= alpha;
    }
    float ps = 0.f;
#pragma unroll
    for (int i = 0; i < 16; ++i) { s0[i] = __builtin_amdgcn_exp2f(s0[i]); s1[i] = __builtin_amdgcn_exp2f(s1[i]); ps += s0[i] + s1[i]; }
    lrun += ps;
#pragma unroll
    for (int kb2 = 0; kb2 < 2; ++kb2)
#pragma unroll
        for (int s = 0; s < 2; ++s) {
            u32x4 pw;
            if (kb2 == 0) { pw.x = pk2(s0[8 * s], s0[8 * s + 1]); pw.y = pk2(s0[8 * s + 2], s0[8 * s + 3]); pw.z = pk2(s0[8 * s + 4], s0[8 * s + 5]); pw.w = pk2(s0[8 * s + 6], s0[8 * s + 7]); }
            else { pw.x = pk2(s1[8 * s], s1[8 * s + 1]); pw.y = pk2(s1[8 * s + 2], s1[8 * s + 3]); pw.z = pk2(s1[8 * s + 4], s1[8 * s + 5]); pw.w = pk2(s1[8 * s + 6], s1[8 * s + 7]); }
            const bf16x8 pf = __builtin_bit_cast(bf16x8, pw);
            const int koff = (32 * kb2 + 16 * s + 4 * h) * 2;
#pragma unroll
            for (int db = 0; db < NDB; ++db) {
                const u32x2 lo = *(const LAS u32x2*)(vb + (32 * db + r) * VROW + koff), hi = *(const LAS u32x2*)(vb + (32 * db + r) * VROW + koff + 16);
                u32x4 vw; vw.x = lo.x; vw.y = lo.y; vw.z = hi.x; vw.w = hi.y;
                o[db] = MFMA32(__builtin_bit_cast(bf16x8, vw), pf, o[db]);
            }
        }
}

template <int DQK, int DV, bool CAUSAL>
DI void attn_item(LAS unsigned char* lds, const bf16* Qp, int qstride, const bf16* Kp, const bf16* VTp, int vt_stride, bf16* Op, int ostride, int q0, int nkeys,
                  const float* ssqq, const float* cosT, const float* sinT) {
    constexpr int KROW = DQK * 2 + 16, VROW = 144, KBYTES = 64 * KROW, VBYTES = DV * VROW, BUF = KBYTES + VBYTES;
    constexpr int NCK = 64 * DQK / 8, NCV = DV * 8, KS = DQK / 16, NDB = DV / 32;
    constexpr int CPR = DQK / 8;
    int tid_o = threadIdx.x; asm volatile("" : "+v"(tid_o)); const int tid = tid_o, wid = __builtin_amdgcn_readfirstlane(tid >> 6), lane = tid & 63, r = lane & 31, h = lane >> 5;
    const int ntiles = CAUSAL ? (q0 + 256) / 64 : nkeys / 64;
    const int qlo = q0 + wid * 32;
    bf16x8 qf[KS];
    { const bf16* qr = Qp + (size_t)(wid * 32 + r) * qstride + 8 * h;
#pragma unroll
      for (int ks = 0; ks < KS; ++ks) qf[ks] = *(const bf16x8*)(qr + 16 * ks);
      if (CAUSAL) {
          const float* sp = ssqq + (size_t)(wid * 32 + r) * 16;
          const f32x4 a = *(const f32x4*)sp, b = *(const f32x4*)(sp + 4), c = *(const f32x4*)(sp + 8);
          const float rs = rsqrtf((((a.x + a.y) + (a.z + a.w)) + ((b.x + b.y) + (b.z + b.w)) + ((c.x + c.y) + (c.z + c.w))) * (1.0f / 384.0f) + EPS) * QSCALE_MLA;
#pragma unroll
          for (int ks = 0; ks < KS; ++ks) {
              float v[8]; unpk8(__builtin_bit_cast(u32x4, qf[ks]), v);
              if (ks >= 4) {
                  const int i0 = 8 * (ks - 4) + 4 * h;
                  const f32x4 cs = *(const f32x4*)(cosT + (size_t)(wid * 32 + r) * 16 + i0), sn = *(const f32x4*)(sinT + (size_t)(wid * 32 + r) * 16 + i0);
                  const float t0 = v[0], t1 = v[1], t2 = v[2], t3 = v[3], t4 = v[4], t5 = v[5], t6 = v[6], t7 = v[7];
                  v[0] = t0 * cs.x - t1 * sn.x; v[1] = t1 * cs.x + t0 * sn.x; v[2] = t2 * cs.y - t3 * sn.y; v[3] = t3 * cs.y + t2 * sn.y;
                  v[4] = t4 * cs.z - t5 * sn.z; v[5] = t5 * cs.z + t4 * sn.z; v[6] = t6 * cs.w - t7 * sn.w; v[7] = t7 * cs.w + t6 * sn.w;
              }
#pragma unroll
              for (int e = 0; e < 8; ++e) v[e] *= rs;
              qf[ks] = __builtin_bit_cast(bf16x8, pk8(v));
          }
      } }
    f32x16 o[NDB];
#pragma unroll
    for (int db = 0; db < NDB; ++db)
#pragma unroll
        for (int i = 0; i < 16; ++i) o[db][i] = 0.f;
    float mrun = 0.f, lrun = 0.f;
    const int kc0 = tid, kc1 = tid + 512; const bool k1on = kc1 < NCK;
    const int kr0 = kc0 / CPR, kcc0 = kc0 % CPR, kr1 = kc1 / CPR, kcc1 = kc1 % CPR;
    const int vc0 = tid, vc1 = tid + 512; const bool v1on = vc1 < NCV;
    const GAS u32x4* Kg = (const GAS u32x4*)Kp;
    u32x4 ak0, ak1 = {0, 0, 0, 0}, av0, av1 = {0, 0, 0, 0}, bk0, bk1 = {0, 0, 0, 0}, bv0, bv1 = {0, 0, 0, 0};
#define ATT_GLOAD(P, t_) do { P##k0 = Kg[(size_t)(t_) * NCK + kc0]; if (k1on) P##k1 = Kg[(size_t)(t_) * NCK + kc1]; \
        P##v0 = *(const GAS u32x4*)(VTp + (size_t)(vc0 >> 3) * vt_stride + (t_) * 64 + (vc0 & 7) * 8); \
        if (v1on) P##v1 = *(const GAS u32x4*)(VTp + (size_t)(vc1 >> 3) * vt_stride + (t_) * 64 + (vc1 & 7) * 8); } while (0)
#define ATT_LSTORE(P, buf_) do { LAS unsigned char* kb_ = lds + (buf_) * BUF; LAS unsigned char* vb_ = kb_ + KBYTES; \
        *(LAS u32x4*)(kb_ + kr0 * KROW + kcc0 * 16) = P##k0; if (k1on) *(LAS u32x4*)(kb_ + kr1 * KROW + kcc1 * 16) = P##k1; \
        *(LAS u32x4*)(vb_ + (vc0 >> 3) * VROW + (vc0 & 7) * 16) = P##v0; if (v1on) *(LAS u32x4*)(vb_ + (vc1 >> 3) * VROW + (vc1 & 7) * 16) = P##v1; } while (0)
    ATT_GLOAD(a, 0); ATT_LSTORE(a, 0);
    if (ntiles > 1) ATT_GLOAD(a, 1);
    __syncthreads();
    for (int t = 0; t < ntiles; t += 2) {
        if (t + 2 < ntiles) ATT_GLOAD(b, t + 2);
        if (!CAUSAL || (64 * t <= qlo + 31)) attn_tile<DQK, DV, CAUSAL>(lds, lds + KBYTES, qf, o, mrun, lrun, t, qlo, r, h);
        if (t + 1 < ntiles) ATT_LSTORE(a, 1);
        __syncthreads();
        if (t + 1 < ntiles) {
            if (t + 3 < ntiles) ATT_GLOAD(a, t + 3);
            if (!CAUSAL || (64 * (t + 1) <= qlo + 31)) attn_tile<DQK, DV, CAUSAL>(lds + BUF, lds + BUF + KBYTES, qf, o, mrun, lrun, t + 1, qlo, r, h);
            if (t + 2 < ntiles) ATT_LSTORE(b, 0);
            __syncthreads();
        }
    }
#undef ATT_GLOAD
#undef ATT_LSTORE
    const float ltot = lrun + __shfl_xor(lrun, 32), inv = 1.0f / ltot;
    bf16* orow = Op + (size_t)(wid * 32 + r) * ostride + 4 * h;
#pragma unroll
    for (int db = 0; db < NDB; ++db)
#pragma unroll
        for (int g = 0; g < 4; ++g) {
            u32x2 w; w.x = pk2(o[db][4 * g] * inv, o[db][4 * g + 1] * inv); w.y = pk2(o[db][4 * g + 2] * inv, o[db][4 * g + 3] * inv);
            *(u32x2*)(orow + 32 * db + 8 * g) = w;
        }
}

template <int KSTEPS> DI void lds_mma(f32x16& c, const LAS unsigned char* A, int astride, const LAS unsigned char* Bt, int bstride, int r, int h) {
#pragma unroll
    for (int s = 0; s < KSTEPS; ++s) {
        const bf16x8 a = *(const LAS bf16x8*)(A + r * astride + 32 * s + 16 * h);
        const bf16x8 b = *(const LAS bf16x8*)(Bt + r * bstride + 32 * s + 16 * h);
        c = MFMA32(a, b, c);
    }
}

DI void hgrn_b1(LAS unsigned char* lds, int ch, float* GG, const bf16* HK, const bf16* HV, bf16* LT, float* DEC) {
    int tid_o = threadIdx.x; asm volatile("" : "+v"(tid_o)); const int tid = tid_o, wid = __builtin_amdgcn_readfirstlane(tid >> 6), lane = tid & 63, r = lane & 31, h = lane >> 5;
    const int bh = ch >> 6, c = ch & 63, b = bh >> 2, hd = bh & 3;
    const size_t t0 = (size_t)b * SEQ + c * 64;
    const int k = tid & 127, seg = tid >> 7;
    LAS float* segsum = (LAS float*)lds;
    LAS unsigned char* kdT = lds + 2048;
    LAS unsigned char* vT = kdT + 128 * 144;
    float g[16]; float run = 0.f;
    float* gp = GG + (t0 + seg * 16) * 512 + hd * 128 + k;
#pragma unroll
    for (int i = 0; i < 16; ++i) { run += gp[(size_t)i * 512]; g[i] = run; }
    segsum[seg * 128 + k] = run;
    __syncthreads();
    float off = 0.f, tot = 0.f;
#pragma unroll
    for (int s = 0; s < 4; ++s) { const float v = segsum[s * 128 + k]; if (s < seg) off += v; tot += v; }
    const bf16* kp = HK + (t0 + seg * 16) * 512 + hd * 128 + k;
    const bf16* vp = HV + (t0 + seg * 16) * 512 + hd * 128 + k;
#pragma unroll
    for (int i = 0; i < 16; ++i) {
        const float G = g[i] + off; gp[(size_t)i * 512] = G;
        const float kd = bf2f(kp[(size_t)i * 512]) * __expf(tot - G);
        *(LAS bf16*)(kdT + k * 144 + (seg * 16 + i) * 2) = f2bf(kd);
        *(LAS bf16*)(vT + k * 144 + (seg * 16 + i) * 2) = vp[(size_t)i * 512];
    }
    if (seg == 0) DEC[(size_t)ch * 128 + k] = __expf(tot);
    __syncthreads();
    const int vb = wid >> 1;
#pragma unroll
    for (int q = 0; q < 2; ++q) {
        const int kb = (wid & 1) * 2 + q;
        f32x16 acc;
#pragma unroll
        for (int i = 0; i < 16; ++i) acc[i] = 0.f;
        lds_mma<4>(acc, vT + vb * 32 * 144, 144, kdT + kb * 32 * 144, 144, r, h);
        bf16* lp = LT + (size_t)ch * 16384 + (size_t)(vb * 32 + 4 * h) * 128 + kb * 32 + r;
#pragma unroll
        for (int i = 0; i < 16; ++i) lp[(size_t)((i & 3) + 8 * (i >> 2)) * 128] = f2bf(acc[i]);
    }
    __syncthreads();
}

DI void hgrn_b3(LAS unsigned char* lds, int ch, const float* GG, const bf16* HQ, const bf16* HK, const bf16* HV, const bf16* HGT, const bf16* LT, const float* onorm, bf16* HO) {
    constexpr int RS = 272;
    int tid_o = threadIdx.x; asm volatile("" : "+v"(tid_o)); const int tid = tid_o, wid = __builtin_amdgcn_readfirstlane(tid >> 6), lane = tid & 63, r = lane & 31, h = lane >> 5;
    const int bh = ch >> 6, c = ch & 63, b = bh >> 2, hd = bh & 3;
    const size_t t0 = (size_t)b * SEQ + c * 64;
    LAS unsigned char* qG = lds;
    LAS unsigned char* q1 = qG + 64 * RS;
    LAS unsigned char* kA0 = q1 + 32 * RS;
    LAS unsigned char* kA1 = kA0 + 32 * RS;
    LAS unsigned char* ST = kA1 + 64 * RS;
    LAS unsigned char* vT = ST + 128 * RS;
    LAS unsigned char* Am = vT + 128 * 144;
    {
        const int k8 = tid & 15;
        const float* g31p = GG + (t0 + 31) * 512 + hd * 128 + k8 * 8;
        const f32x4 ga = *(const f32x4*)g31p, gb = *(const f32x4*)(g31p + 4);
        const float g31[8] = {ga.x, ga.y, ga.z, ga.w, gb.x, gb.y, gb.z, gb.w};
#pragma unroll
        for (int pass = 0; pass < 2; ++pass) {
            const int t = (tid >> 4) + 32 * pass;
            const size_t off = (t0 + t) * 512 + hd * 128 + k8 * 8;
            const f32x4 a = *(const f32x4*)(GG + off), bq = *(const f32x4*)(GG + off + 4);
            const float G[8] = {a.x, a.y, a.z, a.w, bq.x, bq.y, bq.z, bq.w};
            float q[8], kk[8], o1[8], o2[8], o3[8];
            unpk8(*(const u32x4*)(HQ + off), q); unpk8(*(const u32x4*)(HK + off), kk);
#pragma unroll
            for (int e = 0; e < 8; ++e) o1[e] = q[e] * __expf(G[e]);
            *(LAS u32x4*)(qG + t * RS + k8 * 16) = pk8(o1);
            if (pass == 0) {
#pragma unroll
                for (int e = 0; e < 8; ++e) { o2[e] = kk[e] * __expf(fminf(-G[e], 80.f)); o3[e] = kk[e] * __expf(g31[e] - G[e]); }
                *(LAS u32x4*)(kA0 + t * RS + k8 * 16) = pk8(o2);
                *(LAS u32x4*)(kA1 + t * RS + k8 * 16) = pk8(o3);
            } else {
#pragma unroll
                for (int e = 0; e < 8; ++e) { o2[e] = q[e] * __expf(G[e] - g31[e]); o3[e] = kk[e] * __expf(fminf(g31[e] - G[e], 80.f)); }
                *(LAS u32x4*)(q1 + (t - 32) * RS + k8 * 16) = pk8(o2);
                *(LAS u32x4*)(kA1 + t * RS + k8 * 16) = pk8(o3);
            }
        }
        const bf16* lp = LT + (size_t)ch * 16384;
#pragma unroll
        for (int p = 0; p < 4; ++p) {
            const int idx = tid + 512 * p, v = idx >> 4, kk8 = idx & 15;
            *(LAS u32x4*)(ST + v * RS + kk8 * 16) = *(const u32x4*)(lp + v * 128 + kk8 * 8);
        }
        const int v = tid & 127, seg = tid >> 7;
        const bf16* vp = HV + (t0 + seg * 16) * 512 + hd * 128 + v;
#pragma unroll
        for (int i = 0; i < 16; ++i) *(LAS bf16*)(vT + v * 144 + (seg * 16 + i) * 2) = vp[(size_t)i * 512];
    }
    __syncthreads();
    if (wid < 3) {
        f32x16 a;
#pragma unroll
        for (int i = 0; i < 16; ++i) a[i] = 0.f;
        const int tb = wid == 0 ? 0 : 1, sb = wid == 2 ? 1 : 0;
        if (wid == 0) lds_mma<8>(a, qG, RS, kA0, RS, r, h);
        else lds_mma<8>(a, q1, RS, kA1 + sb * 32 * RS, RS, r, h);
#pragma unroll
        for (int i = 0; i < 16; ++i) { const int tl = (i & 3) + 8 * (i >> 2) + 4 * h; float val = a[i]; if (tb == sb && r > tl) val = 0.f;
            *(LAS bf16*)(Am + (tb * 32 + tl) * 144 + (sb * 32 + r) * 2) = f2bf(val); }
    } else if (wid == 3) {
#pragma unroll
        for (int i = 0; i < 16; ++i) { const int tl = (i & 3) + 8 * (i >> 2) + 4 * h; *(LAS bf16*)(Am + tl * 144 + (32 + r) * 2) = (bf16)0; }
    }
    __syncthreads();
    f32x16 acc;
#pragma unroll
    for (int i = 0; i < 16; ++i) acc[i] = 0.f;
    const int tb = wid >> 2, vb = wid & 3;
    lds_mma<8>(acc, qG + tb * 32 * RS, RS, ST + vb * 32 * RS, RS, r, h);
    lds_mma<4>(acc, Am + tb * 32 * 144, 144, vT + vb * 32 * 144, 144, r, h);
    __syncthreads();
    LAS float* Ost = (LAS float*)ST;
#pragma unroll
    for (int i = 0; i < 16; ++i) Ost[(tb * 32 + (i & 3) + 8 * (i >> 2) + 4 * h) * 132 + vb * 32 + r] = acc[i];
    __syncthreads();
    {
        const int t = tid >> 3, part = tid & 7;
        float ov[16]; float ss = 0.f;
#pragma unroll
        for (int q4 = 0; q4 < 4; ++q4) { const f32x4 x = *(const LAS f32x4*)(Ost + t * 132 + part * 16 + q4 * 4); ov[4 * q4] = x.x; ov[4 * q4 + 1] = x.y; ov[4 * q4 + 2] = x.z; ov[4 * q4 + 3] = x.w; }
#pragma unroll
        for (int e = 0; e < 16; ++e) ss += ov[e] * ov[e];
        ss += __shfl_xor(ss, 1); ss += __shfl_xor(ss, 2); ss += __shfl_xor(ss, 4);
        const float rs = rsqrtf(ss * (1.0f / 128.0f) + EPS);
        const size_t off = (t0 + t) * 512 + hd * 128 + part * 16;
        float gt[16];
        unpk8(*(const u32x4*)(HGT + off), gt); unpk8(*(const u32x4*)(HGT + off + 8), gt + 8);
#pragma unroll
        for (int e = 0; e < 16; ++e) ov[e] = ov[e] * rs * onorm[part * 16 + e] * gt[e];
        *(u32x4*)(HO + off) = pk8(ov); *(u32x4*)(HO + off + 8) = pk8(ov + 8);
    }
    __syncthreads();
}

DI int dest_row(int mode, int n) {
    if (mode == 0) return n;
    if (mode == 1) { const int j = n < DFF ? n : n - DFF; return (j >> 7) * 256 + (n < DFF ? 0 : 128) + (j & 127); }
    if (mode == 2) { if (n < 640) return n; if (n < 672) { const int j = n - 640; return 640 + (j < 16 ? 2 * j : 2 * (j - 16) + 1); } if (n < 3232) return 768 + (n - 672); return 3328 + (n - 3232); }
    const int hd = n / 96, w = n - hd * 96; if (w < 64) return n; const int j = w - 64; return hd * 96 + 64 + (j < 16 ? 2 * j : 2 * (j - 16) + 1);
}
DI void conv_item(const float* W, int K, int N, bf16* WT, const float* gain, int mode, int row_off, LAS float* scr, int item, int lane) {
    const int nblk = N / 32, kb = item / nblk, nb = item - kb * nblk, k0 = 64 * kb, n0 = 32 * nb;
    float wv[32];
    const float* wp = W + (size_t)(k0 + (lane >> 5)) * N + n0 + (lane & 31);
#pragma unroll
    for (int i = 0; i < 32; ++i) wv[i] = __builtin_nontemporal_load(wp + (size_t)(2 * i) * N);
#pragma unroll
    for (int i = 0; i < 32; ++i) scr[(2 * i + (lane >> 5)) * 33 + (lane & 31)] = wv[i];
    asm volatile("s_waitcnt lgkmcnt(0)" ::: "memory");
    const int c = lane & 7;
    float gn[8];
#pragma unroll
    for (int e = 0; e < 8; ++e) gn[e] = gain ? gain[k0 + 8 * c + e] : 1.0f;
#pragma unroll
    for (int j = 0; j < 4; ++j) { const int n = (lane >> 3) + 8 * j; const LAS float* s = scr + (8 * c) * 33 + n;
        float v[8];
#pragma unroll
        for (int e = 0; e < 8; ++e) v[e] = s[e * 33] * gn[e];
        *(u32x4*)(WT + (size_t)(row_off + dest_row(mode, n0 + n)) * K + k0 + 8 * c) = pk8(v); }
    asm volatile("s_waitcnt lgkmcnt(0)" ::: "memory");
}

#define XB_TMO      128
#define XB_XCNT(j)  (256  + 64 * (j))
#define XB_XSUB(j)  (1280 + 64 * (j))
#define XB_XGEN(j)  (2304 + 64 * (j))
#define XB_TOP      3328
#define XB_TOPGEN   3392
#define XCD_BAR_WORDS 3456
#define XB_SPIN_CAP (1u << 18)
static_assert(XCD_BAR_WORDS * 4 <= CTL_BYTES, "barrier words inside the memset region");
DI unsigned xb_ld(unsigned* p)              { return __hip_atomic_load(p, __ATOMIC_RELAXED, __HIP_MEMORY_SCOPE_AGENT); }
DI unsigned xb_add(unsigned* p, unsigned v) { return __hip_atomic_fetch_add(p, v, __ATOMIC_RELAXED, __HIP_MEMORY_SCOPE_AGENT); }
DI unsigned xb_xcc_id() { return (unsigned)__builtin_amdgcn_s_getreg((3 << 11) | 20) & 0xFu; }
#define XB_SPIN(cond, bar) do { unsigned _sp = 0; while (cond) { __builtin_amdgcn_s_sleep(1); \
    if ((++_sp & 255u) == 0u) { if (xb_ld(&(bar)[XB_TMO])) break; if (_sp > XB_SPIN_CAP) { atomicAdd(&(bar)[XB_TMO], 1u); break; } } } } while (0)
struct XcdBarrier { unsigned* bar; unsigned x; volatile LAS unsigned* st; };
DI void xcd_barrier_complete(unsigned* bar, unsigned x, unsigned& nloc, unsigned& nx) {
    const unsigned G = gridDim.x * gridDim.y * gridDim.z;
    unsigned sum, cnt, mine, sp = 0u;
    for (;;) {
        sum = 0u; cnt = 0u; mine = 0u;
#pragma unroll
        for (unsigned j = 0; j < 16; ++j) { const unsigned c = xb_ld(&bar[XB_XCNT(j)]); sum += c; cnt += (c > 0u) ? 1u : 0u; mine = (j == x) ? c : mine; }
        if (sum == G) break;
        __builtin_amdgcn_s_sleep(1);
        if ((++sp & 255u) == 0u) { if (xb_ld(&bar[XB_TMO])) break; if (sp > XB_SPIN_CAP) { atomicAdd(&bar[XB_TMO], 1u); break; } }
    }
    nloc = mine > 0u ? mine : 1u; nx = cnt > 0u ? cnt : 1u;
}
DI void xcd_barrier(const XcdBarrier& b) {
    asm volatile("s_waitcnt vmcnt(0)" ::: "memory");
    __syncthreads();
    if (threadIdx.x == 0) {
        unsigned* bar = b.bar;
        __builtin_amdgcn_s_waitcnt(0);
        unsigned nloc = b.st[0], nx = b.st[1];
        if (nloc == 0u) { xcd_barrier_complete(bar, b.x, nloc, nx); b.st[0] = nloc; b.st[1] = nx; }
        const unsigned old = xb_add(&bar[XB_XSUB(b.x)], 1u);
        const unsigned gen = old / nloc;
        if (old + 1u == (gen + 1u) * nloc) {
            __builtin_amdgcn_fence(__ATOMIC_RELEASE, "agent");
            asm volatile("s_waitcnt vmcnt(0)" ::: "memory");
            const unsigned og = xb_add(&bar[XB_TOP], 1u);
            const unsigned tg = og / nx;
            if (og + 1u == (tg + 1u) * nx) xb_add(&bar[XB_TOPGEN], 1u);
            else XB_SPIN(xb_ld(&bar[XB_TOPGEN]) == tg, bar);
            __builtin_amdgcn_fence(__ATOMIC_ACQUIRE, "agent");
            xb_add(&bar[XB_XGEN(b.x)], 1u);
            asm volatile("s_waitcnt vmcnt(0)" ::: "memory");
        } else {
            XB_SPIN(xb_ld(&bar[XB_XGEN(b.x)]) == gen, bar);
            __builtin_amdgcn_fence(__ATOMIC_ACQUIRE, "agent");
            asm volatile("s_waitcnt vmcnt(0)" ::: "memory");
        }
    }
    __syncthreads();
}

struct Args { const void* in[25]; float* out; unsigned char* ws; int ph_lo, ph_hi; };
typedef const __attribute__((address_space(4))) unsigned long long* ka_t;
DI unsigned long long KA(int i) { ka_t p = (ka_t)__builtin_amdgcn_kernarg_segment_ptr(); asm volatile("" : "+s"(p)); return p[i]; }
#define KIN(i) ((const float*)KA(i))
#define KOUT ((float*)KA(25))
#define KWS ((unsigned char*)KA(26))

DI void conv_set(int mask, int l, int bpart, int nbparts, LAS unsigned char* lds) {
    int tid_o = threadIdx.x; asm volatile("" : "+v"(tid_o)); const int tid = tid_o, wave = __builtin_amdgcn_readfirstlane(tid >> 6), lane = tid & 63;
    const int part = bpart * NWAVES + wave, nparts = nbparts * NWAVES, tpart = bpart * NTHREADS + tid, ntparts = nbparts * NTHREADS;
    LAS float* scr = (LAS float*)(lds + wave * 16384);
    unsigned char* ws = KWS;
    constexpr int I_FI = 16 * 176, I_FO = 44 * 32, I_WIN = 16 * 197, I_UQ = 6 * 24, I_UK = 4 * 16, I_WO = 8 * 32, I_SQ = 16 * 32;
    if (mask & 1) {
        const float* f1n = KIN(3) + l * 1024; const float* w1i = KIN(4) + (size_t)l * 1024 * 5632; const float* w1o = KIN(5) + (size_t)l * 2816 * 1024;
        for (int it = part; it < I_FI + I_FO; it += nparts) {
            if (it < I_FI) conv_item(w1i, 1024, 5632, (bf16*)(ws + WT_W1IN), f1n, 1, 0, scr, it, lane);
            else conv_item(w1o, 2816, 1024, (bf16*)(ws + WT_W1OUT), nullptr, 0, 0, scr, it - I_FI, lane);
        }
    }
    if (mask & 4) {
        const float* f2n = KIN(21) + l * 1024; const float* w2i = KIN(22) + (size_t)l * 1024 * 5632; const float* w2o = KIN(23) + (size_t)l * 2816 * 1024;
        for (int it = part; it < I_FI + I_FO; it += nparts) {
            if (it < I_FI) conv_item(w2i, 1024, 5632, (bf16*)(ws + WT_W2IN), f2n, 1, 0, scr, it, lane);
            else conv_item(w2o, 2816, 1024, (bf16*)(ws + WT_W2OUT), nullptr, 0, 0, scr, it - I_FI, lane);
        }
    }
    if (mask & 2) {
        const float* mxn = KIN(6) + l * 1024; const float* win = KIN(7) + (size_t)l * 1024 * DIN;
        for (int it = part; it < I_WIN; it += nparts) conv_item(win, 1024, DIN, (bf16*)(ws + WT_WIN), mxn, 2, 0, scr, it, lane);
        u32x4* pad = (u32x4*)(ws + WT_WIN + (size_t)672 * 1024 * 2);
        unsigned zz = 0u; asm volatile("" : "+v"(zz));
        for (int i = tpart; i < 96 * 1024 * 2 / 16; i += ntparts) pad[i] = (u32x4){zz, zz, zz, zz};
    }
    if (mask & 8) {
        const float* qln = KIN(8) + l * 384; const float* kvn = KIN(9) + l * 256;
        const float* wuq = KIN(10) + (size_t)l * 384 * 768; const float* wuk = KIN(11) + (size_t)l * 256 * 512; const float* wuv = KIN(12) + (size_t)l * 256 * 512;
        const float* womla = KIN(13) + (size_t)l * 512 * 1024; const float* wohg = KIN(16) + (size_t)l * 512 * 1024; const float* womem = KIN(19) + (size_t)l * 512 * 1024;
        const float* wout = KIN(20) + (size_t)l * 1024 * 1024;
        constexpr int NIT = I_UQ + 2 * I_UK + 3 * I_WO + I_SQ;
        for (int it = part; it < NIT; it += nparts) {
            int r = it;
            if (r < I_UQ) { conv_item(wuq, 384, 768, (bf16*)(ws + WT_WUQ), qln, 3, 0, scr, r, lane); continue; } r -= I_UQ;
            if (r < I_UK) { conv_item(wuk, 256, 512, (bf16*)(ws + WT_WUKV), kvn, 0, 0, scr, r, lane); continue; } r -= I_UK;
            if (r < I_UK) { conv_item(wuv, 256, 512, (bf16*)(ws + WT_WUKV), kvn, 0, 512, scr, r, lane); continue; } r -= I_UK;
            if (r < I_WO) { conv_item(womla, 512, 1024, (bf16*)(ws + WT_WOMLA), nullptr, 0, 0, scr, r, lane); continue; } r -= I_WO;
            if (r < I_WO) { conv_item(wohg, 512, 1024, (bf16*)(ws + WT_WOHG), nullptr, 0, 0, scr, r, lane); continue; } r -= I_WO;
            if (r < I_WO) { conv_item(womem, 512, 1024, (bf16*)(ws + WT_WOMEM), nullptr, 0, 0, scr, r, lane); continue; } r -= I_WO;
            conv_item(wout, 1024, 1024, (bf16*)(ws + WT_WOUT), nullptr, 0, 0, scr, r, lane);
        }
    }
    if (mask & 16) {
        const float* memn = KIN(17); const float* wmkv = KIN(18);
        for (int it = part; it < 4 * I_SQ; it += nparts) { const int ll = it / I_SQ, r = it - ll * I_SQ;
            conv_item(wmkv + (size_t)ll * 1024 * 1024, 1024, 1024, (bf16*)(ws + WT_WMEMKV) + (size_t)ll * 1024 * 1024, memn + ll * 1024, 0, 0, scr, r, lane); }
    }
    __syncthreads();
}
DI void conv_tail(int mask, int l, int nwg, LAS unsigned char* lds) {
    const int G = (int)gridDim.x, rem = nwg % G, c = (int)blockIdx.x;
    if (c < rem) return;
    conv_set(mask, l, c - rem, G - rem, lds);
}

DI void prep_phase() {
    int tid_o = threadIdx.x; asm volatile("" : "+v"(tid_o)); const int tid = tid_o, wave = __builtin_amdgcn_readfirstlane(tid >> 6), lane = tid & 63;
    const int gw = blockIdx.x * NWAVES + wave, NGW = gridDim.x * NWAVES;
    unsigned char* ws = KWS;
    const float* x = KIN(0); const float* mem = KIN(1); const int* pos = (const int*)KA(2);
    bf16* XB = (bf16*)(ws + WS_XB); float* SSQ = (float*)(ws + WS_SSQ);
    for (int m = gw; m < T; m += NGW) {
        const f32x4* xr = (const f32x4*)(x + (size_t)m * D) + lane; u32x2* xb = (u32x2*)(XB + (size_t)m * D) + lane;
        float s = 0.f;
#pragma unroll
        for (int j = 0; j < 4; ++j) { const f32x4 v = xr[64 * j]; u32x2 w; w.x = pk2(v.x, v.y); w.y = pk2(v.z, v.w); xb[64 * j] = w;
            const float a = bflo(w.x), b = bfhi(w.x), c = bflo(w.y), d = bfhi(w.y); s += (a * a + b * b) + (c * c + d * d); }
        s = wave_sum(s);
        if (lane < 16) SSQ[(size_t)m * 16 + lane] = lane == 0 ? s : 0.f;
    }
    bf16* MEMB = (bf16*)(ws + WS_MEMB); float* MRS = (float*)(ws + WS_MEMRSTD);
    for (int m = gw; m < 1024; m += NGW) {
        const f32x4* xr = (const f32x4*)(mem + (size_t)m * D) + lane; u32x2* xb = (u32x2*)(MEMB + (size_t)m * D) + lane;
        float s = 0.f;
#pragma unroll
        for (int j = 0; j < 4; ++j) { const f32x4 v = xr[64 * j]; s += (v.x * v.x + v.y * v.y) + (v.z * v.z + v.w * v.w); u32x2 w; w.x = pk2(v.x, v.y); w.y = pk2(v.z, v.w); xb[64 * j] = w; }
        s = wave_sum(s);
        if (lane == 0) MRS[m] = rsqrtf(s * (1.0f / 1024.0f) + EPS);
    }
    float* COS = (float*)(ws + WS_COS); float* SIN = (float*)(ws + WS_SIN);
    for (int i = blockIdx.x * NTHREADS + tid; i < T * 16; i += gridDim.x * NTHREADS) {
        const int row = i >> 4, fi = i & 15;
        const float invf = exp2f(-13.287712379549449f * (float)fi * (1.0f / 16.0f));
        const float ang = (float)pos[row] * invf;
        const float kq = rintf(ang * 0.15915494309189535f);
        float rr = fmaf(-kq, 6.28125f, ang); rr = fmaf(-kq, 1.9353071795864769e-3f, rr);
        COS[i] = __cosf(rr); SIN[i] = __sinf(rr);
    }
    const float* hlb = KIN(14); float* LBS = (float*)(ws + WS_LBS);
    for (int i = blockIdx.x * NTHREADS + tid; i < 512; i += gridDim.x * NTHREADS) {
        const float a0 = hlb[i], a1 = hlb[512 + i], a2 = hlb[1024 + i], a3 = hlb[1536 + i];
        const float mx = fmaxf(fmaxf(a0, a1), fmaxf(a2, a3));
        const float e0 = __expf(a0 - mx), e1 = __expf(a1 - mx), e2 = __expf(a2 - mx), e3 = __expf(a3 - mx), inv = 1.0f / (e0 + e1 + e2 + e3);
        LBS[i] = 0.f; LBS[512 + i] = e1 * inv; LBS[1024 + i] = (e1 + e2) * inv; LBS[1536 + i] = (e1 + e2 + e3) * inv;
    }
}

__global__ void __launch_bounds__(NTHREADS, 2) fwd_kernel(Args A_unused) {
    extern __shared__ __attribute__((aligned(16))) unsigned char lds_raw[];
    LAS unsigned char* lds = (LAS unsigned char*)lds_raw;
    cg::grid_group grid = cg::this_grid();
    int ph = 0;
    int lo, hi; { const unsigned long long w = KA(27); lo = (int)(unsigned)w; hi = (int)(unsigned)(w >> 32); }
#define RUN (ph >= lo && ph < hi)
    volatile LAS unsigned* bst = (volatile LAS unsigned*)(lds + 131072 + 512);
    if (threadIdx.x < 2) bst[threadIdx.x] = 0u;
    __syncthreads();
    if (threadIdx.x == 0) (void)xb_add(&((unsigned*)(KWS + WS_CTL))[XB_XCNT(xb_xcc_id())], 1u);
#define SEAM do { if (ph >= lo && ph + 1 < hi) { if (ph == 1) grid.sync(); else { XcdBarrier xb_; xb_.bar = (unsigned*)(KWS + WS_CTL); xb_.x = xb_xcc_id(); xb_.st = bst; xcd_barrier(xb_); } } ++ph; } while (0)
#define WSP(T_, name, off) T_* name = (T_*)(ws + (off))
#define REPEAT(n_) for (int rep_ = 0; rep_ < (n_); ++rep_, ((rep_ < (n_)) ? xcd_barrier(XcdBarrier{(unsigned*)(KWS + WS_CTL), xb_xcc_id(), bst}) : (void)0))

    if (RUN) { prep_phase(); }
    ++ph;
    for (int l = 0; l < DEPTH; ++l) {
        if (l == 0) {
            if (RUN) conv_set(1 | 2 | 16, 0, (int)blockIdx.x, (int)gridDim.x, lds);
            SEAM;
        }
#ifdef PROBE_NULL_P1
        if (RUN) { unsigned char* ws = KWS; EpiNull E{(bf16*)(ws + WS_H)}; run_gemm(lds, (const bf16*)(ws + WS_XB), (const bf16*)(ws + WT_W1IN), T, 5632, 1024, 0, E);
            XcdBarrier xb_; xb_.bar = (unsigned*)(KWS + WS_CTL); xb_.x = xb_xcc_id(); xb_.st = bst; xcd_barrier(xb_); }
#endif
#ifndef SKIP_G1
        if (RUN) REPEAT(REP_P1) { unsigned char* ws = KWS; EpiSwiglu E{(bf16*)(ws + WS_H), (const float*)(ws + WS_SSQ)}; run_gemm(lds, (const bf16*)(ws + WS_XB), (const bf16*)(ws + WT_W1IN), T, 5632, 1024, 0, E);
            if (l == 0) {
                const int rem = (64 * 22) % (int)gridDim.x;
#pragma unroll 1
                for (int ll = 0; ll < DEPTH; ++ll) { unsigned char* ws2 = KWS; EpiMemKV E2{(bf16*)(ws2 + WS_MK) + (size_t)ll * 16 * 256 * 128, (bf16*)(ws2 + WS_MVT) + (size_t)ll * 16 * 128 * 256, (const float*)(ws2 + WS_MEMRSTD)};
                    run_gemm(lds, (const bf16*)(ws2 + WS_MEMB), (const bf16*)(ws2 + WT_WMEMKV) + (size_t)ll * 1024 * 1024, 1024, 1024, 1024, (rem + 16 * ll) % (int)gridDim.x, E2); }
            } else conv_tail(2, l, 64 * 22, lds);
        }
#endif
        SEAM;
#ifndef SKIP_G2
        if (RUN) { unsigned char* ws = KWS; EpiResid E{(bf16*)(ws + WS_XB), (float*)(ws + WS_SSQ), 0.5f}; run_gemm(lds, (const bf16*)(ws + WS_H), (const bf16*)(ws + WT_W1OUT), T, 1024, DFF, 0, E); }
#endif
        SEAM;
#ifndef SKIP_WIN
        if (RUN) REPEAT(REP_P3) { unsigned char* ws = KWS;
            EpiWin E{ws, (const float*)(ws + WS_LBS) + l * 512};
            run_gemm(lds, (const bf16*)(ws + WS_XB), (const bf16*)(ws + WT_WIN), T, NIN, 1024, 0, E);
            conv_tail(4 | 8, l, 64 * 25, lds); }
#endif
        SEAM;
        if (RUN) {
#ifndef SKIP_G4
            REPEAT(REP_P4G) {
            { unsigned char* ws = KWS; EpiQ E{(bf16*)(ws + WS_Q)}; run_gemm(lds, (const bf16*)(ws + WS_CQ), (const bf16*)(ws + WT_WUQ), T, 768, 384, 0, E); }
            { unsigned char* ws = KWS; EpiKV E{(bf16*)(ws + WS_KC), (bf16*)(ws + WS_VT), (const float*)(ws + WS_SSQKV)}; run_gemm(lds, (const bf16*)(ws + WS_CKV), (const bf16*)(ws + WT_WUKV), T, 1024, 256, 64, E); }
            }
#endif
#ifndef SKIP_B1
            { unsigned char* ws = KWS; const int G = (int)gridDim.x;
              for (int ch = (int)blockIdx.x; ch < 1024; ch += G) hgrn_b1(lds, ch, (float*)(ws + WS_GG), (const bf16*)(ws + WS_HK), (const bf16*)(ws + WS_HV), (bf16*)(ws + WS_LT), (float*)(ws + WS_DEC)); }
#endif
        }
        SEAM;
        if (RUN) {
            unsigned char* ws = KWS; int tid_o = threadIdx.x; asm volatile("" : "+v"(tid_o)); const int G = (int)gridDim.x, bid = (int)blockIdx.x, tid = tid_o;
#ifndef SKIP_MLA
            REPEAT(REP_MLA) for (int it = bid; it < 256; it += G) {
                const int bh = it >> 3, pr = it & 7, b = bh >> 3, hd = bh & 7;
#pragma unroll 1
                for (int half = 0; half < 2; ++half) {
                    const int qb = half == 0 ? 15 - pr : pr;
                    const size_t row0 = (size_t)b * SEQ + qb * 256;
                    attn_item<96, 64, true>(lds, (const bf16*)(ws + WS_Q) + row0 * 768 + hd * 96, 768, (const bf16*)(ws + WS_KC) + (size_t)bh * SEQ * 96, (const bf16*)(ws + WS_VT) + (size_t)bh * 64 * SEQ, SEQ,
                                            (bf16*)(ws + WS_AO) + row0 * 512 + hd * 64, 512, qb * 256, SEQ, (const float*)(ws + WS_SSQQ) + row0 * 16, (const float*)(ws + WS_COS) + row0 * 16, (const float*)(ws + WS_SIN) + row0 * 16);
                }
            }
#endif
            unsigned* LT2 = (unsigned*)(ws + WS_LT); const float* DEC = (const float*)(ws + WS_DEC);
            for (int gt = bid * NTHREADS + tid; gt < 16 * 8192; gt += G * NTHREADS) {
                const int bh = gt >> 13, e2 = gt & 8191, k = (e2 & 63) * 2;
                unsigned* lp = LT2 + (size_t)bh * 64 * 8192 + e2; const float* dp = DEC + (size_t)bh * 64 * 128 + k;
                float run0 = 0.f, run1 = 0.f;
#pragma unroll 8
                for (int c = 0; c < 64; ++c) { const unsigned tmp = lp[(size_t)c * 8192]; const f32x2_t d = *(const f32x2_t*)(dp + c * 128); lp[(size_t)c * 8192] = pk2(run0, run1); run0 = d.x * run0 + bflo(tmp); run1 = d.y * run1 + bfhi(tmp); }
            }
        }
        SEAM;
        if (RUN) REPEAT(REP_P6) {
            unsigned char* ws = KWS; const int G = (int)gridDim.x, bid = (int)blockIdx.x;
#ifndef SKIP_XATT
            for (int it = bid; it < 256; it += G) {
                const int b = it >> 6, hd = (it >> 4) & 3, qb = it & 15;
                const size_t row0 = (size_t)b * SEQ + qb * 256;
                attn_item<128, 128, false>(lds, (const bf16*)(ws + WS_MQ) + row0 * 512 + hd * 128, 512, (const bf16*)(ws + WS_MK) + (size_t)(l * 16 + b * 4 + hd) * 256 * 128, (const bf16*)(ws + WS_MVT) + (size_t)(l * 16 + b * 4 + hd) * 128 * 256, 256,
                                           (bf16*)(ws + WS_MO) + row0 * 512 + hd * 128, 512, 0, 256, nullptr, nullptr, nullptr);
            }
#endif
#ifndef SKIP_B3
            const float* onorm = KIN(15) + l * 128;
            for (int ch = bid; ch < 1024; ch += G) hgrn_b3(lds, ch, (const float*)(ws + WS_GG), (const bf16*)(ws + WS_HQ), (const bf16*)(ws + WS_HK), (const bf16*)(ws + WS_HV), (const bf16*)(ws + WS_HGT), (const bf16*)(ws + WS_LT), onorm, (bf16*)(ws + WS_HO));
#endif
        }
        SEAM;
#ifndef SKIP_G7
        if (RUN) REPEAT(REP_P7) {
            unsigned char* ws = KWS; EpiBranch3 E{(bf16*)(ws + WS_MERGED), (const bf16*)(ws + WS_GATES)};
            int Kv = 512, Nv = 1024, Mv = T; asm volatile("" : "+s"(Kv), "+s"(Nv), "+s"(Mv));
            pg8::Gemm g{(const bf16*)(ws + WS_AO), (const bf16*)(ws + WT_WOMLA), Mv, Nv, Kv};
            SegOrder3 S; S.init(Mv, Nv, (int)gridDim.x, (int)blockIdx.x); S.wsb = (const char*)ws;
            pg8::gemm_phase<EpiBranch3, SegOrder3, true, true>(lds, g, S, E);
        }
#endif
        SEAM;
#ifndef SKIP_G8
        if (RUN) { unsigned char* ws = KWS; EpiResid E{(bf16*)(ws + WS_XB), (float*)(ws + WS_SSQ), 1.0f}; run_gemm(lds, (const bf16*)(ws + WS_MERGED), (const bf16*)(ws + WT_WOUT), T, 1024, 1024, 0, E); }
#endif
        SEAM;
#ifndef SKIP_G9
        if (RUN) { unsigned char* ws = KWS; EpiSwiglu E{(bf16*)(ws + WS_H), (const float*)(ws + WS_SSQ)}; run_gemm(lds, (const bf16*)(ws + WS_XB), (const bf16*)(ws + WT_W2IN), T, 5632, 1024, 0, E);
            if (l + 1 < DEPTH) conv_tail(1, l + 1, 64 * 22, lds); }
#endif
        SEAM;
#ifndef SKIP_G10
        if (RUN) { unsigned char* ws = KWS; EpiResid E{(bf16*)(ws + WS_XB), (float*)(ws + WS_SSQ), 0.5f}; run_gemm(lds, (const bf16*)(ws + WS_H), (const bf16*)(ws + WT_W2OUT), T, 1024, DFF, 0, E); }
#endif
        SEAM;
    }
    if (RUN) {
        unsigned char* ws = KWS; float* X = KOUT; const float* SSQ = (const float*)(ws + WS_SSQ); const bf16* XB = (const bf16*)(ws + WS_XB);
        int tid_o = threadIdx.x; asm volatile("" : "+v"(tid_o)); const int tid = tid_o, wave = __builtin_amdgcn_readfirstlane(tid >> 6), lane = tid & 63, G = (int)gridDim.x;
        const float* fg = KIN(24);
        for (int m = (int)blockIdx.x * NWAVES + wave; m < T; m += G * NWAVES) {
            const float rs = rsqrtf(sum16(SSQ + (size_t)m * 16) * (1.0f / 1024.0f) + EPS);
            f32x4* xr = (f32x4*)(X + (size_t)m * D) + lane; const f32x4* gr = (const f32x4*)fg + lane; const u32x2* xb = (const u32x2*)(XB + (size_t)m * D) + lane;
#pragma unroll
            for (int j = 0; j < 4; ++j) { const u32x2 w = xb[64 * j]; const f32x4 g = gr[64 * j]; f32x4 v = {bflo(w.x), bfhi(w.x), bflo(w.y), bfhi(w.y)}; v = v * rs * g; xr[64 * j] = v; }
        }
    }
#undef RUN
#undef SEAM
}

constexpr int N_PHASES = 1 + 1 + DEPTH * 10 + 1;

extern "C" void kernel_launch(void* const* d_in, const int* in_sizes, int n_in, void* d_out, int out_size, void* d_ws, size_t ws_size, hipStream_t stream) {
    static int grid = 0;
    if (grid == 0) {
        if (n_in != 25 || out_size != T * D || ws_size < WS_END) { fprintf(stderr, "kernel_launch: unexpected shapes (n_in %d out %d ws %zu need %zu)\n", n_in, out_size, ws_size, (size_t)WS_END); grid = -1; return; }
        int dev = 0, cus = 0, per_cu = 0;
        hipGetDevice(&dev);
        hipDeviceGetAttribute(&cus, hipDeviceAttributeMultiprocessorCount, dev);
        if (hipFuncSetAttribute((const void*)fwd_kernel, hipFuncAttributeMaxDynamicSharedMemorySize, LDS_BYTES) != hipSuccess) { fprintf(stderr, "kernel_launch: hipFuncSetAttribute failed\n"); grid = -1; return; }
        if (hipOccupancyMaxActiveBlocksPerMultiprocessor(&per_cu, (const void*)fwd_kernel, NTHREADS, LDS_BYTES) != hipSuccess || per_cu < 1) { fprintf(stderr, "kernel_launch: occupancy query says %d\n", per_cu); per_cu = 1; }
        (void)hipGetLastError();
        grid = cus * 1;
        if (grid <= 0) grid = 256;
    }
    if (grid < 0) return;
    if (hipMemsetAsync((char*)d_ws + WS_CTL, 0, CTL_BYTES, stream) != hipSuccess) { fprintf(stderr, "kernel_launch: memset of the barrier words failed\n"); return; }
    Args a{};
    for (int i = 0; i < 25; ++i) a.in[i] = d_in[i];
    a.out = (float*)d_out; a.ws = (unsigned char*)d_ws; a.ph_lo = 0; a.ph_hi = N_PHASES;
    void* args[] = {&a};
    hipError_t e = hipLaunchCooperativeKernel((const void*)fwd_kernel, dim3(grid), dim3(NTHREADS), args, LDS_BYTES, stream);
    if (e != hipSuccess) fprintf(stderr, "cooperative launch failed: %s (grid %d)\n", hipGetErrorString(e), grid);
}
```

```cpp
#include <hip/hip_runtime.h>
#include <hip/hip_cooperative_groups.h>
#include <cstdio>
#include <cstdint>
namespace cg = cooperative_groups;
#define DI __device__ __forceinline__
namespace pg8 {
#define PG8_LAS __attribute__((address_space(3)))
typedef unsigned short bf16_t;
typedef short bf16x8 __attribute__((ext_vector_type(8)));
typedef float f32x4 __attribute__((ext_vector_type(4)));
typedef unsigned u32x4 __attribute__((ext_vector_type(4)));
constexpr int BM = 256, BK = 64, HALF = 128, HTB = HALF * BK * 2  , STAGE_BYTES = 8 * HTB, NXCD = 8, WGM = 8;

__host__ __device__ __forceinline__ int lds_byte(int r, int c) { const int st = (r >> 4) * 2 + (c >> 5), rr = r & 15, cc = c & 31, ob = rr * 64 + cc * 2; return st * 1024 + (ob ^ (((ob >> 9) & 1) << 5)); }
__host__ __device__ __forceinline__ void stage_rc(int b, int& R, int& C) { const int st = b / 1024, sb = b % 1024, swz = sb ^ (((sb >> 9) & 1) << 5); R = (st >> 1) * 16 + swz / 64; C = (st & 1) * 32 + (swz % 64) / 2; }
__host__ __device__ __forceinline__ int perm32(int rho) { const int n = rho >> 4, i = rho & 15; return 8 * (i >> 2) + 4 * n + (i & 3); }

struct Unit { int pm, pn, seg; };
struct Gemm { const bf16_t* A; const bf16_t* Bt; int M, N, K; };

struct StaticOrder {
    int nM, nN, nwg, G, c;
    __host__ __device__ void init(int M, int N, int G_, int c_) { nM = M / BM; nN = N / BM; nwg = nM * nN; G = G_; c = c_; }
    __host__ __device__ bool next(int i, Unit& u) const {
        const long L = (long)i * G + c; if (L >= nwg) return false;
        int wgid = (int)L; { const int q = nwg / NXCD, r = nwg % NXCD, xcd = wgid % NXCD, off = wgid / NXCD; wgid = (xcd < r ? xcd * (q + 1) : r * (q + 1) + (xcd - r) * q) + off; }
        const int nig = WGM * nN, gid = wgid / nig, fm = gid * WGM, gsz = (nM - fm) < WGM ? (nM - fm) : WGM;
        u.pm = fm + ((wgid % nig) % gsz); u.pn = (wgid % nig) / gsz; u.seg = 0; return true;
    }
    __device__ __forceinline__ const char* a_ptr(const Gemm& g, const Unit&) const { return (const char*)g.A; }
    __device__ __forceinline__ const char* b_ptr(const Gemm& g, const Unit&) const { return (const char*)g.Bt; }
    __device__ __forceinline__ void a_ready(const Unit&) const {}
    __device__ __forceinline__ void done(const Unit&) const {}
};
template <class Epi, class Sched, bool ALIGN_EPI = false, bool SP2 = false>
__device__ __forceinline__ void gemm_phase(PG8_LAS unsigned char* lds, const Gemm g, const Sched& S, const Epi& E) {
    int tid_o = threadIdx.x; asm volatile("" : "+v"(tid_o));
    const int tid = tid_o, wid = __builtin_amdgcn_readfirstlane(tid >> 6), lane = tid & 63, wr = wid >> 2, wc = wid & 3, fr = lane & 15, fq = lane >> 4;
    const int K = g.K, nt = K / BK;
    unsigned voffA[2], voffB[2];
#pragma unroll
    for (int i = 0; i < 2; ++i) { int R, C; stage_rc(tid * 16 + i * 8192, R, C); const int Rb = Epi::PERM ? ((R & ~31) + perm32(R & 31)) : R;
        voffA[i] = (unsigned)(R * K + C) * 2u; voffB[i] = (unsigned)(Rb * K + C) * 2u; }
    const size_t kstep = (size_t)(BK * 2);
    const size_t hstep = (size_t)HALF * K * 2;
    const size_t tstep = 2 * hstep;
    const unsigned ldsw = (unsigned)wid * 1024u;
    const int aoff = lds_byte(wr * 64 + fr, fq * 8), boff = lds_byte(wc * 32 + fr, fq * 8);
#define PG8_SA(b, h) (((b) * 2 + (h)) * HTB)
#define PG8_SB(b, h) ((4 + (b) * 2 + (h)) * HTB)
#define PG8_STAGE(bufoff, gbase, voff) do { _Pragma("unroll") for (int _i = 0; _i < 2; ++_i) \
        __builtin_amdgcn_global_load_lds((const unsigned*)((const char*)(gbase) + (voff)[_i]), (PG8_LAS unsigned*)(lds + (bufoff) + ldsw + _i * 8192), 16, 0, 0); } while (0)
#define PG8_LDA(dst, b, h) do { _Pragma("unroll") for (int m = 0; m < 4; ++m) _Pragma("unroll") for (int k = 0; k < 2; ++k) dst[m][k] = *(const PG8_LAS bf16x8*)(lds + PG8_SA(b, h) + aoff + m * 2048 + k * 1024); } while (0)
#define PG8_LDB(dst, b, h) do { _Pragma("unroll") for (int n = 0; n < 2; ++n) _Pragma("unroll") for (int k = 0; k < 2; ++k) dst[n][k] = *(const PG8_LAS bf16x8*)(lds + PG8_SB(b, h) + boff + n * 2048 + k * 1024); } while (0)
#define PG8_MMA(ai, bj, At, Bt) do { __builtin_amdgcn_s_setprio(1); _Pragma("unroll") for (int m = 0; m < 4; ++m) _Pragma("unroll") for (int n = 0; n < 2; ++n) _Pragma("unroll") for (int k = 0; k < 2; ++k) \
        acc[ai][bj][m][n] = __builtin_amdgcn_mfma_f32_16x16x32_bf16(Bt[n][k], At[m][k], acc[ai][bj][m][n], 0, 0, 0); __builtin_amdgcn_s_setprio(0); } while (0)
#define PG8_WAIT_V(n) asm volatile("s_waitcnt vmcnt(" #n ")" ::: "memory")
#define PG8_WAIT_L(n) asm volatile("s_waitcnt lgkmcnt(" #n ")" ::: "memory")
#define PG8_BAR __builtin_amdgcn_s_barrier()
#define PG8_SCHED __builtin_amdgcn_sched_barrier(0)
    Unit cur, nxt; int ui = 0;
    if (!S.next(0, cur)) return;
    f32x4 acc[2][2][4][2];
#pragma unroll
    for (int a = 0; a < 2; ++a)
#pragma unroll
        for (int b = 0; b < 2; ++b)
#pragma unroll
            for (int m = 0; m < 4; ++m)
#pragma unroll
                for (int n = 0; n < 2; ++n) acc[a][b][m][n] = (f32x4){0.f, 0.f, 0.f, 0.f};
    bf16x8 At[4][2], B0[2][2], B1[2][2];
    const char* cA = S.a_ptr(g, cur) + (size_t)cur.pm * tstep; const char* cB = S.b_ptr(g, cur) + (size_t)cur.pn * tstep;
    S.a_ready(cur);
    if constexpr (SP2) {
        PG8_STAGE(PG8_SB(0, 0), cB, voffB); PG8_STAGE(PG8_SB(0, 1), cB + hstep, voffB); PG8_STAGE(PG8_SA(0, 0), cA, voffA); PG8_STAGE(PG8_SA(0, 1), cA + hstep, voffA);
        if (wr == 1) PG8_BAR;
        PG8_WAIT_V(2); PG8_BAR;
        PG8_STAGE(PG8_SB(1, 0), cB + kstep, voffB); PG8_STAGE(PG8_SA(1, 0), cA + kstep, voffA); PG8_STAGE(PG8_SB(1, 1), cB + hstep + kstep, voffB);
        PG8_WAIT_V(6); PG8_BAR;
    } else {
        PG8_STAGE(PG8_SB(0, 0), cB, voffB); PG8_STAGE(PG8_SA(0, 0), cA, voffA); PG8_STAGE(PG8_SB(0, 1), cB + hstep, voffB); PG8_STAGE(PG8_SA(0, 1), cA + hstep, voffA);
        if (wr == 1) PG8_BAR;
        PG8_WAIT_V(4); PG8_BAR;
        PG8_STAGE(PG8_SB(1, 0), cB + kstep, voffB); PG8_STAGE(PG8_SA(1, 0), cA + kstep, voffA); PG8_STAGE(PG8_SB(1, 1), cB + hstep + kstep, voffB);
        PG8_WAIT_V(6); PG8_BAR;
    }
    for (;;) {
        const bool has_next = S.next(ui + 1, nxt);
        const char* nA = has_next ? S.a_ptr(g, nxt) + (size_t)nxt.pm * tstep : cA; const char* nB = has_next ? S.b_ptr(g, nxt) + (size_t)nxt.pn * tstep : cB;
        for (int t = 0; t < nt; t += 2) {
            const bool last = (t == nt - 2);
            const char* a1 = cA + (size_t)(t + 1) * kstep;
            const char* a2 = last ? nA : cA + (size_t)(t + 2) * kstep; const char* b2 = last ? nB : cB + (size_t)(t + 2) * kstep;
            const char* a3 = a2 + kstep; const char* b3 = b2 + kstep;
            if (last && has_next) S.a_ready(nxt);
            if (last) E.prefetch(lds, cur, wid, lane);
            if constexpr (SP2) {
            PG8_LDB(B0, 0, 0); PG8_LDB(B1, 0, 1); PG8_SCHED; PG8_LDA(At, 0, 0); PG8_STAGE(PG8_SA(1, 1), a1 + hstep, voffA);
            PG8_WAIT_V(8); PG8_WAIT_L(0); PG8_BAR; PG8_MMA(0, 0, At, B0); PG8_MMA(0, 1, At, B1); PG8_BAR; PG8_SCHED;
            PG8_LDA(At, 0, 1); PG8_STAGE(PG8_SB(0, 0), b2, voffB); PG8_STAGE(PG8_SB(0, 1), b2 + hstep, voffB); PG8_STAGE(PG8_SA(0, 0), a2, voffA);
            PG8_WAIT_V(8); PG8_WAIT_L(0); PG8_BAR; PG8_MMA(1, 0, At, B0); PG8_MMA(1, 1, At, B1); PG8_BAR; PG8_SCHED;
            PG8_LDB(B0, 1, 0); PG8_LDB(B1, 1, 1); PG8_SCHED; PG8_LDA(At, 1, 0); PG8_STAGE(PG8_SA(0, 1), a2 + hstep, voffA);
            PG8_WAIT_V(8); PG8_WAIT_L(0); PG8_BAR; PG8_MMA(0, 0, At, B0); PG8_MMA(0, 1, At, B1); PG8_BAR; PG8_SCHED;
            PG8_LDA(At, 1, 1); PG8_STAGE(PG8_SB(1, 0), b3, voffB); PG8_STAGE(PG8_SB(1, 1), b3 + hstep, voffB); PG8_STAGE(PG8_SA(1, 0), a3, voffA);
            PG8_WAIT_V(8); PG8_WAIT_L(0); PG8_BAR; PG8_MMA(1, 0, At, B0); PG8_MMA(1, 1, At, B1); PG8_BAR; PG8_SCHED;
            } else {
            PG8_LDB(B0, 0, 0); PG8_SCHED; PG8_LDA(At, 0, 0); PG8_STAGE(PG8_SA(1, 1), a1 + hstep, voffA);
            PG8_WAIT_L(8); PG8_BAR; PG8_WAIT_L(0); PG8_MMA(0, 0, At, B0); PG8_BAR; PG8_SCHED;
            PG8_LDB(B1, 0, 1); PG8_STAGE(PG8_SB(0, 0), b2, voffB);
            PG8_BAR; PG8_WAIT_L(0); PG8_MMA(0, 1, At, B1); PG8_BAR;
            PG8_LDA(At, 0, 1); PG8_STAGE(PG8_SA(0, 0), a2, voffA);
            PG8_BAR; PG8_WAIT_L(0); PG8_MMA(1, 0, At, B0); PG8_BAR; PG8_SCHED;
            PG8_STAGE(PG8_SB(0, 1), b2 + hstep, voffB);
            PG8_WAIT_V(6); PG8_BAR; PG8_MMA(1, 1, At, B1); PG8_BAR;
            PG8_LDB(B0, 1, 0); PG8_SCHED; PG8_LDA(At, 1, 0); PG8_STAGE(PG8_SA(0, 1), a2 + hstep, voffA);
            PG8_WAIT_L(8); PG8_BAR; PG8_WAIT_L(0); PG8_MMA(0, 0, At, B0); PG8_BAR; PG8_SCHED;
            PG8_LDB(B1, 1, 1); PG8_STAGE(PG8_SB(1, 0), b3, voffB);
            PG8_BAR; PG8_WAIT_L(0); PG8_MMA(0, 1, At, B1); PG8_BAR;
            PG8_LDA(At, 1, 1); PG8_STAGE(PG8_SA(1, 0), a3, voffA);
            PG8_BAR; PG8_WAIT_L(0); PG8_MMA(1, 0, At, B0); PG8_BAR; PG8_SCHED;
            PG8_STAGE(PG8_SB(1, 1), b3 + hstep, voffB);
            PG8_WAIT_V(6); PG8_BAR; PG8_MMA(1, 1, At, B1); PG8_BAR;
            }
        }
        if constexpr (ALIGN_EPI) { if (wr == 0) PG8_BAR; }
        if constexpr (!Epi::AFTER_DRAIN) { E(acc, cur, wr, wc, fr, fq); S.done(cur); }
        if (!has_next) break;
        if (!E.keep_acc(cur))
#pragma unroll
        for (int a = 0; a < 2; ++a)
#pragma unroll
            for (int b = 0; b < 2; ++b)
#pragma unroll
                for (int m = 0; m < 4; ++m)
#pragma unroll
                    for (int n = 0; n < 2; ++n) acc[a][b][m][n] = (f32x4){0.f, 0.f, 0.f, 0.f};
        cur = nxt; cA = nA; cB = nB; ++ui;
        if constexpr (ALIGN_EPI) { if (wr == 1) PG8_BAR; }
    }
    PG8_WAIT_V(0);
    if constexpr (!ALIGN_EPI) { if (wr == 0) PG8_BAR; }
    PG8_BAR;
    if constexpr (Epi::AFTER_DRAIN) { E.fused(acc, cur, wr, wc, fr, fq, lds, wid, lane); S.done(cur); }
#undef PG8_SA
#undef PG8_SB
#undef PG8_STAGE
#undef PG8_LDA
#undef PG8_LDB
#undef PG8_MMA
#undef PG8_WAIT_V
#undef PG8_WAIT_L
#undef PG8_BAR
#undef PG8_SCHED
}
}

typedef unsigned short bf16;
#define LAS __attribute__((address_space(3)))
#define GAS __attribute__((address_space(1)))
typedef float f32x4 __attribute__((ext_vector_type(4)));
typedef float f32x16 __attribute__((ext_vector_type(16)));
typedef float f32x2_t __attribute__((ext_vector_type(2)));
typedef __bf16 bf16x2_t __attribute__((ext_vector_type(2)));
typedef short bf16x8 __attribute__((ext_vector_type(8)));
typedef short s16x4 __attribute__((ext_vector_type(4)));
typedef unsigned u32x4 __attribute__((ext_vector_type(4)));
typedef unsigned u32x2 __attribute__((ext_vector_type(2)));

constexpr int T = 16384, D = 1024, SEQ = 4096, NBATCH = 4, DFF = 2816, DEPTH = 4, NIN = 6400, DIN = 6304;
constexpr int NTHREADS = 512, NWAVES = 8;
constexpr float EPS = 1e-6f;
constexpr float QSCALE_MLA = 0.14724498f;
constexpr float QSCALE_MEM = 0.12751743f;

constexpr size_t MiB = 1u << 20;
constexpr size_t WT_W1IN = 0;
constexpr size_t WT_W1OUT = WT_W1IN + (size_t)5632 * 1024 * 2;
constexpr size_t WT_WIN = WT_W1OUT + (size_t)1024 * 2816 * 2;
constexpr size_t WT_WUQ = WT_WIN + (size_t)NIN * 1024 * 2;
constexpr size_t WT_WUKV = WT_WUQ + (size_t)768 * 384 * 2;
constexpr size_t WT_WOMLA = WT_WUKV + (size_t)1024 * 256 * 2;
constexpr size_t WT_WOHG = WT_WOMLA + (size_t)1024 * 512 * 2;
constexpr size_t WT_WOMEM = WT_WOHG + (size_t)1024 * 512 * 2;
constexpr size_t WT_WMEMKV = WT_WOMEM + (size_t)1024 * 512 * 2;
constexpr size_t WT_WOUT = WT_WMEMKV + (size_t)4 * 1024 * 1024 * 2;
constexpr size_t WT_W2IN = WT_WOUT + (size_t)1024 * 1024 * 2;
constexpr size_t WT_W2OUT = WT_W2IN + (size_t)5632 * 1024 * 2;
constexpr size_t WT_END = WT_W2OUT + (size_t)1024 * 2816 * 2;
static_assert(WT_END <= 60 * MiB, "weights");
constexpr size_t WS_XB = 60 * MiB;
constexpr size_t WS_SSQ = WS_XB + 32 * MiB;
constexpr size_t WS_SSQQ = WS_SSQ + 1 * MiB;
constexpr size_t WS_SSQKV = WS_SSQQ + 1 * MiB;
constexpr size_t WS_COS = WS_SSQKV + 1 * MiB;
constexpr size_t WS_SIN = WS_COS + 1 * MiB;
constexpr size_t WS_LBS = WS_SIN + 1 * MiB;
constexpr size_t WS_MEMB = WS_LBS + 65536;
constexpr size_t WS_MEMRSTD = WS_MEMB + 2 * MiB;
constexpr size_t WS_MK = WS_MEMRSTD + 65536;
constexpr size_t WS_MVT = WS_MK + 4 * MiB;
constexpr size_t WS_DEC = WS_MVT + 4 * MiB;
constexpr size_t WS_MIX = WS_DEC + 1 * MiB;
constexpr size_t WS_CQ = WS_MIX;
constexpr size_t WS_CKV = WS_CQ + 12 * MiB;
constexpr size_t WS_KR = WS_CKV + 8 * MiB;
constexpr size_t WS_HQ = WS_KR + 1 * MiB;
constexpr size_t WS_GG = WS_HQ + 16 * MiB;
constexpr size_t WS_HK = WS_GG + 32 * MiB;
constexpr size_t WS_HV = WS_HK + 16 * MiB;
constexpr size_t WS_HGT = WS_HV + 16 * MiB;
constexpr size_t WS_MQ = WS_HGT + 16 * MiB;
constexpr size_t WS_GATES = WS_MQ + 16 * MiB;
constexpr size_t WS_Q = WS_GATES + 96 * MiB;
constexpr size_t WS_KC = WS_Q + 24 * MiB;
constexpr size_t WS_VT = WS_KC + 24 * MiB;
constexpr size_t WS_LT = WS_VT + 16 * MiB;
constexpr size_t WS_AO = WS_LT + 64 * MiB;
constexpr size_t WS_CTL = WS_AO + 16 * MiB;
constexpr size_t CTL_BYTES = 16384;
constexpr size_t WS_END = WS_CTL + 65536;
constexpr size_t WS_HO = WS_CQ;
constexpr size_t WS_MERGED = WS_GG;
constexpr size_t WS_MO = WS_Q;
constexpr size_t WS_H = WS_MIX;
static_assert(WS_H + (size_t)T * DFF * 2 <= WS_END, "h overlay");

constexpr int LDS_BYTES = 163840;
constexpr int LDS_SSQ_OFF = 131072 + 4096;
#ifndef REP_CONV
#define REP_CONV 1
#endif
#ifndef REP_P1
#define REP_P1 1
#endif
#ifndef REP_P3
#define REP_P3 1
#endif
#ifndef REP_MLA
#define REP_MLA 1
#endif
#ifndef REP_P6
#define REP_P6 1
#endif
#ifndef REP_P7
#define REP_P7 1
#endif
#ifndef REP_P4G
#define REP_P4G 1
#endif

DI unsigned pk2(float lo, float hi) { f32x2_t v = {lo, hi}; bf16x2_t b = __builtin_convertvector(v, bf16x2_t); return __builtin_bit_cast(unsigned, b); }
DI u32x4 pk8(const float* v) { u32x4 w; w.x = pk2(v[0], v[1]); w.y = pk2(v[2], v[3]); w.z = pk2(v[4], v[5]); w.w = pk2(v[6], v[7]); return w; }
DI float bflo(unsigned w) { return __uint_as_float(w << 16); }
DI float bfhi(unsigned w) { return __uint_as_float(w & 0xffff0000u); }
DI void unpk8(u32x4 w, float* v) { v[0] = bflo(w.x); v[1] = bfhi(w.x); v[2] = bflo(w.y); v[3] = bfhi(w.y); v[4] = bflo(w.z); v[5] = bfhi(w.z); v[6] = bflo(w.w); v[7] = bfhi(w.w); }
DI float bf2f(bf16 b) { return __uint_as_float(((unsigned)b) << 16); }
DI bf16 f2bf(float f) { return (bf16)(pk2(f, 0.f) & 0xffffu); }
DI float sigmoidf_(float z) { return __builtin_amdgcn_rcpf(1.0f + __expf(-z)); }
DI float wave_sum(float v) {
#pragma unroll
    for (int o = 1; o < 64; o <<= 1) v += __shfl_xor(v, o);
    return v;
}
DI float rowsum_q(const float* p, int fq, int nq) {
    float s = 0.f;
    if (fq < nq) { const f32x4 a = *(const f32x4*)(p + 4 * fq); s = (a.x + a.y) + (a.z + a.w); }
    s += __shfl_xor(s, 16); s += __shfl_xor(s, 32);
    return s;
}
DI void rstd8(const float* ssq, int stride, int nq, float inv_n, float post, int rowb, int fq, float (&rs)[8]) {
    f32x4 q[8];
#pragma unroll
    for (int i = 0; i < 8; ++i) q[i] = *(const f32x4*)(ssq + (size_t)(rowb + (i >> 2) * 128 + (i & 3) * 16) * stride + 4 * fq);
    const float keep = fq < nq ? 1.0f : 0.0f;
#pragma unroll
    for (int i = 0; i < 8; ++i) { float t = ((q[i].x + q[i].y) + (q[i].z + q[i].w)) * keep; t += __shfl_xor(t, 16); t += __shfl_xor(t, 32); rs[i] = __builtin_amdgcn_rsqf(t * inv_n + EPS) * post; }
}
DI void rstd8_lds(const LAS unsigned char* pan, float inv_n, int rowl, int fq, float (&rs)[8]) {
    f32x4 q[8];
#pragma unroll
    for (int i = 0; i < 8; ++i) q[i] = *(const LAS f32x4*)(pan + (rowl + (i >> 2) * 128 + (i & 3) * 16) * 64 + 16 * fq);
#pragma unroll
    for (int i = 0; i < 8; ++i) { float t = (q[i].x + q[i].y) + (q[i].z + q[i].w); t += __shfl_xor(t, 16); t += __shfl_xor(t, 32); rs[i] = __builtin_amdgcn_rsqf(t * inv_n + EPS); }
}
DI void ssq_panel_dma(LAS unsigned char* lds, const float* ssq, int pm, int wid, int lane) {
    const char* src = (const char*)(ssq + (size_t)pm * 256 * 16);
    const unsigned voff = (unsigned)(wid * 64 + lane) * 16u;
#pragma unroll
    for (int i = 0; i < 2; ++i)
        __builtin_amdgcn_global_load_lds((const unsigned*)(src + i * 8192 + voff), (LAS unsigned*)(lds + LDS_SSQ_OFF + wid * 1024 + i * 8192), 16, 0, 0);
}
DI float sum16(const float* p) {
    const f32x4 a = *(const f32x4*)p, b = *(const f32x4*)(p + 4), c = *(const f32x4*)(p + 8), d = *(const f32x4*)(p + 12);
    return ((a.x + a.y) + (a.z + a.w)) + ((b.x + b.y) + (b.z + b.w)) + ((c.x + c.y) + (c.z + c.w)) + ((d.x + d.y) + (d.z + d.w));
}

using pg8::Unit;
#define EPI_ARGS const f32x4 (&acc)[2][2][4][2], const Unit& u, int wr, int wc, int fr_in, int fq_in
#define EPI_OPAQUE int fr = fr_in, fq = fq_in; asm volatile("" : "+v"(fr), "+v"(fq));

struct EpiSwiglu {
    static constexpr bool PERM = true, AFTER_DRAIN = false;
    DI bool keep_acc(const Unit&) const { return false; }
    bf16* H; const float* ssq; LAS unsigned char* ldsb;
    DI void prefetch(LAS unsigned char* lds, const Unit& u, int wid, int lane) const { ssq_panel_dma(lds, ssq, u.pm, wid, lane); }
    DI void operator()(EPI_ARGS) const {
        EPI_OPAQUE
        const int rowb = u.pm * 256 + wr * 64 + fr;
        asm volatile("s_waitcnt vmcnt(16)" ::: "memory"); __builtin_amdgcn_s_barrier(); asm volatile("" ::: "memory");
        float rs[8]; rstd8_lds(ldsb + LDS_SSQ_OFF, 1.0f / 1024.0f, wr * 64 + fr, fq, rs);
#pragma unroll
        for (int ai = 0; ai < 2; ++ai)
#pragma unroll
            for (int m = 0; m < 4; ++m) {
                const int row = rowb + ai * 128 + m * 16;
                const float r1 = rs[ai * 4 + m];
                float o[8];
#pragma unroll
                for (int n = 0; n < 2; ++n)
#pragma unroll
                    for (int j = 0; j < 4; ++j) { const float a = acc[ai][0][m][n][j] * r1, b = acc[ai][1][m][n][j] * r1; o[4 * n + j] = a * b * __builtin_amdgcn_rcpf(1.0f + __expf(-a)); }
                *(u32x4*)(H + (size_t)row * DFF + u.pn * 128 + 32 * wc + 8 * fq) = pk8(o);
            }
    }
};

struct EpiSwigluNoLoad {
    static constexpr bool PERM = true, AFTER_DRAIN = false;
    DI bool keep_acc(const Unit&) const { return false; }
    DI void prefetch(LAS unsigned char*, const Unit&, int, int) const {}
    bf16* H;
    DI void operator()(EPI_ARGS) const {
        EPI_OPAQUE
        const int rowb = u.pm * 256 + wr * 64 + fr;
#pragma unroll
        for (int ai = 0; ai < 2; ++ai)
#pragma unroll
            for (int m = 0; m < 4; ++m) {
                const int row = rowb + ai * 128 + m * 16;
                float o[8];
#pragma unroll
                for (int n = 0; n < 2; ++n)
#pragma unroll
                    for (int j = 0; j < 4; ++j) { const float a = acc[ai][0][m][n][j], b = acc[ai][1][m][n][j]; o[4 * n + j] = a * b * __builtin_amdgcn_rcpf(1.0f + __expf(-a)); }
#ifndef PROBE_NOSTORE
                *(u32x4*)(H + (size_t)row * DFF + u.pn * 128 + 32 * wc + 8 * fq) = pk8(o);
#else
                if (o[0] + o[1] + o[2] + o[3] + o[4] + o[5] + o[6] + o[7] == 12345.678f) *(u32x4*)(H + (size_t)row * DFF + u.pn * 128 + 32 * wc + 8 * fq) = pk8(o);
#endif
            }
    }
};

struct EpiNull {
    static constexpr bool PERM = true, AFTER_DRAIN = false;
    DI bool keep_acc(const Unit&) const { return false; }
    DI void prefetch(LAS unsigned char*, const Unit&, int, int) const {}
    bf16* H;
    DI void operator()(EPI_ARGS) const {
        float t = 0.f;
#pragma unroll
        for (int ai = 0; ai < 2; ++ai)
#pragma unroll
            for (int bj = 0; bj < 2; ++bj)
#pragma unroll
                for (int m = 0; m < 4; ++m)
#pragma unroll
                    for (int n = 0; n < 2; ++n) t += acc[ai][bj][m][n][0] + acc[ai][bj][m][n][1] + acc[ai][bj][m][n][2] + acc[ai][bj][m][n][3];
        if (t == 12345.678f) H[0] = 0;
    }
};

struct EpiResid {
    static constexpr bool PERM = true, AFTER_DRAIN = false;
    DI bool keep_acc(const Unit&) const { return false; }
    DI void prefetch(LAS unsigned char*, const Unit&, int, int) const {}
    bf16* XB; float* ssq; float scale;
    DI void operator()(EPI_ARGS) const {
        EPI_OPAQUE
        const int rowb = u.pm * 256 + wr * 64 + fr, colb = u.pn * 256 + 32 * wc + 8 * fq;
#pragma unroll
        for (int ai = 0; ai < 2; ++ai) {
            u32x4 xv[4][2];
#pragma unroll
            for (int m = 0; m < 4; ++m)
#pragma unroll
                for (int bj = 0; bj < 2; ++bj) xv[m][bj] = *(const u32x4*)(XB + (size_t)(rowb + ai * 128 + m * 16) * D + colb + 128 * bj);
#pragma unroll
            for (int m = 0; m < 4; ++m) {
                const int row = rowb + ai * 128 + m * 16;
                float ss = 0.f;
#pragma unroll
                for (int bj = 0; bj < 2; ++bj) {
                    float o[8]; unpk8(xv[m][bj], o);
#pragma unroll
                    for (int n = 0; n < 2; ++n)
#pragma unroll
                        for (int j = 0; j < 4; ++j) o[4 * n + j] += scale * acc[ai][bj][m][n][j];
                    const u32x4 w = pk8(o);
                    *(u32x4*)(XB + (size_t)row * D + colb + 128 * bj) = w;
                    float q[8]; unpk8(w, q);
#pragma unroll
                    for (int e = 0; e < 8; ++e) ss += q[e] * q[e];
                }
                ss += __shfl_xor(ss, 16); ss += __shfl_xor(ss, 32);
                if (fq == 0) ssq[(size_t)row * 16 + u.pn * 4 + wc] = ss;
            }
        }
    }
};

struct EpiWin {
    static constexpr bool PERM = true, AFTER_DRAIN = false;
    DI bool keep_acc(const Unit&) const { return false; }
    DI void prefetch(LAS unsigned char* lds, const Unit& u, int wid, int lane) const { ssq_panel_dma(lds, (const float*)(ws + WS_SSQ), u.pm, wid, lane); }
    unsigned char* ws; const float* lbs  ; LAS unsigned char* ldsb;
    DI void operator()(EPI_ARGS) const {
        EPI_OPAQUE
        const float* ssq = (const float*)(ws + WS_SSQ); const float* cosT = (const float*)(ws + WS_COS); const float* sinT = (const float*)(ws + WS_SIN);
        bf16* CQ = (bf16*)(ws + WS_CQ); bf16* CKV = (bf16*)(ws + WS_CKV); bf16* KC = (bf16*)(ws + WS_KC); bf16* HQ = (bf16*)(ws + WS_HQ); bf16* HK = (bf16*)(ws + WS_HK); bf16* HV = (bf16*)(ws + WS_HV);
        bf16* HGT = (bf16*)(ws + WS_HGT); bf16* MQ = (bf16*)(ws + WS_MQ); bf16* GATES = (bf16*)(ws + WS_GATES); float* GG = (float*)(ws + WS_GG); float* SSQQ = (float*)(ws + WS_SSQQ); float* SSQKV = (float*)(ws + WS_SSQKV);
        const int rowb = u.pm * 256 + wr * 64 + fr;
        asm volatile("s_waitcnt vmcnt(16)" ::: "memory"); __builtin_amdgcn_s_barrier(); asm volatile("" ::: "memory");
        float rs8[8]; rstd8_lds(ldsb + LDS_SSQ_OFF, 1.0f / 1024.0f, wr * 64 + fr, fq, rs8);
#pragma unroll
        for (int ai = 0; ai < 2; ++ai)
#pragma unroll
            for (int m = 0; m < 4; ++m) {
                const int row = rowb + ai * 128 + m * 16;
                const float rs = rs8[ai * 4 + m];
#pragma unroll
                for (int bj = 0; bj < 2; ++bj) {
                    const int hh = 2 * u.pn + bj, cw = 32 * wc + 8 * fq;
                    float v[8];
#pragma unroll
                    for (int n = 0; n < 2; ++n)
#pragma unroll
                        for (int j = 0; j < 4; ++j) v[4 * n + j] = acc[ai][bj][m][n][j] * rs;
                    if (hh < 5) {
                        float ss = 0.f;
#pragma unroll
                        for (int e = 0; e < 8; ++e) ss += v[e] * v[e];
                        ss += __shfl_xor(ss, 16); ss += __shfl_xor(ss, 32);
                        if (hh < 3) { *(u32x4*)(CQ + (size_t)row * 384 + hh * 128 + cw) = pk8(v); if (fq == 0) SSQQ[(size_t)row * 16 + hh * 4 + wc] = ss; }
                        else { *(u32x4*)(CKV + (size_t)row * 256 + (hh - 3) * 128 + cw) = pk8(v); if (fq == 0) SSQKV[(size_t)row * 8 + (hh - 3) * 4 + wc] = ss; }
                    } else if (hh == 5) {
                        if (wc == 0) {
                            const f32x4 c = *(const f32x4*)(cosT + (size_t)row * 16 + 4 * fq), s = *(const f32x4*)(sinT + (size_t)row * 16 + 4 * fq);
                            u32x4 o;
                            o.x = pk2(v[0] * c.x - v[1] * s.x, v[1] * c.x + v[0] * s.x); o.y = pk2(v[2] * c.y - v[3] * s.y, v[3] * c.y + v[2] * s.y);
                            o.z = pk2(v[4] * c.z - v[5] * s.z, v[5] * c.z + v[4] * s.z); o.w = pk2(v[6] * c.w - v[7] * s.w, v[7] * c.w + v[6] * s.w);
                            bf16* kp = KC + ((size_t)(row >> 12) * 8 * SEQ + (row & 4095)) * 96 + 64 + 8 * fq;
#pragma unroll
                            for (int hd = 0; hd < 8; ++hd) *(u32x4*)(kp + (size_t)hd * SEQ * 96) = o;
                        }
                    } else if (hh < 10) {
#pragma unroll
                        for (int e = 0; e < 8; ++e) v[e] = v[e] * sigmoidf_(v[e]);
                        *(u32x4*)(HQ + (size_t)row * 512 + (hh - 6) * 128 + cw) = pk8(v);
                    } else if (hh < 14) {
                        const int c0 = (hh - 10) * 128 + cw;
                        const f32x4 l0 = *(const f32x4*)(lbs + c0), l1 = *(const f32x4*)(lbs + c0 + 4);
                        const float lb[8] = {l0.x, l0.y, l0.z, l0.w, l1.x, l1.y, l1.z, l1.w};
                        float g[8], k[8];
#pragma unroll
                        for (int e = 0; e < 8; ++e) { const float z = fminf(fmaxf(v[e], -60.f), 60.f); const float en = __expf(-z), sg = __builtin_amdgcn_rcpf(1.0f + en);
                            g[e] = __logf(lb[e] + (1.0f - lb[e]) * sg); k[e] = (1.0f - lb[e]) * (en * sg); }
                        *(f32x4*)(GG + (size_t)row * 512 + c0) = (f32x4){g[0], g[1], g[2], g[3]}; *(f32x4*)(GG + (size_t)row * 512 + c0 + 4) = (f32x4){g[4], g[5], g[6], g[7]};
                        *(u32x4*)(HK + (size_t)row * 512 + c0) = pk8(k);
                    } else if (hh < 18) {
                        *(u32x4*)(HV + (size_t)row * 512 + (hh - 14) * 128 + cw) = pk8(v);
                    } else if (hh < 22) {
#pragma unroll
                        for (int e = 0; e < 8; ++e) v[e] = v[e] * sigmoidf_(v[e]);
                        *(u32x4*)(HGT + (size_t)row * 512 + (hh - 18) * 128 + cw) = pk8(v);
                    } else if (hh < 26) {
#pragma unroll
                        for (int e = 0; e < 8; ++e) v[e] *= QSCALE_MEM;
                        *(u32x4*)(MQ + (size_t)row * 512 + (hh - 22) * 128 + cw) = pk8(v);
                    } else {
                        const int c0 = (hh - 26) * 128 + cw, br = c0 >> 10, cc = c0 & 1023;
#pragma unroll
                        for (int e = 0; e < 8; ++e) v[e] = sigmoidf_(v[e]);
                        *(u32x4*)(GATES + ((size_t)br * T + row) * 1024 + cc) = pk8(v);
                    }
                }
            }
    }
};

struct EpiQ {
    static constexpr bool PERM = true, AFTER_DRAIN = false;
    DI bool keep_acc(const Unit&) const { return false; }
    DI void prefetch(LAS unsigned char*, const Unit&, int, int) const {}
    bf16* Q;
    DI void operator()(EPI_ARGS) const {
        EPI_OPAQUE
#pragma unroll
        for (int ai = 0; ai < 2; ++ai)
#pragma unroll
            for (int m = 0; m < 4; ++m) {
                const int row = u.pm * 256 + ai * 128 + wr * 64 + m * 16 + fr;
#pragma unroll
                for (int bj = 0; bj < 2; ++bj) {
                    float v[8];
#pragma unroll
                    for (int n = 0; n < 2; ++n)
#pragma unroll
                        for (int j = 0; j < 4; ++j) v[4 * n + j] = acc[ai][bj][m][n][j];
                    *(u32x4*)(Q + (size_t)row * 768 + u.pn * 256 + 128 * bj + 32 * wc + 8 * fq) = pk8(v);
                }
            }
    }
};

struct EpiKV {
    static constexpr bool PERM = true, AFTER_DRAIN = false;
    DI bool keep_acc(const Unit&) const { return false; }
    DI void prefetch(LAS unsigned char*, const Unit&, int, int) const {}
    bf16* KC; bf16* VT; const float* ssqkv;
    DI void operator()(EPI_ARGS) const {
        EPI_OPAQUE
        float rs8[8]; rstd8(ssqkv, 8, 2, 1.0f / 256.0f, 1.0f, u.pm * 256 + wr * 64 + fr, fq, rs8);
#pragma unroll
        for (int ai = 0; ai < 2; ++ai)
#pragma unroll
            for (int m = 0; m < 4; ++m) {
                const int row = u.pm * 256 + ai * 128 + wr * 64 + m * 16 + fr, b = row >> 12, s = row & 4095;
                const float rs = rs8[ai * 4 + m];
#pragma unroll
                for (int bj = 0; bj < 2; ++bj) {
                    const int c0 = u.pn * 256 + 128 * bj + 32 * wc + 8 * fq;
                    float v[8];
#pragma unroll
                    for (int n = 0; n < 2; ++n)
#pragma unroll
                        for (int j = 0; j < 4; ++j) v[4 * n + j] = acc[ai][bj][m][n][j] * rs;
                    if (c0 < 512) {
                        const int hd = c0 >> 6, d = c0 & 63;
                        bf16* kp = KC + ((size_t)(b * 8 + hd) * SEQ + s) * 96;
                        *(u32x4*)(kp + d) = pk8(v);
                    } else {
                        const int c = c0 - 512, hd = c >> 6, dv = c & 63;
                        bf16* vp = VT + ((size_t)(b * 8 + hd) * 64 + dv) * SEQ + s;
#pragma unroll
                        for (int e = 0; e < 8; ++e) vp[(size_t)e * SEQ] = f2bf(v[e]);
                    }
                }
            }
    }
};

struct EpiMemKV {
    static constexpr bool PERM = true, AFTER_DRAIN = false;
    DI bool keep_acc(const Unit&) const { return false; }
    DI void prefetch(LAS unsigned char*, const Unit&, int, int) const {}
    bf16* MK; bf16* MVT; const float* rstd;
    DI void operator()(EPI_ARGS) const {
        EPI_OPAQUE
#pragma unroll
        for (int ai = 0; ai < 2; ++ai)
#pragma unroll
            for (int m = 0; m < 4; ++m) {
                const int row = u.pm * 256 + ai * 128 + wr * 64 + m * 16 + fr, b = row >> 8, mm = row & 255;
                const float rs = rstd[row];
#pragma unroll
                for (int bj = 0; bj < 2; ++bj) {
                    const int c0 = u.pn * 256 + 128 * bj + 32 * wc + 8 * fq;
                    float v[8];
#pragma unroll
                    for (int n = 0; n < 2; ++n)
#pragma unroll
                        for (int j = 0; j < 4; ++j) v[4 * n + j] = acc[ai][bj][m][n][j] * rs;
                    if (c0 < 512) { const int hd = c0 >> 7, d = c0 & 127; *(u32x4*)(MK + ((size_t)(b * 4 + hd) * 256 + mm) * 128 + d) = pk8(v); }
                    else { const int c = c0 - 512, hd = c >> 7, dv = c & 127; bf16* vp = MVT + ((size_t)(b * 4 + hd) * 128 + dv) * 256 + mm;
#pragma unroll
                        for (int e = 0; e < 8; ++e) vp[(size_t)e * 256] = f2bf(v[e]); }
                }
            }
    }
};

struct EpiBranch {
    static constexpr bool PERM = true, AFTER_DRAIN = false;
    DI bool keep_acc(const Unit&) const { return false; }
    DI void prefetch(LAS unsigned char*, const Unit&, int, int) const {}
    bf16* MG; const bf16* gate; int first;
    DI void operator()(EPI_ARGS) const {
        EPI_OPAQUE
        const int rowb = u.pm * 256 + wr * 64 + fr, colb = u.pn * 256 + 32 * wc + 8 * fq;
#pragma unroll
        for (int ai = 0; ai < 2; ++ai) {
            u32x4 gv[4][2], pv[4][2];
#pragma unroll
            for (int m = 0; m < 4; ++m)
#pragma unroll
                for (int bj = 0; bj < 2; ++bj) { const size_t off = (size_t)(rowb + ai * 128 + m * 16) * 1024 + colb + 128 * bj;
                    gv[m][bj] = *(const u32x4*)(gate + off); pv[m][bj] = (u32x4){0, 0, 0, 0}; if (!first) pv[m][bj] = *(const u32x4*)(MG + off); }
#pragma unroll
            for (int m = 0; m < 4; ++m)
#pragma unroll
                for (int bj = 0; bj < 2; ++bj) {
                    const size_t off = (size_t)(rowb + ai * 128 + m * 16) * 1024 + colb + 128 * bj;
                    float g[8], o[8];
                    unpk8(gv[m][bj], g); unpk8(pv[m][bj], o);
#pragma unroll
                    for (int n = 0; n < 2; ++n)
#pragma unroll
                        for (int j = 0; j < 4; ++j) o[4 * n + j] += g[4 * n + j] * acc[ai][bj][m][n][j];
                    *(u32x4*)(MG + off) = pk8(o);
                }
        }
    }
};

struct EpiBranch3 {
    static constexpr bool PERM = true, AFTER_DRAIN = false;
    bf16* MG; const bf16* gates;
    DI bool keep_acc(const Unit& u) const { return u.seg < 2; }
    DI void prefetch(LAS unsigned char*, const Unit&, int, int) const {}
    DI void operator()(f32x4 (&acc)[2][2][4][2], const Unit& u, int wr, int wc, int fr_in, int fq_in) const {
        EPI_OPAQUE
        const int rowb = u.pm * 256 + wr * 64 + fr, colb = u.pn * 256 + 32 * wc + 8 * fq, seg = u.seg;
        const bf16* gcur = gates + (size_t)seg * T * 1024; const bf16* gnxt = gates + (size_t)(seg < 2 ? seg + 1 : seg) * T * 1024;
#pragma unroll
        for (int ai = 0; ai < 2; ++ai) {
            u32x4 gv[4][2], nv[4][2];
#pragma unroll
            for (int m = 0; m < 4; ++m)
#pragma unroll
                for (int bj = 0; bj < 2; ++bj) { const size_t off = (size_t)(rowb + ai * 128 + m * 16) * 1024 + colb + 128 * bj; gv[m][bj] = *(const u32x4*)(gcur + off); nv[m][bj] = *(const u32x4*)(gnxt + off); }
#pragma unroll
            for (int m = 0; m < 4; ++m)
#pragma unroll
                for (int bj = 0; bj < 2; ++bj) {
                    float g[8], gn[8];
                    unpk8(gv[m][bj], g); unpk8(nv[m][bj], gn);
                    if (seg < 2) {
#pragma unroll
                        for (int n = 0; n < 2; ++n)
#pragma unroll
                            for (int j = 0; j < 4; ++j) acc[ai][bj][m][n][j] *= g[4 * n + j] * __builtin_amdgcn_rcpf(fmaxf(gn[4 * n + j], 1e-30f));
                    } else {
                        float o[8];
#pragma unroll
                        for (int n = 0; n < 2; ++n)
#pragma unroll
                            for (int j = 0; j < 4; ++j) o[4 * n + j] = acc[ai][bj][m][n][j] * g[4 * n + j];
                        *(u32x4*)(MG + (size_t)(rowb + ai * 128 + m * 16) * 1024 + colb + 128 * bj) = pk8(o);
                    }
                }
        }
    }
};
struct SegOrder3 : pg8::StaticOrder {
    const char* wsb;
    DI bool next(int i, Unit& u) const { const int base = i / 3; if (!pg8::StaticOrder::next(base, u)) return false; u.seg = i - 3 * base; return true; }
    DI const char* a_ptr(const pg8::Gemm&, const Unit& u) const {
        const long long off = (long long)WS_AO + (long long)(u.seg == 1) * ((long long)WS_HO - (long long)WS_AO) + (long long)(u.seg == 2) * ((long long)WS_MO - (long long)WS_AO);
        return wsb + off; }
    DI const char* b_ptr(const pg8::Gemm& g, const Unit& u) const { return (const char*)g.Bt + (size_t)u.seg * ((size_t)1024 * 512 * 2); }
};

template <class Epi> DI void run_gemm(LAS unsigned char* lds, const bf16* A, const bf16* Bt, int M, int N, int K, int rot, const Epi& E) {
    int Kv = K, Nv = N, Mv = M; asm volatile("" : "+s"(Kv), "+s"(Nv), "+s"(Mv));
    pg8::Gemm g{A, Bt, Mv, Nv, Kv}; pg8::StaticOrder S; const int G = (int)gridDim.x;
    S.init(Mv, Nv, G, (int)((blockIdx.x + (unsigned)G - (unsigned)rot) % (unsigned)G));
    pg8::gemm_phase<Epi, pg8::StaticOrder, true, true>(lds, g, S, E);
}

#define MFMA32(a, b, c) __builtin_amdgcn_mfma_f32_32x32x16_bf16((a), (b), (c), 0, 0, 0)
template <int DQK, int DV, bool CAUSAL>
DI void attn_tile(const LAS unsigned char* kb, const LAS unsigned char* vb, const bf16x8 (&qf)[DQK / 16], f32x16 (&o)[DV / 32], float& mrun, float& lrun, int t, int qlo, int r, int h) {
    constexpr int KROW = DQK * 2 + 16, VROW = 144, KS = DQK / 16, NDB = DV / 32;
    f32x16 s0, s1;
    const float negm = -mrun;
#pragma unroll
    for (int i = 0; i < 16; ++i) { s0[i] = negm; s1[i] = negm; }
#pragma unroll
    for (int ks = 0; ks < KS; ++ks) {
        const bf16x8 k0 = *(const LAS bf16x8*)(kb + r * KROW + 32 * ks + 16 * h);
        const bf16x8 k1 = *(const LAS bf16x8*)(kb + (32 + r) * KROW + 32 * ks + 16 * h);
        s0 = MFMA32(k0, qf[ks], s0); s1 = MFMA32(k1, qf[ks], s1);
    }
    if (CAUSAL && (64 * t + 63 > qlo)) {
        const int qpos = qlo + r, kbase = 64 * t + 4 * h;
#pragma unroll
        for (int i = 0; i < 16; ++i) { const int key = kbase + (i & 3) + 8 * (i >> 2);
            if (key > qpos) s0[i] = -1e30f; if (key + 32 > qpos) s1[i] = -1e30f; }
    }
    float mx = fmaxf(s0[0], s1[0]);
#pragma unroll
    for (int i = 1; i < 16; ++i) mx = fmaxf(mx, fmaxf(s0[i], s1[i]));
    mx = fmaxf(mx, __shfl_xor(mx, 32));
    if (__builtin_amdgcn_ballot_w64(mx > 8.0f) != 0ull) {
        const float delta = fmaxf(mx, 0.f), alpha = __builtin_amdgcn_exp2f(-delta);
        mrun += delta; lrun *= alpha;
#pragma unroll
        for (int i = 0; i < 16; ++i) { s0[i] -= delta; s1[i] -= delta; }
#pragma unroll
        for (int db = 0; db < NDB; ++db)
#pragma unroll
            for (int i = 0; i < 16; ++i) o[db][i] *= alpha;
    }
    float ps = 0.f;
#pragma unroll
    for (int i = 0; i < 16; ++i) { s0[i] = __builtin_amdgcn_exp2f(s0[i]); s1[i] = __builtin_amdgcn_exp2f(s1[i]); ps += s0[i] + s1[i]; }
    lrun += ps;
#pragma unroll
    for (int kb2 = 0; kb2 < 2; ++kb2)
#pragma unroll
        for (int s = 0; s < 2; ++s) {
            u32x4 pw;
            if (kb2 == 0) { pw.x = pk2(s0[8 * s], s0[8 * s + 1]); pw.y = pk2(s0[8 * s + 2], s0[8 * s + 3]); pw.z = pk2(s0[8 * s + 4], s0[8 * s + 5]); pw.w = pk2(s0[8 * s + 6], s0[8 * s + 7]); }
            else { pw.x = pk2(s1[8 * s], s1[8 * s + 1]); pw.y = pk2(s1[8 * s + 2], s1[8 * s + 3]); pw.z = pk2(s1[8 * s + 4], s1[8 * s + 5]); pw.w = pk2(s1[8 * s + 6], s1[8 * s + 7]); }
            const bf16x8 pf = __builtin_bit_cast(bf16x8, pw);
            const int koff = (32 * kb2 + 16 * s + 4 * h) * 2;
#pragma unroll
            for (int db = 0; db < NDB; ++db) {
                const u32x2 lo = *(const LAS u32x2*)(vb + (32 * db + r) * VROW + koff), hi = *(const LAS u32x2*)(vb + (32 * db + r) * VROW + koff + 16);
                u32x4 vw; vw.x = lo.x; vw.y = lo.y; vw.z = hi.x; vw.w = hi.y;
                o[db] = MFMA32(__builtin_bit_cast(bf16x8, vw), pf, o[db]);
            }
        }
}

template <int DQK, int DV, bool CAUSAL>
DI void attn_item(LAS unsigned char* lds, const bf16* Qp, int qstride, const bf16* Kp, const bf16* VTp, int vt_stride, bf16* Op, int ostride, int q0, int nkeys,
                  const float* ssqq, const float* cosT, const float* sinT) {
    constexpr int KROW = DQK * 2 + 16, VROW = 144, KBYTES = 64 * KROW, VBYTES = DV * VROW, BUF = KBYTES + VBYTES;
    constexpr int NCK = 64 * DQK / 8, NCV = DV * 8, KS = DQK / 16, NDB = DV / 32;
    constexpr int CPR = DQK / 8;
    int tid_o = threadIdx.x; asm volatile("" : "+v"(tid_o)); const int tid = tid_o, wid = __builtin_amdgcn_readfirstlane(tid >> 6), lane = tid & 63, r = lane & 31, h = lane >> 5;
    const int ntiles = CAUSAL ? (q0 + 256) / 64 : nkeys / 64;
    const int qlo = q0 + wid * 32;
    bf16x8 qf[KS];
    { const bf16* qr = Qp + (size_t)(wid * 32 + r) * qstride + 8 * h;
#pragma unroll
      for (int ks = 0; ks < KS; ++ks) qf[ks] = *(const bf16x8*)(qr + 16 * ks);
      if (CAUSAL) {
          const float* sp = ssqq + (size_t)(wid * 32 + r) * 16;
          const f32x4 a = *(const f32x4*)sp, b = *(const f32x4*)(sp + 4), c = *(const f32x4*)(sp + 8);
          const float rs = rsqrtf((((a.x + a.y) + (a.z + a.w)) + ((b.x + b.y) + (b.z + b.w)) + ((c.x + c.y) + (c.z + c.w))) * (1.0f / 384.0f) + EPS) * QSCALE_MLA;
#pragma unroll
          for (int ks = 0; ks < KS; ++ks) {
              float v[8]; unpk8(__builtin_bit_cast(u32x4, qf[ks]), v);
              if (ks >= 4) {
                  const int i0 = 8 * (ks - 4) + 4 * h;
                  const f32x4 cs = *(const f32x4*)(cosT + (size_t)(wid * 32 + r) * 16 + i0), sn = *(const f32x4*)(sinT + (size_t)(wid * 32 + r) * 16 + i0);
                  const float t0 = v[0], t1 = v[1], t2 = v[2], t3 = v[3], t4 = v[4], t5 = v[5], t6 = v[6], t7 = v[7];
                  v[0] = t0 * cs.x - t1 * sn.x; v[1] = t1 * cs.x + t0 * sn.x; v[2] = t2 * cs.y - t3 * sn.y; v[3] = t3 * cs.y + t2 * sn.y;
                  v[4] = t4 * cs.z - t5 * sn.z; v[5] = t5 * cs.z + t4 * sn.z; v[6] = t6 * cs.w - t7 * sn.w; v[7] = t7 * cs.w + t6 * sn.w;
              }
#pragma unroll
              for (int e = 0; e < 8; ++e) v[e] *= rs;
              qf[ks] = __builtin_bit_cast(bf16x8, pk8(v));
          }
      } }
    f32x16 o[NDB];
#pragma unroll
    for (int db = 0; db < NDB; ++db)
#pragma unroll
        for (int i = 0; i < 16; ++i) o[db][i] = 0.f;
    float mrun = 0.f, lrun = 0.f;
    const int kc0 = tid, kc1 = tid + 512; const bool k1on = kc1 < NCK;
    const int kr0 = kc0 / CPR, kcc0 = kc0 % CPR, kr1 = kc1 / CPR, kcc1 = kc1 % CPR;
    const int vc0 = tid, vc1 = tid + 512; const bool v1on = vc1 < NCV;
    const GAS u32x4* Kg = (const GAS u32x4*)Kp;
    u32x4 ak0, ak1 = {0, 0, 0, 0}, av0, av1 = {0, 0, 0, 0}, bk0, bk1 = {0, 0, 0, 0}, bv0, bv1 = {0, 0, 0, 0};
#define ATT_GLOAD(P, t_) do { P##k0 = Kg[(size_t)(t_) * NCK + kc0]; if (k1on) P##k1 = Kg[(size_t)(t_) * NCK + kc1]; \
        P##v0 = *(const GAS u32x4*)(VTp + (size_t)(vc0 >> 3) * vt_stride + (t_) * 64 + (vc0 & 7) * 8); \
        if (v1on) P##v1 = *(const GAS u32x4*)(VTp + (size_t)(vc1 >> 3) * vt_stride + (t_) * 64 + (vc1 & 7) * 8); } while (0)
#define ATT_LSTORE(P, buf_) do { LAS unsigned char* kb_ = lds + (buf_) * BUF; LAS unsigned char* vb_ = kb_ + KBYTES; \
        *(LAS u32x4*)(kb_ + kr0 * KROW + kcc0 * 16) = P##k0; if (k1on) *(LAS u32x4*)(kb_ + kr1 * KROW + kcc1 * 16) = P##k1; \
        *(LAS u32x4*)(vb_ + (vc0 >> 3) * VROW + (vc0 & 7) * 16) = P##v0; if (v1on) *(LAS u32x4*)(vb_ + (vc1 >> 3) * VROW + (vc1 & 7) * 16) = P##v1; } while (0)
    ATT_GLOAD(a, 0); ATT_LSTORE(a, 0);
    if (ntiles > 1) ATT_GLOAD(a, 1);
    __syncthreads();
    for (int t = 0; t < ntiles; t += 2) {
        if (t + 2 < ntiles) ATT_GLOAD(b, t + 2);
        if (!CAUSAL || (64 * t <= qlo + 31)) attn_tile<DQK, DV, CAUSAL>(lds, lds + KBYTES, qf, o, mrun, lrun, t, qlo, r, h);
        if (t + 1 < ntiles) ATT_LSTORE(a, 1);
        __syncthreads();
        if (t + 1 < ntiles) {
            if (t + 3 < ntiles) ATT_GLOAD(a, t + 3);
            if (!CAUSAL || (64 * (t + 1) <= qlo + 31)) attn_tile<DQK, DV, CAUSAL>(lds + BUF, lds + BUF + KBYTES, qf, o, mrun, lrun, t + 1, qlo, r, h);
            if (t + 2 < ntiles) ATT_LSTORE(b, 0);
            __syncthreads();
        }
    }
#undef ATT_GLOAD
#undef ATT_LSTORE
    const float ltot = lrun + __shfl_xor(lrun, 32), inv = 1.0f / ltot;
    bf16* orow = Op + (size_t)(wid * 32 + r) * ostride + 4 * h;
#pragma unroll
    for (int db = 0; db < NDB; ++db)
#pragma unroll
        for (int g = 0; g < 4; ++g) {
            u32x2 w; w.x = pk2(o[db][4 * g] * inv, o[db][4 * g + 1] * inv); w.y = pk2(o[db][4 * g + 2] * inv, o[db][4 * g + 3] * inv);
            *(u32x2*)(orow + 32 * db + 8 * g) = w;
        }
}

template <int KSTEPS> DI void lds_mma(f32x16& c, const LAS unsigned char* A, int astride, const LAS unsigned char* Bt, int bstride, int r, int h) {
#pragma unroll
    for (int s = 0; s < KSTEPS; ++s) {
        const bf16x8 a = *(const LAS bf16x8*)(A + r * astride + 32 * s + 16 * h);
        const bf16x8 b = *(const LAS bf16x8*)(Bt + r * bstride + 32 * s + 16 * h);
        c = MFMA32(a, b, c);
    }
}

DI void hgrn_b1(LAS unsigned char* lds, int ch, float* GG, const bf16* HK, const bf16* HV, bf16* LT, float* DEC) {
    int tid_o = threadIdx.x; asm volatile("" : "+v"(tid_o)); const int tid = tid_o, wid = __builtin_amdgcn_readfirstlane(tid >> 6), lane = tid & 63, r = lane & 31, h = lane >> 5;
    const int bh = ch >> 6, c = ch & 63, b = bh >> 2, hd = bh & 3;
    const size_t t0 = (size_t)b * SEQ + c * 64;
    const int k = tid & 127, seg = tid >> 7;
    LAS float* segsum = (LAS float*)lds;
    LAS unsigned char* kdT = lds + 2048;
    LAS unsigned char* vT = kdT + 128 * 144;
    float g[16]; float run = 0.f;
    float* gp = GG + (t0 + seg * 16) * 512 + hd * 128 + k;
#pragma unroll
    for (int i = 0; i < 16; ++i) { run += gp[(size_t)i * 512]; g[i] = run; }
    segsum[seg * 128 + k] = run;
    __syncthreads();
    float off = 0.f, tot = 0.f;
#pragma unroll
    for (int s = 0; s < 4; ++s) { const float v = segsum[s * 128 + k]; if (s < seg) off += v; tot += v; }
    const bf16* kp = HK + (t0 + seg * 16) * 512 + hd * 128 + k;
    const bf16* vp = HV + (t0 + seg * 16) * 512 + hd * 128 + k;
#pragma unroll
    for (int i = 0; i < 16; ++i) {
        const float G = g[i] + off; gp[(size_t)i * 512] = G;
        const float kd = bf2f(kp[(size_t)i * 512]) * __expf(tot - G);
        *(LAS bf16*)(kdT + k * 144 + (seg * 16 + i) * 2) = f2bf(kd);
        *(LAS bf16*)(vT + k * 144 + (seg * 16 + i) * 2) = vp[(size_t)i * 512];
    }
    if (seg == 0) DEC[(size_t)ch * 128 + k] = __expf(tot);
    __syncthreads();
    const int vb = wid >> 1;
#pragma unroll
    for (int q = 0; q < 2; ++q) {
        const int kb = (wid & 1) * 2 + q;
        f32x16 acc;
#pragma unroll
        for (int i = 0; i < 16; ++i) acc[i] = 0.f;
        lds_mma<4>(acc, vT + vb * 32 * 144, 144, kdT + kb * 32 * 144, 144, r, h);
        bf16* lp = LT + (size_t)ch * 16384 + (size_t)(vb * 32 + 4 * h) * 128 + kb * 32 + r;
#pragma unroll
        for (int i = 0; i < 16; ++i) lp[(size_t)((i & 3) + 8 * (i >> 2)) * 128] = f2bf(acc[i]);
    }
    __syncthreads();
}

DI void hgrn_b3(LAS unsigned char* lds, int ch, const float* GG, const bf16* HQ, const bf16* HK, const bf16* HV, const bf16* HGT, const bf16* LT, const float* onorm, bf16* HO) {
    constexpr int RS = 272;
    int tid_o = threadIdx.x; asm volatile("" : "+v"(tid_o)); const int tid = tid_o, wid = __builtin_amdgcn_readfirstlane(tid >> 6), lane = tid & 63, r = lane & 31, h = lane >> 5;
    const int bh = ch >> 6, c = ch & 63, b = bh >> 2, hd = bh & 3;
    const size_t t0 = (size_t)b * SEQ + c * 64;
    LAS unsigned char* qG = lds;
    LAS unsigned char* q1 = qG + 64 * RS;
    LAS unsigned char* kA0 = q1 + 32 * RS;
    LAS unsigned char* kA1 = kA0 + 32 * RS;
    LAS unsigned char* ST = kA1 + 64 * RS;
    LAS unsigned char* vT = ST + 128 * RS;
    LAS unsigned char* Am = vT + 128 * 144;
    {
        const int k8 = tid & 15;
        const float* g31p = GG + (t0 + 31) * 512 + hd * 128 + k8 * 8;
        const f32x4 ga = *(const f32x4*)g31p, gb = *(const f32x4*)(g31p + 4);
        const float g31[8] = {ga.x, ga.y, ga.z, ga.w, gb.x, gb.y, gb.z, gb.w};
#pragma unroll
        for (int pass = 0; pass < 2; ++pass) {
            const int t = (tid >> 4) + 32 * pass;
            const size_t off = (t0 + t) * 512 + hd * 128 + k8 * 8;
            const f32x4 a = *(const f32x4*)(GG + off), bq = *(const f32x4*)(GG + off + 4);
            const float G[8] = {a.x, a.y, a.z, a.w, bq.x, bq.y, bq.z, bq.w};
            float q[8], kk[8], o1[8], o2[8], o3[8];
            unpk8(*(const u32x4*)(HQ + off), q); unpk8(*(const u32x4*)(HK + off), kk);
#pragma unroll
            for (int e = 0; e < 8; ++e) o1[e] = q[e] * __expf(G[e]);
            *(LAS u32x4*)(qG + t * RS + k8 * 16) = pk8(o1);
            if (pass == 0) {
#pragma unroll
                for (int e = 0; e < 8; ++e) { o2[e] = kk[e] * __expf(fminf(-G[e], 80.f)); o3[e] = kk[e] * __expf(g31[e] - G[e]); }
                *(LAS u32x4*)(kA0 + t * RS + k8 * 16) = pk8(o2);
                *(LAS u32x4*)(kA1 + t * RS + k8 * 16) = pk8(o3);
            } else {
#pragma unroll
                for (int e = 0; e < 8; ++e) { o2[e] = q[e] * __expf(G[e] - g31[e]); o3[e] = kk[e] * __expf(fminf(g31[e] - G[e], 80.f)); }
                *(LAS u32x4*)(q1 + (t - 32) * RS + k8 * 16) = pk8(o2);
                *(LAS u32x4*)(kA1 + t * RS + k8 * 16) = pk8(o3);
            }
        }
        const bf16* lp = LT + (size_t)ch * 16384;
#pragma unroll
        for (int p = 0; p < 4; ++p) {
            const int idx = tid + 512 * p, v = idx >> 4, kk8 = idx & 15;
            *(LAS u32x4*)(ST + v * RS + kk8 * 16) = *(const u32x4*)(lp + v * 128 + kk8 * 8);
        }
        const int v = tid & 127, seg = tid >> 7;
        const bf16* vp = HV + (t0 + seg * 16) * 512 + hd * 128 + v;
#pragma unroll
        for (int i = 0; i < 16; ++i) *(LAS bf16*)(vT + v * 144 + (seg * 16 + i) * 2) = vp[(size_t)i * 512];
    }
    __syncthreads();
    if (wid < 3) {
        f32x16 a;
#pragma unroll
        for (int i = 0; i < 16; ++i) a[i] = 0.f;
        const int tb = wid == 0 ? 0 : 1, sb = wid == 2 ? 1 : 0;
        if (wid == 0) lds_mma<8>(a, qG, RS, kA0, RS, r, h);
        else lds_mma<8>(a, q1, RS, kA1 + sb * 32 * RS, RS, r, h);
#pragma unroll
        for (int i = 0; i < 16; ++i) { const int tl = (i & 3) + 8 * (i >> 2) + 4 * h; float val = a[i]; if (tb == sb && r > tl) val = 0.f;
            *(LAS bf16*)(Am + (tb * 32 + tl) * 144 + (sb * 32 + r) * 2) = f2bf(val); }
    } else if (wid == 3) {
#pragma unroll
        for (int i = 0; i < 16; ++i) { const int tl = (i & 3) + 8 * (i >> 2) + 4 * h; *(LAS bf16*)(Am + tl * 144 + (32 + r) * 2) = (bf16)0; }
    }
    __syncthreads();
    f32x16 acc;
#pragma unroll
    for (int i = 0; i < 16; ++i) acc[i] = 0.f;
    const int tb = wid >> 2, vb = wid & 3;
    lds_mma<8>(acc, qG + tb * 32 * RS, RS, ST + vb * 32 * RS, RS, r, h);
    lds_mma<4>(acc, Am + tb * 32 * 144, 144, vT + vb * 32 * 144, 144, r, h);
    __syncthreads();
    LAS float* Ost = (LAS float*)ST;
#pragma unroll
    for (int i = 0; i < 16; ++i) Ost[(tb * 32 + (i & 3) + 8 * (i >> 2) + 4 * h) * 132 + vb * 32 + r] = acc[i];
    __syncthreads();
    {
        const int t = tid >> 3, part = tid & 7;
        float ov[16]; float ss = 0.f;
#pragma unroll
        for (int q4 = 0; q4 < 4; ++q4) { const f32x4 x = *(const LAS f32x4*)(Ost + t * 132 + part * 16 + q4 * 4); ov[4 * q4] = x.x; ov[4 * q4 + 1] = x.y; ov[4 * q4 + 2] = x.z; ov[4 * q4 + 3] = x.w; }
#pragma unroll
        for (int e = 0; e < 16; ++e) ss += ov[e] * ov[e];
        ss += __shfl_xor(ss, 1); ss += __shfl_xor(ss, 2); ss += __shfl_xor(ss, 4);
        const float rs = rsqrtf(ss * (1.0f / 128.0f) + EPS);
        const size_t off = (t0 + t) * 512 + hd * 128 + part * 16;
        float gt[16];
        unpk8(*(const u32x4*)(HGT + off), gt); unpk8(*(const u32x4*)(HGT + off + 8), gt + 8);
#pragma unroll
        for (int e = 0; e < 16; ++e) ov[e] = ov[e] * rs * onorm[part * 16 + e] * gt[e];
        *(u32x4*)(HO + off) = pk8(ov); *(u32x4*)(HO + off + 8) = pk8(ov + 8);
    }
    __syncthreads();
}

DI int dest_row(int mode, int n) {
    if (mode == 0) return n;
    if (mode == 1) { const int j = n < DFF ? n : n - DFF; return (j >> 7) * 256 + (n < DFF ? 0 : 128) + (j & 127); }
    if (mode == 2) { if (n < 640) return n; if (n < 672) { const int j = n - 640; return 640 + (j < 16 ? 2 * j : 2 * (j - 16) + 1); } if (n < 3232) return 768 + (n - 672); return 3328 + (n - 3232); }
    const int hd = n / 96, w = n - hd * 96; if (w < 64) return n; const int j = w - 64; return hd * 96 + 64 + (j < 16 ? 2 * j : 2 * (j - 16) + 1);
}
DI void conv_item(const float* W, int K, int N, bf16* WT, const float* gain, int mode, int row_off, LAS float* scr, int item, int lane) {
    const int nblk = N / 32, kb = item / nblk, nb = item - kb * nblk, k0 = 64 * kb, n0 = 32 * nb;
    float wv[32];
    const float* wp = W + (size_t)(k0 + (lane >> 5)) * N + n0 + (lane & 31);
#pragma unroll
    for (int i = 0; i < 32; ++i) wv[i] = __builtin_nontemporal_load(wp + (size_t)(2 * i) * N);
#pragma unroll
    for (int i = 0; i < 32; ++i) scr[(2 * i + (lane >> 5)) * 33 + (lane & 31)] = wv[i];
    asm volatile("s_waitcnt lgkmcnt(0)" ::: "memory");
    const int c = lane & 7;
    float gn[8];
#pragma unroll
    for (int e = 0; e < 8; ++e) gn[e] = gain ? gain[k0 + 8 * c + e] : 1.0f;
#pragma unroll
    for (int j = 0; j < 4; ++j) { const int n = (lane >> 3) + 8 * j; const LAS float* s = scr + (8 * c) * 33 + n;
        float v[8];
#pragma unroll
        for (int e = 0; e < 8; ++e) v[e] = s[e * 33] * gn[e];
        *(u32x4*)(WT + (size_t)(row_off + dest_row(mode, n0 + n)) * K + k0 + 8 * c) = pk8(v); }
    asm volatile("s_waitcnt lgkmcnt(0)" ::: "memory");
}

#define XB_TMO      128
#define XB_XCNT(j)  (256  + 64 * (j))
#define XB_XSUB(j)  (1280 + 64 * (j))
#define XB_XGEN(j)  (2304 + 64 * (j))
#define XB_TOP      3328
#define XB_TOPGEN   3392
#define XCD_BAR_WORDS 3456
#define XB_SPIN_CAP (1u << 18)
static_assert(XCD_BAR_WORDS * 4 <= CTL_BYTES, "barrier words inside the memset region");
DI unsigned xb_ld(unsigned* p)              { return __hip_atomic_load(p, __ATOMIC_RELAXED, __HIP_MEMORY_SCOPE_AGENT); }
DI unsigned xb_add(unsigned* p, unsigned v) { return __hip_atomic_fetch_add(p, v, __ATOMIC_RELAXED, __HIP_MEMORY_SCOPE_AGENT); }
DI unsigned xb_xcc_id() { return (unsigned)__builtin_amdgcn_s_getreg((3 << 11) | 20) & 0xFu; }
#define XB_SPIN(cond, bar) do { unsigned _sp = 0; while (cond) { __builtin_amdgcn_s_sleep(1); \
    if ((++_sp & 255u) == 0u) { if (xb_ld(&(bar)[XB_TMO])) break; if (_sp > XB_SPIN_CAP) { atomicAdd(&(bar)[XB_TMO], 1u); break; } } } } while (0)
struct XcdBarrier { unsigned* bar; unsigned x; volatile LAS unsigned* st; };
DI void xcd_barrier_complete(unsigned* bar, unsigned x, unsigned& nloc, unsigned& nx) {
    const unsigned G = gridDim.x * gridDim.y * gridDim.z;
    unsigned sum, cnt, mine, sp = 0u;
    for (;;) {
        sum = 0u; cnt = 0u; mine = 0u;
#pragma unroll
        for (unsigned j = 0; j < 16; ++j) { const unsigned c = xb_ld(&bar[XB_XCNT(j)]); sum += c; cnt += (c > 0u) ? 1u : 0u; mine = (j == x) ? c : mine; }
        if (sum == G) break;
        __builtin_amdgcn_s_sleep(1);
        if ((++sp & 255u) == 0u) { if (xb_ld(&bar[XB_TMO])) break; if (sp > XB_SPIN_CAP) { atomicAdd(&bar[XB_TMO], 1u); break; } }
    }
    nloc = mine > 0u ? mine : 1u; nx = cnt > 0u ? cnt : 1u;
}
DI void xcd_barrier(const XcdBarrier& b) {
    asm volatile("s_waitcnt vmcnt(0)" ::: "memory");
    __syncthreads();
    if (threadIdx.x == 0) {
        unsigned* bar = b.bar;
        __builtin_amdgcn_s_waitcnt(0);
        unsigned nloc = b.st[0], nx = b.st[1];
        if (nloc == 0u) { xcd_barrier_complete(bar, b.x, nloc, nx); b.st[0] = nloc; b.st[1] = nx; }
        const unsigned old = xb_add(&bar[XB_XSUB(b.x)], 1u);
        const unsigned gen = old / nloc;
        if (old + 1u == (gen + 1u) * nloc) {
            __builtin_amdgcn_fence(__ATOMIC_RELEASE, "agent");
            asm volatile("s_waitcnt vmcnt(0)" ::: "memory");
            const unsigned og = xb_add(&bar[XB_TOP], 1u);
            const unsigned tg = og / nx;
            if (og + 1u == (tg + 1u) * nx) xb_add(&bar[XB_TOPGEN], 1u);
            else XB_SPIN(xb_ld(&bar[XB_TOPGEN]) == tg, bar);
            __builtin_amdgcn_fence(__ATOMIC_ACQUIRE, "agent");
            xb_add(&bar[XB_XGEN(b.x)], 1u);
            asm volatile("s_waitcnt vmcnt(0)" ::: "memory");
        } else {
            XB_SPIN(xb_ld(&bar[XB_XGEN(b.x)]) == gen, bar);
            __builtin_amdgcn_fence(__ATOMIC_ACQUIRE, "agent");
            asm volatile("s_waitcnt vmcnt(0)" ::: "memory");
        }
    }
    __syncthreads();
}

struct Args { const void* in[25]; float* out; unsigned char* ws; int ph_lo, ph_hi; };
typedef const __attribute__((address_space(4))) unsigned long long* ka_t;
DI unsigned long long KA(int i) { ka_t p = (ka_t)__builtin_amdgcn_kernarg_segment_ptr(); asm volatile("" : "+s"(p)); return p[i]; }
#define KIN(i) ((const float*)KA(i))
#define KOUT ((float*)KA(25))
#define KWS ((unsigned char*)KA(26))

DI void conv_set(int mask, int l, int bpart, int nbparts, LAS unsigned char* lds) {
    int tid_o = threadIdx.x; asm volatile("" : "+v"(tid_o)); const int tid = tid_o, wave = __builtin_amdgcn_readfirstlane(tid >> 6), lane = tid & 63;
    const int part = bpart * NWAVES + wave, nparts = nbparts * NWAVES, tpart = bpart * NTHREADS + tid, ntparts = nbparts * NTHREADS;
    LAS float* scr = (LAS float*)(lds + wave * 16384);
    unsigned char* ws = KWS;
    constexpr int I_FI = 16 * 176, I_FO = 44 * 32, I_WIN = 16 * 197, I_UQ = 6 * 24, I_UK = 4 * 16, I_WO = 8 * 32, I_SQ = 16 * 32;
    if (mask & 1) {
        const float* f1n = KIN(3) + l * 1024; const float* w1i = KIN(4) + (size_t)l * 1024 * 5632; const float* w1o = KIN(5) + (size_t)l * 2816 * 1024;
        for (int it = part; it < I_FI + I_FO; it += nparts) {
            if (it < I_FI) conv_item(w1i, 1024, 5632, (bf16*)(ws + WT_W1IN), f1n, 1, 0, scr, it, lane);
            else conv_item(w1o, 2816, 1024, (bf16*)(ws + WT_W1OUT), nullptr, 0, 0, scr, it - I_FI, lane);
        }
    }
    if (mask & 4) {
        const float* f2n = KIN(21) + l * 1024; const float* w2i = KIN(22) + (size_t)l * 1024 * 5632; const float* w2o = KIN(23) + (size_t)l * 2816 * 1024;
        for (int it = part; it < I_FI + I_FO; it += nparts) {
            if (it < I_FI) conv_item(w2i, 1024, 5632, (bf16*)(ws + WT_W2IN), f2n, 1, 0, scr, it, lane);
            else conv_item(w2o, 2816, 1024, (bf16*)(ws + WT_W2OUT), nullptr, 0, 0, scr, it - I_FI, lane);
        }
    }
    if (mask & 2) {
        const float* mxn = KIN(6) + l * 1024; const float* win = KIN(7) + (size_t)l * 1024 * DIN;
        for (int it = part; it < I_WIN; it += nparts) conv_item(win, 1024, DIN, (bf16*)(ws + WT_WIN), mxn, 2, 0, scr, it, lane);
        u32x4* pad = (u32x4*)(ws + WT_WIN + (size_t)672 * 1024 * 2);
        unsigned zz = 0u; asm volatile("" : "+v"(zz));
        for (int i = tpart; i < 96 * 1024 * 2 / 16; i += ntparts) pad[i] = (u32x4){zz, zz, zz, zz};
    }
    if (mask & 8) {
        const float* qln = KIN(8) + l * 384; const float* kvn = KIN(9) + l * 256;
        const float* wuq = KIN(10) + (size_t)l * 384 * 768; const float* wuk = KIN(11) + (size_t)l * 256 * 512; const float* wuv = KIN(12) + (size_t)l * 256 * 512;
        const float* womla = KIN(13) + (size_t)l * 512 * 1024; const float* wohg = KIN(16) + (size_t)l * 512 * 1024; const float* womem = KIN(19) + (size_t)l * 512 * 1024;
        const float* wout = KIN(20) + (size_t)l * 1024 * 1024;
        constexpr int NIT = I_UQ + 2 * I_UK + 3 * I_WO + I_SQ;
        for (int it = part; it < NIT; it += nparts) {
            int r = it;
            if (r < I_UQ) { conv_item(wuq, 384, 768, (bf16*)(ws + WT_WUQ), qln, 3, 0, scr, r, lane); continue; } r -= I_UQ;
            if (r < I_UK) { conv_item(wuk, 256, 512, (bf16*)(ws + WT_WUKV), kvn, 0, 0, scr, r, lane); continue; } r -= I_UK;
            if (r < I_UK) { conv_item(wuv, 256, 512, (bf16*)(ws + WT_WUKV), kvn, 0, 512, scr, r, lane); continue; } r -= I_UK;
            if (r < I_WO) { conv_item(womla, 512, 1024, (bf16*)(ws + WT_WOMLA), nullptr, 0, 0, scr, r, lane); continue; } r -= I_WO;
            if (r < I_WO) { conv_item(wohg, 512, 1024, (bf16*)(ws + WT_WOHG), nullptr, 0, 0, scr, r, lane); continue; } r -= I_WO;
            if (r < I_WO) { conv_item(womem, 512, 1024, (bf16*)(ws + WT_WOMEM), nullptr, 0, 0, scr, r, lane); continue; } r -= I_WO;
            conv_item(wout, 1024, 1024, (bf16*)(ws + WT_WOUT), nullptr, 0, 0, scr, r, lane);
        }
    }
    if (mask & 16) {
        const float* memn = KIN(17); const float* wmkv = KIN(18);
        for (int it = part; it < 4 * I_SQ; it += nparts) { const int ll = it / I_SQ, r = it - ll * I_SQ;
            conv_item(wmkv + (size_t)ll * 1024 * 1024, 1024, 1024, (bf16*)(ws + WT_WMEMKV) + (size_t)ll * 1024 * 1024, memn + ll * 1024, 0, 0, scr, r, lane); }
    }
    __syncthreads();
}
DI void conv_tail(int mask, int l, int nwg, LAS unsigned char* lds) {
    const int G = (int)gridDim.x, rem = nwg % G, c = (int)blockIdx.x;
    if (c < rem) return;
    conv_set(mask, l, c - rem, G - rem, lds);
}

DI void prep_phase() {
    int tid_o = threadIdx.x; asm volatile("" : "+v"(tid_o)); const int tid = tid_o, wave = __builtin_amdgcn_readfirstlane(tid >> 6), lane = tid & 63;
    const int gw = blockIdx.x * NWAVES + wave, NGW = gridDim.x * NWAVES;
    unsigned char* ws = KWS;
    const float* x = KIN(0); const float* mem = KIN(1); const int* pos = (const int*)KA(2);
    bf16* XB = (bf16*)(ws + WS_XB); float* SSQ = (float*)(ws + WS_SSQ);
    for (int m = gw; m < T; m += NGW) {
        const f32x4* xr = (const f32x4*)(x + (size_t)m * D) + lane; u32x2* xb = (u32x2*)(XB + (size_t)m * D) + lane;
        float s = 0.f;
#pragma unroll
        for (int j = 0; j < 4; ++j) { const f32x4 v = xr[64 * j]; u32x2 w; w.x = pk2(v.x, v.y); w.y = pk2(v.z, v.w); xb[64 * j] = w;
            const float a = bflo(w.x), b = bfhi(w.x), c = bflo(w.y), d = bfhi(w.y); s += (a * a + b * b) + (c * c + d * d); }
        s = wave_sum(s);
        if (lane < 16) SSQ[(size_t)m * 16 + lane] = lane == 0 ? s : 0.f;
    }
    bf16* MEMB = (bf16*)(ws + WS_MEMB); float* MRS = (float*)(ws + WS_MEMRSTD);
    for (int m = gw; m < 1024; m += NGW) {
        const f32x4* xr = (const f32x4*)(mem + (size_t)m * D) + lane; u32x2* xb = (u32x2*)(MEMB + (size_t)m * D) + lane;
        float s = 0.f;
#pragma unroll
        for (int j = 0; j < 4; ++j) { const f32x4 v = xr[64 * j]; s += (v.x * v.x + v.y * v.y) + (v.z * v.z + v.w * v.w); u32x2 w; w.x = pk2(v.x, v.y); w.y = pk2(v.z, v.w); xb[64 * j] = w; }
        s = wave_sum(s);
        if (lane == 0) MRS[m] = rsqrtf(s * (1.0f / 1024.0f) + EPS);
    }
    float* COS = (float*)(ws + WS_COS); float* SIN = (float*)(ws + WS_SIN);
    for (int i = blockIdx.x * NTHREADS + tid; i < T * 16; i += gridDim.x * NTHREADS) {
        const int row = i >> 4, fi = i & 15;
        const float invf = exp2f(-13.287712379549449f * (float)fi * (1.0f / 16.0f));
        const float ang = (float)pos[row] * invf;
        const float kq = rintf(ang * 0.15915494309189535f);
        float rr = fmaf(-kq, 6.28125f, ang); rr = fmaf(-kq, 1.9353071795864769e-3f, rr);
        COS[i] = __cosf(rr); SIN[i] = __sinf(rr);
    }
    const float* hlb = KIN(14); float* LBS = (float*)(ws + WS_LBS);
    for (int i = blockIdx.x * NTHREADS + tid; i < 512; i += gridDim.x * NTHREADS) {
        const float a0 = hlb[i], a1 = hlb[512 + i], a2 = hlb[1024 + i], a3 = hlb[1536 + i];
        const float mx = fmaxf(fmaxf(a0, a1), fmaxf(a2, a3));
        const float e0 = __expf(a0 - mx), e1 = __expf(a1 - mx), e2 = __expf(a2 - mx), e3 = __expf(a3 - mx), inv = 1.0f / (e0 + e1 + e2 + e3);
        LBS[i] = 0.f; LBS[512 + i] = e1 * inv; LBS[1024 + i] = (e1 + e2) * inv; LBS[1536 + i] = (e1 + e2 + e3) * inv;
    }
}

__global__ void __launch_bounds__(NTHREADS, 2) fwd_kernel(Args A_unused) {
    extern __shared__ __attribute__((aligned(16))) unsigned char lds_raw[];
    LAS unsigned char* lds = (LAS unsigned char*)lds_raw;
    cg::grid_group grid = cg::this_grid();
    int ph = 0;
    int lo, hi; { const unsigned long long w = KA(27); lo = (int)(unsigned)w; hi = (int)(unsigned)(w >> 32); }
#define RUN (ph >= lo && ph < hi)
    volatile LAS unsigned* bst = (volatile LAS unsigned*)(lds + 131072 + 512);
    if (threadIdx.x < 2) bst[threadIdx.x] = 0u;
    __syncthreads();
    if (threadIdx.x == 0) (void)xb_add(&((unsigned*)(KWS + WS_CTL))[XB_XCNT(xb_xcc_id())], 1u);
#define SEAM do { if (ph >= lo && ph + 1 < hi) { if (ph == 1) grid.sync(); else { XcdBarrier xb_; xb_.bar = (unsigned*)(KWS + WS_CTL); xb_.x = xb_xcc_id(); xb_.st = bst; xcd_barrier(xb_); } } ++ph; } while (0)
#define WSP(T_, name, off) T_* name = (T_*)(ws + (off))
#define REPEAT(n_) for (int rep_ = 0; rep_ < (n_); ++rep_, ((rep_ < (n_)) ? xcd_barrier(XcdBarrier{(unsigned*)(KWS + WS_CTL), xb_xcc_id(), bst}) : (void)0))

    if (RUN) { prep_phase(); }
    ++ph;
    for (int l = 0; l < DEPTH; ++l) {
        if (l == 0) {
            if (RUN) conv_set(1 | 2 | 16, 0, (int)blockIdx.x, (int)gridDim.x, lds);
            SEAM;
        }
#ifdef PROBE_NULL_P1
        if (RUN) { unsigned char* ws = KWS; PROBE_NULL_P1 E{(bf16*)(ws + WS_H)}; run_gemm(lds, (const bf16*)(ws + WS_XB), (const bf16*)(ws + WT_W1IN), T, 5632, 1024, 0, E);
            XcdBarrier xb_; xb_.bar = (unsigned*)(KWS + WS_CTL); xb_.x = xb_xcc_id(); xb_.st = bst; xcd_barrier(xb_); }
#endif
#ifndef SKIP_G1
        if (RUN) REPEAT(REP_P1) { unsigned char* ws = KWS; EpiSwiglu E{(bf16*)(ws + WS_H), (const float*)(ws + WS_SSQ), lds}; run_gemm(lds, (const bf16*)(ws + WS_XB), (const bf16*)(ws + WT_W1IN), T, 5632, 1024, 0, E);
            if (l == 0) {
                const int rem = (64 * 22) % (int)gridDim.x;
#pragma unroll 1
                for (int ll = 0; ll < DEPTH; ++ll) { unsigned char* ws2 = KWS; EpiMemKV E2{(bf16*)(ws2 + WS_MK) + (size_t)ll * 16 * 256 * 128, (bf16*)(ws2 + WS_MVT) + (size_t)ll * 16 * 128 * 256, (const float*)(ws2 + WS_MEMRSTD)};
                    run_gemm(lds, (const bf16*)(ws2 + WS_MEMB), (const bf16*)(ws2 + WT_WMEMKV) + (size_t)ll * 1024 * 1024, 1024, 1024, 1024, (rem + 16 * ll) % (int)gridDim.x, E2); }
            } else conv_tail(2, l, 64 * 22, lds);
        }
#endif
        SEAM;
#ifndef SKIP_G2
        if (RUN) { unsigned char* ws = KWS; EpiResid E{(bf16*)(ws + WS_XB), (float*)(ws + WS_SSQ), 0.5f}; run_gemm(lds, (const bf16*)(ws + WS_H), (const bf16*)(ws + WT_W1OUT), T, 1024, DFF, 0, E); }
#endif
        SEAM;
#ifndef SKIP_WIN
        if (RUN) REPEAT(REP_P3) { unsigned char* ws = KWS;
            EpiWin E{ws, (const float*)(ws + WS_LBS) + l * 512, lds};
            run_gemm(lds, (const bf16*)(ws + WS_XB), (const bf16*)(ws + WT_WIN), T, NIN, 1024, 0, E);
            conv_tail(4 | 8, l, 64 * 25, lds); }
#endif
        SEAM;
        if (RUN) {
#ifndef SKIP_G4
            REPEAT(REP_P4G) {
            { unsigned char* ws = KWS; EpiQ E{(bf16*)(ws + WS_Q)}; run_gemm(lds, (const bf16*)(ws + WS_CQ), (const bf16*)(ws + WT_WUQ), T, 768, 384, 0, E); }
            { unsigned char* ws = KWS; EpiKV E{(bf16*)(ws + WS_KC), (bf16*)(ws + WS_VT), (const float*)(ws + WS_SSQKV)}; run_gemm(lds, (const bf16*)(ws + WS_CKV), (const bf16*)(ws + WT_WUKV), T, 1024, 256, 64, E); }
            }
#endif
#ifndef SKIP_B1
            { unsigned char* ws = KWS; const int G = (int)gridDim.x;
              for (int ch = (int)blockIdx.x; ch < 1024; ch += G) hgrn_b1(lds, ch, (float*)(ws + WS_GG), (const bf16*)(ws + WS_HK), (const bf16*)(ws + WS_HV), (bf16*)(ws + WS_LT), (float*)(ws + WS_DEC)); }
#endif
        }
        SEAM;
        if (RUN) {
            unsigned char* ws = KWS; int tid_o = threadIdx.x; asm volatile("" : "+v"(tid_o)); const int G = (int)gridDim.x, bid = (int)blockIdx.x, tid = tid_o;
#ifndef SKIP_MLA
            REPEAT(REP_MLA) for (int it = bid; it < 256; it += G) {
                const int bh = it >> 3, pr = it & 7, b = bh >> 3, hd = bh & 7;
#pragma unroll 1
                for (int half = 0; half < 2; ++half) {
                    const int qb = half == 0 ? 15 - pr : pr;
                    const size_t row0 = (size_t)b * SEQ + qb * 256;
                    attn_item<96, 64, true>(lds, (const bf16*)(ws + WS_Q) + row0 * 768 + hd * 96, 768, (const bf16*)(ws + WS_KC) + (size_t)bh * SEQ * 96, (const bf16*)(ws + WS_VT) + (size_t)bh * 64 * SEQ, SEQ,
                                            (bf16*)(ws + WS_AO) + row0 * 512 + hd * 64, 512, qb * 256, SEQ, (const float*)(ws + WS_SSQQ) + row0 * 16, (const float*)(ws + WS_COS) + row0 * 16, (const float*)(ws + WS_SIN) + row0 * 16);
                }
            }
#endif
            unsigned* LT2 = (unsigned*)(ws + WS_LT); const float* DEC = (const float*)(ws + WS_DEC);
            for (int gt = bid * NTHREADS + tid; gt < 16 * 8192; gt += G * NTHREADS) {
                const int bh = gt >> 13, e2 = gt & 8191, k = (e2 & 63) * 2;
                unsigned* lp = LT2 + (size_t)bh * 64 * 8192 + e2; const float* dp = DEC + (size_t)bh * 64 * 128 + k;
                float run0 = 0.f, run1 = 0.f;
#pragma unroll 8
                for (int c = 0; c < 64; ++c) { const unsigned tmp = lp[(size_t)c * 8192]; const f32x2_t d = *(const f32x2_t*)(dp + c * 128); lp[(size_t)c * 8192] = pk2(run0, run1); run0 = d.x * run0 + bflo(tmp); run1 = d.y * run1 + bfhi(tmp); }
            }
        }
        SEAM;
        if (RUN) REPEAT(REP_P6) {
            unsigned char* ws = KWS; const int G = (int)gridDim.x, bid = (int)blockIdx.x;
#ifndef SKIP_XATT
            for (int it = bid; it < 256; it += G) {
                const int b = it >> 6, hd = (it >> 4) & 3, qb = it & 15;
                const size_t row0 = (size_t)b * SEQ + qb * 256;
                attn_item<128, 128, false>(lds, (const bf16*)(ws + WS_MQ) + row0 * 512 + hd * 128, 512, (const bf16*)(ws + WS_MK) + (size_t)(l * 16 + b * 4 + hd) * 256 * 128, (const bf16*)(ws + WS_MVT) + (size_t)(l * 16 + b * 4 + hd) * 128 * 256, 256,
                                           (bf16*)(ws + WS_MO) + row0 * 512 + hd * 128, 512, 0, 256, nullptr, nullptr, nullptr);
            }
#endif
#ifndef SKIP_B3
            const float* onorm = KIN(15) + l * 128;
            for (int ch = bid; ch < 1024; ch += G) hgrn_b3(lds, ch, (const float*)(ws + WS_GG), (const bf16*)(ws + WS_HQ), (const bf16*)(ws + WS_HK), (const bf16*)(ws + WS_HV), (const bf16*)(ws + WS_HGT), (const bf16*)(ws + WS_LT), onorm, (bf16*)(ws + WS_HO));
#endif
        }
        SEAM;
#ifndef SKIP_G7
        if (RUN) REPEAT(REP_P7) {
            unsigned char* ws = KWS; EpiBranch3 E{(bf16*)(ws + WS_MERGED), (const bf16*)(ws + WS_GATES)};
            int Kv = 512, Nv = 1024, Mv = T; asm volatile("" : "+s"(Kv), "+s"(Nv), "+s"(Mv));
            pg8::Gemm g{(const bf16*)(ws + WS_AO), (const bf16*)(ws + WT_WOMLA), Mv, Nv, Kv};
            SegOrder3 S; S.init(Mv, Nv, (int)gridDim.x, (int)blockIdx.x); S.wsb = (const char*)ws;
            pg8::gemm_phase<EpiBranch3, SegOrder3, true, true>(lds, g, S, E);
        }
#endif
        SEAM;
#ifndef SKIP_G8
        if (RUN) { unsigned char* ws = KWS; EpiResid E{(bf16*)(ws + WS_XB), (float*)(ws + WS_SSQ), 1.0f}; run_gemm(lds, (const bf16*)(ws + WS_MERGED), (const bf16*)(ws + WT_WOUT), T, 1024, 1024, 0, E); }
#endif
        SEAM;
#ifndef SKIP_G9
        if (RUN) { unsigned char* ws = KWS; EpiSwiglu E{(bf16*)(ws + WS_H), (const float*)(ws + WS_SSQ), lds}; run_gemm(lds, (const bf16*)(ws + WS_XB), (const bf16*)(ws + WT_W2IN), T, 5632, 1024, 0, E);
            if (l + 1 < DEPTH) conv_tail(1, l + 1, 64 * 22, lds); }
#endif
        SEAM;
#ifndef SKIP_G10
        if (RUN) { unsigned char* ws = KWS; EpiResid E{(bf16*)(ws + WS_XB), (float*)(ws + WS_SSQ), 0.5f}; run_gemm(lds, (const bf16*)(ws + WS_H), (const bf16*)(ws + WT_W2OUT), T, 1024, DFF, 0, E); }
#endif
        SEAM;
    }
    if (RUN) {
        unsigned char* ws = KWS; float* X = KOUT; const float* SSQ = (const float*)(ws + WS_SSQ); const bf16* XB = (const bf16*)(ws + WS_XB);
        int tid_o = threadIdx.x; asm volatile("" : "+v"(tid_o)); const int tid = tid_o, wave = __builtin_amdgcn_readfirstlane(tid >> 6), lane = tid & 63, G = (int)gridDim.x;
        const float* fg = KIN(24);
        for (int m = (int)blockIdx.x * NWAVES + wave; m < T; m += G * NWAVES) {
            const float rs = rsqrtf(sum16(SSQ + (size_t)m * 16) * (1.0f / 1024.0f) + EPS);
            f32x4* xr = (f32x4*)(X + (size_t)m * D) + lane; const f32x4* gr = (const f32x4*)fg + lane; const u32x2* xb = (const u32x2*)(XB + (size_t)m * D) + lane;
#pragma unroll
            for (int j = 0; j < 4; ++j) { const u32x2 w = xb[64 * j]; const f32x4 g = gr[64 * j]; f32x4 v = {bflo(w.x), bfhi(w.x), bflo(w.y), bfhi(w.y)}; v = v * rs * g; xr[64 * j] = v; }
        }
    }
#undef RUN
#undef SEAM
}

constexpr int N_PHASES = 1 + 1 + DEPTH * 10 + 1;

extern "C" void kernel_launch(void* const* d_in, const int* in_sizes, int n_in, void* d_out, int out_size, void* d_ws, size_t ws_size, hipStream_t stream) {
    static int grid = 0;
    if (grid == 0) {
        if (n_in != 25 || out_size != T * D || ws_size < WS_END) { fprintf(stderr, "kernel_launch: unexpected shapes (n_in %d out %d ws %zu need %zu)\n", n_in, out_size, ws_size, (size_t)WS_END); grid = -1; return; }
        int dev = 0, cus = 0, per_cu = 0;
        hipGetDevice(&dev);
        hipDeviceGetAttribute(&cus, hipDeviceAttributeMultiprocessorCount, dev);
        if (hipFuncSetAttribute((const void*)fwd_kernel, hipFuncAttributeMaxDynamicSharedMemorySize, LDS_BYTES) != hipSuccess) { fprintf(stderr, "kernel_launch: hipFuncSetAttribute failed\n"); grid = -1; return; }
        if (hipOccupancyMaxActiveBlocksPerMultiprocessor(&per_cu, (const void*)fwd_kernel, NTHREADS, LDS_BYTES) != hipSuccess || per_cu < 1) { fprintf(stderr, "kernel_launch: occupancy query says %d\n", per_cu); per_cu = 1; }
        (void)hipGetLastError();
        grid = cus * 1;
        if (grid <= 0) grid = 256;
    }
    if (grid < 0) return;
    if (hipMemsetAsync((char*)d_ws + WS_CTL, 0, CTL_BYTES, stream) != hipSuccess) { fprintf(stderr, "kernel_launch: memset of the barrier words failed\n"); return; }
    Args a{};
    for (int i = 0; i < 25; ++i) a.in[i] = d_in[i];
    a.out = (float*)d_out; a.ws = (unsigned char*)d_ws; a.ph_lo = 0; a.ph_hi = N_PHASES;
    void* args[] = {&a};
    hipError_t e = hipLaunchCooperativeKernel((const void*)fwd_kernel, dim3(grid), dim3(NTHREADS), args, LDS_BYTES, stream);
    if (e != hipSuccess) fprintf(stderr, "cooperative launch failed: %s (grid %d)\n", hipGetErrorString(e), grid);
}
```

```cpp
#include <hip/hip_runtime.h>
#include <hip/hip_cooperative_groups.h>
#include <cstdio>
#include <cstdint>
namespace cg = cooperative_groups;
#define DI __device__ __forceinline__
namespace pg8 {
#define PG8_LAS __attribute__((address_space(3)))
typedef unsigned short bf16_t;
typedef short bf16x8 __attribute__((ext_vector_type(8)));
typedef float f32x4 __attribute__((ext_vector_type(4)));
typedef unsigned u32x4 __attribute__((ext_vector_type(4)));
constexpr int BM = 256, BK = 64, HALF = 128, HTB = HALF * BK * 2  , STAGE_BYTES = 8 * HTB, NXCD = 8, WGM = 8;

__host__ __device__ __forceinline__ int lds_byte(int r, int c) { const int st = (r >> 4) * 2 + (c >> 5), rr = r & 15, cc = c & 31, ob = rr * 64 + cc * 2; return st * 1024 + (ob ^ (((ob >> 9) & 1) << 5)); }
__host__ __device__ __forceinline__ void stage_rc(int b, int& R, int& C) { const int st = b / 1024, sb = b % 1024, swz = sb ^ (((sb >> 9) & 1) << 5); R = (st >> 1) * 16 + swz / 64; C = (st & 1) * 32 + (swz % 64) / 2; }
__host__ __device__ __forceinline__ int perm32(int rho) { const int n = rho >> 4, i = rho & 15; return 8 * (i >> 2) + 4 * n + (i & 3); }

struct Unit { int pm, pn, seg; };
struct Gemm { const bf16_t* A; const bf16_t* Bt; int M, N, K; };

struct StaticOrder {
    int nM, nN, nwg, G, c;
    __host__ __device__ void init(int M, int N, int G_, int c_) { nM = M / BM; nN = N / BM; nwg = nM * nN; G = G_; c = c_; }
    __host__ __device__ bool next(int i, Unit& u) const {
        const long L = (long)i * G + c; if (L >= nwg) return false;
        int wgid = (int)L; { const int q = nwg / NXCD, r = nwg % NXCD, xcd = wgid % NXCD, off = wgid / NXCD; wgid = (xcd < r ? xcd * (q + 1) : r * (q + 1) + (xcd - r) * q) + off; }
        const int nig = WGM * nN, gid = wgid / nig, fm = gid * WGM, gsz = (nM - fm) < WGM ? (nM - fm) : WGM;
        u.pm = fm + ((wgid % nig) % gsz); u.pn = (wgid % nig) / gsz; u.seg = 0; return true;
    }
    __device__ __forceinline__ const char* a_ptr(const Gemm& g, const Unit&) const { return (const char*)g.A; }
    __device__ __forceinline__ const char* b_ptr(const Gemm& g, const Unit&) const { return (const char*)g.Bt; }
    __device__ __forceinline__ void a_ready(const Unit&) const {}
    __device__ __forceinline__ void done(const Unit&) const {}
};
template <class Epi, class Sched, bool ALIGN_EPI = false, bool SP2 = false>
__device__ __forceinline__ void gemm_phase(PG8_LAS unsigned char* lds, const Gemm g, const Sched& S, const Epi& E) {
    int tid_o = threadIdx.x; asm volatile("" : "+v"(tid_o));
    const int tid = tid_o, wid = __builtin_amdgcn_readfirstlane(tid >> 6), lane = tid & 63, wr = wid >> 2, wc = wid & 3, fr = lane & 15, fq = lane >> 4;
    const int K = g.K, nt = K / BK;
    unsigned voffA[2], voffB[2];
#pragma unroll
    for (int i = 0; i < 2; ++i) { int R, C; stage_rc(tid * 16 + i * 8192, R, C); const int Rb = Epi::PERM ? ((R & ~31) + perm32(R & 31)) : R;
        voffA[i] = (unsigned)(R * K + C) * 2u; voffB[i] = (unsigned)(Rb * K + C) * 2u; }
    const size_t kstep = (size_t)(BK * 2);
    const size_t hstep = (size_t)HALF * K * 2;
    const size_t tstep = 2 * hstep;
    const unsigned ldsw = (unsigned)wid * 1024u;
    const int aoff = lds_byte(wr * 64 + fr, fq * 8), boff = lds_byte(wc * 32 + fr, fq * 8);
#define PG8_SA(b, h) (((b) * 2 + (h)) * HTB)
#define PG8_SB(b, h) ((4 + (b) * 2 + (h)) * HTB)
#define PG8_STAGE(bufoff, gbase, voff) do { _Pragma("unroll") for (int _i = 0; _i < 2; ++_i) \
        __builtin_amdgcn_global_load_lds((const unsigned*)((const char*)(gbase) + (voff)[_i]), (PG8_LAS unsigned*)(lds + (bufoff) + ldsw + _i * 8192), 16, 0, 0); } while (0)
#define PG8_LDA(dst, b, h) do { _Pragma("unroll") for (int m = 0; m < 4; ++m) _Pragma("unroll") for (int k = 0; k < 2; ++k) dst[m][k] = *(const PG8_LAS bf16x8*)(lds + PG8_SA(b, h) + aoff + m * 2048 + k * 1024); } while (0)
#define PG8_LDB(dst, b, h) do { _Pragma("unroll") for (int n = 0; n < 2; ++n) _Pragma("unroll") for (int k = 0; k < 2; ++k) dst[n][k] = *(const PG8_LAS bf16x8*)(lds + PG8_SB(b, h) + boff + n * 2048 + k * 1024); } while (0)
#define PG8_MMA(ai, bj, At, Bt) do { __builtin_amdgcn_s_setprio(1); _Pragma("unroll") for (int m = 0; m < 4; ++m) _Pragma("unroll") for (int n = 0; n < 2; ++n) _Pragma("unroll") for (int k = 0; k < 2; ++k) \
        acc[ai][bj][m][n] = __builtin_amdgcn_mfma_f32_16x16x32_bf16(Bt[n][k], At[m][k], acc[ai][bj][m][n], 0, 0, 0); __builtin_amdgcn_s_setprio(0); } while (0)
#define PG8_WAIT_V(n) asm volatile("s_waitcnt vmcnt(" #n ")" ::: "memory")
#define PG8_WAIT_L(n) asm volatile("s_waitcnt lgkmcnt(" #n ")" ::: "memory")
#define PG8_BAR __builtin_amdgcn_s_barrier()
#define PG8_SCHED __builtin_amdgcn_sched_barrier(0)
    Unit cur, nxt; int ui = 0;
    if (!S.next(0, cur)) return;
    f32x4 acc[2][2][4][2];
#pragma unroll
    for (int a = 0; a < 2; ++a)
#pragma unroll
        for (int b = 0; b < 2; ++b)
#pragma unroll
            for (int m = 0; m < 4; ++m)
#pragma unroll
                for (int n = 0; n < 2; ++n) acc[a][b][m][n] = (f32x4){0.f, 0.f, 0.f, 0.f};
    bf16x8 At[4][2], B0[2][2], B1[2][2];
    const char* cA = S.a_ptr(g, cur) + (size_t)cur.pm * tstep; const char* cB = S.b_ptr(g, cur) + (size_t)cur.pn * tstep;
    S.a_ready(cur);
    if constexpr (SP2) {
        PG8_STAGE(PG8_SB(0, 0), cB, voffB); PG8_STAGE(PG8_SB(0, 1), cB + hstep, voffB); PG8_STAGE(PG8_SA(0, 0), cA, voffA); PG8_STAGE(PG8_SA(0, 1), cA + hstep, voffA);
        if (wr == 1) PG8_BAR;
        PG8_WAIT_V(2); PG8_BAR;
        PG8_STAGE(PG8_SB(1, 0), cB + kstep, voffB); PG8_STAGE(PG8_SA(1, 0), cA + kstep, voffA); PG8_STAGE(PG8_SB(1, 1), cB + hstep + kstep, voffB);
        PG8_WAIT_V(6); PG8_BAR;
    } else {
        PG8_STAGE(PG8_SB(0, 0), cB, voffB); PG8_STAGE(PG8_SA(0, 0), cA, voffA); PG8_STAGE(PG8_SB(0, 1), cB + hstep, voffB); PG8_STAGE(PG8_SA(0, 1), cA + hstep, voffA);
        if (wr == 1) PG8_BAR;
        PG8_WAIT_V(4); PG8_BAR;
        PG8_STAGE(PG8_SB(1, 0), cB + kstep, voffB); PG8_STAGE(PG8_SA(1, 0), cA + kstep, voffA); PG8_STAGE(PG8_SB(1, 1), cB + hstep + kstep, voffB);
        PG8_WAIT_V(6); PG8_BAR;
    }
    for (;;) {
        const bool has_next = S.next(ui + 1, nxt);
        const char* nA = has_next ? S.a_ptr(g, nxt) + (size_t)nxt.pm * tstep : cA; const char* nB = has_next ? S.b_ptr(g, nxt) + (size_t)nxt.pn * tstep : cB;
        for (int t = 0; t < nt; t += 2) {
            const bool last = (t == nt - 2);
            const char* a1 = cA + (size_t)(t + 1) * kstep;
            const char* a2 = last ? nA : cA + (size_t)(t + 2) * kstep; const char* b2 = last ? nB : cB + (size_t)(t + 2) * kstep;
            const char* a3 = a2 + kstep; const char* b3 = b2 + kstep;
            if (last && has_next) S.a_ready(nxt);
            if (last) E.prefetch(lds, cur, wid, lane);
            if constexpr (SP2) {
            PG8_LDB(B0, 0, 0); PG8_LDB(B1, 0, 1); PG8_SCHED; PG8_LDA(At, 0, 0); PG8_STAGE(PG8_SA(1, 1), a1 + hstep, voffA);
            PG8_WAIT_V(8); PG8_WAIT_L(0); PG8_BAR; PG8_MMA(0, 0, At, B0); PG8_MMA(0, 1, At, B1); PG8_BAR; PG8_SCHED;
            PG8_LDA(At, 0, 1); PG8_STAGE(PG8_SB(0, 0), b2, voffB); PG8_STAGE(PG8_SB(0, 1), b2 + hstep, voffB); PG8_STAGE(PG8_SA(0, 0), a2, voffA);
            PG8_WAIT_V(8); PG8_WAIT_L(0); PG8_BAR; PG8_MMA(1, 0, At, B0); PG8_MMA(1, 1, At, B1); PG8_BAR; PG8_SCHED;
            PG8_LDB(B0, 1, 0); PG8_LDB(B1, 1, 1); PG8_SCHED; PG8_LDA(At, 1, 0); PG8_STAGE(PG8_SA(0, 1), a2 + hstep, voffA);
            PG8_WAIT_V(8); PG8_WAIT_L(0); PG8_BAR; PG8_MMA(0, 0, At, B0); PG8_MMA(0, 1, At, B1); PG8_BAR; PG8_SCHED;
            PG8_LDA(At, 1, 1); PG8_STAGE(PG8_SB(1, 0), b3, voffB); PG8_STAGE(PG8_SB(1, 1), b3 + hstep, voffB); PG8_STAGE(PG8_SA(1, 0), a3, voffA);
            PG8_WAIT_V(8); PG8_WAIT_L(0); PG8_BAR; PG8_MMA(1, 0, At, B0); PG8_MMA(1, 1, At, B1); PG8_BAR; PG8_SCHED;
            } else {
            PG8_LDB(B0, 0, 0); PG8_SCHED; PG8_LDA(At, 0, 0); PG8_STAGE(PG8_SA(1, 1), a1 + hstep, voffA);
            PG8_WAIT_L(8); PG8_BAR; PG8_WAIT_L(0); PG8_MMA(0, 0, At, B0); PG8_BAR; PG8_SCHED;
            PG8_LDB(B1, 0, 1); PG8_STAGE(PG8_SB(0, 0), b2, voffB);
            PG8_BAR; PG8_WAIT_L(0); PG8_MMA(0, 1, At, B1); PG8_BAR;
            PG8_LDA(At, 0, 1); PG8_STAGE(PG8_SA(0, 0), a2, voffA);
            PG8_BAR; PG8_WAIT_L(0); PG8_MMA(1, 0, At, B0); PG8_BAR; PG8_SCHED;
            PG8_STAGE(PG8_SB(0, 1), b2 + hstep, voffB);
            PG8_WAIT_V(6); PG8_BAR; PG8_MMA(1, 1, At, B1); PG8_BAR;
            PG8_LDB(B0, 1, 0); PG8_SCHED; PG8_LDA(At, 1, 0); PG8_STAGE(PG8_SA(0, 1), a2 + hstep, voffA);
            PG8_WAIT_L(8); PG8_BAR; PG8_WAIT_L(0); PG8_MMA(0, 0, At, B0); PG8_BAR; PG8_SCHED;
            PG8_LDB(B1, 1, 1); PG8_STAGE(PG8_SB(1, 0), b3, voffB);
            PG8_BAR; PG8_WAIT_L(0); PG8_MMA(0, 1, At, B1); PG8_BAR;
            PG8_LDA(At, 1, 1); PG8_STAGE(PG8_SA(1, 0), a3, voffA);
            PG8_BAR; PG8_WAIT_L(0); PG8_MMA(1, 0, At, B0); PG8_BAR; PG8_SCHED;
            PG8_STAGE(PG8_SB(1, 1), b3 + hstep, voffB);
            PG8_WAIT_V(6); PG8_BAR; PG8_MMA(1, 1, At, B1); PG8_BAR;
            }
        }
        if constexpr (ALIGN_EPI) { if (wr == 0) PG8_BAR; }
        if constexpr (!Epi::AFTER_DRAIN) { E(acc, cur, wr, wc, fr, fq); S.done(cur); }
        if (!has_next) break;
        if (!E.keep_acc(cur))
#pragma unroll
        for (int a = 0; a < 2; ++a)
#pragma unroll
            for (int b = 0; b < 2; ++b)
#pragma unroll
                for (int m = 0; m < 4; ++m)
#pragma unroll
                    for (int n = 0; n < 2; ++n) acc[a][b][m][n] = (f32x4){0.f, 0.f, 0.f, 0.f};
        cur = nxt; cA = nA; cB = nB; ++ui;
        if constexpr (ALIGN_EPI) { if (wr == 1) PG8_BAR; }
    }
    PG8_WAIT_V(0);
    if constexpr (!ALIGN_EPI) { if (wr == 0) PG8_BAR; }
    PG8_BAR;
    if constexpr (Epi::AFTER_DRAIN) { E.fused(acc, cur, wr, wc, fr, fq, lds, wid, lane); S.done(cur); }
#undef PG8_SA
#undef PG8_SB
#undef PG8_STAGE
#undef PG8_LDA
#undef PG8_LDB
#undef PG8_MMA
#undef PG8_WAIT_V
#undef PG8_WAIT_L
#undef PG8_BAR
#undef PG8_SCHED
}
}

typedef unsigned short bf16;
#define LAS __attribute__((address_space(3)))
#define GAS __attribute__((address_space(1)))
typedef float f32x4 __attribute__((ext_vector_type(4)));
typedef float f32x16 __attribute__((ext_vector_type(16)));
typedef float f32x2_t __attribute__((ext_vector_type(2)));
typedef __bf16 bf16x2_t __attribute__((ext_vector_type(2)));
typedef short bf16x8 __attribute__((ext_vector_type(8)));
typedef short s16x4 __attribute__((ext_vector_type(4)));
typedef unsigned u32x4 __attribute__((ext_vector_type(4)));
typedef unsigned u32x2 __attribute__((ext_vector_type(2)));

constexpr int T = 16384, D = 1024, SEQ = 4096, NBATCH = 4, DFF = 2816, DEPTH = 4, NIN = 6400, DIN = 6304;
constexpr int NTHREADS = 512, NWAVES = 8;
constexpr float EPS = 1e-6f;
constexpr float QSCALE_MLA = 0.14724498f;
constexpr float QSCALE_MEM = 0.12751743f;

constexpr size_t MiB = 1u << 20;
constexpr size_t WT_W1IN = 0;
constexpr size_t WT_W1OUT = WT_W1IN + (size_t)5632 * 1024 * 2;
constexpr size_t WT_WIN = WT_W1OUT + (size_t)1024 * 2816 * 2;
constexpr size_t WT_WUQ = WT_WIN + (size_t)NIN * 1024 * 2;
constexpr size_t WT_WUKV = WT_WUQ + (size_t)768 * 384 * 2;
constexpr size_t WT_WOMLA = WT_WUKV + (size_t)1024 * 256 * 2;
constexpr size_t WT_WOHG = WT_WOMLA + (size_t)1024 * 512 * 2;
constexpr size_t WT_WOMEM = WT_WOHG + (size_t)1024 * 512 * 2;
constexpr size_t WT_WMEMKV = WT_WOMEM + (size_t)1024 * 512 * 2;
constexpr size_t WT_WOUT = WT_WMEMKV + (size_t)4 * 1024 * 1024 * 2;
constexpr size_t WT_W2IN = WT_WOUT + (size_t)1024 * 1024 * 2;
constexpr size_t WT_W2OUT = WT_W2IN + (size_t)5632 * 1024 * 2;
constexpr size_t WT_END = WT_W2OUT + (size_t)1024 * 2816 * 2;
static_assert(WT_END <= 60 * MiB, "weights");
constexpr size_t WS_XB = 60 * MiB;
constexpr size_t WS_SSQ = WS_XB + 32 * MiB;
constexpr size_t WS_SSQQ = WS_SSQ + 1 * MiB;
constexpr size_t WS_SSQKV = WS_SSQQ + 1 * MiB;
constexpr size_t WS_COS = WS_SSQKV + 1 * MiB;
constexpr size_t WS_SIN = WS_COS + 1 * MiB;
constexpr size_t WS_LBS = WS_SIN + 1 * MiB;
constexpr size_t WS_MEMB = WS_LBS + 65536;
constexpr size_t WS_MEMRSTD = WS_MEMB + 2 * MiB;
constexpr size_t WS_MK = WS_MEMRSTD + 65536;
constexpr size_t WS_MVT = WS_MK + 4 * MiB;
constexpr size_t WS_DEC = WS_MVT + 4 * MiB;
constexpr size_t WS_MIX = WS_DEC + 1 * MiB;
constexpr size_t WS_CQ = WS_MIX;
constexpr size_t WS_CKV = WS_CQ + 12 * MiB;
constexpr size_t WS_KR = WS_CKV + 8 * MiB;
constexpr size_t WS_HQ = WS_KR + 1 * MiB;
constexpr size_t WS_GG = WS_HQ + 16 * MiB;
constexpr size_t WS_HK = WS_GG + 32 * MiB;
constexpr size_t WS_HV = WS_HK + 16 * MiB;
constexpr size_t WS_HGT = WS_HV + 16 * MiB;
constexpr size_t WS_MQ = WS_HGT + 16 * MiB;
constexpr size_t WS_GATES = WS_MQ + 16 * MiB;
constexpr size_t WS_Q = WS_GATES + 96 * MiB;
constexpr size_t WS_KC = WS_Q + 24 * MiB;
constexpr size_t WS_VT = WS_KC + 24 * MiB;
constexpr size_t WS_LT = WS_VT + 16 * MiB;
constexpr size_t WS_AO = WS_LT + 64 * MiB;
constexpr size_t WS_CTL = WS_AO + 16 * MiB;
constexpr size_t CTL_BYTES = 16384;
constexpr size_t WS_END = WS_CTL + 65536;
constexpr size_t WS_HO = WS_CQ;
constexpr size_t WS_MERGED = WS_GG;
constexpr size_t WS_MO = WS_Q;
constexpr size_t WS_H = WS_MIX;
static_assert(WS_H + (size_t)T * DFF * 2 <= WS_END, "h overlay");

constexpr int LDS_BYTES = 163840;
constexpr int LDS_SSQ_OFF = 131072 + 4096;
#ifndef REP_CONV
#define REP_CONV 1
#endif
#ifndef REP_P1
#define REP_P1 1
#endif
#ifndef REP_P3
#define REP_P3 1
#endif
#ifndef REP_MLA
#define REP_MLA 1
#endif
#ifndef REP_P6
#define REP_P6 1
#endif
#ifndef REP_P7
#define REP_P7 1
#endif
#ifndef REP_P4G
#define REP_P4G 1
#endif

DI unsigned pk2(float lo, float hi) { f32x2_t v = {lo, hi}; bf16x2_t b = __builtin_convertvector(v, bf16x2_t); return __builtin_bit_cast(unsigned, b); }
DI u32x4 pk8(const float* v) { u32x4 w; w.x = pk2(v[0], v[1]); w.y = pk2(v[2], v[3]); w.z = pk2(v[4], v[5]); w.w = pk2(v[6], v[7]); return w; }
DI float bflo(unsigned w) { return __uint_as_float(w << 16); }
DI float bfhi(unsigned w) { return __uint_as_float(w & 0xffff0000u); }
DI void unpk8(u32x4 w, float* v) { v[0] = bflo(w.x); v[1] = bfhi(w.x); v[2] = bflo(w.y); v[3] = bfhi(w.y); v[4] = bflo(w.z); v[5] = bfhi(w.z); v[6] = bflo(w.w); v[7] = bfhi(w.w); }
DI float bf2f(bf16 b) { return __uint_as_float(((unsigned)b) << 16); }
DI bf16 f2bf(float f) { return (bf16)(pk2(f, 0.f) & 0xffffu); }
DI float sigmoidf_(float z) { return __builtin_amdgcn_rcpf(1.0f + __expf(-z)); }
DI float wave_sum(float v) {
#pragma unroll
    for (int o = 1; o < 64; o <<= 1) v += __shfl_xor(v, o);
    return v;
}
DI float rowsum_q(const float* p, int fq, int nq) {
    float s = 0.f;
    if (fq < nq) { const f32x4 a = *(const f32x4*)(p + 4 * fq); s = (a.x + a.y) + (a.z + a.w); }
    s += __shfl_xor(s, 16); s += __shfl_xor(s, 32);
    return s;
}
DI void rstd8(const float* ssq, int stride, int nq, float inv_n, float post, int rowb, int fq, float (&rs)[8]) {
    f32x4 q[8];
#pragma unroll
    for (int i = 0; i < 8; ++i) q[i] = *(const f32x4*)(ssq + (size_t)(rowb + (i >> 2) * 128 + (i & 3) * 16) * stride + 4 * fq);
    const float keep = fq < nq ? 1.0f : 0.0f;
#pragma unroll
    for (int i = 0; i < 8; ++i) { float t = ((q[i].x + q[i].y) + (q[i].z + q[i].w)) * keep; t += __shfl_xor(t, 16); t += __shfl_xor(t, 32); rs[i] = __builtin_amdgcn_rsqf(t * inv_n + EPS) * post; }
}
DI void rstd8_lds(const LAS unsigned char* pan, float inv_n, int rowl, int fq, float (&rs)[8]) {
    f32x4 q[8];
#pragma unroll
    for (int i = 0; i < 8; ++i) q[i] = *(const LAS f32x4*)(pan + (rowl + (i >> 2) * 128 + (i & 3) * 16) * 64 + 16 * fq);
#pragma unroll
    for (int i = 0; i < 8; ++i) { float t = (q[i].x + q[i].y) + (q[i].z + q[i].w); t += __shfl_xor(t, 16); t += __shfl_xor(t, 32); rs[i] = __builtin_amdgcn_rsqf(t * inv_n + EPS); }
}
DI void ssq_panel_dma(LAS unsigned char* lds, const float* ssq, int pm, int wid, int lane) {
    const char* src = (const char*)(ssq + (size_t)pm * 256 * 16);
    const unsigned voff = (unsigned)(wid * 64 + lane) * 16u;
#pragma unroll
    for (int i = 0; i < 2; ++i)
        __builtin_amdgcn_global_load_lds((const unsigned*)(src + i * 8192 + voff), (LAS unsigned*)(lds + LDS_SSQ_OFF + wid * 1024 + i * 8192), 16, 0, 0);
}
DI float sum16(const float* p) {
    const f32x4 a = *(const f32x4*)p, b = *(const f32x4*)(p + 4), c = *(const f32x4*)(p + 8), d = *(const f32x4*)(p + 12);
    return ((a.x + a.y) + (a.z + a.w)) + ((b.x + b.y) + (b.z + b.w)) + ((c.x + c.y) + (c.z + c.w)) + ((d.x + d.y) + (d.z + d.w));
}

using pg8::Unit;
#define EPI_ARGS const f32x4 (&acc)[2][2][4][2], const Unit& u, int wr, int wc, int fr_in, int fq_in
#define EPI_OPAQUE int fr = fr_in, fq = fq_in; asm volatile("" : "+v"(fr), "+v"(fq));

struct EpiSwiglu {
    static constexpr bool PERM = true, AFTER_DRAIN = false;
    DI bool keep_acc(const Unit&) const { return false; }
    bf16* H; const float* ssq; LAS unsigned char* ldsb;
    DI void prefetch(LAS unsigned char* lds, const Unit& u, int wid, int lane) const { ssq_panel_dma(lds, ssq, u.pm, wid, lane); }
    DI void operator()(EPI_ARGS) const {
        EPI_OPAQUE
        const int rowb = u.pm * 256 + wr * 64 + fr;
        asm volatile("s_waitcnt vmcnt(16)" ::: "memory"); __builtin_amdgcn_s_barrier(); asm volatile("" ::: "memory");
        float rs[8]; rstd8_lds(ldsb + LDS_SSQ_OFF, 1.0f / 1024.0f, wr * 64 + fr, fq, rs);
#pragma unroll
        for (int ai = 0; ai < 2; ++ai)
#pragma unroll
            for (int m = 0; m < 4; ++m) {
                const int row = rowb + ai * 128 + m * 16;
                const float r1 = rs[ai * 4 + m];
                float o[8];
#pragma unroll
                for (int n = 0; n < 2; ++n)
#pragma unroll
                    for (int j = 0; j < 4; ++j) { const float a = acc[ai][0][m][n][j] * r1, b = acc[ai][1][m][n][j] * r1; o[4 * n + j] = a * b * __builtin_amdgcn_rcpf(1.0f + __expf(-a)); }
                *(u32x4*)(H + (size_t)row * DFF + u.pn * 128 + 32 * wc + 8 * fq) = pk8(o);
            }
    }
};

struct EpiSwigluNoLoad {
    static constexpr bool PERM = true, AFTER_DRAIN = false;
    DI bool keep_acc(const Unit&) const { return false; }
    DI void prefetch(LAS unsigned char*, const Unit&, int, int) const {}
    bf16* H;
    DI void operator()(EPI_ARGS) const {
        EPI_OPAQUE
        const int rowb = u.pm * 256 + wr * 64 + fr;
#pragma unroll
        for (int ai = 0; ai < 2; ++ai)
#pragma unroll
            for (int m = 0; m < 4; ++m) {
                const int row = rowb + ai * 128 + m * 16;
                float o[8];
#pragma unroll
                for (int n = 0; n < 2; ++n)
#pragma unroll
                    for (int j = 0; j < 4; ++j) { const float a = acc[ai][0][m][n][j], b = acc[ai][1][m][n][j]; o[4 * n + j] = a * b * __builtin_amdgcn_rcpf(1.0f + __expf(-a)); }
#ifndef PROBE_NOSTORE
                *(u32x4*)(H + (size_t)row * DFF + u.pn * 128 + 32 * wc + 8 * fq) = pk8(o);
#else
                if (o[0] + o[1] + o[2] + o[3] + o[4] + o[5] + o[6] + o[7] == 12345.678f) *(u32x4*)(H + (size_t)row * DFF + u.pn * 128 + 32 * wc + 8 * fq) = pk8(o);
#endif
            }
    }
};

struct EpiNull {
    static constexpr bool PERM = true, AFTER_DRAIN = false;
    DI bool keep_acc(const Unit&) const { return false; }
    DI void prefetch(LAS unsigned char*, const Unit&, int, int) const {}
    bf16* H;
    DI void operator()(EPI_ARGS) const {
        float t = 0.f;
#pragma unroll
        for (int ai = 0; ai < 2; ++ai)
#pragma unroll
            for (int bj = 0; bj < 2; ++bj)
#pragma unroll
                for (int m = 0; m < 4; ++m)
#pragma unroll
                    for (int n = 0; n < 2; ++n) t += acc[ai][bj][m][n][0] + acc[ai][bj][m][n][1] + acc[ai][bj][m][n][2] + acc[ai][bj][m][n][3];
        if (t == 12345.678f) H[0] = 0;
    }
};

struct EpiResid {
    static constexpr bool PERM = true, AFTER_DRAIN = false;
    DI bool keep_acc(const Unit&) const { return false; }
    DI void prefetch(LAS unsigned char*, const Unit&, int, int) const {}
    bf16* XB; float* ssq; float scale;
    DI void operator()(EPI_ARGS) const {
        EPI_OPAQUE
        const int rowb = u.pm * 256 + wr * 64 + fr, colb = u.pn * 256 + 32 * wc + 8 * fq;
#pragma unroll
        for (int ai = 0; ai < 2; ++ai) {
            u32x4 xv[4][2];
#pragma unroll
            for (int m = 0; m < 4; ++m)
#pragma unroll
                for (int bj = 0; bj < 2; ++bj) xv[m][bj] = *(const u32x4*)(XB + (size_t)(rowb + ai * 128 + m * 16) * D + colb + 128 * bj);
#pragma unroll
            for (int m = 0; m < 4; ++m) {
                const int row = rowb + ai * 128 + m * 16;
                float ss = 0.f;
#pragma unroll
                for (int bj = 0; bj < 2; ++bj) {
                    float o[8]; unpk8(xv[m][bj], o);
#pragma unroll
                    for (int n = 0; n < 2; ++n)
#pragma unroll
                        for (int j = 0; j < 4; ++j) o[4 * n + j] += scale * acc[ai][bj][m][n][j];
                    const u32x4 w = pk8(o);
                    *(u32x4*)(XB + (size_t)row * D + colb + 128 * bj) = w;
                    float q[8]; unpk8(w, q);
#pragma unroll
                    for (int e = 0; e < 8; ++e) ss += q[e] * q[e];
                }
                ss += __shfl_xor(ss, 16); ss += __shfl_xor(ss, 32);
                if (fq == 0) ssq[(size_t)row * 16 + u.pn * 4 + wc] = ss;
            }
        }
    }
};

struct EpiWin {
    static constexpr bool PERM = true, AFTER_DRAIN = false;
    DI bool keep_acc(const Unit&) const { return false; }
    DI void prefetch(LAS unsigned char* lds, const Unit& u, int wid, int lane) const { ssq_panel_dma(lds, (const float*)(ws + WS_SSQ), u.pm, wid, lane); }
    unsigned char* ws; const float* lbs  ; LAS unsigned char* ldsb;
    DI void operator()(EPI_ARGS) const {
        EPI_OPAQUE
        const float* ssq = (const float*)(ws + WS_SSQ); const float* cosT = (const float*)(ws + WS_COS); const float* sinT = (const float*)(ws + WS_SIN);
        bf16* CQ = (bf16*)(ws + WS_CQ); bf16* CKV = (bf16*)(ws + WS_CKV); bf16* KC = (bf16*)(ws + WS_KC); bf16* HQ = (bf16*)(ws + WS_HQ); bf16* HK = (bf16*)(ws + WS_HK); bf16* HV = (bf16*)(ws + WS_HV);
        bf16* HGT = (bf16*)(ws + WS_HGT); bf16* MQ = (bf16*)(ws + WS_MQ); bf16* GATES = (bf16*)(ws + WS_GATES); float* GG = (float*)(ws + WS_GG); float* SSQQ = (float*)(ws + WS_SSQQ); float* SSQKV = (float*)(ws + WS_SSQKV);
        const int rowb = u.pm * 256 + wr * 64 + fr;
        asm volatile("s_waitcnt vmcnt(16)" ::: "memory"); __builtin_amdgcn_s_barrier(); asm volatile("" ::: "memory");
        float rs8[8]; rstd8_lds(ldsb + LDS_SSQ_OFF, 1.0f / 1024.0f, wr * 64 + fr, fq, rs8);
#pragma unroll
        for (int ai = 0; ai < 2; ++ai)
#pragma unroll
            for (int m = 0; m < 4; ++m) {
                const int row = rowb + ai * 128 + m * 16;
                const float rs = rs8[ai * 4 + m];
#pragma unroll
                for (int bj = 0; bj < 2; ++bj) {
                    const int hh = 2 * u.pn + bj, cw = 32 * wc + 8 * fq;
                    float v[8];
#pragma unroll
                    for (int n = 0; n < 2; ++n)
#pragma unroll
                        for (int j = 0; j < 4; ++j) v[4 * n + j] = acc[ai][bj][m][n][j] * rs;
                    if (hh < 5) {
                        float ss = 0.f;
#pragma unroll
                        for (int e = 0; e < 8; ++e) ss += v[e] * v[e];
                        ss += __shfl_xor(ss, 16); ss += __shfl_xor(ss, 32);
                        if (hh < 3) { *(u32x4*)(CQ + (size_t)row * 384 + hh * 128 + cw) = pk8(v); if (fq == 0) SSQQ[(size_t)row * 16 + hh * 4 + wc] = ss; }
                        else { *(u32x4*)(CKV + (size_t)row * 256 + (hh - 3) * 128 + cw) = pk8(v); if (fq == 0) SSQKV[(size_t)row * 8 + (hh - 3) * 4 + wc] = ss; }
                    } else if (hh == 5) {
                        if (wc == 0) {
                            const f32x4 c = *(const f32x4*)(cosT + (size_t)row * 16 + 4 * fq), s = *(const f32x4*)(sinT + (size_t)row * 16 + 4 * fq);
                            u32x4 o;
                            o.x = pk2(v[0] * c.x - v[1] * s.x, v[1] * c.x + v[0] * s.x); o.y = pk2(v[2] * c.y - v[3] * s.y, v[3] * c.y + v[2] * s.y);
                            o.z = pk2(v[4] * c.z - v[5] * s.z, v[5] * c.z + v[4] * s.z); o.w = pk2(v[6] * c.w - v[7] * s.w, v[7] * c.w + v[6] * s.w);
                            bf16* kp = KC + ((size_t)(row >> 12) * 8 * SEQ + (row & 4095)) * 96 + 64 + 8 * fq;
#pragma unroll
                            for (int hd = 0; hd < 8; ++hd) *(u32x4*)(kp + (size_t)hd * SEQ * 96) = o;
                        }
                    } else if (hh < 10) {
#pragma unroll
                        for (int e = 0; e < 8; ++e) v[e] = v[e] * sigmoidf_(v[e]);
                        *(u32x4*)(HQ + (size_t)row * 512 + (hh - 6) * 128 + cw) = pk8(v);
                    } else if (hh < 14) {
                        const int c0 = (hh - 10) * 128 + cw;
                        const f32x4 l0 = *(const f32x4*)(lbs + c0), l1 = *(const f32x4*)(lbs + c0 + 4);
                        const float lb[8] = {l0.x, l0.y, l0.z, l0.w, l1.x, l1.y, l1.z, l1.w};
                        float g[8], k[8];
#pragma unroll
                        for (int e = 0; e < 8; ++e) { const float z = fminf(fmaxf(v[e], -60.f), 60.f); const float en = __expf(-z), sg = __builtin_amdgcn_rcpf(1.0f + en);
                            g[e] = __logf(lb[e] + (1.0f - lb[e]) * sg); k[e] = (1.0f - lb[e]) * (en * sg); }
                        *(f32x4*)(GG + (size_t)row * 512 + c0) = (f32x4){g[0], g[1], g[2], g[3]}; *(f32x4*)(GG + (size_t)row * 512 + c0 + 4) = (f32x4){g[4], g[5], g[6], g[7]};
                        *(u32x4*)(HK + (size_t)row * 512 + c0) = pk8(k);
                    } else if (hh < 18) {
                        *(u32x4*)(HV + (size_t)row * 512 + (hh - 14) * 128 + cw) = pk8(v);
                    } else if (hh < 22) {
#pragma unroll
                        for (int e = 0; e < 8; ++e) v[e] = v[e] * sigmoidf_(v[e]);
                        *(u32x4*)(HGT + (size_t)row * 512 + (hh - 18) * 128 + cw) = pk8(v);
                    } else if (hh < 26) {
#pragma unroll
                        for (int e = 0; e < 8; ++e) v[e] *= QSCALE_MEM;
                        *(u32x4*)(MQ + (size_t)row * 512 + (hh - 22) * 128 + cw) = pk8(v);
                    } else {
                        const int c0 = (hh - 26) * 128 + cw, br = c0 >> 10, cc = c0 & 1023;
#pragma unroll
                        for (int e = 0; e < 8; ++e) v[e] = sigmoidf_(v[e]);
                        *(u32x4*)(GATES + ((size_t)br * T + row) * 1024 + cc) = pk8(v);
                    }
                }
            }
    }
};

struct EpiQ {
    static constexpr bool PERM = true, AFTER_DRAIN = false;
    DI bool keep_acc(const Unit&) const { return false; }
    DI void prefetch(LAS unsigned char*, const Unit&, int, int) const {}
    bf16* Q;
    DI void operator()(EPI_ARGS) const {
        EPI_OPAQUE
#pragma unroll
        for (int ai = 0; ai < 2; ++ai)
#pragma unroll
            for (int m = 0; m < 4; ++m) {
                const int row = u.pm * 256 + ai * 128 + wr * 64 + m * 16 + fr;
#pragma unroll
                for (int bj = 0; bj < 2; ++bj) {
                    float v[8];
#pragma unroll
                    for (int n = 0; n < 2; ++n)
#pragma unroll
                        for (int j = 0; j < 4; ++j) v[4 * n + j] = acc[ai][bj][m][n][j];
                    *(u32x4*)(Q + (size_t)row * 768 + u.pn * 256 + 128 * bj + 32 * wc + 8 * fq) = pk8(v);
                }
            }
    }
};

struct EpiKV {
    static constexpr bool PERM = true, AFTER_DRAIN = false;
    DI bool keep_acc(const Unit&) const { return false; }
    DI void prefetch(LAS unsigned char*, const Unit&, int, int) const {}
    bf16* KC; bf16* VT; const float* ssqkv;
    DI void operator()(EPI_ARGS) const {
        EPI_OPAQUE
        float rs8[8]; rstd8(ssqkv, 8, 2, 1.0f / 256.0f, 1.0f, u.pm * 256 + wr * 64 + fr, fq, rs8);
#pragma unroll
        for (int ai = 0; ai < 2; ++ai)
#pragma unroll
            for (int m = 0; m < 4; ++m) {
                const int row = u.pm * 256 + ai * 128 + wr * 64 + m * 16 + fr, b = row >> 12, s = row & 4095;
                const float rs = rs8[ai * 4 + m];
#pragma unroll
                for (int bj = 0; bj < 2; ++bj) {
                    const int c0 = u.pn * 256 + 128 * bj + 32 * wc + 8 * fq;
                    float v[8];
#pragma unroll
                    for (int n = 0; n < 2; ++n)
#pragma unroll
                        for (int j = 0; j < 4; ++j) v[4 * n + j] = acc[ai][bj][m][n][j] * rs;
                    if (c0 < 512) {
                        const int hd = c0 >> 6, d = c0 & 63;
                        bf16* kp = KC + ((size_t)(b * 8 + hd) * SEQ + s) * 96;
                        *(u32x4*)(kp + d) = pk8(v);
                    } else {
                        const int c = c0 - 512, hd = c >> 6, dv = c & 63;
                        bf16* vp = VT + ((size_t)(b * 8 + hd) * 64 + dv) * SEQ + s;
#pragma unroll
                        for (int e = 0; e < 8; ++e) vp[(size_t)e * SEQ] = f2bf(v[e]);
                    }
                }
            }
    }
};

struct EpiMemKV {
    static constexpr bool PERM = true, AFTER_DRAIN = false;
    DI bool keep_acc(const Unit&) const { return false; }
    DI void prefetch(LAS unsigned char*, const Unit&, int, int) const {}
    bf16* MK; bf16* MVT; const float* rstd;
    DI void operator()(EPI_ARGS) const {
        EPI_OPAQUE
#pragma unroll
        for (int ai = 0; ai < 2; ++ai)
#pragma unroll
            for (int m = 0; m < 4; ++m) {
                const int row = u.pm * 256 + ai * 128 + wr * 64 + m * 16 + fr, b = row >> 8, mm = row & 255;
                const float rs = rstd[row];
#pragma unroll
                for (int bj = 0; bj < 2; ++bj) {
                    const int c0 = u.pn * 256 + 128 * bj + 32 * wc + 8 * fq;
                    float v[8];
#pragma unroll
                    for (int n = 0; n < 2; ++n)
#pragma unroll
                        for (int j = 0; j < 4; ++j) v[4 * n + j] = acc[ai][bj][m][n][j] * rs;
                    if (c0 < 512) { const int hd = c0 >> 7, d = c0 & 127; *(u32x4*)(MK + ((size_t)(b * 4 + hd) * 256 + mm) * 128 + d) = pk8(v); }
                    else { const int c = c0 - 512, hd = c >> 7, dv = c & 127; bf16* vp = MVT + ((size_t)(b * 4 + hd) * 128 + dv) * 256 + mm;
#pragma unroll
                        for (int e = 0; e < 8; ++e) vp[(size_t)e * 256] = f2bf(v[e]); }
                }
            }
    }
};

struct EpiBranch {
    static constexpr bool PERM = true, AFTER_DRAIN = false;
    DI bool keep_acc(const Unit&) const { return false; }
    DI void prefetch(LAS unsigned char*, const Unit&, int, int) const {}
    bf16* MG; const bf16* gate; int first;
    DI void operator()(EPI_ARGS) const {
        EPI_OPAQUE
        const int rowb = u.pm * 256 + wr * 64 + fr, colb = u.pn * 256 + 32 * wc + 8 * fq;
#pragma unroll
        for (int ai = 0; ai < 2; ++ai) {
            u32x4 gv[4][2], pv[4][2];
#pragma unroll
            for (int m = 0; m < 4; ++m)
#pragma unroll
                for (int bj = 0; bj < 2; ++bj) { const size_t off = (size_t)(rowb + ai * 128 + m * 16) * 1024 + colb + 128 * bj;
                    gv[m][bj] = *(const u32x4*)(gate + off); pv[m][bj] = (u32x4){0, 0, 0, 0}; if (!first) pv[m][bj] = *(const u32x4*)(MG + off); }
#pragma unroll
            for (int m = 0; m < 4; ++m)
#pragma unroll
                for (int bj = 0; bj < 2; ++bj) {
                    const size_t off = (size_t)(rowb + ai * 128 + m * 16) * 1024 + colb + 128 * bj;
                    float g[8], o[8];
                    unpk8(gv[m][bj], g); unpk8(pv[m][bj], o);
#pragma unroll
                    for (int n = 0; n < 2; ++n)
#pragma unroll
                        for (int j = 0; j < 4; ++j) o[4 * n + j] += g[4 * n + j] * acc[ai][bj][m][n][j];
                    *(u32x4*)(MG + off) = pk8(o);
                }
        }
    }
};

struct EpiBranch3 {
    static constexpr bool PERM = true, AFTER_DRAIN = false;
    bf16* MG; const bf16* gates;
    DI bool keep_acc(const Unit& u) const { return u.seg < 2; }
    DI void prefetch(LAS unsigned char*, const Unit&, int, int) const {}
    DI void operator()(f32x4 (&acc)[2][2][4][2], const Unit& u, int wr, int wc, int fr_in, int fq_in) const {
        EPI_OPAQUE
        const int rowb = u.pm * 256 + wr * 64 + fr, colb = u.pn * 256 + 32 * wc + 8 * fq, seg = u.seg;
        const bf16* gcur = gates + (size_t)seg * T * 1024; const bf16* gnxt = gates + (size_t)(seg < 2 ? seg + 1 : seg) * T * 1024;
#pragma unroll
        for (int ai = 0; ai < 2; ++ai) {
            u32x4 gv[4][2], nv[4][2];
#pragma unroll
            for (int m = 0; m < 4; ++m)
#pragma unroll
                for (int bj = 0; bj < 2; ++bj) { const size_t off = (size_t)(rowb + ai * 128 + m * 16) * 1024 + colb + 128 * bj; gv[m][bj] = *(const u32x4*)(gcur + off); nv[m][bj] = *(const u32x4*)(gnxt + off); }
#pragma unroll
            for (int m = 0; m < 4; ++m)
#pragma unroll
                for (int bj = 0; bj < 2; ++bj) {
                    float g[8], gn[8];
                    unpk8(gv[m][bj], g); unpk8(nv[m][bj], gn);
                    if (seg < 2) {
#pragma unroll
                        for (int n = 0; n < 2; ++n)
#pragma unroll
                            for (int j = 0; j < 4; ++j) acc[ai][bj][m][n][j] *= g[4 * n + j] * __builtin_amdgcn_rcpf(fmaxf(gn[4 * n + j], 1e-30f));
                    } else {
                        float o[8];
#pragma unroll
                        for (int n = 0; n < 2; ++n)
#pragma unroll
                            for (int j = 0; j < 4; ++j) o[4 * n + j] = acc[ai][bj][m][n][j] * g[4 * n + j];
                        *(u32x4*)(MG + (size_t)(rowb + ai * 128 + m * 16) * 1024 + colb + 128 * bj) = pk8(o);
                    }
                }
        }
    }
};
struct SegOrder3 : pg8::StaticOrder {
    const char* wsb;
    DI bool next(int i, Unit& u) const { const int base = i / 3; if (!pg8::StaticOrder::next(base, u)) return false; u.seg = i - 3 * base; return true; }
    DI const char* a_ptr(const pg8::Gemm&, const Unit& u) const {
        const long long off = (long long)WS_AO + (long long)(u.seg == 1) * ((long long)WS_HO - (long long)WS_AO) + (long long)(u.seg == 2) * ((long long)WS_MO - (long long)WS_AO);
        return wsb + off; }
    DI const char* b_ptr(const pg8::Gemm& g, const Unit& u) const { return (const char*)g.Bt + (size_t)u.seg * ((size_t)1024 * 512 * 2); }
};

template <class Epi> DI void run_gemm(LAS unsigned char* lds, const bf16* A, const bf16* Bt, int M, int N, int K, int rot, const Epi& E) {
    int Kv = K, Nv = N, Mv = M; asm volatile("" : "+s"(Kv), "+s"(Nv), "+s"(Mv));
    pg8::Gemm g{A, Bt, Mv, Nv, Kv}; pg8::StaticOrder S; const int G = (int)gridDim.x;
    S.init(Mv, Nv, G, (int)((blockIdx.x + (unsigned)G - (unsigned)rot) % (unsigned)G));
    pg8::gemm_phase<Epi, pg8::StaticOrder, true, true>(lds, g, S, E);
}

#define MFMA32(a, b, c) __builtin_amdgcn_mfma_f32_32x32x16_bf16((a), (b), (c), 0, 0, 0)
template <int DQK, int DV, bool CAUSAL>
DI void attn_tile(const LAS unsigned char* kb, const LAS unsigned char* vb, const bf16x8 (&qf)[DQK / 16], f32x16 (&o)[DV / 32], float& mrun, float& lrun, int t, int qlo, int r, int h) {
    constexpr int KROW = DQK * 2 + 16, VROW = 136, KS = DQK / 16, NDB = DV / 32;
    f32x16 s0, s1;
    const float negm = -mrun;
#pragma unroll
    for (int i = 0; i < 16; ++i) { s0[i] = negm; s1[i] = negm; }
#pragma unroll
    for (int ks = 0; ks < KS; ++ks) {
        const bf16x8 k0 = *(const LAS bf16x8*)(kb + r * KROW + 32 * ks + 16 * h);
        const bf16x8 k1 = *(const LAS bf16x8*)(kb + (32 + r) * KROW + 32 * ks + 16 * h);
        s0 = MFMA32(k0, qf[ks], s0); s1 = MFMA32(k1, qf[ks], s1);
    }
    if (CAUSAL && (64 * t + 63 > qlo)) {
        const int qpos = qlo + r, kbase = 64 * t + 4 * h;
#pragma unroll
        for (int i = 0; i < 16; ++i) { const int key = kbase + (i & 3) + 8 * (i >> 2);
            if (key > qpos) s0[i] = -1e30f; if (key + 32 > qpos) s1[i] = -1e30f; }
    }
    float mx = fmaxf(s0[0], s1[0]);
#pragma unroll
    for (int i = 1; i < 16; ++i) mx = fmaxf(mx, fmaxf(s0[i], s1[i]));
    mx = fmaxf(mx, __shfl_xor(mx, 32));
    if (__builtin_amdgcn_ballot_w64(mx > 8.0f) != 0ull) {
        const float delta = fmaxf(mx, 0.f), alpha = __builtin_amdgcn_exp2f(-delta);
        mrun += delta; lrun *= alpha;
#pragma unroll
        for (int i = 0; i < 16; ++i) { s0[i] -= delta; s1[i] -= delta; }
#pragma unroll
        for (int db = 0; db < NDB; ++db)
#pragma unroll
            for (int i = 0; i < 16; ++i) o[db][i] *= alpha;
    }
    float ps = 0.f;
#pragma unroll
    for (int i = 0; i < 16; ++i) { s0[i] = __builtin_amdgcn_exp2f(s0[i]); s1[i] = __builtin_amdgcn_exp2f(s1[i]); ps += s0[i] + s1[i]; }
    lrun += ps;
#pragma unroll
    for (int kb2 = 0; kb2 < 2; ++kb2)
#pragma unroll
        for (int s = 0; s < 2; ++s) {
            u32x4 pw;
            if (kb2 == 0) { pw.x = pk2(s0[8 * s], s0[8 * s + 1]); pw.y = pk2(s0[8 * s + 2], s0[8 * s + 3]); pw.z = pk2(s0[8 * s + 4], s0[8 * s + 5]); pw.w = pk2(s0[8 * s + 6], s0[8 * s + 7]); }
            else { pw.x = pk2(s1[8 * s], s1[8 * s + 1]); pw.y = pk2(s1[8 * s + 2], s1[8 * s + 3]); pw.z = pk2(s1[8 * s + 4], s1[8 * s + 5]); pw.w = pk2(s1[8 * s + 6], s1[8 * s + 7]); }
            const bf16x8 pf = __builtin_bit_cast(bf16x8, pw);
            const int koff = (32 * kb2 + 16 * s + 4 * h) * 2;
#pragma unroll
            for (int db = 0; db < NDB; ++db) {
                const u32x2 lo = *(const LAS u32x2*)(vb + (32 * db + r) * VROW + koff), hi = *(const LAS u32x2*)(vb + (32 * db + r) * VROW + koff + 16);
                u32x4 vw; vw.x = lo.x; vw.y = lo.y; vw.z = hi.x; vw.w = hi.y;
                o[db] = MFMA32(__builtin_bit_cast(bf16x8, vw), pf, o[db]);
            }
        }
}

template <int DQK, int DV, bool CAUSAL>
DI void attn_item(LAS unsigned char* lds, const bf16* Qp, int qstride, const bf16* Kp, const bf16* VTp, int vt_stride, bf16* Op, int ostride, int q0, int nkeys,
                  const float* ssqq, const float* cosT, const float* sinT) {
    constexpr int KROW = DQK * 2 + 16, VROW = 136, KBYTES = 64 * KROW, VBYTES = DV * VROW, BUF = KBYTES + VBYTES;
    constexpr int NCK = 64 * DQK / 8, NCV = DV * 8, KS = DQK / 16, NDB = DV / 32;
    constexpr int CPR = DQK / 8;
    int tid_o = threadIdx.x; asm volatile("" : "+v"(tid_o)); const int tid = tid_o, wid = __builtin_amdgcn_readfirstlane(tid >> 6), lane = tid & 63, r = lane & 31, h = lane >> 5;
    const int ntiles = CAUSAL ? (q0 + 256) / 64 : nkeys / 64;
    const int qlo = q0 + wid * 32;
    bf16x8 qf[KS];
    { const bf16* qr = Qp + (size_t)(wid * 32 + r) * qstride + 8 * h;
#pragma unroll
      for (int ks = 0; ks < KS; ++ks) qf[ks] = *(const bf16x8*)(qr + 16 * ks);
      if (CAUSAL) {
          const float* sp = ssqq + (size_t)(wid * 32 + r) * 16;
          const f32x4 a = *(const f32x4*)sp, b = *(const f32x4*)(sp + 4), c = *(const f32x4*)(sp + 8);
          const float rs = rsqrtf((((a.x + a.y) + (a.z + a.w)) + ((b.x + b.y) + (b.z + b.w)) + ((c.x + c.y) + (c.z + c.w))) * (1.0f / 384.0f) + EPS) * QSCALE_MLA;
#pragma unroll
          for (int ks = 0; ks < KS; ++ks) {
              float v[8]; unpk8(__builtin_bit_cast(u32x4, qf[ks]), v);
              if (ks >= 4) {
                  const int i0 = 8 * (ks - 4) + 4 * h;
                  const f32x4 cs = *(const f32x4*)(cosT + (size_t)(wid * 32 + r) * 16 + i0), sn = *(const f32x4*)(sinT + (size_t)(wid * 32 + r) * 16 + i0);
                  const float t0 = v[0], t1 = v[1], t2 = v[2], t3 = v[3], t4 = v[4], t5 = v[5], t6 = v[6], t7 = v[7];
                  v[0] = t0 * cs.x - t1 * sn.x; v[1] = t1 * cs.x + t0 * sn.x; v[2] = t2 * cs.y - t3 * sn.y; v[3] = t3 * cs.y + t2 * sn.y;
                  v[4] = t4 * cs.z - t5 * sn.z; v[5] = t5 * cs.z + t4 * sn.z; v[6] = t6 * cs.w - t7 * sn.w; v[7] = t7 * cs.w + t6 * sn.w;
              }
#pragma unroll
              for (int e = 0; e < 8; ++e) v[e] *= rs;
              qf[ks] = __builtin_bit_cast(bf16x8, pk8(v));
          }
      } }
    f32x16 o[NDB];
#pragma unroll
    for (int db = 0; db < NDB; ++db)
#pragma unroll
        for (int i = 0; i < 16; ++i) o[db][i] = 0.f;
    float mrun = 0.f, lrun = 0.f;
    const int kc0 = tid, kc1 = tid + 512; const bool k1on = kc1 < NCK;
    const int kr0 = kc0 / CPR, kcc0 = kc0 % CPR, kr1 = kc1 / CPR, kcc1 = kc1 % CPR;
    const int vc0 = tid, vc1 = tid + 512; const bool v1on = vc1 < NCV;
    const GAS u32x4* Kg = (const GAS u32x4*)Kp;
    u32x4 ak0, ak1 = {0, 0, 0, 0}, av0, av1 = {0, 0, 0, 0}, bk0, bk1 = {0, 0, 0, 0}, bv0, bv1 = {0, 0, 0, 0};
#define ATT_GLOAD(P, t_) do { P##k0 = Kg[(size_t)(t_) * NCK + kc0]; if (k1on) P##k1 = Kg[(size_t)(t_) * NCK + kc1]; \
        P##v0 = *(const GAS u32x4*)(VTp + (size_t)(vc0 >> 3) * vt_stride + (t_) * 64 + (vc0 & 7) * 8); \
        if (v1on) P##v1 = *(const GAS u32x4*)(VTp + (size_t)(vc1 >> 3) * vt_stride + (t_) * 64 + (vc1 & 7) * 8); } while (0)
#define ATT_LSTORE(P, buf_) do { LAS unsigned char* kb_ = lds + (buf_) * BUF; LAS unsigned char* vb_ = kb_ + KBYTES; \
        *(LAS u32x4*)(kb_ + kr0 * KROW + kcc0 * 16) = P##k0; if (k1on) *(LAS u32x4*)(kb_ + kr1 * KROW + kcc1 * 16) = P##k1; \
        { LAS u32x2* d_ = (LAS u32x2*)(vb_ + (vc0 >> 3) * VROW + (vc0 & 7) * 16); d_[0] = (u32x2){P##v0.x, P##v0.y}; d_[1] = (u32x2){P##v0.z, P##v0.w}; } \
        if (v1on) { LAS u32x2* d_ = (LAS u32x2*)(vb_ + (vc1 >> 3) * VROW + (vc1 & 7) * 16); d_[0] = (u32x2){P##v1.x, P##v1.y}; d_[1] = (u32x2){P##v1.z, P##v1.w}; } } while (0)
    ATT_GLOAD(a, 0); ATT_LSTORE(a, 0);
    if (ntiles > 1) ATT_GLOAD(a, 1);
    __syncthreads();
    for (int t = 0; t < ntiles; t += 2) {
        if (t + 2 < ntiles) ATT_GLOAD(b, t + 2);
        if (!CAUSAL || (64 * t <= qlo + 31)) attn_tile<DQK, DV, CAUSAL>(lds, lds + KBYTES, qf, o, mrun, lrun, t, qlo, r, h);
        if (t + 1 < ntiles) ATT_LSTORE(a, 1);
        __syncthreads();
        if (t + 1 < ntiles) {
            if (t + 3 < ntiles) ATT_GLOAD(a, t + 3);
            if (!CAUSAL || (64 * (t + 1) <= qlo + 31)) attn_tile<DQK, DV, CAUSAL>(lds + BUF, lds + BUF + KBYTES, qf, o, mrun, lrun, t + 1, qlo, r, h);
            if (t + 2 < ntiles) ATT_LSTORE(b, 0);
            __syncthreads();
        }
    }
#undef ATT_GLOAD
#undef ATT_LSTORE
    const float ltot = lrun + __shfl_xor(lrun, 32), inv = 1.0f / ltot;
    bf16* orow = Op + (size_t)(wid * 32 + r) * ostride + 4 * h;
#pragma unroll
    for (int db = 0; db < NDB; ++db)
#pragma unroll
        for (int g = 0; g < 4; ++g) {
            u32x2 w; w.x = pk2(o[db][4 * g] * inv, o[db][4 * g + 1] * inv); w.y = pk2(o[db][4 * g + 2] * inv, o[db][4 * g + 3] * inv);
            *(u32x2*)(orow + 32 * db + 8 * g) = w;
        }
}

template <int KSTEPS> DI void lds_mma(f32x16& c, const LAS unsigned char* A, int astride, const LAS unsigned char* Bt, int bstride, int r, int h) {
#pragma unroll
    for (int s = 0; s < KSTEPS; ++s) {
        const bf16x8 a = *(const LAS bf16x8*)(A + r * astride + 32 * s + 16 * h);
        const bf16x8 b = *(const LAS bf16x8*)(Bt + r * bstride + 32 * s + 16 * h);
        c = MFMA32(a, b, c);
    }
}

DI void hgrn_b1(LAS unsigned char* lds, int ch, float* GG, const bf16* HK, const bf16* HV, bf16* LT, float* DEC) {
    int tid_o = threadIdx.x; asm volatile("" : "+v"(tid_o)); const int tid = tid_o, wid = __builtin_amdgcn_readfirstlane(tid >> 6), lane = tid & 63, r = lane & 31, h = lane >> 5;
    const int bh = ch >> 6, c = ch & 63, b = bh >> 2, hd = bh & 3;
    const size_t t0 = (size_t)b * SEQ + c * 64;
    const int k = tid & 127, seg = tid >> 7;
    LAS float* segsum = (LAS float*)lds;
    LAS unsigned char* kdT = lds + 2048;
    LAS unsigned char* vT = kdT + 128 * 144;
    float g[16]; float run = 0.f;
    float* gp = GG + (t0 + seg * 16) * 512 + hd * 128 + k;
#pragma unroll
    for (int i = 0; i < 16; ++i) { run += gp[(size_t)i * 512]; g[i] = run; }
    segsum[seg * 128 + k] = run;
    __syncthreads();
    float off = 0.f, tot = 0.f;
#pragma unroll
    for (int s = 0; s < 4; ++s) { const float v = segsum[s * 128 + k]; if (s < seg) off += v; tot += v; }
    const bf16* kp = HK + (t0 + seg * 16) * 512 + hd * 128 + k;
    const bf16* vp = HV + (t0 + seg * 16) * 512 + hd * 128 + k;
#pragma unroll
    for (int i = 0; i < 16; ++i) {
        const float G = g[i] + off; gp[(size_t)i * 512] = G;
        const float kd = bf2f(kp[(size_t)i * 512]) * __expf(tot - G);
        *(LAS bf16*)(kdT + k * 144 + (seg * 16 + i) * 2) = f2bf(kd);
        *(LAS bf16*)(vT + k * 144 + (seg * 16 + i) * 2) = vp[(size_t)i * 512];
    }
    if (seg == 0) DEC[(size_t)ch * 128 + k] = __expf(tot);
    __syncthreads();
    const int vb = wid >> 1;
#pragma unroll
    for (int q = 0; q < 2; ++q) {
        const int kb = (wid & 1) * 2 + q;
        f32x16 acc;
#pragma unroll
        for (int i = 0; i < 16; ++i) acc[i] = 0.f;
        lds_mma<4>(acc, vT + vb * 32 * 144, 144, kdT + kb * 32 * 144, 144, r, h);
        bf16* lp = LT + (size_t)ch * 16384 + (size_t)(vb * 32 + 4 * h) * 128 + kb * 32 + r;
#pragma unroll
        for (int i = 0; i < 16; ++i) lp[(size_t)((i & 3) + 8 * (i >> 2)) * 128] = f2bf(acc[i]);
    }
    __syncthreads();
}

DI void hgrn_b3(LAS unsigned char* lds, int ch, const float* GG, const bf16* HQ, const bf16* HK, const bf16* HV, const bf16* HGT, const bf16* LT, const float* onorm, bf16* HO) {
    constexpr int RS = 272;
    int tid_o = threadIdx.x; asm volatile("" : "+v"(tid_o)); const int tid = tid_o, wid = __builtin_amdgcn_readfirstlane(tid >> 6), lane = tid & 63, r = lane & 31, h = lane >> 5;
    const int bh = ch >> 6, c = ch & 63, b = bh >> 2, hd = bh & 3;
    const size_t t0 = (size_t)b * SEQ + c * 64;
    LAS unsigned char* qG = lds;
    LAS unsigned char* q1 = qG + 64 * RS;
    LAS unsigned char* kA0 = q1 + 32 * RS;
    LAS unsigned char* kA1 = kA0 + 32 * RS;
    LAS unsigned char* ST = kA1 + 64 * RS;
    LAS unsigned char* vT = ST + 128 * RS;
    LAS unsigned char* Am = vT + 128 * 144;
    {
        const int k8 = tid & 15;
        const float* g31p = GG + (t0 + 31) * 512 + hd * 128 + k8 * 8;
        const f32x4 ga = *(const f32x4*)g31p, gb = *(const f32x4*)(g31p + 4);
        const float g31[8] = {ga.x, ga.y, ga.z, ga.w, gb.x, gb.y, gb.z, gb.w};
#pragma unroll
        for (int pass = 0; pass < 2; ++pass) {
            const int t = (tid >> 4) + 32 * pass;
            const size_t off = (t0 + t) * 512 + hd * 128 + k8 * 8;
            const f32x4 a = *(const f32x4*)(GG + off), bq = *(const f32x4*)(GG + off + 4);
            const float G[8] = {a.x, a.y, a.z, a.w, bq.x, bq.y, bq.z, bq.w};
            float q[8], kk[8], o1[8], o2[8], o3[8];
            unpk8(*(const u32x4*)(HQ + off), q); unpk8(*(const u32x4*)(HK + off), kk);
#pragma unroll
            for (int e = 0; e < 8; ++e) o1[e] = q[e] * __expf(G[e]);
            *(LAS u32x4*)(qG + t * RS + k8 * 16) = pk8(o1);
            if (pass == 0) {
#pragma unroll
                for (int e = 0; e < 8; ++e) { o2[e] = kk[e] * __expf(fminf(-G[e], 80.f)); o3[e] = kk[e] * __expf(g31[e] - G[e]); }
                *(LAS u32x4*)(kA0 + t * RS + k8 * 16) = pk8(o2);
                *(LAS u32x4*)(kA1 + t * RS + k8 * 16) = pk8(o3);
            } else {
#pragma unroll
                for (int e = 0; e < 8; ++e) { o2[e] = q[e] * __expf(G[e] - g31[e]); o3[e] = kk[e] * __expf(fminf(g31[e] - G[e], 80.f)); }
                *(LAS u32x4*)(q1 + (t - 32) * RS + k8 * 16) = pk8(o2);
                *(LAS u32x4*)(kA1 + t * RS + k8 * 16) = pk8(o3);
            }
        }
        const bf16* lp = LT + (size_t)ch * 16384;
#pragma unroll
        for (int p = 0; p < 4; ++p) {
            const int idx = tid + 512 * p, v = idx >> 4, kk8 = idx & 15;
            *(LAS u32x4*)(ST + v * RS + kk8 * 16) = *(const u32x4*)(lp + v * 128 + kk8 * 8);
        }
        const int v = tid & 127, seg = tid >> 7;
        const bf16* vp = HV + (t0 + seg * 16) * 512 + hd * 128 + v;
#pragma unroll
        for (int i = 0; i < 16; ++i) *(LAS bf16*)(vT + v * 144 + (seg * 16 + i) * 2) = vp[(size_t)i * 512];
    }
    __syncthreads();
    if (wid < 3) {
        f32x16 a;
#pragma unroll
        for (int i = 0; i < 16; ++i) a[i] = 0.f;
        const int tb = wid == 0 ? 0 : 1, sb = wid == 2 ? 1 : 0;
        if (wid == 0) lds_mma<8>(a, qG, RS, kA0, RS, r, h);
        else lds_mma<8>(a, q1, RS, kA1 + sb * 32 * RS, RS, r, h);
#pragma unroll
        for (int i = 0; i < 16; ++i) { const int tl = (i & 3) + 8 * (i >> 2) + 4 * h; float val = a[i]; if (tb == sb && r > tl) val = 0.f;
            *(LAS bf16*)(Am + (tb * 32 + tl) * 144 + (sb * 32 + r) * 2) = f2bf(val); }
    } else if (wid == 3) {
#pragma unroll
        for (int i = 0; i < 16; ++i) { const int tl = (i & 3) + 8 * (i >> 2) + 4 * h; *(LAS bf16*)(Am + tl * 144 + (32 + r) * 2) = (bf16)0; }
    }
    __syncthreads();
    f32x16 acc;
#pragma unroll
    for (int i = 0; i < 16; ++i) acc[i] = 0.f;
    const int tb = wid >> 2, vb = wid & 3;
    lds_mma<8>(acc, qG + tb * 32 * RS, RS, ST + vb * 32 * RS, RS, r, h);
    lds_mma<4>(acc, Am + tb * 32 * 144, 144, vT + vb * 32 * 144, 144, r, h);
    __syncthreads();
    LAS float* Ost = (LAS float*)ST;
#pragma unroll
    for (int i = 0; i < 16; ++i) Ost[(tb * 32 + (i & 3) + 8 * (i >> 2) + 4 * h) * 132 + vb * 32 + r] = acc[i];
    __syncthreads();
    {
        const int t = tid >> 3, part = tid & 7;
        float ov[16]; float ss = 0.f;
#pragma unroll
        for (int q4 = 0; q4 < 4; ++q4) { const f32x4 x = *(const LAS f32x4*)(Ost + t * 132 + part * 16 + q4 * 4); ov[4 * q4] = x.x; ov[4 * q4 + 1] = x.y; ov[4 * q4 + 2] = x.z; ov[4 * q4 + 3] = x.w; }
#pragma unroll
        for (int e = 0; e < 16; ++e) ss += ov[e] * ov[e];
        ss += __shfl_xor(ss, 1); ss += __shfl_xor(ss, 2); ss += __shfl_xor(ss, 4);
        const float rs = rsqrtf(ss * (1.0f / 128.0f) + EPS);
        const size_t off = (t0 + t) * 512 + hd * 128 + part * 16;
        float gt[16];
        unpk8(*(const u32x4*)(HGT + off), gt); unpk8(*(const u32x4*)(HGT + off + 8), gt + 8);
#pragma unroll
        for (int e = 0; e < 16; ++e) ov[e] = ov[e] * rs * onorm[part * 16 + e] * gt[e];
        *(u32x4*)(HO + off) = pk8(ov); *(u32x4*)(HO + off + 8) = pk8(ov + 8);
    }
    __syncthreads();
}

DI int dest_row(int mode, int n) {
    if (mode == 0) return n;
    if (mode == 1) { const int j = n < DFF ? n : n - DFF; return (j >> 7) * 256 + (n < DFF ? 0 : 128) + (j & 127); }
    if (mode == 2) { if (n < 640) return n; if (n < 672) { const int j = n - 640; return 640 + (j < 16 ? 2 * j : 2 * (j - 16) + 1); } if (n < 3232) return 768 + (n - 672); return 3328 + (n - 3232); }
    const int hd = n / 96, w = n - hd * 96; if (w < 64) return n; const int j = w - 64; return hd * 96 + 64 + (j < 16 ? 2 * j : 2 * (j - 16) + 1);
}
DI void conv_item(const float* W, int K, int N, bf16* WT, const float* gain, int mode, int row_off, LAS float* scr, int item, int lane) {
    const int nblk = N / 32, kb = item / nblk, nb = item - kb * nblk, k0 = 64 * kb, n0 = 32 * nb;
    float wv[32];
    const float* wp = W + (size_t)(k0 + (lane >> 5)) * N + n0 + (lane & 31);
#pragma unroll
    for (int i = 0; i < 32; ++i) wv[i] = __builtin_nontemporal_load(wp + (size_t)(2 * i) * N);
#pragma unroll
    for (int i = 0; i < 32; ++i) scr[(2 * i + (lane >> 5)) * 33 + (lane & 31)] = wv[i];
    asm volatile("s_waitcnt lgkmcnt(0)" ::: "memory");
    const int c = lane & 7;
    float gn[8];
#pragma unroll
    for (int e = 0; e < 8; ++e) gn[e] = gain ? gain[k0 + 8 * c + e] : 1.0f;
#pragma unroll
    for (int j = 0; j < 4; ++j) { const int n = (lane >> 3) + 8 * j; const LAS float* s = scr + (8 * c) * 33 + n;
        float v[8];
#pragma unroll
        for (int e = 0; e < 8; ++e) v[e] = s[e * 33] * gn[e];
        *(u32x4*)(WT + (size_t)(row_off + dest_row(mode, n0 + n)) * K + k0 + 8 * c) = pk8(v); }
    asm volatile("s_waitcnt lgkmcnt(0)" ::: "memory");
}

#define XB_TMO      128
#define XB_XCNT(j)  (256  + 64 * (j))
#define XB_XSUB(j)  (1280 + 64 * (j))
#define XB_XGEN(j)  (2304 + 64 * (j))
#define XB_TOP      3328
#define XB_TOPGEN   3392
#define XCD_BAR_WORDS 3456
#define XB_SPIN_CAP (1u << 18)
static_assert(XCD_BAR_WORDS * 4 <= CTL_BYTES, "barrier words inside the memset region");
DI unsigned xb_ld(unsigned* p)              { return __hip_atomic_load(p, __ATOMIC_RELAXED, __HIP_MEMORY_SCOPE_AGENT); }
DI unsigned xb_add(unsigned* p, unsigned v) { return __hip_atomic_fetch_add(p, v, __ATOMIC_RELAXED, __HIP_MEMORY_SCOPE_AGENT); }
DI unsigned xb_xcc_id() { return (unsigned)__builtin_amdgcn_s_getreg((3 << 11) | 20) & 0xFu; }
#define XB_SPIN(cond, bar) do { unsigned _sp = 0; while (cond) { __builtin_amdgcn_s_sleep(1); \
    if ((++_sp & 255u) == 0u) { if (xb_ld(&(bar)[XB_TMO])) break; if (_sp > XB_SPIN_CAP) { atomicAdd(&(bar)[XB_TMO], 1u); break; } } } } while (0)
struct XcdBarrier { unsigned* bar; unsigned x; volatile LAS unsigned* st; };
DI void xcd_barrier_complete(unsigned* bar, unsigned x, unsigned& nloc, unsigned& nx) {
    const unsigned G = gridDim.x * gridDim.y * gridDim.z;
    unsigned sum, cnt, mine, sp = 0u;
    for (;;) {
        sum = 0u; cnt = 0u; mine = 0u;
#pragma unroll
        for (unsigned j = 0; j < 16; ++j) { const unsigned c = xb_ld(&bar[XB_XCNT(j)]); sum += c; cnt += (c > 0u) ? 1u : 0u; mine = (j == x) ? c : mine; }
        if (sum == G) break;
        __builtin_amdgcn_s_sleep(1);
        if ((++sp & 255u) == 0u) { if (xb_ld(&bar[XB_TMO])) break; if (sp > XB_SPIN_CAP) { atomicAdd(&bar[XB_TMO], 1u); break; } }
    }
    nloc = mine > 0u ? mine : 1u; nx = cnt > 0u ? cnt : 1u;
}
DI void xcd_barrier(const XcdBarrier& b) {
    asm volatile("s_waitcnt vmcnt(0)" ::: "memory");
    __syncthreads();
    if (threadIdx.x == 0) {
        unsigned* bar = b.bar;
        __builtin_amdgcn_s_waitcnt(0);
        unsigned nloc = b.st[0], nx = b.st[1];
        if (nloc == 0u) { xcd_barrier_complete(bar, b.x, nloc, nx); b.st[0] = nloc; b.st[1] = nx; }
        const unsigned old = xb_add(&bar[XB_XSUB(b.x)], 1u);
        const unsigned gen = old / nloc;
        if (old + 1u == (gen + 1u) * nloc) {
            __builtin_amdgcn_fence(__ATOMIC_RELEASE, "agent");
            asm volatile("s_waitcnt vmcnt(0)" ::: "memory");
            const unsigned og = xb_add(&bar[XB_TOP], 1u);
            const unsigned tg = og / nx;
            if (og + 1u == (tg + 1u) * nx) xb_add(&bar[XB_TOPGEN], 1u);
            else XB_SPIN(xb_ld(&bar[XB_TOPGEN]) == tg, bar);
            __builtin_amdgcn_fence(__ATOMIC_ACQUIRE, "agent");
            xb_add(&bar[XB_XGEN(b.x)], 1u);
            asm volatile("s_waitcnt vmcnt(0)" ::: "memory");
        } else {
            XB_SPIN(xb_ld(&bar[XB_XGEN(b.x)]) == gen, bar);
            __builtin_amdgcn_fence(__ATOMIC_ACQUIRE, "agent");
            asm volatile("s_waitcnt vmcnt(0)" ::: "memory");
        }
    }
    __syncthreads();
}

struct Args { const void* in[25]; float* out; unsigned char* ws; int ph_lo, ph_hi; };
typedef const __attribute__((address_space(4))) unsigned long long* ka_t;
DI unsigned long long KA(int i) { ka_t p = (ka_t)__builtin_amdgcn_kernarg_segment_ptr(); asm volatile("" : "+s"(p)); return p[i]; }
#define KIN(i) ((const float*)KA(i))
#define KOUT ((float*)KA(25))
#define KWS ((unsigned char*)KA(26))

DI void conv_set(int mask, int l, int bpart, int nbparts, LAS unsigned char* lds) {
    int tid_o = threadIdx.x; asm volatile("" : "+v"(tid_o)); const int tid = tid_o, wave = __builtin_amdgcn_readfirstlane(tid >> 6), lane = tid & 63;
    const int part = bpart * NWAVES + wave, nparts = nbparts * NWAVES, tpart = bpart * NTHREADS + tid, ntparts = nbparts * NTHREADS;
    LAS float* scr = (LAS float*)(lds + wave * 16384);
    unsigned char* ws = KWS;
    constexpr int I_FI = 16 * 176, I_FO = 44 * 32, I_WIN = 16 * 197, I_UQ = 6 * 24, I_UK = 4 * 16, I_WO = 8 * 32, I_SQ = 16 * 32;
    if (mask & 1) {
        const float* f1n = KIN(3) + l * 1024; const float* w1i = KIN(4) + (size_t)l * 1024 * 5632; const float* w1o = KIN(5) + (size_t)l * 2816 * 1024;
        for (int it = part; it < I_FI + I_FO; it += nparts) {
            if (it < I_FI) conv_item(w1i, 1024, 5632, (bf16*)(ws + WT_W1IN), f1n, 1, 0, scr, it, lane);
            else conv_item(w1o, 2816, 1024, (bf16*)(ws + WT_W1OUT), nullptr, 0, 0, scr, it - I_FI, lane);
        }
    }
    if (mask & 4) {
        const float* f2n = KIN(21) + l * 1024; const float* w2i = KIN(22) + (size_t)l * 1024 * 5632; const float* w2o = KIN(23) + (size_t)l * 2816 * 1024;
        for (int it = part; it < I_FI + I_FO; it += nparts) {
            if (it < I_FI) conv_item(w2i, 1024, 5632, (bf16*)(ws + WT_W2IN), f2n, 1, 0, scr, it, lane);
            else conv_item(w2o, 2816, 1024, (bf16*)(ws + WT_W2OUT), nullptr, 0, 0, scr, it - I_FI, lane);
        }
    }
    if (mask & 2) {
        const float* mxn = KIN(6) + l * 1024; const float* win = KIN(7) + (size_t)l * 1024 * DIN;
        for (int it = part; it < I_WIN; it += nparts) conv_item(win, 1024, DIN, (bf16*)(ws + WT_WIN), mxn, 2, 0, scr, it, lane);
        u32x4* pad = (u32x4*)(ws + WT_WIN + (size_t)672 * 1024 * 2);
        unsigned zz = 0u; asm volatile("" : "+v"(zz));
        for (int i = tpart; i < 96 * 1024 * 2 / 16; i += ntparts) pad[i] = (u32x4){zz, zz, zz, zz};
    }
    if (mask & 8) {
        const float* qln = KIN(8) + l * 384; const float* kvn = KIN(9) + l * 256;
        const float* wuq = KIN(10) + (size_t)l * 384 * 768; const float* wuk = KIN(11) + (size_t)l * 256 * 512; const float* wuv = KIN(12) + (size_t)l * 256 * 512;
        const float* womla = KIN(13) + (size_t)l * 512 * 1024; const float* wohg = KIN(16) + (size_t)l * 512 * 1024; const float* womem = KIN(19) + (size_t)l * 512 * 1024;
        const float* wout = KIN(20) + (size_t)l * 1024 * 1024;
        constexpr int NIT = I_UQ + 2 * I_UK + 3 * I_WO + I_SQ;
        for (int it = part; it < NIT; it += nparts) {
            int r = it;
            if (r < I_UQ) { conv_item(wuq, 384, 768, (bf16*)(ws + WT_WUQ), qln, 3, 0, scr, r, lane); continue; } r -= I_UQ;
            if (r < I_UK) { conv_item(wuk, 256, 512, (bf16*)(ws + WT_WUKV), kvn, 0, 0, scr, r, lane); continue; } r -= I_UK;
            if (r < I_UK) { conv_item(wuv, 256, 512, (bf16*)(ws + WT_WUKV), kvn, 0, 512, scr, r, lane); continue; } r -= I_UK;
            if (r < I_WO) { conv_item(womla, 512, 1024, (bf16*)(ws + WT_WOMLA), nullptr, 0, 0, scr, r, lane); continue; } r -= I_WO;
            if (r < I_WO) { conv_item(wohg, 512, 1024, (bf16*)(ws + WT_WOHG), nullptr, 0, 0, scr, r, lane); continue; } r -= I_WO;
            if (r < I_WO) { conv_item(womem, 512, 1024, (bf16*)(ws + WT_WOMEM), nullptr, 0, 0, scr, r, lane); continue; } r -= I_WO;
            conv_item(wout, 1024, 1024, (bf16*)(ws + WT_WOUT), nullptr, 0, 0, scr, r, lane);
        }
    }
    if (mask & 16) {
        const float* memn = KIN(17); const float* wmkv = KIN(18);
        for (int it = part; it < 4 * I_SQ; it += nparts) { const int ll = it / I_SQ, r = it - ll * I_SQ;
            conv_item(wmkv + (size_t)ll * 1024 * 1024, 1024, 1024, (bf16*)(ws + WT_WMEMKV) + (size_t)ll * 1024 * 1024, memn + ll * 1024, 0, 0, scr, r, lane); }
    }
    __syncthreads();
}
DI void conv_tail(int mask, int l, int nwg, LAS unsigned char* lds) {
    const int G = (int)gridDim.x, rem = nwg % G, c = (int)blockIdx.x;
    if (c < rem) return;
    conv_set(mask, l, c - rem, G - rem, lds);
}

DI void prep_phase() {
    int tid_o = threadIdx.x; asm volatile("" : "+v"(tid_o)); const int tid = tid_o, wave = __builtin_amdgcn_readfirstlane(tid >> 6), lane = tid & 63;
    const int gw = blockIdx.x * NWAVES + wave, NGW = gridDim.x * NWAVES;
    unsigned char* ws = KWS;
    const float* x = KIN(0); const float* mem = KIN(1); const int* pos = (const int*)KA(2);
    bf16* XB = (bf16*)(ws + WS_XB); float* SSQ = (float*)(ws + WS_SSQ);
    for (int m = gw; m < T; m += NGW) {
        const f32x4* xr = (const f32x4*)(x + (size_t)m * D) + lane; u32x2* xb = (u32x2*)(XB + (size_t)m * D) + lane;
        float s = 0.f;
#pragma unroll
        for (int j = 0; j < 4; ++j) { const f32x4 v = xr[64 * j]; u32x2 w; w.x = pk2(v.x, v.y); w.y = pk2(v.z, v.w); xb[64 * j] = w;
            const float a = bflo(w.x), b = bfhi(w.x), c = bflo(w.y), d = bfhi(w.y); s += (a * a + b * b) + (c * c + d * d); }
        s = wave_sum(s);
        if (lane < 16) SSQ[(size_t)m * 16 + lane] = lane == 0 ? s : 0.f;
    }
    bf16* MEMB = (bf16*)(ws + WS_MEMB); float* MRS = (float*)(ws + WS_MEMRSTD);
    for (int m = gw; m < 1024; m += NGW) {
        const f32x4* xr = (const f32x4*)(mem + (size_t)m * D) + lane; u32x2* xb = (u32x2*)(MEMB + (size_t)m * D) + lane;
        float s = 0.f;
#pragma unroll
        for (int j = 0; j < 4; ++j) { const f32x4 v = xr[64 * j]; s += (v.x * v.x + v.y * v.y) + (v.z * v.z + v.w * v.w); u32x2 w; w.x = pk2(v.x, v.y); w.y = pk2(v.z, v.w); xb[64 * j] = w; }
        s = wave_sum(s);
        if (lane == 0) MRS[m] = rsqrtf(s * (1.0f / 1024.0f) + EPS);
    }
    float* COS = (float*)(ws + WS_COS); float* SIN = (float*)(ws + WS_SIN);
    for (int i = blockIdx.x * NTHREADS + tid; i < T * 16; i += gridDim.x * NTHREADS) {
        const int row = i >> 4, fi = i & 15;
        const float invf = exp2f(-13.287712379549449f * (float)fi * (1.0f / 16.0f));
        const float ang = (float)pos[row] * invf;
        const float kq = rintf(ang * 0.15915494309189535f);
        float rr = fmaf(-kq, 6.28125f, ang); rr = fmaf(-kq, 1.9353071795864769e-3f, rr);
        COS[i] = __cosf(rr); SIN[i] = __sinf(rr);
    }
    const float* hlb = KIN(14); float* LBS = (float*)(ws + WS_LBS);
    for (int i = blockIdx.x * NTHREADS + tid; i < 512; i += gridDim.x * NTHREADS) {
        const float a0 = hlb[i], a1 = hlb[512 + i], a2 = hlb[1024 + i], a3 = hlb[1536 + i];
        const float mx = fmaxf(fmaxf(a0, a1), fmaxf(a2, a3));
        const float e0 = __expf(a0 - mx), e1 = __expf(a1 - mx), e2 = __expf(a2 - mx), e3 = __expf(a3 - mx), inv = 1.0f / (e0 + e1 + e2 + e3);
        LBS[i] = 0.f; LBS[512 + i] = e1 * inv; LBS[1024 + i] = (e1 + e2) * inv; LBS[1536 + i] = (e1 + e2 + e3) * inv;
    }
}

__global__ void __launch_bounds__(NTHREADS, 2) fwd_kernel(Args A_unused) {
    extern __shared__ __attribute__((aligned(16))) unsigned char lds_raw[];
    LAS unsigned char* lds = (LAS unsigned char*)lds_raw;
    cg::grid_group grid = cg::this_grid();
    int ph = 0;
    int lo, hi; { const unsigned long long w = KA(27); lo = (int)(unsigned)w; hi = (int)(unsigned)(w >> 32); }
#define RUN (ph >= lo && ph < hi)
    volatile LAS unsigned* bst = (volatile LAS unsigned*)(lds + 131072 + 512);
    if (threadIdx.x < 2) bst[threadIdx.x] = 0u;
    __syncthreads();
    if (threadIdx.x == 0) (void)xb_add(&((unsigned*)(KWS + WS_CTL))[XB_XCNT(xb_xcc_id())], 1u);
#define SEAM do { if (ph >= lo && ph + 1 < hi) { if (ph == 1) grid.sync(); else { XcdBarrier xb_; xb_.bar = (unsigned*)(KWS + WS_CTL); xb_.x = xb_xcc_id(); xb_.st = bst; xcd_barrier(xb_); } } ++ph; } while (0)
#define WSP(T_, name, off) T_* name = (T_*)(ws + (off))
#define REPEAT(n_) for (int rep_ = 0; rep_ < (n_); ++rep_, ((rep_ < (n_)) ? xcd_barrier(XcdBarrier{(unsigned*)(KWS + WS_CTL), xb_xcc_id(), bst}) : (void)0))

    if (RUN) { prep_phase(); }
    ++ph;
    for (int l = 0; l < DEPTH; ++l) {
        if (l == 0) {
            if (RUN) conv_set(1 | 2 | 16, 0, (int)blockIdx.x, (int)gridDim.x, lds);
            SEAM;
        }
#ifdef PROBE_NULL_P1
        if (RUN) { unsigned char* ws = KWS; PROBE_NULL_P1 E{(bf16*)(ws + WS_H)}; run_gemm(lds, (const bf16*)(ws + WS_XB), (const bf16*)(ws + WT_W1IN), T, 5632, 1024, 0, E);
            XcdBarrier xb_; xb_.bar = (unsigned*)(KWS + WS_CTL); xb_.x = xb_xcc_id(); xb_.st = bst; xcd_barrier(xb_); }
#endif
#ifndef SKIP_G1
        if (RUN) REPEAT(REP_P1) { unsigned char* ws = KWS; EpiSwiglu E{(bf16*)(ws + WS_H), (const float*)(ws + WS_SSQ), lds}; run_gemm(lds, (const bf16*)(ws + WS_XB), (const bf16*)(ws + WT_W1IN), T, 5632, 1024, 0, E);
            if (l == 0) {
                const int rem = (64 * 22) % (int)gridDim.x;
#pragma unroll 1
                for (int ll = 0; ll < DEPTH; ++ll) { unsigned char* ws2 = KWS; EpiMemKV E2{(bf16*)(ws2 + WS_MK) + (size_t)ll * 16 * 256 * 128, (bf16*)(ws2 + WS_MVT) + (size_t)ll * 16 * 128 * 256, (const float*)(ws2 + WS_MEMRSTD)};
                    run_gemm(lds, (const bf16*)(ws2 + WS_MEMB), (const bf16*)(ws2 + WT_WMEMKV) + (size_t)ll * 1024 * 1024, 1024, 1024, 1024, (rem + 16 * ll) % (int)gridDim.x, E2); }
            } else conv_tail(2, l, 64 * 22, lds);
        }
#endif
        SEAM;
#ifndef SKIP_G2
        if (RUN) { unsigned char* ws = KWS; EpiResid E{(bf16*)(ws + WS_XB), (float*)(ws + WS_SSQ), 0.5f}; run_gemm(lds, (const bf16*)(ws + WS_H), (const bf16*)(ws + WT_W1OUT), T, 1024, DFF, 0, E); }
#endif
        SEAM;
#ifndef SKIP_WIN
        if (RUN) REPEAT(REP_P3) { unsigned char* ws = KWS;
            EpiWin E{ws, (const float*)(ws + WS_LBS) + l * 512, lds};
            run_gemm(lds, (const bf16*)(ws + WS_XB), (const bf16*)(ws + WT_WIN), T, NIN, 1024, 0, E);
            conv_tail(4 | 8, l, 64 * 25, lds); }
#endif
        SEAM;
        if (RUN) {
#ifndef SKIP_G4
            REPEAT(REP_P4G) {
            { unsigned char* ws = KWS; EpiQ E{(bf16*)(ws + WS_Q)}; run_gemm(lds, (const bf16*)(ws + WS_CQ), (const bf16*)(ws + WT_WUQ), T, 768, 384, 0, E); }
            { unsigned char* ws = KWS; EpiKV E{(bf16*)(ws + WS_KC), (bf16*)(ws + WS_VT), (const float*)(ws + WS_SSQKV)}; run_gemm(lds, (const bf16*)(ws + WS_CKV), (const bf16*)(ws + WT_WUKV), T, 1024, 256, 64, E); }
            }
#endif
#ifndef SKIP_B1
            { unsigned char* ws = KWS; const int G = (int)gridDim.x;
              for (int ch = (int)blockIdx.x; ch < 1024; ch += G) hgrn_b1(lds, ch, (float*)(ws + WS_GG), (const bf16*)(ws + WS_HK), (const bf16*)(ws + WS_HV), (bf16*)(ws + WS_LT), (float*)(ws + WS_DEC)); }
#endif
        }
        SEAM;
        if (RUN) {
            unsigned char* ws = KWS; int tid_o = threadIdx.x; asm volatile("" : "+v"(tid_o)); const int G = (int)gridDim.x, bid = (int)blockIdx.x, tid = tid_o;
#ifndef SKIP_MLA
            REPEAT(REP_MLA) for (int it = bid; it < 256; it += G) {
                const int bh = it >> 3, pr = it & 7, b = bh >> 3, hd = bh & 7;
#pragma unroll 1
                for (int half = 0; half < 2; ++half) {
                    const int qb = half == 0 ? 15 - pr : pr;
                    const size_t row0 = (size_t)b * SEQ + qb * 256;
                    attn_item<96, 64, true>(lds, (const bf16*)(ws + WS_Q) + row0 * 768 + hd * 96, 768, (const bf16*)(ws + WS_KC) + (size_t)bh * SEQ * 96, (const bf16*)(ws + WS_VT) + (size_t)bh * 64 * SEQ, SEQ,
                                            (bf16*)(ws + WS_AO) + row0 * 512 + hd * 64, 512, qb * 256, SEQ, (const float*)(ws + WS_SSQQ) + row0 * 16, (const float*)(ws + WS_COS) + row0 * 16, (const float*)(ws + WS_SIN) + row0 * 16);
                }
            }
#endif
            unsigned* LT2 = (unsigned*)(ws + WS_LT); const float* DEC = (const float*)(ws + WS_DEC);
            for (int gt = bid * NTHREADS + tid; gt < 16 * 8192; gt += G * NTHREADS) {
                const int bh = gt >> 13, e2 = gt & 8191, k = (e2 & 63) * 2;
                unsigned* lp = LT2 + (size_t)bh * 64 * 8192 + e2; const float* dp = DEC + (size_t)bh * 64 * 128 + k;
                float run0 = 0.f, run1 = 0.f;
#pragma unroll 8
                for (int c = 0; c < 64; ++c) { const unsigned tmp = lp[(size_t)c * 8192]; const f32x2_t d = *(const f32x2_t*)(dp + c * 128); lp[(size_t)c * 8192] = pk2(run0, run1); run0 = d.x * run0 + bflo(tmp); run1 = d.y * run1 + bfhi(tmp); }
            }
        }
        SEAM;
        if (RUN) REPEAT(REP_P6) {
            unsigned char* ws = KWS; const int G = (int)gridDim.x, bid = (int)blockIdx.x;
#ifndef SKIP_XATT
            for (int it = bid; it < 256; it += G) {
                const int b = it >> 6, hd = (it >> 4) & 3, qb = it & 15;
                const size_t row0 = (size_t)b * SEQ + qb * 256;
                attn_item<128, 128, false>(lds, (const bf16*)(ws + WS_MQ) + row0 * 512 + hd * 128, 512, (const bf16*)(ws + WS_MK) + (size_t)(l * 16 + b * 4 + hd) * 256 * 128, (const bf16*)(ws + WS_MVT) + (size_t)(l * 16 + b * 4 + hd) * 128 * 256, 256,
                                           (bf16*)(ws + WS_MO) + row0 * 512 + hd * 128, 512, 0, 256, nullptr, nullptr, nullptr);
            }
#endif
#ifndef SKIP_B3
            const float* onorm = KIN(15) + l * 128;
            for (int ch = bid; ch < 1024; ch += G) hgrn_b3(lds, ch, (const float*)(ws + WS_GG), (const bf16*)(ws + WS_HQ), (const bf16*)(ws + WS_HK), (const bf16*)(ws + WS_HV), (const bf16*)(ws + WS_HGT), (const bf16*)(ws + WS_LT), onorm, (bf16*)(ws + WS_HO));
#endif
        }
        SEAM;
#ifndef SKIP_G7
        if (RUN) REPEAT(REP_P7) {
            unsigned char* ws = KWS; EpiBranch3 E{(bf16*)(ws + WS_MERGED), (const bf16*)(ws + WS_GATES)};
            int Kv = 512, Nv = 1024, Mv = T; asm volatile("" : "+s"(Kv), "+s"(Nv), "+s"(Mv));
            pg8::Gemm g{(const bf16*)(ws + WS_AO), (const bf16*)(ws + WT_WOMLA), Mv, Nv, Kv};
            SegOrder3 S; S.init(Mv, Nv, (int)gridDim.x, (int)blockIdx.x); S.wsb = (const char*)ws;
            pg8::gemm_phase<EpiBranch3, SegOrder3, true, true>(lds, g, S, E);
        }
#endif
        SEAM;
#ifndef SKIP_G8
        if (RUN) { unsigned char* ws = KWS; EpiResid E{(bf16*)(ws + WS_XB), (float*)(ws + WS_SSQ), 1.0f}; run_gemm(lds, (const bf16*)(ws + WS_MERGED), (const bf16*)(ws + WT_WOUT), T, 1024, 1024, 0, E); }
#endif
        SEAM;
#ifndef SKIP_G9
        if (RUN) { unsigned char* ws = KWS; EpiSwiglu E{(bf16*)(ws + WS_H), (const float*)(ws + WS_SSQ), lds}; run_gemm(lds, (const bf16*)(ws + WS_XB), (const bf16*)(ws + WT_W2IN), T, 5632, 1024, 0, E);
            if (l + 1 < DEPTH) conv_tail(1, l + 1, 64 * 22, lds); }
#endif
        SEAM;
#ifndef SKIP_G10
        if (RUN) { unsigned char* ws = KWS; EpiResid E{(bf16*)(ws + WS_XB), (float*)(ws + WS_SSQ), 0.5f}; run_gemm(lds, (const bf16*)(ws + WS_H), (const bf16*)(ws + WT_W2OUT), T, 1024, DFF, 0, E); }
#endif
        SEAM;
    }
    if (RUN) {
        unsigned char* ws = KWS; float* X = KOUT; const float* SSQ = (const float*)(ws + WS_SSQ); const bf16* XB = (const bf16*)(ws + WS_XB);
        int tid_o = threadIdx.x; asm volatile("" : "+v"(tid_o)); const int tid = tid_o, wave = __builtin_amdgcn_readfirstlane(tid >> 6), lane = tid & 63, G = (int)gridDim.x;
        const float* fg = KIN(24);
        for (int m = (int)blockIdx.x * NWAVES + wave; m < T; m += G * NWAVES) {
            const float rs = rsqrtf(sum16(SSQ + (size_t)m * 16) * (1.0f / 1024.0f) + EPS);
            f32x4* xr = (f32x4*)(X + (size_t)m * D) + lane; const f32x4* gr = (const f32x4*)fg + lane; const u32x2* xb = (const u32x2*)(XB + (size_t)m * D) + lane;
#pragma unroll
            for (int j = 0; j < 4; ++j) { const u32x2 w = xb[64 * j]; const f32x4 g = gr[64 * j]; f32x4 v = {bflo(w.x), bfhi(w.x), bflo(w.y), bfhi(w.y)}; v = v * rs * g; xr[64 * j] = v; }
        }
    }
#undef RUN
#undef SEAM
}

constexpr int N_PHASES = 1 + 1 + DEPTH * 10 + 1;

extern "C" void kernel_launch(void* const* d_in, const int* in_sizes, int n_in, void* d_out, int out_size, void* d_ws, size_t ws_size, hipStream_t stream) {
    static int grid = 0;
    if (grid == 0) {
        if (n_in != 25 || out_size != T * D || ws_size < WS_END) { fprintf(stderr, "kernel_launch: unexpected shapes (n_in %d out %d ws %zu need %zu)\n", n_in, out_size, ws_size, (size_t)WS_END); grid = -1; return; }
        int dev = 0, cus = 0, per_cu = 0;
        hipGetDevice(&dev);
        hipDeviceGetAttribute(&cus, hipDeviceAttributeMultiprocessorCount, dev);
        if (hipFuncSetAttribute((const void*)fwd_kernel, hipFuncAttributeMaxDynamicSharedMemorySize, LDS_BYTES) != hipSuccess) { fprintf(stderr, "kernel_launch: hipFuncSetAttribute failed\n"); grid = -1; return; }
        if (hipOccupancyMaxActiveBlocksPerMultiprocessor(&per_cu, (const void*)fwd_kernel, NTHREADS, LDS_BYTES) != hipSuccess || per_cu < 1) { fprintf(stderr, "kernel_launch: occupancy query says %d\n", per_cu); per_cu = 1; }
        (void)hipGetLastError();
        grid = cus * 1;
        if (grid <= 0) grid = 256;
    }
    if (grid < 0) return;
    if (hipMemsetAsync((char*)d_ws + WS_CTL, 0, CTL_BYTES, stream) != hipSuccess) { fprintf(stderr, "kernel_launch: memset of the barrier words failed\n"); return; }
    Args a{};
    for (int i = 0; i < 25; ++i) a.in[i] = d_in[i];
    a.out = (float*)d_out; a.ws = (unsigned char*)d_ws; a.ph_lo = 0; a.ph_hi = N_PHASES;
    void* args[] = {&a};
    hipError_t e = hipLaunchCooperativeKernel((const void*)fwd_kernel, dim3(grid), dim3(NTHREADS), args, LDS_BYTES, stream);
    if (e != hipSuccess) fprintf(stderr, "cooperative launch failed: %s (grid %d)\n", hipGetErrorString(e), grid);
}
```

```cpp
#include <hip/hip_runtime.h>
#include <hip/hip_cooperative_groups.h>
#include <cstdio>
#include <cstdint>
namespace cg = cooperative_groups;
#define DI __device__ __forceinline__
namespace pg8 {
#define PG8_LAS __attribute__((address_space(3)))
typedef unsigned short bf16_t;
typedef short bf16x8 __attribute__((ext_vector_type(8)));
typedef float f32x4 __attribute__((ext_vector_type(4)));
typedef unsigned u32x4 __attribute__((ext_vector_type(4)));
constexpr int BM = 256, BK = 64, HALF = 128, HTB = HALF * BK * 2  , STAGE_BYTES = 8 * HTB, NXCD = 8, WGM = 8;

__host__ __device__ __forceinline__ int lds_byte(int r, int c) { const int st = (r >> 4) * 2 + (c >> 5), rr = r & 15, cc = c & 31, ob = rr * 64 + cc * 2; return st * 1024 + (ob ^ (((ob >> 9) & 1) << 5)); }
__host__ __device__ __forceinline__ void stage_rc(int b, int& R, int& C) { const int st = b / 1024, sb = b % 1024, swz = sb ^ (((sb >> 9) & 1) << 5); R = (st >> 1) * 16 + swz / 64; C = (st & 1) * 32 + (swz % 64) / 2; }
__host__ __device__ __forceinline__ int perm32(int rho) { const int n = rho >> 4, i = rho & 15; return 8 * (i >> 2) + 4 * n + (i & 3); }

struct Unit { int pm, pn, seg; };
struct Gemm { const bf16_t* A; const bf16_t* Bt; int M, N, K; };

struct StaticOrder {
    int nM, nN, nwg, G, c;
    __host__ __device__ void init(int M, int N, int G_, int c_) { nM = M / BM; nN = N / BM; nwg = nM * nN; G = G_; c = c_; }
    __host__ __device__ bool next(int i, Unit& u) const {
        const long L = (long)i * G + c; if (L >= nwg) return false;
        int wgid = (int)L; { const int q = nwg / NXCD, r = nwg % NXCD, xcd = wgid % NXCD, off = wgid / NXCD; wgid = (xcd < r ? xcd * (q + 1) : r * (q + 1) + (xcd - r) * q) + off; }
        const int nig = WGM * nN, gid = wgid / nig, fm = gid * WGM, gsz = (nM - fm) < WGM ? (nM - fm) : WGM;
        u.pm = fm + ((wgid % nig) % gsz); u.pn = (wgid % nig) / gsz; u.seg = 0; return true;
    }
    __device__ __forceinline__ const char* a_ptr(const Gemm& g, const Unit&) const { return (const char*)g.A; }
    __device__ __forceinline__ const char* b_ptr(const Gemm& g, const Unit&) const { return (const char*)g.Bt; }
    __device__ __forceinline__ void a_ready(const Unit&) const {}
    __device__ __forceinline__ void done(const Unit&) const {}
};
template <class Epi, class Sched, bool ALIGN_EPI = false, bool SP2 = false>
__device__ __forceinline__ void gemm_phase(PG8_LAS unsigned char* lds, const Gemm g, const Sched& S, const Epi& E) {
    int tid_o = threadIdx.x; asm volatile("" : "+v"(tid_o));
    const int tid = tid_o, wid = __builtin_amdgcn_readfirstlane(tid >> 6), lane = tid & 63, wr = wid >> 2, wc = wid & 3, fr = lane & 15, fq = lane >> 4;
    const int K = g.K, nt = K / BK;
    unsigned voffA[2], voffB[2];
#pragma unroll
    for (int i = 0; i < 2; ++i) { int R, C; stage_rc(tid * 16 + i * 8192, R, C); const int Rb = Epi::PERM ? ((R & ~31) + perm32(R & 31)) : R;
        voffA[i] = (unsigned)(R * K + C) * 2u; voffB[i] = (unsigned)(Rb * K + C) * 2u; }
    const size_t kstep = (size_t)(BK * 2);
    const size_t hstep = (size_t)HALF * K * 2;
    const size_t tstep = 2 * hstep;
    const unsigned ldsw = (unsigned)wid * 1024u;
    const int aoff = lds_byte(wr * 64 + fr, fq * 8), boff = lds_byte(wc * 32 + fr, fq * 8);
#define PG8_SA(b, h) (((b) * 2 + (h)) * HTB)
#define PG8_SB(b, h) ((4 + (b) * 2 + (h)) * HTB)
#define PG8_STAGE(bufoff, gbase, voff) do { _Pragma("unroll") for (int _i = 0; _i < 2; ++_i) \
        __builtin_amdgcn_global_load_lds((const unsigned*)((const char*)(gbase) + (voff)[_i]), (PG8_LAS unsigned*)(lds + (bufoff) + ldsw + _i * 8192), 16, 0, 0); } while (0)
#define PG8_LDA(dst, b, h) do { _Pragma("unroll") for (int m = 0; m < 4; ++m) _Pragma("unroll") for (int k = 0; k < 2; ++k) dst[m][k] = *(const PG8_LAS bf16x8*)(lds + PG8_SA(b, h) + aoff + m * 2048 + k * 1024); } while (0)
#define PG8_LDB(dst, b, h) do { _Pragma("unroll") for (int n = 0; n < 2; ++n) _Pragma("unroll") for (int k = 0; k < 2; ++k) dst[n][k] = *(const PG8_LAS bf16x8*)(lds + PG8_SB(b, h) + boff + n * 2048 + k * 1024); } while (0)
#define PG8_MMA(ai, bj, At, Bt) do { __builtin_amdgcn_s_setprio(1); _Pragma("unroll") for (int m = 0; m < 4; ++m) _Pragma("unroll") for (int n = 0; n < 2; ++n) _Pragma("unroll") for (int k = 0; k < 2; ++k) \
        acc[ai][bj][m][n] = __builtin_amdgcn_mfma_f32_16x16x32_bf16(Bt[n][k], At[m][k], acc[ai][bj][m][n], 0, 0, 0); __builtin_amdgcn_s_setprio(0); } while (0)
#define PG8_WAIT_V(n) asm volatile("s_waitcnt vmcnt(" #n ")" ::: "memory")
#define PG8_WAIT_L(n) asm volatile("s_waitcnt lgkmcnt(" #n ")" ::: "memory")
#define PG8_BAR __builtin_amdgcn_s_barrier()
#define PG8_SCHED __builtin_amdgcn_sched_barrier(0)
    Unit cur, nxt; int ui = 0;
    if (!S.next(0, cur)) return;
    f32x4 acc[2][2][4][2];
#pragma unroll
    for (int a = 0; a < 2; ++a)
#pragma unroll
        for (int b = 0; b < 2; ++b)
#pragma unroll
            for (int m = 0; m < 4; ++m)
#pragma unroll
                for (int n = 0; n < 2; ++n) acc[a][b][m][n] = (f32x4){0.f, 0.f, 0.f, 0.f};
    bf16x8 At[4][2], B0[2][2], B1[2][2];
    const char* cA = S.a_ptr(g, cur) + (size_t)cur.pm * tstep; const char* cB = S.b_ptr(g, cur) + (size_t)cur.pn * tstep;
    S.a_ready(cur);
    if constexpr (SP2) {
        PG8_STAGE(PG8_SB(0, 0), cB, voffB); PG8_STAGE(PG8_SB(0, 1), cB + hstep, voffB); PG8_STAGE(PG8_SA(0, 0), cA, voffA); PG8_STAGE(PG8_SA(0, 1), cA + hstep, voffA);
        if (wr == 1) PG8_BAR;
        PG8_WAIT_V(2); PG8_BAR;
        PG8_STAGE(PG8_SB(1, 0), cB + kstep, voffB); PG8_STAGE(PG8_SA(1, 0), cA + kstep, voffA); PG8_STAGE(PG8_SB(1, 1), cB + hstep + kstep, voffB);
        PG8_WAIT_V(6); PG8_BAR;
    } else {
        PG8_STAGE(PG8_SB(0, 0), cB, voffB); PG8_STAGE(PG8_SA(0, 0), cA, voffA); PG8_STAGE(PG8_SB(0, 1), cB + hstep, voffB); PG8_STAGE(PG8_SA(0, 1), cA + hstep, voffA);
        if (wr == 1) PG8_BAR;
        PG8_WAIT_V(4); PG8_BAR;
        PG8_STAGE(PG8_SB(1, 0), cB + kstep, voffB); PG8_STAGE(PG8_SA(1, 0), cA + kstep, voffA); PG8_STAGE(PG8_SB(1, 1), cB + hstep + kstep, voffB);
        PG8_WAIT_V(6); PG8_BAR;
    }
    for (;;) {
        const bool has_next = S.next(ui + 1, nxt);
        const char* nA = has_next ? S.a_ptr(g, nxt) + (size_t)nxt.pm * tstep : cA; const char* nB = has_next ? S.b_ptr(g, nxt) + (size_t)nxt.pn * tstep : cB;
        for (int t = 0; t < nt; t += 2) {
            const bool last = (t == nt - 2);
            const char* a1 = cA + (size_t)(t + 1) * kstep;
            const char* a2 = last ? nA : cA + (size_t)(t + 2) * kstep; const char* b2 = last ? nB : cB + (size_t)(t + 2) * kstep;
            const char* a3 = a2 + kstep; const char* b3 = b2 + kstep;
            if (last && has_next) S.a_ready(nxt);
            if (last) E.prefetch(lds, cur, wid, lane);
            if constexpr (SP2) {
            PG8_LDB(B0, 0, 0); PG8_LDB(B1, 0, 1); PG8_SCHED; PG8_LDA(At, 0, 0); PG8_STAGE(PG8_SA(1, 1), a1 + hstep, voffA);
            PG8_WAIT_V(8); PG8_WAIT_L(0); PG8_BAR; PG8_MMA(0, 0, At, B0); PG8_MMA(0, 1, At, B1); PG8_BAR; PG8_SCHED;
            PG8_LDA(At, 0, 1); PG8_STAGE(PG8_SB(0, 0), b2, voffB); PG8_STAGE(PG8_SB(0, 1), b2 + hstep, voffB); PG8_STAGE(PG8_SA(0, 0), a2, voffA);
            PG8_WAIT_V(8); PG8_WAIT_L(0); PG8_BAR; PG8_MMA(1, 0, At, B0); PG8_MMA(1, 1, At, B1); PG8_BAR; PG8_SCHED;
            PG8_LDB(B0, 1, 0); PG8_LDB(B1, 1, 1); PG8_SCHED; PG8_LDA(At, 1, 0); PG8_STAGE(PG8_SA(0, 1), a2 + hstep, voffA);
            PG8_WAIT_V(8); PG8_WAIT_L(0); PG8_BAR; PG8_MMA(0, 0, At, B0); PG8_MMA(0, 1, At, B1); PG8_BAR; PG8_SCHED;
            PG8_LDA(At, 1, 1); PG8_STAGE(PG8_SB(1, 0), b3, voffB); PG8_STAGE(PG8_SB(1, 1), b3 + hstep, voffB); PG8_STAGE(PG8_SA(1, 0), a3, voffA);
            PG8_WAIT_V(8); PG8_WAIT_L(0); PG8_BAR; PG8_MMA(1, 0, At, B0); PG8_MMA(1, 1, At, B1); PG8_BAR; PG8_SCHED;
            } else {
            PG8_LDB(B0, 0, 0); PG8_SCHED; PG8_LDA(At, 0, 0); PG8_STAGE(PG8_SA(1, 1), a1 + hstep, voffA);
            PG8_WAIT_L(8); PG8_BAR; PG8_WAIT_L(0); PG8_MMA(0, 0, At, B0); PG8_BAR; PG8_SCHED;
            PG8_LDB(B1, 0, 1); PG8_STAGE(PG8_SB(0, 0), b2, voffB);
            PG8_BAR; PG8_WAIT_L(0); PG8_MMA(0, 1, At, B1); PG8_BAR;
            PG8_LDA(At, 0, 1); PG8_STAGE(PG8_SA(0, 0), a2, voffA);
            PG8_BAR; PG8_WAIT_L(0); PG8_MMA(1, 0, At, B0); PG8_BAR; PG8_SCHED;
            PG8_STAGE(PG8_SB(0, 1), b2 + hstep, voffB);
            PG8_WAIT_V(6); PG8_BAR; PG8_MMA(1, 1, At, B1); PG8_BAR;
            PG8_LDB(B0, 1, 0); PG8_SCHED; PG8_LDA(At, 1, 0); PG8_STAGE(PG8_SA(0, 1), a2 + hstep, voffA);
            PG8_WAIT_L(8); PG8_BAR; PG8_WAIT_L(0); PG8_MMA(0, 0, At, B0); PG8_BAR; PG8_SCHED;
            PG8_LDB(B1, 1, 1); PG8_STAGE(PG8_SB(1, 0), b3, voffB);
            PG8_BAR; PG8_WAIT_L(0); PG8_MMA(0, 1, At, B1); PG8_BAR;
            PG8_LDA(At, 1, 1); PG8_STAGE(PG8_SA(1, 0), a3, voffA);
            PG8_BAR; PG8_WAIT_L(0); PG8_MMA(1, 0, At, B0); PG8_BAR; PG8_SCHED;
            PG8_STAGE(PG8_SB(1, 1), b3 + hstep, voffB);
            PG8_WAIT_V(6); PG8_BAR; PG8_MMA(1, 1, At, B1); PG8_BAR;
            }
        }
        if constexpr (ALIGN_EPI) { if (wr == 0) PG8_BAR; }
        if constexpr (!Epi::AFTER_DRAIN) { E(acc, cur, wr, wc, fr, fq); S.done(cur); }
        if (!has_next) break;
        if (!E.keep_acc(cur))
#pragma unroll
        for (int a = 0; a < 2; ++a)
#pragma unroll
            for (int b = 0; b < 2; ++b)
#pragma unroll
                for (int m = 0; m < 4; ++m)
#pragma unroll
                    for (int n = 0; n < 2; ++n) acc[a][b][m][n] = (f32x4){0.f, 0.f, 0.f, 0.f};
        cur = nxt; cA = nA; cB = nB; ++ui;
        if constexpr (ALIGN_EPI) { if (wr == 1) PG8_BAR; }
    }
    PG8_WAIT_V(0);
    if constexpr (!ALIGN_EPI) { if (wr == 0) PG8_BAR; }
    PG8_BAR;
    if constexpr (Epi::AFTER_DRAIN) { E.fused(acc, cur, wr, wc, fr, fq, lds, wid, lane); S.done(cur); }
#undef PG8_SA
#undef PG8_SB
#undef PG8_STAGE
#undef PG8_LDA
#undef PG8_LDB
#undef PG8_MMA
#undef PG8_WAIT_V
#undef PG8_WAIT_L
#undef PG8_BAR
#undef PG8_SCHED
}
}

typedef unsigned short bf16;
#define LAS __attribute__((address_space(3)))
#define GAS __attribute__((address_space(1)))
typedef float f32x4 __attribute__((ext_vector_type(4)));
typedef float f32x16 __attribute__((ext_vector_type(16)));
typedef float f32x2_t __attribute__((ext_vector_type(2)));
typedef __bf16 bf16x2_t __attribute__((ext_vector_type(2)));
typedef short bf16x8 __attribute__((ext_vector_type(8)));
typedef short s16x4 __attribute__((ext_vector_type(4)));
typedef unsigned u32x4 __attribute__((ext_vector_type(4)));
typedef unsigned u32x2 __attribute__((ext_vector_type(2)));

constexpr int T = 16384, D = 1024, SEQ = 4096, NBATCH = 4, DFF = 2816, DEPTH = 4, NIN = 6400, DIN = 6304;
constexpr int NTHREADS = 512, NWAVES = 8;
constexpr float EPS = 1e-6f;
constexpr float QSCALE_MLA = 0.14724498f;
constexpr float QSCALE_MEM = 0.12751743f;

constexpr size_t MiB = 1u << 20;
constexpr size_t WT_W1IN = 0;
constexpr size_t WT_W1OUT = WT_W1IN + (size_t)5632 * 1024 * 2;
constexpr size_t WT_WIN = WT_W1OUT + (size_t)1024 * 2816 * 2;
constexpr size_t WT_WUQ = WT_WIN + (size_t)NIN * 1024 * 2;
constexpr size_t WT_WUKV = WT_WUQ + (size_t)768 * 384 * 2;
constexpr size_t WT_WOMLA = WT_WUKV + (size_t)1024 * 256 * 2;
constexpr size_t WT_WOHG = WT_WOMLA + (size_t)1024 * 512 * 2;
constexpr size_t WT_WOMEM = WT_WOHG + (size_t)1024 * 512 * 2;
constexpr size_t WT_WMEMKV = WT_WOMEM + (size_t)1024 * 512 * 2;
constexpr size_t WT_WOUT = WT_WMEMKV + (size_t)4 * 1024 * 1024 * 2;
constexpr size_t WT_W2IN = WT_WOUT + (size_t)1024 * 1024 * 2;
constexpr size_t WT_W2OUT = WT_W2IN + (size_t)5632 * 1024 * 2;
constexpr size_t WT_END = WT_W2OUT + (size_t)1024 * 2816 * 2;
static_assert(WT_END <= 60 * MiB, "weights");
constexpr size_t WS_XB = 60 * MiB;
constexpr size_t WS_SSQ = WS_XB + 32 * MiB;
constexpr size_t WS_SSQQ = WS_SSQ + 1 * MiB;
constexpr size_t WS_SSQKV = WS_SSQQ + 1 * MiB;
constexpr size_t WS_COS = WS_SSQKV + 1 * MiB;
constexpr size_t WS_SIN = WS_COS + 1 * MiB;
constexpr size_t WS_LBS = WS_SIN + 1 * MiB;
constexpr size_t WS_MEMB = WS_LBS + 65536;
constexpr size_t WS_MEMRSTD = WS_MEMB + 2 * MiB;
constexpr size_t WS_MK = WS_MEMRSTD + 65536;
constexpr size_t WS_MVT = WS_MK + 4 * MiB;
constexpr size_t WS_DEC = WS_MVT + 4 * MiB;
constexpr size_t WS_MIX = WS_DEC + 1 * MiB;
constexpr size_t WS_CQ = WS_MIX;
constexpr size_t WS_CKV = WS_CQ + 12 * MiB;
constexpr size_t WS_KR = WS_CKV + 8 * MiB;
constexpr size_t WS_HQ = WS_KR + 1 * MiB;
constexpr size_t WS_GG = WS_HQ + 16 * MiB;
constexpr size_t WS_HK = WS_GG + 32 * MiB;
constexpr size_t WS_HV = WS_HK + 16 * MiB;
constexpr size_t WS_HGT = WS_HV + 16 * MiB;
constexpr size_t WS_MQ = WS_HGT + 16 * MiB;
constexpr size_t WS_GATES = WS_MQ + 16 * MiB;
constexpr size_t WS_Q = WS_GATES + 96 * MiB;
constexpr size_t WS_KC = WS_Q + 24 * MiB;
constexpr size_t WS_VT = WS_KC + 24 * MiB;
constexpr size_t WS_LT = WS_VT + 16 * MiB;
constexpr size_t WS_AO = WS_LT + 64 * MiB;
constexpr size_t WS_CTL = WS_AO + 16 * MiB;
constexpr size_t CTL_BYTES = 16384;
constexpr size_t WS_END = WS_CTL + 65536;
constexpr size_t WS_HO = WS_CQ;
constexpr size_t WS_MERGED = WS_GG;
constexpr size_t WS_MO = WS_Q;
constexpr size_t WS_H = WS_MIX;
static_assert(WS_H + (size_t)T * DFF * 2 <= WS_END, "h overlay");

constexpr int LDS_BYTES = 163840;
constexpr int LDS_SSQ_OFF = 131072 + 4096;
#ifndef REP_CONV
#define REP_CONV 1
#endif
#ifndef REP_P1
#define REP_P1 1
#endif
#ifndef REP_P3
#define REP_P3 1
#endif
#ifndef REP_MLA
#define REP_MLA 1
#endif
#ifndef REP_P6
#define REP_P6 1
#endif
#ifndef REP_P7
#define REP_P7 1
#endif
#ifndef REP_P4G
#define REP_P4G 1
#endif

DI unsigned pk2(float lo, float hi) { f32x2_t v = {lo, hi}; bf16x2_t b = __builtin_convertvector(v, bf16x2_t); return __builtin_bit_cast(unsigned, b); }
DI u32x4 pk8(const float* v) { u32x4 w; w.x = pk2(v[0], v[1]); w.y = pk2(v[2], v[3]); w.z = pk2(v[4], v[5]); w.w = pk2(v[6], v[7]); return w; }
DI float bflo(unsigned w) { return __uint_as_float(w << 16); }
DI float bfhi(unsigned w) { return __uint_as_float(w & 0xffff0000u); }
DI void unpk8(u32x4 w, float* v) { v[0] = bflo(w.x); v[1] = bfhi(w.x); v[2] = bflo(w.y); v[3] = bfhi(w.y); v[4] = bflo(w.z); v[5] = bfhi(w.z); v[6] = bflo(w.w); v[7] = bfhi(w.w); }
DI float bf2f(bf16 b) { return __uint_as_float(((unsigned)b) << 16); }
DI bf16 f2bf(float f) { return (bf16)(pk2(f, 0.f) & 0xffffu); }
DI float sigmoidf_(float z) { return __builtin_amdgcn_rcpf(1.0f + __expf(-z)); }
DI float wave_sum(float v) {
#pragma unroll
    for (int o = 1; o < 64; o <<= 1) v += __shfl_xor(v, o);
    return v;
}
DI float rowsum_q(const float* p, int fq, int nq) {
    float s = 0.f;
    if (fq < nq) { const f32x4 a = *(const GAS f32x4*)(p + 4 * fq); s = (a.x + a.y) + (a.z + a.w); }
    s += __shfl_xor(s, 16); s += __shfl_xor(s, 32);
    return s;
}
DI void rstd8(const float* ssq, int stride, int nq, float inv_n, float post, int rowb, int fq, float (&rs)[8]) {
    f32x4 q[8];
#pragma unroll
    for (int i = 0; i < 8; ++i) q[i] = *(const GAS f32x4*)(ssq + (size_t)(rowb + (i >> 2) * 128 + (i & 3) * 16) * stride + 4 * fq);
    const float keep = fq < nq ? 1.0f : 0.0f;
#pragma unroll
    for (int i = 0; i < 8; ++i) { float t = ((q[i].x + q[i].y) + (q[i].z + q[i].w)) * keep; t += __shfl_xor(t, 16); t += __shfl_xor(t, 32); rs[i] = __builtin_amdgcn_rsqf(t * inv_n + EPS) * post; }
}
DI void rstd8_lds(const LAS unsigned char* pan, float inv_n, int rowl, int fq, float (&rs)[8]) {
    f32x4 q[8];
#pragma unroll
    for (int i = 0; i < 8; ++i) q[i] = *(const LAS f32x4*)(pan + (rowl + (i >> 2) * 128 + (i & 3) * 16) * 64 + 16 * fq);
#pragma unroll
    for (int i = 0; i < 8; ++i) { float t = (q[i].x + q[i].y) + (q[i].z + q[i].w); t += __shfl_xor(t, 16); t += __shfl_xor(t, 32); rs[i] = __builtin_amdgcn_rsqf(t * inv_n + EPS); }
}
DI void ssq_panel_dma(LAS unsigned char* lds, const float* ssq, int pm, int wid, int lane) {
    const char* src = (const char*)(ssq + (size_t)pm * 256 * 16);
    const unsigned voff = (unsigned)(wid * 64 + lane) * 16u;
#pragma unroll
    for (int i = 0; i < 2; ++i)
        __builtin_amdgcn_global_load_lds((const unsigned*)(src + i * 8192 + voff), (LAS unsigned*)(lds + LDS_SSQ_OFF + wid * 1024 + i * 8192), 16, 0, 0);
}
DI float sum16(const float* p) {
    const f32x4 a = *(const f32x4*)p, b = *(const GAS f32x4*)(p + 4), c = *(const GAS f32x4*)(p + 8), d = *(const GAS f32x4*)(p + 12);
    return ((a.x + a.y) + (a.z + a.w)) + ((b.x + b.y) + (b.z + b.w)) + ((c.x + c.y) + (c.z + c.w)) + ((d.x + d.y) + (d.z + d.w));
}

using pg8::Unit;
#define EPI_ARGS const f32x4 (&acc)[2][2][4][2], const Unit& u, int wr, int wc, int fr_in, int fq_in
#define EPI_OPAQUE int fr = fr_in, fq = fq_in; asm volatile("" : "+v"(fr), "+v"(fq));

struct EpiSwiglu {
    static constexpr bool PERM = true, AFTER_DRAIN = false;
    DI bool keep_acc(const Unit&) const { return false; }
    bf16* H; const float* ssq; LAS unsigned char* ldsb;
    DI void prefetch(LAS unsigned char* lds, const Unit& u, int wid, int lane) const { ssq_panel_dma(lds, ssq, u.pm, wid, lane); }
    DI void operator()(EPI_ARGS) const {
        EPI_OPAQUE
        const int rowb = u.pm * 256 + wr * 64 + fr;
        asm volatile("s_waitcnt vmcnt(16)" ::: "memory"); __builtin_amdgcn_s_barrier(); asm volatile("" ::: "memory");
        float rs[8]; rstd8_lds(ldsb + LDS_SSQ_OFF, 1.0f / 1024.0f, wr * 64 + fr, fq, rs);
#pragma unroll
        for (int ai = 0; ai < 2; ++ai)
#pragma unroll
            for (int m = 0; m < 4; ++m) {
                const int row = rowb + ai * 128 + m * 16;
                const float r1 = rs[ai * 4 + m];
                float o[8];
#pragma unroll
                for (int n = 0; n < 2; ++n)
#pragma unroll
                    for (int j = 0; j < 4; ++j) { const float a = acc[ai][0][m][n][j] * r1, b = acc[ai][1][m][n][j] * r1; o[4 * n + j] = a * b * __builtin_amdgcn_rcpf(1.0f + __expf(-a)); }
                *(GAS u32x4*)(H + (size_t)row * DFF + u.pn * 128 + 32 * wc + 8 * fq) = pk8(o);
            }
    }
};

struct EpiSwigluNoLoad {
    static constexpr bool PERM = true, AFTER_DRAIN = false;
    DI bool keep_acc(const Unit&) const { return false; }
    DI void prefetch(LAS unsigned char*, const Unit&, int, int) const {}
    bf16* H;
    DI void operator()(EPI_ARGS) const {
        EPI_OPAQUE
        const int rowb = u.pm * 256 + wr * 64 + fr;
#pragma unroll
        for (int ai = 0; ai < 2; ++ai)
#pragma unroll
            for (int m = 0; m < 4; ++m) {
                const int row = rowb + ai * 128 + m * 16;
                float o[8];
#pragma unroll
                for (int n = 0; n < 2; ++n)
#pragma unroll
                    for (int j = 0; j < 4; ++j) { const float a = acc[ai][0][m][n][j], b = acc[ai][1][m][n][j]; o[4 * n + j] = a * b * __builtin_amdgcn_rcpf(1.0f + __expf(-a)); }
#ifndef PROBE_NOSTORE
                *(GAS u32x4*)(H + (size_t)row * DFF + u.pn * 128 + 32 * wc + 8 * fq) = pk8(o);
#else
                if (o[0] + o[1] + o[2] + o[3] + o[4] + o[5] + o[6] + o[7] == 12345.678f) *(GAS u32x4*)(H + (size_t)row * DFF + u.pn * 128 + 32 * wc + 8 * fq) = pk8(o);
#endif
            }
    }
};

struct EpiNull {
    static constexpr bool PERM = true, AFTER_DRAIN = false;
    DI bool keep_acc(const Unit&) const { return false; }
    DI void prefetch(LAS unsigned char*, const Unit&, int, int) const {}
    bf16* H;
    DI void operator()(EPI_ARGS) const {
        float t = 0.f;
#pragma unroll
        for (int ai = 0; ai < 2; ++ai)
#pragma unroll
            for (int bj = 0; bj < 2; ++bj)
#pragma unroll
                for (int m = 0; m < 4; ++m)
#pragma unroll
                    for (int n = 0; n < 2; ++n) t += acc[ai][bj][m][n][0] + acc[ai][bj][m][n][1] + acc[ai][bj][m][n][2] + acc[ai][bj][m][n][3];
        if (t == 12345.678f) H[0] = 0;
    }
};

struct EpiResid {
    static constexpr bool PERM = true, AFTER_DRAIN = false;
    DI bool keep_acc(const Unit&) const { return false; }
    DI void prefetch(LAS unsigned char*, const Unit&, int, int) const {}
    bf16* XB; float* ssq; float scale;
    DI void operator()(EPI_ARGS) const {
        EPI_OPAQUE
        const int rowb = u.pm * 256 + wr * 64 + fr, colb = u.pn * 256 + 32 * wc + 8 * fq;
#pragma unroll
        for (int ai = 0; ai < 2; ++ai) {
            u32x4 xv[4][2];
#pragma unroll
            for (int m = 0; m < 4; ++m)
#pragma unroll
                for (int bj = 0; bj < 2; ++bj) xv[m][bj] = *(const GAS u32x4*)(XB + (size_t)(rowb + ai * 128 + m * 16) * D + colb + 128 * bj);
#pragma unroll
            for (int m = 0; m < 4; ++m) {
                const int row = rowb + ai * 128 + m * 16;
                float ss = 0.f;
#pragma unroll
                for (int bj = 0; bj < 2; ++bj) {
                    float o[8]; unpk8(xv[m][bj], o);
#pragma unroll
                    for (int n = 0; n < 2; ++n)
#pragma unroll
                        for (int j = 0; j < 4; ++j) o[4 * n + j] += scale * acc[ai][bj][m][n][j];
                    const u32x4 w = pk8(o);
                    *(GAS u32x4*)(XB + (size_t)row * D + colb + 128 * bj) = w;
                    float q[8]; unpk8(w, q);
#pragma unroll
                    for (int e = 0; e < 8; ++e) ss += q[e] * q[e];
                }
                ss += __shfl_xor(ss, 16); ss += __shfl_xor(ss, 32);
                if (fq == 0) ((GAS float*)ssq)[(size_t)row * 16 + u.pn * 4 + wc] = ss;
            }
        }
    }
};

struct EpiWin {
    static constexpr bool PERM = true, AFTER_DRAIN = false;
    DI bool keep_acc(const Unit&) const { return false; }
    DI void prefetch(LAS unsigned char* lds, const Unit& u, int wid, int lane) const { ssq_panel_dma(lds, (const float*)(ws + WS_SSQ), u.pm, wid, lane); }
    unsigned char* ws; const float* lbs  ; LAS unsigned char* ldsb;
    DI void operator()(EPI_ARGS) const {
        EPI_OPAQUE
        const float* ssq = (const float*)(ws + WS_SSQ); const float* cosT = (const float*)(ws + WS_COS); const float* sinT = (const float*)(ws + WS_SIN);
        bf16* CQ = (bf16*)(ws + WS_CQ); bf16* CKV = (bf16*)(ws + WS_CKV); bf16* KC = (bf16*)(ws + WS_KC); bf16* HQ = (bf16*)(ws + WS_HQ); bf16* HK = (bf16*)(ws + WS_HK); bf16* HV = (bf16*)(ws + WS_HV);
        bf16* HGT = (bf16*)(ws + WS_HGT); bf16* MQ = (bf16*)(ws + WS_MQ); bf16* GATES = (bf16*)(ws + WS_GATES); float* GG = (float*)(ws + WS_GG); float* SSQQ = (float*)(ws + WS_SSQQ); float* SSQKV = (float*)(ws + WS_SSQKV);
        const int rowb = u.pm * 256 + wr * 64 + fr;
        asm volatile("s_waitcnt vmcnt(16)" ::: "memory"); __builtin_amdgcn_s_barrier(); asm volatile("" ::: "memory");
        float rs8[8]; rstd8_lds(ldsb + LDS_SSQ_OFF, 1.0f / 1024.0f, wr * 64 + fr, fq, rs8);
#pragma unroll
        for (int ai = 0; ai < 2; ++ai)
#pragma unroll
            for (int m = 0; m < 4; ++m) {
                const int row = rowb + ai * 128 + m * 16;
                const float rs = rs8[ai * 4 + m];
#pragma unroll
                for (int bj = 0; bj < 2; ++bj) {
                    const int hh = 2 * u.pn + bj, cw = 32 * wc + 8 * fq;
                    float v[8];
#pragma unroll
                    for (int n = 0; n < 2; ++n)
#pragma unroll
                        for (int j = 0; j < 4; ++j) v[4 * n + j] = acc[ai][bj][m][n][j] * rs;
                    if (hh < 5) {
                        float ss = 0.f;
#pragma unroll
                        for (int e = 0; e < 8; ++e) ss += v[e] * v[e];
                        ss += __shfl_xor(ss, 16); ss += __shfl_xor(ss, 32);
                        if (hh < 3) { *(GAS u32x4*)(CQ + (size_t)row * 384 + hh * 128 + cw) = pk8(v); if (fq == 0) ((GAS float*)SSQQ)[(size_t)row * 16 + hh * 4 + wc] = ss; }
                        else { *(GAS u32x4*)(CKV + (size_t)row * 256 + (hh - 3) * 128 + cw) = pk8(v); if (fq == 0) ((GAS float*)SSQKV)[(size_t)row * 8 + (hh - 3) * 4 + wc] = ss; }
                    } else if (hh == 5) {
                        if (wc == 0) {
                            const f32x4 c = *(const GAS f32x4*)(cosT + (size_t)row * 16 + 4 * fq), s = *(const GAS f32x4*)(sinT + (size_t)row * 16 + 4 * fq);
                            u32x4 o;
                            o.x = pk2(v[0] * c.x - v[1] * s.x, v[1] * c.x + v[0] * s.x); o.y = pk2(v[2] * c.y - v[3] * s.y, v[3] * c.y + v[2] * s.y);
                            o.z = pk2(v[4] * c.z - v[5] * s.z, v[5] * c.z + v[4] * s.z); o.w = pk2(v[6] * c.w - v[7] * s.w, v[7] * c.w + v[6] * s.w);
                            bf16* kp = KC + ((size_t)(row >> 12) * 8 * SEQ + (row & 4095)) * 96 + 64 + 8 * fq;
#pragma unroll
                            for (int hd = 0; hd < 8; ++hd) *(GAS u32x4*)(kp + (size_t)hd * SEQ * 96) = o;
                        }
                    } else if (hh < 10) {
#pragma unroll
                        for (int e = 0; e < 8; ++e) v[e] = v[e] * sigmoidf_(v[e]);
                        *(GAS u32x4*)(HQ + (size_t)row * 512 + (hh - 6) * 128 + cw) = pk8(v);
                    } else if (hh < 14) {
                        const int c0 = (hh - 10) * 128 + cw;
                        const f32x4 l0 = *(const GAS f32x4*)(lbs + c0), l1 = *(const GAS f32x4*)(lbs + c0 + 4);
                        const float lb[8] = {l0.x, l0.y, l0.z, l0.w, l1.x, l1.y, l1.z, l1.w};
                        float g[8], k[8];
#pragma unroll
                        for (int e = 0; e < 8; ++e) { const float z = fminf(fmaxf(v[e], -60.f), 60.f); const float en = __expf(-z), sg = __builtin_amdgcn_rcpf(1.0f + en);
                            g[e] = __logf(lb[e] + (1.0f - lb[e]) * sg); k[e] = (1.0f - lb[e]) * (en * sg); }
                        *(GAS f32x4*)(GG + (size_t)row * 512 + c0) = (f32x4){g[0], g[1], g[2], g[3]}; *(GAS f32x4*)(GG + (size_t)row * 512 + c0 + 4) = (f32x4){g[4], g[5], g[6], g[7]};
                        *(GAS u32x4*)(HK + (size_t)row * 512 + c0) = pk8(k);
                    } else if (hh < 18) {
                        *(GAS u32x4*)(HV + (size_t)row * 512 + (hh - 14) * 128 + cw) = pk8(v);
                    } else if (hh < 22) {
#pragma unroll
                        for (int e = 0; e < 8; ++e) v[e] = v[e] * sigmoidf_(v[e]);
                        *(GAS u32x4*)(HGT + (size_t)row * 512 + (hh - 18) * 128 + cw) = pk8(v);
                    } else if (hh < 26) {
#pragma unroll
                        for (int e = 0; e < 8; ++e) v[e] *= QSCALE_MEM;
                        *(GAS u32x4*)(MQ + (size_t)row * 512 + (hh - 22) * 128 + cw) = pk8(v);
                    } else {
                        const int c0 = (hh - 26) * 128 + cw, br = c0 >> 10, cc = c0 & 1023;
#pragma unroll
                        for (int e = 0; e < 8; ++e) v[e] = sigmoidf_(v[e]);
                        *(GAS u32x4*)(GATES + ((size_t)br * T + row) * 1024 + cc) = pk8(v);
                    }
                }
            }
    }
};

struct EpiQ {
    static constexpr bool PERM = true, AFTER_DRAIN = false;
    DI bool keep_acc(const Unit&) const { return false; }
    DI void prefetch(LAS unsigned char*, const Unit&, int, int) const {}
    bf16* Q;
    DI void operator()(EPI_ARGS) const {
        EPI_OPAQUE
#pragma unroll
        for (int ai = 0; ai < 2; ++ai)
#pragma unroll
            for (int m = 0; m < 4; ++m) {
                const int row = u.pm * 256 + ai * 128 + wr * 64 + m * 16 + fr;
#pragma unroll
                for (int bj = 0; bj < 2; ++bj) {
                    float v[8];
#pragma unroll
                    for (int n = 0; n < 2; ++n)
#pragma unroll
                        for (int j = 0; j < 4; ++j) v[4 * n + j] = acc[ai][bj][m][n][j];
                    *(GAS u32x4*)(Q + (size_t)row * 768 + u.pn * 256 + 128 * bj + 32 * wc + 8 * fq) = pk8(v);
                }
            }
    }
};

struct EpiKV {
    static constexpr bool PERM = true, AFTER_DRAIN = false;
    DI bool keep_acc(const Unit&) const { return false; }
    DI void prefetch(LAS unsigned char*, const Unit&, int, int) const {}
    bf16* KC; bf16* VT; const float* ssqkv;
    DI void operator()(EPI_ARGS) const {
        EPI_OPAQUE
        float rs8[8]; rstd8(ssqkv, 8, 2, 1.0f / 256.0f, 1.0f, u.pm * 256 + wr * 64 + fr, fq, rs8);
#pragma unroll
        for (int ai = 0; ai < 2; ++ai)
#pragma unroll
            for (int m = 0; m < 4; ++m) {
                const int row = u.pm * 256 + ai * 128 + wr * 64 + m * 16 + fr, b = row >> 12, s = row & 4095;
                const float rs = rs8[ai * 4 + m];
#pragma unroll
                for (int bj = 0; bj < 2; ++bj) {
                    const int c0 = u.pn * 256 + 128 * bj + 32 * wc + 8 * fq;
                    float v[8];
#pragma unroll
                    for (int n = 0; n < 2; ++n)
#pragma unroll
                        for (int j = 0; j < 4; ++j) v[4 * n + j] = acc[ai][bj][m][n][j] * rs;
                    if (c0 < 512) {
                        const int hd = c0 >> 6, d = c0 & 63;
                        bf16* kp = KC + ((size_t)(b * 8 + hd) * SEQ + s) * 96;
                        *(GAS u32x4*)(kp + d) = pk8(v);
                    } else {
                        const int c = c0 - 512, hd = c >> 6, dv = c & 63;
                        GAS bf16* vp = (GAS bf16*)(VT + ((size_t)(b * 8 + hd) * 64 + dv) * SEQ + s);
#pragma unroll
                        for (int e = 0; e < 8; ++e) vp[(size_t)e * SEQ] = f2bf(v[e]);
                    }
                }
            }
    }
};

struct EpiMemKV {
    static constexpr bool PERM = true, AFTER_DRAIN = false;
    DI bool keep_acc(const Unit&) const { return false; }
    DI void prefetch(LAS unsigned char*, const Unit&, int, int) const {}
    bf16* MK; bf16* MVT; const float* rstd;
    DI void operator()(EPI_ARGS) const {
        EPI_OPAQUE
#pragma unroll
        for (int ai = 0; ai < 2; ++ai)
#pragma unroll
            for (int m = 0; m < 4; ++m) {
                const int row = u.pm * 256 + ai * 128 + wr * 64 + m * 16 + fr, b = row >> 8, mm = row & 255;
                const float rs = rstd[row];
#pragma unroll
                for (int bj = 0; bj < 2; ++bj) {
                    const int c0 = u.pn * 256 + 128 * bj + 32 * wc + 8 * fq;
                    float v[8];
#pragma unroll
                    for (int n = 0; n < 2; ++n)
#pragma unroll
                        for (int j = 0; j < 4; ++j) v[4 * n + j] = acc[ai][bj][m][n][j] * rs;
                    if (c0 < 512) { const int hd = c0 >> 7, d = c0 & 127; *(GAS u32x4*)(MK + ((size_t)(b * 4 + hd) * 256 + mm) * 128 + d) = pk8(v); }
                    else { const int c = c0 - 512, hd = c >> 7, dv = c & 127; GAS bf16* vp = (GAS bf16*)(MVT + ((size_t)(b * 4 + hd) * 128 + dv) * 256 + mm);
#pragma unroll
                        for (int e = 0; e < 8; ++e) vp[(size_t)e * 256] = f2bf(v[e]); }
                }
            }
    }
};

struct EpiBranch {
    static constexpr bool PERM = true, AFTER_DRAIN = false;
    DI bool keep_acc(const Unit&) const { return false; }
    DI void prefetch(LAS unsigned char*, const Unit&, int, int) const {}
    bf16* MG; const bf16* gate; int first;
    DI void operator()(EPI_ARGS) const {
        EPI_OPAQUE
        const int rowb = u.pm * 256 + wr * 64 + fr, colb = u.pn * 256 + 32 * wc + 8 * fq;
#pragma unroll
        for (int ai = 0; ai < 2; ++ai) {
            u32x4 gv[4][2], pv[4][2];
#pragma unroll
            for (int m = 0; m < 4; ++m)
#pragma unroll
                for (int bj = 0; bj < 2; ++bj) { const size_t off = (size_t)(rowb + ai * 128 + m * 16) * 1024 + colb + 128 * bj;
                    gv[m][bj] = *(const GAS u32x4*)(gate + off); pv[m][bj] = (u32x4){0, 0, 0, 0}; if (!first) pv[m][bj] = *(const GAS u32x4*)(MG + off); }
#pragma unroll
            for (int m = 0; m < 4; ++m)
#pragma unroll
                for (int bj = 0; bj < 2; ++bj) {
                    const size_t off = (size_t)(rowb + ai * 128 + m * 16) * 1024 + colb + 128 * bj;
                    float g[8], o[8];
                    unpk8(gv[m][bj], g); unpk8(pv[m][bj], o);
#pragma unroll
                    for (int n = 0; n < 2; ++n)
#pragma unroll
                        for (int j = 0; j < 4; ++j) o[4 * n + j] += g[4 * n + j] * acc[ai][bj][m][n][j];
                    *(GAS u32x4*)(MG + off) = pk8(o);
                }
        }
    }
};

struct EpiBranch3 {
    static constexpr bool PERM = true, AFTER_DRAIN = false;
    bf16* MG; const bf16* gates;
    DI bool keep_acc(const Unit& u) const { return u.seg < 2; }
    DI void prefetch(LAS unsigned char*, const Unit&, int, int) const {}
    DI void operator()(f32x4 (&acc)[2][2][4][2], const Unit& u, int wr, int wc, int fr_in, int fq_in) const {
        EPI_OPAQUE
        const int rowb = u.pm * 256 + wr * 64 + fr, colb = u.pn * 256 + 32 * wc + 8 * fq, seg = u.seg;
        const bf16* gcur = gates + (size_t)seg * T * 1024; const bf16* gnxt = gates + (size_t)(seg < 2 ? seg + 1 : seg) * T * 1024;
#pragma unroll
        for (int ai = 0; ai < 2; ++ai) {
            u32x4 gv[4][2], nv[4][2];
#pragma unroll
            for (int m = 0; m < 4; ++m)
#pragma unroll
                for (int bj = 0; bj < 2; ++bj) { const size_t off = (size_t)(rowb + ai * 128 + m * 16) * 1024 + colb + 128 * bj; gv[m][bj] = *(const GAS u32x4*)(gcur + off); nv[m][bj] = *(const GAS u32x4*)(gnxt + off); }
#pragma unroll
            for (int m = 0; m < 4; ++m)
#pragma unroll
                for (int bj = 0; bj < 2; ++bj) {
                    float g[8], gn[8];
                    unpk8(gv[m][bj], g); unpk8(nv[m][bj], gn);
                    if (seg < 2) {
#pragma unroll
                        for (int n = 0; n < 2; ++n)
#pragma unroll
                            for (int j = 0; j < 4; ++j) acc[ai][bj][m][n][j] *= g[4 * n + j] * __builtin_amdgcn_rcpf(fmaxf(gn[4 * n + j], 1e-30f));
                    } else {
                        float o[8];
#pragma unroll
                        for (int n = 0; n < 2; ++n)
#pragma unroll
                            for (int j = 0; j < 4; ++j) o[4 * n + j] = acc[ai][bj][m][n][j] * g[4 * n + j];
                        *(GAS u32x4*)(MG + (size_t)(rowb + ai * 128 + m * 16) * 1024 + colb + 128 * bj) = pk8(o);
                    }
                }
        }
    }
};
struct SegOrder3 : pg8::StaticOrder {
    const char* wsb;
    DI bool next(int i, Unit& u) const { const int base = i / 3; if (!pg8::StaticOrder::next(base, u)) return false; u.seg = i - 3 * base; return true; }
    DI const char* a_ptr(const pg8::Gemm&, const Unit& u) const {
        const long long off = (long long)WS_AO + (long long)(u.seg == 1) * ((long long)WS_HO - (long long)WS_AO) + (long long)(u.seg == 2) * ((long long)WS_MO - (long long)WS_AO);
        return wsb + off; }
    DI const char* b_ptr(const pg8::Gemm& g, const Unit& u) const { return (const char*)g.Bt + (size_t)u.seg * ((size_t)1024 * 512 * 2); }
};

template <class Epi> DI void run_gemm(LAS unsigned char* lds, const bf16* A, const bf16* Bt, int M, int N, int K, int rot, const Epi& E) {
    int Kv = K, Nv = N, Mv = M; asm volatile("" : "+s"(Kv), "+s"(Nv), "+s"(Mv));
    pg8::Gemm g{A, Bt, Mv, Nv, Kv}; pg8::StaticOrder S; const int G = (int)gridDim.x;
    S.init(Mv, Nv, G, (int)((blockIdx.x + (unsigned)G - (unsigned)rot) % (unsigned)G));
    pg8::gemm_phase<Epi, pg8::StaticOrder, true, true>(lds, g, S, E);
}

#define MFMA32(a, b, c) __builtin_amdgcn_mfma_f32_32x32x16_bf16((a), (b), (c), 0, 0, 0)
template <int DQK, int DV, bool CAUSAL>
DI void attn_tile(const LAS unsigned char* kb, const LAS unsigned char* vb, const bf16x8 (&qf)[DQK / 16], f32x16 (&o)[DV / 32], float& mrun, float& lrun, int t, int qlo, int r, int h) {
    constexpr int KROW = DQK * 2 + 16, VROW = 136, KS = DQK / 16, NDB = DV / 32;
    f32x16 s0, s1;
    const float negm = -mrun;
#pragma unroll
    for (int i = 0; i < 16; ++i) { s0[i] = negm; s1[i] = negm; }
#pragma unroll
    for (int ks = 0; ks < KS; ++ks) {
        const bf16x8 k0 = *(const LAS bf16x8*)(kb + r * KROW + 32 * ks + 16 * h);
        const bf16x8 k1 = *(const LAS bf16x8*)(kb + (32 + r) * KROW + 32 * ks + 16 * h);
        s0 = MFMA32(k0, qf[ks], s0); s1 = MFMA32(k1, qf[ks], s1);
    }
    if (CAUSAL && (64 * t + 63 > qlo)) {
        const int qpos = qlo + r, kbase = 64 * t + 4 * h;
#pragma unroll
        for (int i = 0; i < 16; ++i) { const int key = kbase + (i & 3) + 8 * (i >> 2);
            if (key > qpos) s0[i] = -1e30f; if (key + 32 > qpos) s1[i] = -1e30f; }
    }
    float mx = fmaxf(s0[0], s1[0]);
#pragma unroll
    for (int i = 1; i < 16; ++i) mx = fmaxf(mx, fmaxf(s0[i], s1[i]));
    mx = fmaxf(mx, __shfl_xor(mx, 32));
    if (__builtin_amdgcn_ballot_w64(mx > 8.0f) != 0ull) {
        const float delta = fmaxf(mx, 0.f), alpha = __builtin_amdgcn_exp2f(-delta);
        mrun += delta; lrun *= alpha;
#pragma unroll
        for (int i = 0; i < 16; ++i) { s0[i] -= delta; s1[i] -= delta; }
#pragma unroll
        for (int db = 0; db < NDB; ++db)
#pragma unroll
            for (int i = 0; i < 16; ++i) o[db][i] *= alpha;
    }
    float ps = 0.f;
#pragma unroll
    for (int i = 0; i < 16; ++i) { s0[i] = __builtin_amdgcn_exp2f(s0[i]); s1[i] = __builtin_amdgcn_exp2f(s1[i]); ps += s0[i] + s1[i]; }
    lrun += ps;
#pragma unroll
    for (int kb2 = 0; kb2 < 2; ++kb2)
#pragma unroll
        for (int s = 0; s < 2; ++s) {
            u32x4 pw;
            if (kb2 == 0) { pw.x = pk2(s0[8 * s], s0[8 * s + 1]); pw.y = pk2(s0[8 * s + 2], s0[8 * s + 3]); pw.z = pk2(s0[8 * s + 4], s0[8 * s + 5]); pw.w = pk2(s0[8 * s + 6], s0[8 * s + 7]); }
            else { pw.x = pk2(s1[8 * s], s1[8 * s + 1]); pw.y = pk2(s1[8 * s + 2], s1[8 * s + 3]); pw.z = pk2(s1[8 * s + 4], s1[8 * s + 5]); pw.w = pk2(s1[8 * s + 6], s1[8 * s + 7]); }
            const bf16x8 pf = __builtin_bit_cast(bf16x8, pw);
            const int koff = (32 * kb2 + 16 * s + 4 * h) * 2;
#pragma unroll
            for (int db = 0; db < NDB; ++db) {
                const u32x2 lo = *(const LAS u32x2*)(vb + (32 * db + r) * VROW + koff), hi = *(const LAS u32x2*)(vb + (32 * db + r) * VROW + koff + 16);
                u32x4 vw; vw.x = lo.x; vw.y = lo.y; vw.z = hi.x; vw.w = hi.y;
                o[db] = MFMA32(__builtin_bit_cast(bf16x8, vw), pf, o[db]);
            }
        }
}

template <int DQK, int DV, bool CAUSAL>
DI void attn_item(LAS unsigned char* lds, const bf16* Qp, int qstride, const bf16* Kp, const bf16* VTp, int vt_stride, bf16* Op, int ostride, int q0, int nkeys,
                  const float* ssqq, const float* cosT, const float* sinT) {
    constexpr int KROW = DQK * 2 + 16, VROW = 136, KBYTES = 64 * KROW, VBYTES = DV * VROW, BUF = KBYTES + VBYTES;
    constexpr int NCK = 64 * DQK / 8, NCV = DV * 8, KS = DQK / 16, NDB = DV / 32;
    constexpr int CPR = DQK / 8;
    int tid_o = threadIdx.x; asm volatile("" : "+v"(tid_o)); const int tid = tid_o, wid = __builtin_amdgcn_readfirstlane(tid >> 6), lane = tid & 63, r = lane & 31, h = lane >> 5;
    const int ntiles = CAUSAL ? (q0 + 256) / 64 : nkeys / 64;
    const int qlo = q0 + wid * 32;
    bf16x8 qf[KS];
    { const bf16* qr = Qp + (size_t)(wid * 32 + r) * qstride + 8 * h;
#pragma unroll
      for (int ks = 0; ks < KS; ++ks) qf[ks] = *(const GAS bf16x8*)(qr + 16 * ks);
      if (CAUSAL) {
          const float* sp = ssqq + (size_t)(wid * 32 + r) * 16;
          const f32x4 a = *(const f32x4*)sp, b = *(const GAS f32x4*)(sp + 4), c = *(const GAS f32x4*)(sp + 8);
          const float rs = rsqrtf((((a.x + a.y) + (a.z + a.w)) + ((b.x + b.y) + (b.z + b.w)) + ((c.x + c.y) + (c.z + c.w))) * (1.0f / 384.0f) + EPS) * QSCALE_MLA;
#pragma unroll
          for (int ks = 0; ks < KS; ++ks) {
              float v[8]; unpk8(__builtin_bit_cast(u32x4, qf[ks]), v);
              if (ks >= 4) {
                  const int i0 = 8 * (ks - 4) + 4 * h;
                  const f32x4 cs = *(const GAS f32x4*)(cosT + (size_t)(wid * 32 + r) * 16 + i0), sn = *(const GAS f32x4*)(sinT + (size_t)(wid * 32 + r) * 16 + i0);
                  const float t0 = v[0], t1 = v[1], t2 = v[2], t3 = v[3], t4 = v[4], t5 = v[5], t6 = v[6], t7 = v[7];
                  v[0] = t0 * cs.x - t1 * sn.x; v[1] = t1 * cs.x + t0 * sn.x; v[2] = t2 * cs.y - t3 * sn.y; v[3] = t3 * cs.y + t2 * sn.y;
                  v[4] = t4 * cs.z - t5 * sn.z; v[5] = t5 * cs.z + t4 * sn.z; v[6] = t6 * cs.w - t7 * sn.w; v[7] = t7 * cs.w + t6 * sn.w;
              }
#pragma unroll
              for (int e = 0; e < 8; ++e) v[e] *= rs;
              qf[ks] = __builtin_bit_cast(bf16x8, pk8(v));
          }
      } }
    f32x16 o[NDB];
#pragma unroll
    for (int db = 0; db < NDB; ++db)
#pragma unroll
        for (int i = 0; i < 16; ++i) o[db][i] = 0.f;
    float mrun = 0.f, lrun = 0.f;
    const int kc0 = tid, kc1 = tid + 512; const bool k1on = kc1 < NCK;
    const int kr0 = kc0 / CPR, kcc0 = kc0 % CPR, kr1 = kc1 / CPR, kcc1 = kc1 % CPR;
    const int vc0 = tid, vc1 = tid + 512; const bool v1on = vc1 < NCV;
    const GAS u32x4* Kg = (const GAS u32x4*)Kp;
    u32x4 ak0, ak1 = {0, 0, 0, 0}, av0, av1 = {0, 0, 0, 0}, bk0, bk1 = {0, 0, 0, 0}, bv0, bv1 = {0, 0, 0, 0};
#define ATT_GLOAD(P, t_) do { P##k0 = Kg[(size_t)(t_) * NCK + kc0]; if (k1on) P##k1 = Kg[(size_t)(t_) * NCK + kc1]; \
        P##v0 = *(const GAS u32x4*)(VTp + (size_t)(vc0 >> 3) * vt_stride + (t_) * 64 + (vc0 & 7) * 8); \
        if (v1on) P##v1 = *(const GAS u32x4*)(VTp + (size_t)(vc1 >> 3) * vt_stride + (t_) * 64 + (vc1 & 7) * 8); } while (0)
#define ATT_LSTORE(P, buf_) do { LAS unsigned char* kb_ = lds + (buf_) * BUF; LAS unsigned char* vb_ = kb_ + KBYTES; \
        *(LAS u32x4*)(kb_ + kr0 * KROW + kcc0 * 16) = P##k0; if (k1on) *(LAS u32x4*)(kb_ + kr1 * KROW + kcc1 * 16) = P##k1; \
        { LAS u32x2* d_ = (LAS u32x2*)(vb_ + (vc0 >> 3) * VROW + (vc0 & 7) * 16); d_[0] = (u32x2){P##v0.x, P##v0.y}; d_[1] = (u32x2){P##v0.z, P##v0.w}; } \
        if (v1on) { LAS u32x2* d_ = (LAS u32x2*)(vb_ + (vc1 >> 3) * VROW + (vc1 & 7) * 16); d_[0] = (u32x2){P##v1.x, P##v1.y}; d_[1] = (u32x2){P##v1.z, P##v1.w}; } } while (0)
    ATT_GLOAD(a, 0); ATT_LSTORE(a, 0);
    if (ntiles > 1) ATT_GLOAD(a, 1);
    __syncthreads();
    for (int t = 0; t < ntiles; t += 2) {
        if (t + 2 < ntiles) ATT_GLOAD(b, t + 2);
        if (!CAUSAL || (64 * t <= qlo + 31)) attn_tile<DQK, DV, CAUSAL>(lds, lds + KBYTES, qf, o, mrun, lrun, t, qlo, r, h);
        if (t + 1 < ntiles) ATT_LSTORE(a, 1);
        __syncthreads();
        if (t + 1 < ntiles) {
            if (t + 3 < ntiles) ATT_GLOAD(a, t + 3);
            if (!CAUSAL || (64 * (t + 1) <= qlo + 31)) attn_tile<DQK, DV, CAUSAL>(lds + BUF, lds + BUF + KBYTES, qf, o, mrun, lrun, t + 1, qlo, r, h);
            if (t + 2 < ntiles) ATT_LSTORE(b, 0);
            __syncthreads();
        }
    }
#undef ATT_GLOAD
#undef ATT_LSTORE
    const float ltot = lrun + __shfl_xor(lrun, 32), inv = 1.0f / ltot;
    bf16* orow = Op + (size_t)(wid * 32 + r) * ostride + 4 * h;
#pragma unroll
    for (int db = 0; db < NDB; ++db)
#pragma unroll
        for (int g = 0; g < 4; ++g) {
            u32x2 w; w.x = pk2(o[db][4 * g] * inv, o[db][4 * g + 1] * inv); w.y = pk2(o[db][4 * g + 2] * inv, o[db][4 * g + 3] * inv);
            *(GAS u32x2*)(orow + 32 * db + 8 * g) = w;
        }
}

template <int KSTEPS> DI void lds_mma(f32x16& c, const LAS unsigned char* A, int astride, const LAS unsigned char* Bt, int bstride, int r, int h) {
#pragma unroll
    for (int s = 0; s < KSTEPS; ++s) {
        const bf16x8 a = *(const LAS bf16x8*)(A + r * astride + 32 * s + 16 * h);
        const bf16x8 b = *(const LAS bf16x8*)(Bt + r * bstride + 32 * s + 16 * h);
        c = MFMA32(a, b, c);
    }
}

DI void hgrn_b1(LAS unsigned char* lds, int ch, float* GG, const bf16* HK, const bf16* HV, bf16* LT, float* DEC) {
    int tid_o = threadIdx.x; asm volatile("" : "+v"(tid_o)); const int tid = tid_o, wid = __builtin_amdgcn_readfirstlane(tid >> 6), lane = tid & 63, r = lane & 31, h = lane >> 5;
    const int bh = ch >> 6, c = ch & 63, b = bh >> 2, hd = bh & 3;
    const size_t t0 = (size_t)b * SEQ + c * 64;
    const int k = tid & 127, seg = tid >> 7;
    LAS float* segsum = (LAS float*)lds;
    LAS unsigned char* kdT = lds + 2048;
    LAS unsigned char* vT = kdT + 128 * 144;
    float g[16]; float run = 0.f;
    GAS float* gp = (GAS float*)(GG + (t0 + seg * 16) * 512 + hd * 128 + k);
#pragma unroll
    for (int i = 0; i < 16; ++i) { run += gp[(size_t)i * 512]; g[i] = run; }
    segsum[seg * 128 + k] = run;
    __syncthreads();
    float off = 0.f, tot = 0.f;
#pragma unroll
    for (int s = 0; s < 4; ++s) { const float v = segsum[s * 128 + k]; if (s < seg) off += v; tot += v; }
    const GAS bf16* kp = (const GAS bf16*)(HK + (t0 + seg * 16) * 512 + hd * 128 + k);
    const GAS bf16* vp = (const GAS bf16*)(HV + (t0 + seg * 16) * 512 + hd * 128 + k);
#pragma unroll
    for (int i = 0; i < 16; ++i) {
        const float G = g[i] + off; gp[(size_t)i * 512] = G;
        const float kd = bf2f(kp[(size_t)i * 512]) * __expf(tot - G);
        *(LAS bf16*)(kdT + k * 144 + (seg * 16 + i) * 2) = f2bf(kd);
        *(LAS bf16*)(vT + k * 144 + (seg * 16 + i) * 2) = vp[(size_t)i * 512];
    }
    if (seg == 0) ((GAS float*)DEC)[(size_t)ch * 128 + k] = __expf(tot);
    __syncthreads();
    const int vb = wid >> 1;
#pragma unroll
    for (int q = 0; q < 2; ++q) {
        const int kb = (wid & 1) * 2 + q;
        f32x16 acc;
#pragma unroll
        for (int i = 0; i < 16; ++i) acc[i] = 0.f;
        lds_mma<4>(acc, vT + vb * 32 * 144, 144, kdT + kb * 32 * 144, 144, r, h);
        GAS bf16* lp = (GAS bf16*)(LT + (size_t)ch * 16384 + (size_t)(vb * 32 + 4 * h) * 128 + kb * 32 + r);
#pragma unroll
        for (int i = 0; i < 16; ++i) lp[(size_t)((i & 3) + 8 * (i >> 2)) * 128] = f2bf(acc[i]);
    }
    __syncthreads();
}

DI void hgrn_b3(LAS unsigned char* lds, int ch, const float* GG, const bf16* HQ, const bf16* HK, const bf16* HV, const bf16* HGT, const bf16* LT, const float* onorm, bf16* HO) {
    constexpr int RS = 272;
    int tid_o = threadIdx.x; asm volatile("" : "+v"(tid_o)); const int tid = tid_o, wid = __builtin_amdgcn_readfirstlane(tid >> 6), lane = tid & 63, r = lane & 31, h = lane >> 5;
    const int bh = ch >> 6, c = ch & 63, b = bh >> 2, hd = bh & 3;
    const size_t t0 = (size_t)b * SEQ + c * 64;
    LAS unsigned char* qG = lds;
    LAS unsigned char* q1 = qG + 64 * RS;
    LAS unsigned char* kA0 = q1 + 32 * RS;
    LAS unsigned char* kA1 = kA0 + 32 * RS;
    LAS unsigned char* ST = kA1 + 64 * RS;
    LAS unsigned char* vT = ST + 128 * RS;
    LAS unsigned char* Am = vT + 128 * 144;
    {
        const int k8 = tid & 15;
        const float* g31p = GG + (t0 + 31) * 512 + hd * 128 + k8 * 8;
        const f32x4 ga = *(const f32x4*)g31p, gb = *(const GAS f32x4*)(g31p + 4);
        const float g31[8] = {ga.x, ga.y, ga.z, ga.w, gb.x, gb.y, gb.z, gb.w};
#pragma unroll
        for (int pass = 0; pass < 2; ++pass) {
            const int t = (tid >> 4) + 32 * pass;
            const size_t off = (t0 + t) * 512 + hd * 128 + k8 * 8;
            const f32x4 a = *(const GAS f32x4*)(GG + off), bq = *(const GAS f32x4*)(GG + off + 4);
            const float G[8] = {a.x, a.y, a.z, a.w, bq.x, bq.y, bq.z, bq.w};
            float q[8], kk[8], o1[8], o2[8], o3[8];
            unpk8(*(const GAS u32x4*)(HQ + off), q); unpk8(*(const GAS u32x4*)(HK + off), kk);
#pragma unroll
            for (int e = 0; e < 8; ++e) o1[e] = q[e] * __expf(G[e]);
            *(LAS u32x4*)(qG + t * RS + k8 * 16) = pk8(o1);
            if (pass == 0) {
#pragma unroll
                for (int e = 0; e < 8; ++e) { o2[e] = kk[e] * __expf(fminf(-G[e], 80.f)); o3[e] = kk[e] * __expf(g31[e] - G[e]); }
                *(LAS u32x4*)(kA0 + t * RS + k8 * 16) = pk8(o2);
                *(LAS u32x4*)(kA1 + t * RS + k8 * 16) = pk8(o3);
            } else {
#pragma unroll
                for (int e = 0; e < 8; ++e) { o2[e] = q[e] * __expf(G[e] - g31[e]); o3[e] = kk[e] * __expf(fminf(g31[e] - G[e], 80.f)); }
                *(LAS u32x4*)(q1 + (t - 32) * RS + k8 * 16) = pk8(o2);
                *(LAS u32x4*)(kA1 + t * RS + k8 * 16) = pk8(o3);
            }
        }
        const bf16* lp = LT + (size_t)ch * 16384;
#pragma unroll
        for (int p = 0; p < 4; ++p) {
            const int idx = tid + 512 * p, v = idx >> 4, kk8 = idx & 15;
            *(LAS u32x4*)(ST + v * RS + kk8 * 16) = *(const GAS u32x4*)(lp + v * 128 + kk8 * 8);
        }
        const int v = tid & 127, seg = tid >> 7;
        const GAS bf16* vp = (const GAS bf16*)(HV + (t0 + seg * 16) * 512 + hd * 128 + v);
#pragma unroll
        for (int i = 0; i < 16; ++i) *(LAS bf16*)(vT + v * 144 + (seg * 16 + i) * 2) = vp[(size_t)i * 512];
    }
    __syncthreads();
    if (wid < 3) {
        f32x16 a;
#pragma unroll
        for (int i = 0; i < 16; ++i) a[i] = 0.f;
        const int tb = wid == 0 ? 0 : 1, sb = wid == 2 ? 1 : 0;
        if (wid == 0) lds_mma<8>(a, qG, RS, kA0, RS, r, h);
        else lds_mma<8>(a, q1, RS, kA1 + sb * 32 * RS, RS, r, h);
#pragma unroll
        for (int i = 0; i < 16; ++i) { const int tl = (i & 3) + 8 * (i >> 2) + 4 * h; float val = a[i]; if (tb == sb && r > tl) val = 0.f;
            *(LAS bf16*)(Am + (tb * 32 + tl) * 144 + (sb * 32 + r) * 2) = f2bf(val); }
    } else if (wid == 3) {
#pragma unroll
        for (int i = 0; i < 16; ++i) { const int tl = (i & 3) + 8 * (i >> 2) + 4 * h; *(LAS bf16*)(Am + tl * 144 + (32 + r) * 2) = (bf16)0; }
    }
    __syncthreads();
    f32x16 acc;
#pragma unroll
    for (int i = 0; i < 16; ++i) acc[i] = 0.f;
    const int tb = wid >> 2, vb = wid & 3;
    lds_mma<8>(acc, qG + tb * 32 * RS, RS, ST + vb * 32 * RS, RS, r, h);
    lds_mma<4>(acc, Am + tb * 32 * 144, 144, vT + vb * 32 * 144, 144, r, h);
    __syncthreads();
    LAS float* Ost = (LAS float*)ST;
#pragma unroll
    for (int i = 0; i < 16; ++i) Ost[(tb * 32 + (i & 3) + 8 * (i >> 2) + 4 * h) * 132 + vb * 32 + r] = acc[i];
    __syncthreads();
    {
        const int t = tid >> 3, part = tid & 7;
        float ov[16]; float ss = 0.f;
#pragma unroll
        for (int q4 = 0; q4 < 4; ++q4) { const f32x4 x = *(const LAS f32x4*)(Ost + t * 132 + part * 16 + q4 * 4); ov[4 * q4] = x.x; ov[4 * q4 + 1] = x.y; ov[4 * q4 + 2] = x.z; ov[4 * q4 + 3] = x.w; }
#pragma unroll
        for (int e = 0; e < 16; ++e) ss += ov[e] * ov[e];
        ss += __shfl_xor(ss, 1); ss += __shfl_xor(ss, 2); ss += __shfl_xor(ss, 4);
        const float rs = rsqrtf(ss * (1.0f / 128.0f) + EPS);
        const size_t off = (t0 + t) * 512 + hd * 128 + part * 16;
        float gt[16];
        unpk8(*(const GAS u32x4*)(HGT + off), gt); unpk8(*(const GAS u32x4*)(HGT + off + 8), gt + 8);
#pragma unroll
        for (int e = 0; e < 16; ++e) ov[e] = ov[e] * rs * ((const GAS float*)onorm)[part * 16 + e] * gt[e];
        *(GAS u32x4*)(HO + off) = pk8(ov); *(GAS u32x4*)(HO + off + 8) = pk8(ov + 8);
    }
    __syncthreads();
}

DI int dest_row(int mode, int n) {
    if (mode == 0) return n;
    if (mode == 1) { const int j = n < DFF ? n : n - DFF; return (j >> 7) * 256 + (n < DFF ? 0 : 128) + (j & 127); }
    if (mode == 2) { if (n < 640) return n; if (n < 672) { const int j = n - 640; return 640 + (j < 16 ? 2 * j : 2 * (j - 16) + 1); } if (n < 3232) return 768 + (n - 672); return 3328 + (n - 3232); }
    const int hd = n / 96, w = n - hd * 96; if (w < 64) return n; const int j = w - 64; return hd * 96 + 64 + (j < 16 ? 2 * j : 2 * (j - 16) + 1);
}
DI void conv_item(const float* W, int K, int N, bf16* WT, const float* gain, int mode, int row_off, LAS float* scr, int item, int lane) {
    const int nblk = N / 32, kb = item / nblk, nb = item - kb * nblk, k0 = 64 * kb, n0 = 32 * nb;
    float wv[32];
    const GAS float* wp = (const GAS float*)(W + (size_t)(k0 + (lane >> 5)) * N + n0 + (lane & 31));
#pragma unroll
    for (int i = 0; i < 32; ++i) wv[i] = __builtin_nontemporal_load(wp + (size_t)(2 * i) * N);
#pragma unroll
    for (int i = 0; i < 32; ++i) scr[(2 * i + (lane >> 5)) * 33 + (lane & 31)] = wv[i];
    asm volatile("s_waitcnt lgkmcnt(0)" ::: "memory");
    const int c = lane & 7;
    float gn[8];
#pragma unroll
    for (int e = 0; e < 8; ++e) gn[e] = gain ? ((const GAS float*)gain)[k0 + 8 * c + e] : 1.0f;
#pragma unroll
    for (int j = 0; j < 4; ++j) { const int n = (lane >> 3) + 8 * j; const LAS float* s = scr + (8 * c) * 33 + n;
        float v[8];
#pragma unroll
        for (int e = 0; e < 8; ++e) v[e] = s[e * 33] * gn[e];
        *(GAS u32x4*)(WT + (size_t)(row_off + dest_row(mode, n0 + n)) * K + k0 + 8 * c) = pk8(v); }
    asm volatile("s_waitcnt lgkmcnt(0)" ::: "memory");
}

#define XB_TMO      128
#define XB_XCNT(j)  (256  + 64 * (j))
#define XB_XSUB(j)  (1280 + 64 * (j))
#define XB_XGEN(j)  (2304 + 64 * (j))
#define XB_TOP      3328
#define XB_TOPGEN   3392
#define XCD_BAR_WORDS 3456
#define XB_SPIN_CAP (1u << 18)
static_assert(XCD_BAR_WORDS * 4 <= CTL_BYTES, "barrier words inside the memset region");
DI unsigned xb_ld(unsigned* p)              { return __hip_atomic_load(p, __ATOMIC_RELAXED, __HIP_MEMORY_SCOPE_AGENT); }
DI unsigned xb_add(unsigned* p, unsigned v) { return __hip_atomic_fetch_add(p, v, __ATOMIC_RELAXED, __HIP_MEMORY_SCOPE_AGENT); }
DI unsigned xb_xcc_id() { return (unsigned)__builtin_amdgcn_s_getreg((3 << 11) | 20) & 0xFu; }
#define XB_SPIN(cond, bar) do { unsigned _sp = 0; while (cond) { __builtin_amdgcn_s_sleep(1); \
    if ((++_sp & 255u) == 0u) { if (xb_ld(&(bar)[XB_TMO])) break; if (_sp > XB_SPIN_CAP) { atomicAdd(&(bar)[XB_TMO], 1u); break; } } } } while (0)
struct XcdBarrier { unsigned* bar; unsigned x; volatile LAS unsigned* st; };
DI void xcd_barrier_complete(unsigned* bar, unsigned x, unsigned& nloc, unsigned& nx) {
    const unsigned G = gridDim.x * gridDim.y * gridDim.z;
    unsigned sum, cnt, mine, sp = 0u;
    for (;;) {
        sum = 0u; cnt = 0u; mine = 0u;
#pragma unroll
        for (unsigned j = 0; j < 16; ++j) { const unsigned c = xb_ld(&bar[XB_XCNT(j)]); sum += c; cnt += (c > 0u) ? 1u : 0u; mine = (j == x) ? c : mine; }
        if (sum == G) break;
        __builtin_amdgcn_s_sleep(1);
        if ((++sp & 255u) == 0u) { if (xb_ld(&bar[XB_TMO])) break; if (sp > XB_SPIN_CAP) { atomicAdd(&bar[XB_TMO], 1u); break; } }
    }
    nloc = mine > 0u ? mine : 1u; nx = cnt > 0u ? cnt : 1u;
}
DI void xcd_barrier(const XcdBarrier& b) {
    asm volatile("s_waitcnt vmcnt(0)" ::: "memory");
    __syncthreads();
    if (threadIdx.x == 0) {
        unsigned* bar = b.bar;
        __builtin_amdgcn_s_waitcnt(0);
        unsigned nloc = b.st[0], nx = b.st[1];
        if (nloc == 0u) { xcd_barrier_complete(bar, b.x, nloc, nx); b.st[0] = nloc; b.st[1] = nx; }
        const unsigned old = xb_add(&bar[XB_XSUB(b.x)], 1u);
        const unsigned gen = old / nloc;
        if (old + 1u == (gen + 1u) * nloc) {
            __builtin_amdgcn_fence(__ATOMIC_RELEASE, "agent");
            asm volatile("s_waitcnt vmcnt(0)" ::: "memory");
            const unsigned og = xb_add(&bar[XB_TOP], 1u);
            const unsigned tg = og / nx;
            if (og + 1u == (tg + 1u) * nx) xb_add(&bar[XB_TOPGEN], 1u);
            else XB_SPIN(xb_ld(&bar[XB_TOPGEN]) == tg, bar);
            __builtin_amdgcn_fence(__ATOMIC_ACQUIRE, "agent");
            xb_add(&bar[XB_XGEN(b.x)], 1u);
            asm volatile("s_waitcnt vmcnt(0)" ::: "memory");
        } else {
            XB_SPIN(xb_ld(&bar[XB_XGEN(b.x)]) == gen, bar);
            __builtin_amdgcn_fence(__ATOMIC_ACQUIRE, "agent");
            asm volatile("s_waitcnt vmcnt(0)" ::: "memory");
        }
    }
    __syncthreads();
}

struct Args { const void* in[25]; float* out; unsigned char* ws; int ph_lo, ph_hi; };
typedef const __attribute__((address_space(4))) unsigned long long* ka_t;
DI unsigned long long KA(int i) { ka_t p = (ka_t)__builtin_amdgcn_kernarg_segment_ptr(); asm volatile("" : "+s"(p)); return p[i]; }
#define KIN(i) ((const float*)KA(i))
#define KOUT ((float*)KA(25))
#define KWS ((unsigned char*)KA(26))

DI void conv_set(int mask, int l, int bpart, int nbparts, LAS unsigned char* lds) {
    int tid_o = threadIdx.x; asm volatile("" : "+v"(tid_o)); const int tid = tid_o, wave = __builtin_amdgcn_readfirstlane(tid >> 6), lane = tid & 63;
    const int part = bpart * NWAVES + wave, nparts = nbparts * NWAVES, tpart = bpart * NTHREADS + tid, ntparts = nbparts * NTHREADS;
    LAS float* scr = (LAS float*)(lds + wave * 16384);
    unsigned char* ws = KWS;
    constexpr int I_FI = 16 * 176, I_FO = 44 * 32, I_WIN = 16 * 197, I_UQ = 6 * 24, I_UK = 4 * 16, I_WO = 8 * 32, I_SQ = 16 * 32;
    if (mask & 1) {
        const float* f1n = KIN(3) + l * 1024; const float* w1i = KIN(4) + (size_t)l * 1024 * 5632; const float* w1o = KIN(5) + (size_t)l * 2816 * 1024;
        for (int it = part; it < I_FI + I_FO; it += nparts) {
            if (it < I_FI) conv_item(w1i, 1024, 5632, (bf16*)(ws + WT_W1IN), f1n, 1, 0, scr, it, lane);
            else conv_item(w1o, 2816, 1024, (bf16*)(ws + WT_W1OUT), nullptr, 0, 0, scr, it - I_FI, lane);
        }
    }
    if (mask & 4) {
        const float* f2n = KIN(21) + l * 1024; const float* w2i = KIN(22) + (size_t)l * 1024 * 5632; const float* w2o = KIN(23) + (size_t)l * 2816 * 1024;
        for (int it = part; it < I_FI + I_FO; it += nparts) {
            if (it < I_FI) conv_item(w2i, 1024, 5632, (bf16*)(ws + WT_W2IN), f2n, 1, 0, scr, it, lane);
            else conv_item(w2o, 2816, 1024, (bf16*)(ws + WT_W2OUT), nullptr, 0, 0, scr, it - I_FI, lane);
        }
    }
    if (mask & 2) {
        const float* mxn = KIN(6) + l * 1024; const float* win = KIN(7) + (size_t)l * 1024 * DIN;
        for (int it = part; it < I_WIN; it += nparts) conv_item(win, 1024, DIN, (bf16*)(ws + WT_WIN), mxn, 2, 0, scr, it, lane);
        u32x4* pad = (u32x4*)(ws + WT_WIN + (size_t)672 * 1024 * 2);
        unsigned zz = 0u; asm volatile("" : "+v"(zz));
        for (int i = tpart; i < 96 * 1024 * 2 / 16; i += ntparts) pad[i] = (u32x4){zz, zz, zz, zz};
    }
    if (mask & 8) {
        const float* qln = KIN(8) + l * 384; const float* kvn = KIN(9) + l * 256;
        const float* wuq = KIN(10) + (size_t)l * 384 * 768; const float* wuk = KIN(11) + (size_t)l * 256 * 512; const float* wuv = KIN(12) + (size_t)l * 256 * 512;
        const float* womla = KIN(13) + (size_t)l * 512 * 1024; const float* wohg = KIN(16) + (size_t)l * 512 * 1024; const float* womem = KIN(19) + (size_t)l * 512 * 1024;
        const float* wout = KIN(20) + (size_t)l * 1024 * 1024;
        constexpr int NIT = I_UQ + 2 * I_UK + 3 * I_WO + I_SQ;
        for (int it = part; it < NIT; it += nparts) {
            int r = it;
            if (r < I_UQ) { conv_item(wuq, 384, 768, (bf16*)(ws + WT_WUQ), qln, 3, 0, scr, r, lane); continue; } r -= I_UQ;
            if (r < I_UK) { conv_item(wuk, 256, 512, (bf16*)(ws + WT_WUKV), kvn, 0, 0, scr, r, lane); continue; } r -= I_UK;
            if (r < I_UK) { conv_item(wuv, 256, 512, (bf16*)(ws + WT_WUKV), kvn, 0, 512, scr, r, lane); continue; } r -= I_UK;
            if (r < I_WO) { conv_item(womla, 512, 1024, (bf16*)(ws + WT_WOMLA), nullptr, 0, 0, scr, r, lane); continue; } r -= I_WO;
            if (r < I_WO) { conv_item(wohg, 512, 1024, (bf16*)(ws + WT_WOHG), nullptr, 0, 0, scr, r, lane); continue; } r -= I_WO;
            if (r < I_WO) { conv_item(womem, 512, 1024, (bf16*)(ws + WT_WOMEM), nullptr, 0, 0, scr, r, lane); continue; } r -= I_WO;
            conv_item(wout, 1024, 1024, (bf16*)(ws + WT_WOUT), nullptr, 0, 0, scr, r, lane);
        }
    }
    if (mask & 16) {
        const float* memn = KIN(17); const float* wmkv = KIN(18);
        for (int it = part; it < 4 * I_SQ; it += nparts) { const int ll = it / I_SQ, r = it - ll * I_SQ;
            conv_item(wmkv + (size_t)ll * 1024 * 1024, 1024, 1024, (bf16*)(ws + WT_WMEMKV) + (size_t)ll * 1024 * 1024, memn + ll * 1024, 0, 0, scr, r, lane); }
    }
    __syncthreads();
}
DI void conv_tail(int mask, int l, int nwg, LAS unsigned char* lds) {
    const int G = (int)gridDim.x, rem = nwg % G, c = (int)blockIdx.x;
    if (c < rem) return;
    conv_set(mask, l, c - rem, G - rem, lds);
}

DI void prep_phase() {
    int tid_o = threadIdx.x; asm volatile("" : "+v"(tid_o)); const int tid = tid_o, wave = __builtin_amdgcn_readfirstlane(tid >> 6), lane = tid & 63;
    const int gw = blockIdx.x * NWAVES + wave, NGW = gridDim.x * NWAVES;
    unsigned char* ws = KWS;
    const float* x = KIN(0); const float* mem = KIN(1); const int* pos = (const int*)KA(2);
    bf16* XB = (bf16*)(ws + WS_XB); float* SSQ = (float*)(ws + WS_SSQ);
    for (int m = gw; m < T; m += NGW) {
        const GAS f32x4* xr = (const GAS f32x4*)(x + (size_t)m * D) + lane; GAS u32x2* xb = (GAS u32x2*)(XB + (size_t)m * D) + lane;
        float s = 0.f;
#pragma unroll
        for (int j = 0; j < 4; ++j) { const f32x4 v = xr[64 * j]; u32x2 w; w.x = pk2(v.x, v.y); w.y = pk2(v.z, v.w); xb[64 * j] = w;
            const float a = bflo(w.x), b = bfhi(w.x), c = bflo(w.y), d = bfhi(w.y); s += (a * a + b * b) + (c * c + d * d); }
        s = wave_sum(s);
        if (lane < 16) SSQ[(size_t)m * 16 + lane] = lane == 0 ? s : 0.f;
    }
    bf16* MEMB = (bf16*)(ws + WS_MEMB); float* MRS = (float*)(ws + WS_MEMRSTD);
    for (int m = gw; m < 1024; m += NGW) {
        const GAS f32x4* xr = (const GAS f32x4*)(mem + (size_t)m * D) + lane; GAS u32x2* xb = (GAS u32x2*)(MEMB + (size_t)m * D) + lane;
        float s = 0.f;
#pragma unroll
        for (int j = 0; j < 4; ++j) { const f32x4 v = xr[64 * j]; s += (v.x * v.x + v.y * v.y) + (v.z * v.z + v.w * v.w); u32x2 w; w.x = pk2(v.x, v.y); w.y = pk2(v.z, v.w); xb[64 * j] = w; }
        s = wave_sum(s);
        if (lane == 0) MRS[m] = rsqrtf(s * (1.0f / 1024.0f) + EPS);
    }
    float* COS = (float*)(ws + WS_COS); float* SIN = (float*)(ws + WS_SIN);
    for (int i = blockIdx.x * NTHREADS + tid; i < T * 16; i += gridDim.x * NTHREADS) {
        const int row = i >> 4, fi = i & 15;
        const float invf = exp2f(-13.287712379549449f * (float)fi * (1.0f / 16.0f));
        const float ang = (float)pos[row] * invf;
        const float kq = rintf(ang * 0.15915494309189535f);
        float rr = fmaf(-kq, 6.28125f, ang); rr = fmaf(-kq, 1.9353071795864769e-3f, rr);
        COS[i] = __cosf(rr); SIN[i] = __sinf(rr);
    }
    const float* hlb = KIN(14); float* LBS = (float*)(ws + WS_LBS);
    for (int i = blockIdx.x * NTHREADS + tid; i < 512; i += gridDim.x * NTHREADS) {
        const float a0 = hlb[i], a1 = hlb[512 + i], a2 = hlb[1024 + i], a3 = hlb[1536 + i];
        const float mx = fmaxf(fmaxf(a0, a1), fmaxf(a2, a3));
        const float e0 = __expf(a0 - mx), e1 = __expf(a1 - mx), e2 = __expf(a2 - mx), e3 = __expf(a3 - mx), inv = 1.0f / (e0 + e1 + e2 + e3);
        LBS[i] = 0.f; LBS[512 + i] = e1 * inv; LBS[1024 + i] = (e1 + e2) * inv; LBS[1536 + i] = (e1 + e2 + e3) * inv;
    }
}

__global__ void __launch_bounds__(NTHREADS, 2) fwd_kernel(Args A_unused) {
    extern __shared__ __attribute__((aligned(16))) unsigned char lds_raw[];
    LAS unsigned char* lds = (LAS unsigned char*)lds_raw;
    cg::grid_group grid = cg::this_grid();
    int ph = 0;
    int lo, hi; { const unsigned long long w = KA(27); lo = (int)(unsigned)w; hi = (int)(unsigned)(w >> 32); }
#define RUN (ph >= lo && ph < hi)
    volatile LAS unsigned* bst = (volatile LAS unsigned*)(lds + 131072 + 512);
    if (threadIdx.x < 2) bst[threadIdx.x] = 0u;
    __syncthreads();
    if (threadIdx.x == 0) (void)xb_add(&((unsigned*)(KWS + WS_CTL))[XB_XCNT(xb_xcc_id())], 1u);
#define SEAM do { if (ph >= lo && ph + 1 < hi) { if (ph == 1) grid.sync(); else { XcdBarrier xb_; xb_.bar = (unsigned*)(KWS + WS_CTL); xb_.x = xb_xcc_id(); xb_.st = bst; xcd_barrier(xb_); } } ++ph; } while (0)
#define WSP(T_, name, off) T_* name = (T_*)(ws + (off))
#define REPEAT(n_) for (int rep_ = 0; rep_ < (n_); ++rep_, ((rep_ < (n_)) ? xcd_barrier(XcdBarrier{(unsigned*)(KWS + WS_CTL), xb_xcc_id(), bst}) : (void)0))

    if (RUN) { prep_phase(); }
    ++ph;
    for (int l = 0; l < DEPTH; ++l) {
        if (l == 0) {
            if (RUN) conv_set(1 | 2 | 16, 0, (int)blockIdx.x, (int)gridDim.x, lds);
            SEAM;
        }
#ifdef PROBE_NULL_P1
        if (RUN) { unsigned char* ws = KWS; PROBE_NULL_P1 E{(bf16*)(ws + WS_H)}; run_gemm(lds, (const bf16*)(ws + WS_XB), (const bf16*)(ws + WT_W1IN), T, 5632, 1024, 0, E);
            XcdBarrier xb_; xb_.bar = (unsigned*)(KWS + WS_CTL); xb_.x = xb_xcc_id(); xb_.st = bst; xcd_barrier(xb_); }
#endif
#ifndef SKIP_G1
        if (RUN) REPEAT(REP_P1) { unsigned char* ws = KWS; EpiSwiglu E{(bf16*)(ws + WS_H), (const float*)(ws + WS_SSQ), lds}; run_gemm(lds, (const bf16*)(ws + WS_XB), (const bf16*)(ws + WT_W1IN), T, 5632, 1024, 0, E);
            if (l == 0) {
                const int rem = (64 * 22) % (int)gridDim.x;
#pragma unroll 1
                for (int ll = 0; ll < DEPTH; ++ll) { unsigned char* ws2 = KWS; EpiMemKV E2{(bf16*)(ws2 + WS_MK) + (size_t)ll * 16 * 256 * 128, (bf16*)(ws2 + WS_MVT) + (size_t)ll * 16 * 128 * 256, (const float*)(ws2 + WS_MEMRSTD)};
                    run_gemm(lds, (const bf16*)(ws2 + WS_MEMB), (const bf16*)(ws2 + WT_WMEMKV) + (size_t)ll * 1024 * 1024, 1024, 1024, 1024, (rem + 16 * ll) % (int)gridDim.x, E2); }
            } else conv_tail(2, l, 64 * 22, lds);
        }
#endif
        SEAM;
#ifndef SKIP_G2
        if (RUN) { unsigned char* ws = KWS; EpiResid E{(bf16*)(ws + WS_XB), (float*)(ws + WS_SSQ), 0.5f}; run_gemm(lds, (const bf16*)(ws + WS_H), (const bf16*)(ws + WT_W1OUT), T, 1024, DFF, 0, E); }
#endif
        SEAM;
#ifndef SKIP_WIN
        if (RUN) REPEAT(REP_P3) { unsigned char* ws = KWS;
            EpiWin E{ws, (const float*)(ws + WS_LBS) + l * 512, lds};
            run_gemm(lds, (const bf16*)(ws + WS_XB), (const bf16*)(ws + WT_WIN), T, NIN, 1024, 0, E);
            conv_tail(4 | 8, l, 64 * 25, lds); }
#endif
        SEAM;
        if (RUN) {
#ifndef SKIP_G4
            REPEAT(REP_P4G) {
            { unsigned char* ws = KWS; EpiQ E{(bf16*)(ws + WS_Q)}; run_gemm(lds, (const bf16*)(ws + WS_CQ), (const bf16*)(ws + WT_WUQ), T, 768, 384, 0, E); }
            { unsigned char* ws = KWS; EpiKV E{(bf16*)(ws + WS_KC), (bf16*)(ws + WS_VT), (const float*)(ws + WS_SSQKV)}; run_gemm(lds, (const bf16*)(ws + WS_CKV), (const bf16*)(ws + WT_WUKV), T, 1024, 256, 64, E); }
            }
#endif
#ifndef SKIP_B1
            { unsigned char* ws = KWS; const int G = (int)gridDim.x;
              for (int ch = (int)blockIdx.x; ch < 1024; ch += G) hgrn_b1(lds, ch, (float*)(ws + WS_GG), (const bf16*)(ws + WS_HK), (const bf16*)(ws + WS_HV), (bf16*)(ws + WS_LT), (float*)(ws + WS_DEC)); }
#endif
        }
        SEAM;
        if (RUN) {
            unsigned char* ws = KWS; int tid_o = threadIdx.x; asm volatile("" : "+v"(tid_o)); const int G = (int)gridDim.x, bid = (int)blockIdx.x, tid = tid_o;
#ifndef SKIP_MLA
            REPEAT(REP_MLA) for (int it = bid; it < 256; it += G) {
                const int bh = it >> 3, pr = it & 7, b = bh >> 3, hd = bh & 7;
#pragma unroll 1
                for (int half = 0; half < 2; ++half) {
                    const int qb = half == 0 ? 15 - pr : pr;
                    const size_t row0 = (size_t)b * SEQ + qb * 256;
                    attn_item<96, 64, true>(lds, (const bf16*)(ws + WS_Q) + row0 * 768 + hd * 96, 768, (const bf16*)(ws + WS_KC) + (size_t)bh * SEQ * 96, (const bf16*)(ws + WS_VT) + (size_t)bh * 64 * SEQ, SEQ,
                                            (bf16*)(ws + WS_AO) + row0 * 512 + hd * 64, 512, qb * 256, SEQ, (const float*)(ws + WS_SSQQ) + row0 * 16, (const float*)(ws + WS_COS) + row0 * 16, (const float*)(ws + WS_SIN) + row0 * 16);
                }
            }
#endif
            unsigned* LT2 = (unsigned*)(ws + WS_LT); const float* DEC = (const float*)(ws + WS_DEC);
            for (int gt = bid * NTHREADS + tid; gt < 16 * 8192; gt += G * NTHREADS) {
                const int bh = gt >> 13, e2 = gt & 8191, k = (e2 & 63) * 2;
                GAS unsigned* lp = (GAS unsigned*)(LT2 + (size_t)bh * 64 * 8192 + e2); const GAS float* dp = (const GAS float*)(DEC + (size_t)bh * 64 * 128 + k);
                float run0 = 0.f, run1 = 0.f;
#pragma unroll 8
                for (int c = 0; c < 64; ++c) { const unsigned tmp = lp[(size_t)c * 8192]; const f32x2_t d = *(const GAS f32x2_t*)(dp + c * 128); lp[(size_t)c * 8192] = pk2(run0, run1); run0 = d.x * run0 + bflo(tmp); run1 = d.y * run1 + bfhi(tmp); }
            }
        }
        SEAM;
        if (RUN) REPEAT(REP_P6) {
            unsigned char* ws = KWS; const int G = (int)gridDim.x, bid = (int)blockIdx.x;
#ifndef SKIP_XATT
            for (int it = bid; it < 256; it += G) {
                const int b = it >> 6, hd = (it >> 4) & 3, qb = it & 15;
                const size_t row0 = (size_t)b * SEQ + qb * 256;
                attn_item<128, 128, false>(lds, (const bf16*)(ws + WS_MQ) + row0 * 512 + hd * 128, 512, (const bf16*)(ws + WS_MK) + (size_t)(l * 16 + b * 4 + hd) * 256 * 128, (const bf16*)(ws + WS_MVT) + (size_t)(l * 16 + b * 4 + hd) * 128 * 256, 256,
                                           (bf16*)(ws + WS_MO) + row0 * 512 + hd * 128, 512, 0, 256, nullptr, nullptr, nullptr);
            }
#endif
#ifndef SKIP_B3
            const float* onorm = KIN(15) + l * 128;
            for (int ch = bid; ch < 1024; ch += G) hgrn_b3(lds, ch, (const float*)(ws + WS_GG), (const bf16*)(ws + WS_HQ), (const bf16*)(ws + WS_HK), (const bf16*)(ws + WS_HV), (const bf16*)(ws + WS_HGT), (const bf16*)(ws + WS_LT), onorm, (bf16*)(ws + WS_HO));
#endif
        }
        SEAM;
#ifndef SKIP_G7
        if (RUN) REPEAT(REP_P7) {
            unsigned char* ws = KWS; EpiBranch3 E{(bf16*)(ws + WS_MERGED), (const bf16*)(ws + WS_GATES)};
            int Kv = 512, Nv = 1024, Mv = T; asm volatile("" : "+s"(Kv), "+s"(Nv), "+s"(Mv));
            pg8::Gemm g{(const bf16*)(ws + WS_AO), (const bf16*)(ws + WT_WOMLA), Mv, Nv, Kv};
            SegOrder3 S; S.init(Mv, Nv, (int)gridDim.x, (int)blockIdx.x); S.wsb = (const char*)ws;
            pg8::gemm_phase<EpiBranch3, SegOrder3, true, true>(lds, g, S, E);
        }
#endif
        SEAM;
#ifndef SKIP_G8
        if (RUN) { unsigned char* ws = KWS; EpiResid E{(bf16*)(ws + WS_XB), (float*)(ws + WS_SSQ), 1.0f}; run_gemm(lds, (const bf16*)(ws + WS_MERGED), (const bf16*)(ws + WT_WOUT), T, 1024, 1024, 0, E); }
#endif
        SEAM;
#ifndef SKIP_G9
        if (RUN) { unsigned char* ws = KWS; EpiSwiglu E{(bf16*)(ws + WS_H), (const float*)(ws + WS_SSQ), lds}; run_gemm(lds, (const bf16*)(ws + WS_XB), (const bf16*)(ws + WT_W2IN), T, 5632, 1024, 0, E);
            if (l + 1 < DEPTH) conv_tail(1, l + 1, 64 * 22, lds); }
#endif
        SEAM;
#ifndef SKIP_G10
        if (RUN) { unsigned char* ws = KWS; EpiResid E{(bf16*)(ws + WS_XB), (float*)(ws + WS_SSQ), 0.5f}; run_gemm(lds, (const bf16*)(ws + WS_H), (const bf16*)(ws + WT_W2OUT), T, 1024, DFF, 0, E); }
#endif
        SEAM;
    }
    if (RUN) {
        unsigned char* ws = KWS; float* X = KOUT; const float* SSQ = (const float*)(ws + WS_SSQ); const bf16* XB = (const bf16*)(ws + WS_XB);
        int tid_o = threadIdx.x; asm volatile("" : "+v"(tid_o)); const int tid = tid_o, wave = __builtin_amdgcn_readfirstlane(tid >> 6), lane = tid & 63, G = (int)gridDim.x;
        const float* fg = KIN(24);
        for (int m = (int)blockIdx.x * NWAVES + wave; m < T; m += G * NWAVES) {
            const float rs = rsqrtf(sum16(SSQ + (size_t)m * 16) * (1.0f / 1024.0f) + EPS);
            f32x4* xr = (f32x4*)(X + (size_t)m * D) + lane; const f32x4* gr = (const f32x4*)fg + lane; const u32x2* xb = (const u32x2*)(XB + (size_t)m * D) + lane;
#pragma unroll
            for (int j = 0; j < 4; ++j) { const u32x2 w = xb[64 * j]; const f32x4 g = gr[64 * j]; f32x4 v = {bflo(w.x), bfhi(w.x), bflo(w.y), bfhi(w.y)}; v = v * rs * g; xr[64 * j] = v; }
        }
    }
#undef RUN
#undef SEAM
}

constexpr int N_PHASES = 1 + 1 + DEPTH * 10 + 1;

extern "C" void kernel_launch(void* const* d_in, const int* in_sizes, int n_in, void* d_out, int out_size, void* d_ws, size_t ws_size, hipStream_t stream) {
    static int grid = 0;
    if (grid == 0) {
        if (n_in != 25 || out_size != T * D || ws_size < WS_END) { fprintf(stderr, "kernel_launch: unexpected shapes (n_in %d out %d ws %zu need %zu)\n", n_in, out_size, ws_size, (size_t)WS_END); grid = -1; return; }
        int dev = 0, cus = 0, per_cu = 0;
        hipGetDevice(&dev);
        hipDeviceGetAttribute(&cus, hipDeviceAttributeMultiprocessorCount, dev);
        if (hipFuncSetAttribute((const void*)fwd_kernel, hipFuncAttributeMaxDynamicSharedMemorySize, LDS_BYTES) != hipSuccess) { fprintf(stderr, "kernel_launch: hipFuncSetAttribute failed\n"); grid = -1; return; }
        if (hipOccupancyMaxActiveBlocksPerMultiprocessor(&per_cu, (const void*)fwd_kernel, NTHREADS, LDS_BYTES) != hipSuccess || per_cu < 1) { fprintf(stderr, "kernel_launch: occupancy query says %d\n", per_cu); per_cu = 1; }
        (void)hipGetLastError();
        grid = cus * 1;
        if (grid <= 0) grid = 256;
    }
    if (grid < 0) return;
    if (hipMemsetAsync((char*)d_ws + WS_CTL, 0, CTL_BYTES, stream) != hipSuccess) { fprintf(stderr, "kernel_launch: memset of the barrier words failed\n"); return; }
    Args a{};
    for (int i = 0; i < 25; ++i) a.in[i] = d_in[i];
    a.out = (float*)d_out; a.ws = (unsigned char*)d_ws; a.ph_lo = 0; a.ph_hi = N_PHASES;
    void* args[] = {&a};
    hipError_t e = hipLaunchCooperativeKernel((const void*)fwd_kernel, dim3(grid), dim3(NTHREADS), args, LDS_BYTES, stream);
    if (e != hipSuccess) fprintf(stderr, "cooperative launch failed: %s (grid %d)\n", hipGetErrorString(e), grid);
}
```

```cpp
#include <hip/hip_runtime.h>
#include <hip/hip_cooperative_groups.h>
#include <cstdio>
#include <cstdint>
namespace cg = cooperative_groups;
#define DI __device__ __forceinline__
namespace pg8 {
#define PG8_LAS __attribute__((address_space(3)))
typedef unsigned short bf16_t;
typedef short bf16x8 __attribute__((ext_vector_type(8)));
typedef float f32x4 __attribute__((ext_vector_type(4)));
typedef unsigned u32x4 __attribute__((ext_vector_type(4)));
constexpr int BM = 256, BK = 64, HALF = 128, HTB = HALF * BK * 2  , STAGE_BYTES = 8 * HTB, NXCD = 8, WGM = 8;

__host__ __device__ __forceinline__ int lds_byte(int r, int c) { const int st = (r >> 4) * 2 + (c >> 5), rr = r & 15, cc = c & 31, ob = rr * 64 + cc * 2; return st * 1024 + (ob ^ (((ob >> 9) & 1) << 5)); }
__host__ __device__ __forceinline__ void stage_rc(int b, int& R, int& C) { const int st = b / 1024, sb = b % 1024, swz = sb ^ (((sb >> 9) & 1) << 5); R = (st >> 1) * 16 + swz / 64; C = (st & 1) * 32 + (swz % 64) / 2; }
__host__ __device__ __forceinline__ int perm32(int rho) { const int n = rho >> 4, i = rho & 15; return 8 * (i >> 2) + 4 * n + (i & 3); }

struct Unit { int pm, pn, seg; };
struct Gemm { const bf16_t* A; const bf16_t* Bt; int M, N, K; };

struct StaticOrder {
    int nM, nN, nwg, G, c;
    __host__ __device__ void init(int M, int N, int G_, int c_) { nM = M / BM; nN = N / BM; nwg = nM * nN; G = G_; c = c_; }
    __host__ __device__ bool next(int i, Unit& u) const {
        const long L = (long)i * G + c; if (L >= nwg) return false;
        int wgid = (int)L; { const int q = nwg / NXCD, r = nwg % NXCD, xcd = wgid % NXCD, off = wgid / NXCD; wgid = (xcd < r ? xcd * (q + 1) : r * (q + 1) + (xcd - r) * q) + off; }
        const int nig = WGM * nN, gid = wgid / nig, fm = gid * WGM, gsz = (nM - fm) < WGM ? (nM - fm) : WGM;
        u.pm = fm + ((wgid % nig) % gsz); u.pn = (wgid % nig) / gsz; u.seg = 0; return true;
    }
    __device__ __forceinline__ const char* a_ptr(const Gemm& g, const Unit&) const { return (const char*)g.A; }
    __device__ __forceinline__ const char* b_ptr(const Gemm& g, const Unit&) const { return (const char*)g.Bt; }
    __device__ __forceinline__ void a_ready(const Unit&) const {}
    __device__ __forceinline__ void done(const Unit&) const {}
};
template <class Epi, class Sched, bool ALIGN_EPI = false, bool SP2 = false>
__device__ __forceinline__ void gemm_phase(PG8_LAS unsigned char* lds, const Gemm g, const Sched& S, const Epi& E) {
    int tid_o = threadIdx.x; asm volatile("" : "+v"(tid_o));
    const int tid = tid_o, wid = __builtin_amdgcn_readfirstlane(tid >> 6), lane = tid & 63, wr = wid >> 2, wc = wid & 3, fr = lane & 15, fq = lane >> 4;
    const int K = g.K, nt = K / BK;
    unsigned voffA[2], voffB[2];
#pragma unroll
    for (int i = 0; i < 2; ++i) { int R, C; stage_rc(tid * 16 + i * 8192, R, C); const int Rb = Epi::PERM ? ((R & ~31) + perm32(R & 31)) : R;
        voffA[i] = (unsigned)(R * K + C) * 2u; voffB[i] = (unsigned)(Rb * K + C) * 2u; }
    const size_t kstep = (size_t)(BK * 2);
    const size_t hstep = (size_t)HALF * K * 2;
    const size_t tstep = 2 * hstep;
    const unsigned ldsw = (unsigned)wid * 1024u;
    const int aoff = lds_byte(wr * 64 + fr, fq * 8), boff = lds_byte(wc * 32 + fr, fq * 8);
#define PG8_SA(b, h) (((b) * 2 + (h)) * HTB)
#define PG8_SB(b, h) ((4 + (b) * 2 + (h)) * HTB)
#define PG8_STAGE(bufoff, gbase, voff) do { _Pragma("unroll") for (int _i = 0; _i < 2; ++_i) \
        __builtin_amdgcn_global_load_lds((const unsigned*)((const char*)(gbase) + (voff)[_i]), (PG8_LAS unsigned*)(lds + (bufoff) + ldsw + _i * 8192), 16, 0, 0); } while (0)
#define PG8_LDA(dst, b, h) do { _Pragma("unroll") for (int m = 0; m < 4; ++m) _Pragma("unroll") for (int k = 0; k < 2; ++k) dst[m][k] = *(const PG8_LAS bf16x8*)(lds + PG8_SA(b, h) + aoff + m * 2048 + k * 1024); } while (0)
#define PG8_LDB(dst, b, h) do { _Pragma("unroll") for (int n = 0; n < 2; ++n) _Pragma("unroll") for (int k = 0; k < 2; ++k) dst[n][k] = *(const PG8_LAS bf16x8*)(lds + PG8_SB(b, h) + boff + n * 2048 + k * 1024); } while (0)
#define PG8_MMA(ai, bj, At, Bt) do { __builtin_amdgcn_s_setprio(1); _Pragma("unroll") for (int m = 0; m < 4; ++m) _Pragma("unroll") for (int n = 0; n < 2; ++n) _Pragma("unroll") for (int k = 0; k < 2; ++k) \
        acc[ai][bj][m][n] = __builtin_amdgcn_mfma_f32_16x16x32_bf16(Bt[n][k], At[m][k], acc[ai][bj][m][n], 0, 0, 0); __builtin_amdgcn_s_setprio(0); } while (0)
#define PG8_WAIT_V(n) asm volatile("s_waitcnt vmcnt(" #n ")" ::: "memory")
#define PG8_WAIT_L(n) asm volatile("s_waitcnt lgkmcnt(" #n ")" ::: "memory")
#define PG8_BAR __builtin_amdgcn_s_barrier()
#define PG8_SCHED __builtin_amdgcn_sched_barrier(0)
    Unit cur, nxt; int ui = 0;
    if (!S.next(0, cur)) return;
    f32x4 acc[2][2][4][2];
#pragma unroll
    for (int a = 0; a < 2; ++a)
#pragma unroll
        for (int b = 0; b < 2; ++b)
#pragma unroll
            for (int m = 0; m < 4; ++m)
#pragma unroll
                for (int n = 0; n < 2; ++n) acc[a][b][m][n] = (f32x4){0.f, 0.f, 0.f, 0.f};
    bf16x8 At[4][2], B0[2][2], B1[2][2];
    const char* cA = S.a_ptr(g, cur) + (size_t)cur.pm * tstep; const char* cB = S.b_ptr(g, cur) + (size_t)cur.pn * tstep;
    S.a_ready(cur);
    if constexpr (SP2) {
        PG8_STAGE(PG8_SB(0, 0), cB, voffB); PG8_STAGE(PG8_SB(0, 1), cB + hstep, voffB); PG8_STAGE(PG8_SA(0, 0), cA, voffA); PG8_STAGE(PG8_SA(0, 1), cA + hstep, voffA);
        if (wr == 1) PG8_BAR;
        PG8_WAIT_V(2); PG8_BAR;
        PG8_STAGE(PG8_SB(1, 0), cB + kstep, voffB); PG8_STAGE(PG8_SA(1, 0), cA + kstep, voffA); PG8_STAGE(PG8_SB(1, 1), cB + hstep + kstep, voffB);
        PG8_WAIT_V(6); PG8_BAR;
    } else {
        PG8_STAGE(PG8_SB(0, 0), cB, voffB); PG8_STAGE(PG8_SA(0, 0), cA, voffA); PG8_STAGE(PG8_SB(0, 1), cB + hstep, voffB); PG8_STAGE(PG8_SA(0, 1), cA + hstep, voffA);
        if (wr == 1) PG8_BAR;
        PG8_WAIT_V(4); PG8_BAR;
        PG8_STAGE(PG8_SB(1, 0), cB + kstep, voffB); PG8_STAGE(PG8_SA(1, 0), cA + kstep, voffA); PG8_STAGE(PG8_SB(1, 1), cB + hstep + kstep, voffB);
        PG8_WAIT_V(6); PG8_BAR;
    }
    for (;;) {
        const bool has_next = S.next(ui + 1, nxt);
        const char* nA = has_next ? S.a_ptr(g, nxt) + (size_t)nxt.pm * tstep : cA; const char* nB = has_next ? S.b_ptr(g, nxt) + (size_t)nxt.pn * tstep : cB;
        for (int t = 0; t < nt; t += 2) {
            const bool last = (t == nt - 2);
            const char* a1 = cA + (size_t)(t + 1) * kstep;
            const char* a2 = last ? nA : cA + (size_t)(t + 2) * kstep; const char* b2 = last ? nB : cB + (size_t)(t + 2) * kstep;
            const char* a3 = a2 + kstep; const char* b3 = b2 + kstep;
            if (last && has_next) S.a_ready(nxt);
            if (last) E.prefetch(lds, cur, wid, lane);
            if constexpr (SP2) {
            PG8_LDB(B0, 0, 0); PG8_LDB(B1, 0, 1); PG8_SCHED; PG8_LDA(At, 0, 0); PG8_STAGE(PG8_SA(1, 1), a1 + hstep, voffA);
            PG8_WAIT_V(8); PG8_WAIT_L(0); PG8_BAR; PG8_MMA(0, 0, At, B0); PG8_MMA(0, 1, At, B1); PG8_BAR; PG8_SCHED;
            PG8_LDA(At, 0, 1); PG8_STAGE(PG8_SB(0, 0), b2, voffB); PG8_STAGE(PG8_SB(0, 1), b2 + hstep, voffB); PG8_STAGE(PG8_SA(0, 0), a2, voffA);
            PG8_WAIT_V(8); PG8_WAIT_L(0); PG8_BAR; PG8_MMA(1, 0, At, B0); PG8_MMA(1, 1, At, B1); PG8_BAR; PG8_SCHED;
            PG8_LDB(B0, 1, 0); PG8_LDB(B1, 1, 1); PG8_SCHED; PG8_LDA(At, 1, 0); PG8_STAGE(PG8_SA(0, 1), a2 + hstep, voffA);
            PG8_WAIT_V(8); PG8_WAIT_L(0); PG8_BAR; PG8_MMA(0, 0, At, B0); PG8_MMA(0, 1, At, B1); PG8_BAR; PG8_SCHED;
            PG8_LDA(At, 1, 1); PG8_STAGE(PG8_SB(1, 0), b3, voffB); PG8_STAGE(PG8_SB(1, 1), b3 + hstep, voffB); PG8_STAGE(PG8_SA(1, 0), a3, voffA);
            PG8_WAIT_V(8); PG8_WAIT_L(0); PG8_BAR; PG8_MMA(1, 0, At, B0); PG8_MMA(1, 1, At, B1); PG8_BAR; PG8_SCHED;
            } else {
            PG8_LDB(B0, 0, 0); PG8_SCHED; PG8_LDA(At, 0, 0); PG8_STAGE(PG8_SA(1, 1), a1 + hstep, voffA);
            PG8_WAIT_L(8); PG8_BAR; PG8_WAIT_L(0); PG8_MMA(0, 0, At, B0); PG8_BAR; PG8_SCHED;
            PG8_LDB(B1, 0, 1); PG8_STAGE(PG8_SB(0, 0), b2, voffB);
            PG8_BAR; PG8_WAIT_L(0); PG8_MMA(0, 1, At, B1); PG8_BAR;
            PG8_LDA(At, 0, 1); PG8_STAGE(PG8_SA(0, 0), a2, voffA);
            PG8_BAR; PG8_WAIT_L(0); PG8_MMA(1, 0, At, B0); PG8_BAR; PG8_SCHED;
            PG8_STAGE(PG8_SB(0, 1), b2 + hstep, voffB);
            PG8_WAIT_V(6); PG8_BAR; PG8_MMA(1, 1, At, B1); PG8_BAR;
            PG8_LDB(B0, 1, 0); PG8_SCHED; PG8_LDA(At, 1, 0); PG8_STAGE(PG8_SA(0, 1), a2 + hstep, voffA);
            PG8_WAIT_L(8); PG8_BAR; PG8_WAIT_L(0); PG8_MMA(0, 0, At, B0); PG8_BAR; PG8_SCHED;
            PG8_LDB(B1, 1, 1); PG8_STAGE(PG8_SB(1, 0), b3, voffB);
            PG8_BAR; PG8_WAIT_L(0); PG8_MMA(0, 1, At, B1); PG8_BAR;
            PG8_LDA(At, 1, 1); PG8_STAGE(PG8_SA(1, 0), a3, voffA);
            PG8_BAR; PG8_WAIT_L(0); PG8_MMA(1, 0, At, B0); PG8_BAR; PG8_SCHED;
            PG8_STAGE(PG8_SB(1, 1), b3 + hstep, voffB);
            PG8_WAIT_V(6); PG8_BAR; PG8_MMA(1, 1, At, B1); PG8_BAR;
            }
        }
        if constexpr (ALIGN_EPI) { if (wr == 0) PG8_BAR; }
        if constexpr (!Epi::AFTER_DRAIN) { E(acc, cur, wr, wc, fr, fq); S.done(cur); }
        if (!has_next) break;
        if (!E.keep_acc(cur))
#pragma unroll
        for (int a = 0; a < 2; ++a)
#pragma unroll
            for (int b = 0; b < 2; ++b)
#pragma unroll
                for (int m = 0; m < 4; ++m)
#pragma unroll
                    for (int n = 0; n < 2; ++n) acc[a][b][m][n] = (f32x4){0.f, 0.f, 0.f, 0.f};
        cur = nxt; cA = nA; cB = nB; ++ui;
        if constexpr (ALIGN_EPI) { if (wr == 1) PG8_BAR; }
    }
    PG8_WAIT_V(0);
    if constexpr (!ALIGN_EPI) { if (wr == 0) PG8_BAR; }
    PG8_BAR;
    if constexpr (Epi::AFTER_DRAIN) { E.fused(acc, cur, wr, wc, fr, fq, lds, wid, lane); S.done(cur); }
#undef PG8_SA
#undef PG8_SB
#undef PG8_STAGE
#undef PG8_LDA
#undef PG8_LDB
#undef PG8_MMA
#undef PG8_WAIT_V
#undef PG8_WAIT_L
#undef PG8_BAR
#undef PG8_SCHED
}
}

typedef unsigned short bf16;
#define LAS __attribute__((address_space(3)))
#define GAS __attribute__((address_space(1)))
typedef float f32x4 __attribute__((ext_vector_type(4)));
typedef float f32x16 __attribute__((ext_vector_type(16)));
typedef float f32x2_t __attribute__((ext_vector_type(2)));
typedef __bf16 bf16x2_t __attribute__((ext_vector_type(2)));
typedef short bf16x8 __attribute__((ext_vector_type(8)));
typedef short s16x4 __attribute__((ext_vector_type(4)));
typedef unsigned u32x4 __attribute__((ext_vector_type(4)));
typedef unsigned u32x2 __attribute__((ext_vector_type(2)));

constexpr int T = 16384, D = 1024, SEQ = 4096, NBATCH = 4, DFF = 2816, DEPTH = 4, NIN = 6400, DIN = 6304;
constexpr int NTHREADS = 512, NWAVES = 8;
constexpr float EPS = 1e-6f;
constexpr float QSCALE_MLA = 0.14724498f;
constexpr float QSCALE_MEM = 0.12751743f;

constexpr size_t MiB = 1u << 20;
constexpr size_t WT_W1IN = 0;
constexpr size_t WT_W1OUT = WT_W1IN + (size_t)5632 * 1024 * 2;
constexpr size_t WT_WIN = WT_W1OUT + (size_t)1024 * 2816 * 2;
constexpr size_t WT_WUQ = WT_WIN + (size_t)NIN * 1024 * 2;
constexpr size_t WT_WUKV = WT_WUQ + (size_t)768 * 384 * 2;
constexpr size_t WT_WOMLA = WT_WUKV + (size_t)1024 * 256 * 2;
constexpr size_t WT_WOHG = WT_WOMLA + (size_t)1024 * 512 * 2;
constexpr size_t WT_WOMEM = WT_WOHG + (size_t)1024 * 512 * 2;
constexpr size_t WT_WMEMKV = WT_WOMEM + (size_t)1024 * 512 * 2;
constexpr size_t WT_WOUT = WT_WMEMKV + (size_t)4 * 1024 * 1024 * 2;
constexpr size_t WT_W2IN = WT_WOUT + (size_t)1024 * 1024 * 2;
constexpr size_t WT_W2OUT = WT_W2IN + (size_t)5632 * 1024 * 2;
constexpr size_t WT_END = WT_W2OUT + (size_t)1024 * 2816 * 2;
static_assert(WT_END <= 60 * MiB, "weights");
constexpr size_t WS_XB = 60 * MiB;
constexpr size_t WS_SSQ = WS_XB + 32 * MiB;
constexpr size_t WS_SSQQ = WS_SSQ + 1 * MiB;
constexpr size_t WS_SSQKV = WS_SSQQ + 1 * MiB;
constexpr size_t WS_COS = WS_SSQKV + 1 * MiB;
constexpr size_t WS_SIN = WS_COS + 1 * MiB;
constexpr size_t WS_LBS = WS_SIN + 1 * MiB;
constexpr size_t WS_MEMB = WS_LBS + 65536;
constexpr size_t WS_MEMRSTD = WS_MEMB + 2 * MiB;
constexpr size_t WS_MK = WS_MEMRSTD + 65536;
constexpr size_t WS_MVT = WS_MK + 4 * MiB;
constexpr size_t WS_DEC = WS_MVT + 4 * MiB;
constexpr size_t WS_MIX = WS_DEC + 1 * MiB;
constexpr size_t WS_CQ = WS_MIX;
constexpr size_t WS_CKV = WS_CQ + 12 * MiB;
constexpr size_t WS_KR = WS_CKV + 8 * MiB;
constexpr size_t WS_HQ = WS_KR + 1 * MiB;
constexpr size_t WS_GG = WS_HQ + 16 * MiB;
constexpr size_t WS_HK = WS_GG + 32 * MiB;
constexpr size_t WS_HV = WS_HK + 16 * MiB;
constexpr size_t WS_HGT = WS_HV + 16 * MiB;
constexpr size_t WS_MQ = WS_HGT + 16 * MiB;
constexpr size_t WS_GATES = WS_MQ + 16 * MiB;
constexpr size_t WS_Q = WS_GATES + 96 * MiB;
constexpr size_t WS_KC = WS_Q + 24 * MiB;
constexpr size_t WS_VT = WS_KC + 24 * MiB;
constexpr size_t WS_LT = WS_VT + 16 * MiB;
constexpr size_t WS_AO = WS_LT + 64 * MiB;
constexpr size_t WS_CTL = WS_AO + 16 * MiB;
constexpr size_t CTL_BYTES = 16384;
constexpr size_t WS_END = WS_CTL + 65536;
constexpr size_t WS_HO = WS_CQ;
constexpr size_t WS_MERGED = WS_GG;
constexpr size_t WS_MO = WS_Q;
constexpr size_t WS_H = WS_MIX;
static_assert(WS_H + (size_t)T * DFF * 2 <= WS_END, "h overlay");

constexpr int LDS_BYTES = 163840;
constexpr int LDS_SSQ_OFF = 131072 + 4096;
#ifndef REP_CONV
#define REP_CONV 1
#endif
#ifndef REP_P1
#define REP_P1 1
#endif
#ifndef REP_P3
#define REP_P3 1
#endif
#ifndef REP_MLA
#define REP_MLA 1
#endif
#ifndef REP_P6
#define REP_P6 1
#endif
#ifndef REP_P7
#define REP_P7 1
#endif
#ifndef REP_P4G
#define REP_P4G 1
#endif

DI unsigned pk2(float lo, float hi) { f32x2_t v = {lo, hi}; bf16x2_t b = __builtin_convertvector(v, bf16x2_t); return __builtin_bit_cast(unsigned, b); }
DI u32x4 pk8(const float* v) { u32x4 w; w.x = pk2(v[0], v[1]); w.y = pk2(v[2], v[3]); w.z = pk2(v[4], v[5]); w.w = pk2(v[6], v[7]); return w; }
DI float bflo(unsigned w) { return __uint_as_float(w << 16); }
DI float bfhi(unsigned w) { return __uint_as_float(w & 0xffff0000u); }
DI void unpk8(u32x4 w, float* v) { v[0] = bflo(w.x); v[1] = bfhi(w.x); v[2] = bflo(w.y); v[3] = bfhi(w.y); v[4] = bflo(w.z); v[5] = bfhi(w.z); v[6] = bflo(w.w); v[7] = bfhi(w.w); }
DI float bf2f(bf16 b) { return __uint_as_float(((unsigned)b) << 16); }
DI bf16 f2bf(float f) { return (bf16)(pk2(f, 0.f) & 0xffffu); }
DI float sigmoidf_(float z) { return __builtin_amdgcn_rcpf(1.0f + __expf(-z)); }
DI float wave_sum(float v) {
#pragma unroll
    for (int o = 1; o < 64; o <<= 1) v += __shfl_xor(v, o);
    return v;
}
DI float rowsum_q(const float* p, int fq, int nq) {
    float s = 0.f;
    if (fq < nq) { const f32x4 a = *(const GAS f32x4*)(p + 4 * fq); s = (a.x + a.y) + (a.z + a.w); }
    s += __shfl_xor(s, 16); s += __shfl_xor(s, 32);
    return s;
}
DI void rstd8(const float* ssq, int stride, int nq, float inv_n, float post, int rowb, int fq, float (&rs)[8]) {
    f32x4 q[8];
#pragma unroll
    for (int i = 0; i < 8; ++i) q[i] = *(const GAS f32x4*)(ssq + (size_t)(rowb + (i >> 2) * 128 + (i & 3) * 16) * stride + 4 * fq);
    const float keep = fq < nq ? 1.0f : 0.0f;
#pragma unroll
    for (int i = 0; i < 8; ++i) { float t = ((q[i].x + q[i].y) + (q[i].z + q[i].w)) * keep; t += __shfl_xor(t, 16); t += __shfl_xor(t, 32); rs[i] = __builtin_amdgcn_rsqf(t * inv_n + EPS) * post; }
}
DI void rstd8_lds(const LAS unsigned char* pan, float inv_n, int rowl, int fq, float (&rs)[8]) {
    f32x4 q[8];
#pragma unroll
    for (int i = 0; i < 8; ++i) q[i] = *(const LAS f32x4*)(pan + (rowl + (i >> 2) * 128 + (i & 3) * 16) * 64 + 16 * fq);
#pragma unroll
    for (int i = 0; i < 8; ++i) { float t = (q[i].x + q[i].y) + (q[i].z + q[i].w); t += __shfl_xor(t, 16); t += __shfl_xor(t, 32); rs[i] = __builtin_amdgcn_rsqf(t * inv_n + EPS); }
}
DI void ssq_panel_dma(LAS unsigned char* lds, const float* ssq, int pm, int wid, int lane) {
    const char* src = (const char*)(ssq + (size_t)pm * 256 * 16);
    const unsigned voff = (unsigned)(wid * 64 + lane) * 16u;
#pragma unroll
    for (int i = 0; i < 2; ++i)
        __builtin_amdgcn_global_load_lds((const unsigned*)(src + i * 8192 + voff), (LAS unsigned*)(lds + LDS_SSQ_OFF + wid * 1024 + i * 8192), 16, 0, 0);
}
DI float sum16(const float* p) {
    const f32x4 a = *(const f32x4*)p, b = *(const GAS f32x4*)(p + 4), c = *(const GAS f32x4*)(p + 8), d = *(const GAS f32x4*)(p + 12);
    return ((a.x + a.y) + (a.z + a.w)) + ((b.x + b.y) + (b.z + b.w)) + ((c.x + c.y) + (c.z + c.w)) + ((d.x + d.y) + (d.z + d.w));
}

using pg8::Unit;
#define EPI_ARGS const f32x4 (&acc)[2][2][4][2], const Unit& u, int wr, int wc, int fr_in, int fq_in
#define EPI_OPAQUE int fr = fr_in, fq = fq_in; asm volatile("" : "+v"(fr), "+v"(fq));

struct EpiSwiglu {
    static constexpr bool PERM = true, AFTER_DRAIN = false;
    DI bool keep_acc(const Unit&) const { return false; }
    bf16* H; const float* ssq; LAS unsigned char* ldsb;
    DI void prefetch(LAS unsigned char* lds, const Unit& u, int wid, int lane) const { ssq_panel_dma(lds, ssq, u.pm, wid, lane); }
    DI void operator()(EPI_ARGS) const {
        EPI_OPAQUE
        const int rowb = u.pm * 256 + wr * 64 + fr;
        asm volatile("s_waitcnt vmcnt(16)" ::: "memory"); __builtin_amdgcn_s_barrier(); asm volatile("" ::: "memory");
        float rs[8]; rstd8_lds(ldsb + LDS_SSQ_OFF, 1.0f / 1024.0f, wr * 64 + fr, fq, rs);
#pragma unroll
        for (int ai = 0; ai < 2; ++ai)
#pragma unroll
            for (int m = 0; m < 4; ++m) {
                const int row = rowb + ai * 128 + m * 16;
                const float r1 = rs[ai * 4 + m];
                float o[8];
#pragma unroll
                for (int n = 0; n < 2; ++n)
#pragma unroll
                    for (int j = 0; j < 4; ++j) { const float a = acc[ai][0][m][n][j] * r1, b = acc[ai][1][m][n][j] * r1; o[4 * n + j] = a * b * __builtin_amdgcn_rcpf(1.0f + __expf(-a)); }
                *(GAS u32x4*)(H + (size_t)row * DFF + u.pn * 128 + 32 * wc + 8 * fq) = pk8(o);
            }
    }
};

struct EpiSwigluNoLoad {
    static constexpr bool PERM = true, AFTER_DRAIN = false;
    DI bool keep_acc(const Unit&) const { return false; }
    DI void prefetch(LAS unsigned char*, const Unit&, int, int) const {}
    bf16* H;
    DI void operator()(EPI_ARGS) const {
        EPI_OPAQUE
        const int rowb = u.pm * 256 + wr * 64 + fr;
#pragma unroll
        for (int ai = 0; ai < 2; ++ai)
#pragma unroll
            for (int m = 0; m < 4; ++m) {
                const int row = rowb + ai * 128 + m * 16;
                float o[8];
#pragma unroll
                for (int n = 0; n < 2; ++n)
#pragma unroll
                    for (int j = 0; j < 4; ++j) { const float a = acc[ai][0][m][n][j], b = acc[ai][1][m][n][j]; o[4 * n + j] = a * b * __builtin_amdgcn_rcpf(1.0f + __expf(-a)); }
#ifndef PROBE_NOSTORE
                *(GAS u32x4*)(H + (size_t)row * DFF + u.pn * 128 + 32 * wc + 8 * fq) = pk8(o);
#else
                if (o[0] + o[1] + o[2] + o[3] + o[4] + o[5] + o[6] + o[7] == 12345.678f) *(GAS u32x4*)(H + (size_t)row * DFF + u.pn * 128 + 32 * wc + 8 * fq) = pk8(o);
#endif
            }
    }
};

struct EpiNull {
    static constexpr bool PERM = true, AFTER_DRAIN = false;
    DI bool keep_acc(const Unit&) const { return false; }
    DI void prefetch(LAS unsigned char*, const Unit&, int, int) const {}
    bf16* H;
    DI void operator()(EPI_ARGS) const {
        float t = 0.f;
#pragma unroll
        for (int ai = 0; ai < 2; ++ai)
#pragma unroll
            for (int bj = 0; bj < 2; ++bj)
#pragma unroll
                for (int m = 0; m < 4; ++m)
#pragma unroll
                    for (int n = 0; n < 2; ++n) t += acc[ai][bj][m][n][0] + acc[ai][bj][m][n][1] + acc[ai][bj][m][n][2] + acc[ai][bj][m][n][3];
        if (t == 12345.678f) H[0] = 0;
    }
};

struct EpiResid {
    static constexpr bool PERM = true, AFTER_DRAIN = false;
    DI bool keep_acc(const Unit&) const { return false; }
    DI void prefetch(LAS unsigned char*, const Unit&, int, int) const {}
    bf16* XB; float* ssq; float scale;
    DI void operator()(EPI_ARGS) const {
        EPI_OPAQUE
        const int rowb = u.pm * 256 + wr * 64 + fr, colb = u.pn * 256 + 32 * wc + 8 * fq;
#pragma unroll
        for (int ai = 0; ai < 2; ++ai) {
            u32x4 xv[4][2];
#pragma unroll
            for (int m = 0; m < 4; ++m)
#pragma unroll
                for (int bj = 0; bj < 2; ++bj) xv[m][bj] = *(const GAS u32x4*)(XB + (size_t)(rowb + ai * 128 + m * 16) * D + colb + 128 * bj);
#pragma unroll
            for (int m = 0; m < 4; ++m) {
                const int row = rowb + ai * 128 + m * 16;
                float ss = 0.f;
#pragma unroll
                for (int bj = 0; bj < 2; ++bj) {
                    float o[8]; unpk8(xv[m][bj], o);
#pragma unroll
                    for (int n = 0; n < 2; ++n)
#pragma unroll
                        for (int j = 0; j < 4; ++j) o[4 * n + j] += scale * acc[ai][bj][m][n][j];
                    const u32x4 w = pk8(o);
                    *(GAS u32x4*)(XB + (size_t)row * D + colb + 128 * bj) = w;
                    float q[8]; unpk8(w, q);
#pragma unroll
                    for (int e = 0; e < 8; ++e) ss += q[e] * q[e];
                }
                ss += __shfl_xor(ss, 16); ss += __shfl_xor(ss, 32);
                if (fq == 0) ((GAS float*)ssq)[(size_t)row * 16 + u.pn * 4 + wc] = ss;
            }
        }
    }
};

struct EpiWin {
    static constexpr bool PERM = true, AFTER_DRAIN = false;
    DI bool keep_acc(const Unit&) const { return false; }
    DI void prefetch(LAS unsigned char* lds, const Unit& u, int wid, int lane) const { ssq_panel_dma(lds, (const float*)(ws + WS_SSQ), u.pm, wid, lane); }
    unsigned char* ws; const float* lbs  ; LAS unsigned char* ldsb;
    DI void operator()(EPI_ARGS) const {
        EPI_OPAQUE
        const float* ssq = (const float*)(ws + WS_SSQ); const float* cosT = (const float*)(ws + WS_COS); const float* sinT = (const float*)(ws + WS_SIN);
        bf16* CQ = (bf16*)(ws + WS_CQ); bf16* CKV = (bf16*)(ws + WS_CKV); bf16* KC = (bf16*)(ws + WS_KC); bf16* HQ = (bf16*)(ws + WS_HQ); bf16* HK = (bf16*)(ws + WS_HK); bf16* HV = (bf16*)(ws + WS_HV);
        bf16* HGT = (bf16*)(ws + WS_HGT); bf16* MQ = (bf16*)(ws + WS_MQ); bf16* GATES = (bf16*)(ws + WS_GATES); float* GG = (float*)(ws + WS_GG); float* SSQQ = (float*)(ws + WS_SSQQ); float* SSQKV = (float*)(ws + WS_SSQKV);
        const int rowb = u.pm * 256 + wr * 64 + fr;
        asm volatile("s_waitcnt vmcnt(16)" ::: "memory"); __builtin_amdgcn_s_barrier(); asm volatile("" ::: "memory");
        float rs8[8]; rstd8_lds(ldsb + LDS_SSQ_OFF, 1.0f / 1024.0f, wr * 64 + fr, fq, rs8);
#pragma unroll
        for (int ai = 0; ai < 2; ++ai)
#pragma unroll
            for (int m = 0; m < 4; ++m) {
                const int row = rowb + ai * 128 + m * 16;
                const float rs = rs8[ai * 4 + m];
#pragma unroll
                for (int bj = 0; bj < 2; ++bj) {
                    const int hh = 2 * u.pn + bj, cw = 32 * wc + 8 * fq;
                    float v[8];
#pragma unroll
                    for (int n = 0; n < 2; ++n)
#pragma unroll
                        for (int j = 0; j < 4; ++j) v[4 * n + j] = acc[ai][bj][m][n][j] * rs;
                    if (hh < 5) {
                        float ss = 0.f;
#pragma unroll
                        for (int e = 0; e < 8; ++e) ss += v[e] * v[e];
                        ss += __shfl_xor(ss, 16); ss += __shfl_xor(ss, 32);
                        if (hh < 3) { *(GAS u32x4*)(CQ + (size_t)row * 384 + hh * 128 + cw) = pk8(v); if (fq == 0) ((GAS float*)SSQQ)[(size_t)row * 16 + hh * 4 + wc] = ss; }
                        else { *(GAS u32x4*)(CKV + (size_t)row * 256 + (hh - 3) * 128 + cw) = pk8(v); if (fq == 0) ((GAS float*)SSQKV)[(size_t)row * 8 + (hh - 3) * 4 + wc] = ss; }
                    } else if (hh == 5) {
                        if (wc == 0) {
                            const f32x4 c = *(const GAS f32x4*)(cosT + (size_t)row * 16 + 4 * fq), s = *(const GAS f32x4*)(sinT + (size_t)row * 16 + 4 * fq);
                            u32x4 o;
                            o.x = pk2(v[0] * c.x - v[1] * s.x, v[1] * c.x + v[0] * s.x); o.y = pk2(v[2] * c.y - v[3] * s.y, v[3] * c.y + v[2] * s.y);
                            o.z = pk2(v[4] * c.z - v[5] * s.z, v[5] * c.z + v[4] * s.z); o.w = pk2(v[6] * c.w - v[7] * s.w, v[7] * c.w + v[6] * s.w);
                            bf16* kp = KC + ((size_t)(row >> 12) * 8 * SEQ + (row & 4095)) * 96 + 64 + 8 * fq;
#pragma unroll
                            for (int hd = 0; hd < 8; ++hd) *(GAS u32x4*)(kp + (size_t)hd * SEQ * 96) = o;
                        }
                    } else if (hh < 10) {
#pragma unroll
                        for (int e = 0; e < 8; ++e) v[e] = v[e] * sigmoidf_(v[e]);
                        *(GAS u32x4*)(HQ + (size_t)row * 512 + (hh - 6) * 128 + cw) = pk8(v);
                    } else if (hh < 14) {
                        const int c0 = (hh - 10) * 128 + cw;
                        const f32x4 l0 = *(const GAS f32x4*)(lbs + c0), l1 = *(const GAS f32x4*)(lbs + c0 + 4);
                        const float lb[8] = {l0.x, l0.y, l0.z, l0.w, l1.x, l1.y, l1.z, l1.w};
                        float g[8], k[8];
#pragma unroll
                        for (int e = 0; e < 8; ++e) { const float z = fminf(fmaxf(v[e], -60.f), 60.f); const float en = __expf(-z), sg = __builtin_amdgcn_rcpf(1.0f + en);
                            g[e] = __logf(lb[e] + (1.0f - lb[e]) * sg); k[e] = (1.0f - lb[e]) * (en * sg); }
                        *(GAS f32x4*)(GG + (size_t)row * 512 + c0) = (f32x4){g[0], g[1], g[2], g[3]}; *(GAS f32x4*)(GG + (size_t)row * 512 + c0 + 4) = (f32x4){g[4], g[5], g[6], g[7]};
                        *(GAS u32x4*)(HK + (size_t)row * 512 + c0) = pk8(k);
                    } else if (hh < 18) {
                        *(GAS u32x4*)(HV + (size_t)row * 512 + (hh - 14) * 128 + cw) = pk8(v);
                    } else if (hh < 22) {
#pragma unroll
                        for (int e = 0; e < 8; ++e) v[e] = v[e] * sigmoidf_(v[e]);
                        *(GAS u32x4*)(HGT + (size_t)row * 512 + (hh - 18) * 128 + cw) = pk8(v);
                    } else if (hh < 26) {
#pragma unroll
                        for (int e = 0; e < 8; ++e) v[e] *= QSCALE_MEM;
                        *(GAS u32x4*)(MQ + (size_t)row * 512 + (hh - 22) * 128 + cw) = pk8(v);
                    } else {
                        const int c0 = (hh - 26) * 128 + cw, br = c0 >> 10, cc = c0 & 1023;
#pragma unroll
                        for (int e = 0; e < 8; ++e) v[e] = sigmoidf_(v[e]);
                        *(GAS u32x4*)(GATES + ((size_t)br * T + row) * 1024 + cc) = pk8(v);
                    }
                }
            }
    }
};

struct EpiQ {
    static constexpr bool PERM = true, AFTER_DRAIN = false;
    DI bool keep_acc(const Unit&) const { return false; }
    DI void prefetch(LAS unsigned char*, const Unit&, int, int) const {}
    bf16* Q;
    DI void operator()(EPI_ARGS) const {
        EPI_OPAQUE
#pragma unroll
        for (int ai = 0; ai < 2; ++ai)
#pragma unroll
            for (int m = 0; m < 4; ++m) {
                const int row = u.pm * 256 + ai * 128 + wr * 64 + m * 16 + fr;
#pragma unroll
                for (int bj = 0; bj < 2; ++bj) {
                    float v[8];
#pragma unroll
                    for (int n = 0; n < 2; ++n)
#pragma unroll
                        for (int j = 0; j < 4; ++j) v[4 * n + j] = acc[ai][bj][m][n][j];
                    *(GAS u32x4*)(Q + (size_t)row * 768 + u.pn * 256 + 128 * bj + 32 * wc + 8 * fq) = pk8(v);
                }
            }
    }
};

struct EpiKV {
    static constexpr bool PERM = true, AFTER_DRAIN = false;
    DI bool keep_acc(const Unit&) const { return false; }
    DI void prefetch(LAS unsigned char*, const Unit&, int, int) const {}
    bf16* KC; bf16* VT; const float* ssqkv;
    DI void operator()(EPI_ARGS) const {
        EPI_OPAQUE
        float rs8[8]; rstd8(ssqkv, 8, 2, 1.0f / 256.0f, 1.0f, u.pm * 256 + wr * 64 + fr, fq, rs8);
#pragma unroll
        for (int ai = 0; ai < 2; ++ai)
#pragma unroll
            for (int m = 0; m < 4; ++m) {
                const int row = u.pm * 256 + ai * 128 + wr * 64 + m * 16 + fr, b = row >> 12, s = row & 4095;
                const float rs = rs8[ai * 4 + m];
#pragma unroll
                for (int bj = 0; bj < 2; ++bj) {
                    const int c0 = u.pn * 256 + 128 * bj + 32 * wc + 8 * fq;
                    float v[8];
#pragma unroll
                    for (int n = 0; n < 2; ++n)
#pragma unroll
                        for (int j = 0; j < 4; ++j) v[4 * n + j] = acc[ai][bj][m][n][j] * rs;
                    if (c0 < 512) {
                        const int hd = c0 >> 6, d = c0 & 63;
                        bf16* kp = KC + ((size_t)(b * 8 + hd) * SEQ + s) * 96;
                        *(GAS u32x4*)(kp + d) = pk8(v);
                    } else {
                        const int c = c0 - 512, hd = c >> 6, dv = c & 63;
                        GAS bf16* vp = (GAS bf16*)(VT + ((size_t)(b * 8 + hd) * 64 + dv) * SEQ + s);
#pragma unroll
                        for (int e = 0; e < 8; ++e) vp[(size_t)e * SEQ] = f2bf(v[e]);
                    }
                }
            }
    }
};

struct EpiMemKV {
    static constexpr bool PERM = true, AFTER_DRAIN = false;
    DI bool keep_acc(const Unit&) const { return false; }
    DI void prefetch(LAS unsigned char*, const Unit&, int, int) const {}
    bf16* MK; bf16* MVT; const float* rstd;
    DI void operator()(EPI_ARGS) const {
        EPI_OPAQUE
#pragma unroll
        for (int ai = 0; ai < 2; ++ai)
#pragma unroll
            for (int m = 0; m < 4; ++m) {
                const int row = u.pm * 256 + ai * 128 + wr * 64 + m * 16 + fr, b = row >> 8, mm = row & 255;
                const float rs = ((const GAS float*)rstd)[row];
#pragma unroll
                for (int bj = 0; bj < 2; ++bj) {
                    const int c0 = u.pn * 256 + 128 * bj + 32 * wc + 8 * fq;
                    float v[8];
#pragma unroll
                    for (int n = 0; n < 2; ++n)
#pragma unroll
                        for (int j = 0; j < 4; ++j) v[4 * n + j] = acc[ai][bj][m][n][j] * rs;
                    if (c0 < 512) { const int hd = c0 >> 7, d = c0 & 127; *(GAS u32x4*)(MK + ((size_t)(b * 4 + hd) * 256 + mm) * 128 + d) = pk8(v); }
                    else { const int c = c0 - 512, hd = c >> 7, dv = c & 127; GAS bf16* vp = (GAS bf16*)(MVT + ((size_t)(b * 4 + hd) * 128 + dv) * 256 + mm);
#pragma unroll
                        for (int e = 0; e < 8; ++e) vp[(size_t)e * 256] = f2bf(v[e]); }
                }
            }
    }
};

struct EpiBranch {
    static constexpr bool PERM = true, AFTER_DRAIN = false;
    DI bool keep_acc(const Unit&) const { return false; }
    DI void prefetch(LAS unsigned char*, const Unit&, int, int) const {}
    bf16* MG; const bf16* gate; int first;
    DI void operator()(EPI_ARGS) const {
        EPI_OPAQUE
        const int rowb = u.pm * 256 + wr * 64 + fr, colb = u.pn * 256 + 32 * wc + 8 * fq;
#pragma unroll
        for (int ai = 0; ai < 2; ++ai) {
            u32x4 gv[4][2], pv[4][2];
#pragma unroll
            for (int m = 0; m < 4; ++m)
#pragma unroll
                for (int bj = 0; bj < 2; ++bj) { const size_t off = (size_t)(rowb + ai * 128 + m * 16) * 1024 + colb + 128 * bj;
                    gv[m][bj] = *(const GAS u32x4*)(gate + off); pv[m][bj] = (u32x4){0, 0, 0, 0}; if (!first) pv[m][bj] = *(const GAS u32x4*)(MG + off); }
#pragma unroll
            for (int m = 0; m < 4; ++m)
#pragma unroll
                for (int bj = 0; bj < 2; ++bj) {
                    const size_t off = (size_t)(rowb + ai * 128 + m * 16) * 1024 + colb + 128 * bj;
                    float g[8], o[8];
                    unpk8(gv[m][bj], g); unpk8(pv[m][bj], o);
#pragma unroll
                    for (int n = 0; n < 2; ++n)
#pragma unroll
                        for (int j = 0; j < 4; ++j) o[4 * n + j] += g[4 * n + j] * acc[ai][bj][m][n][j];
                    *(GAS u32x4*)(MG + off) = pk8(o);
                }
        }
    }
};

struct EpiBranch3 {
    static constexpr bool PERM = true, AFTER_DRAIN = false;
    bf16* MG; const bf16* gates;
    DI bool keep_acc(const Unit& u) const { return u.seg < 2; }
    DI void prefetch(LAS unsigned char*, const Unit&, int, int) const {}
    DI void operator()(f32x4 (&acc)[2][2][4][2], const Unit& u, int wr, int wc, int fr_in, int fq_in) const {
        EPI_OPAQUE
        const int rowb = u.pm * 256 + wr * 64 + fr, colb = u.pn * 256 + 32 * wc + 8 * fq, seg = u.seg;
        const bf16* gcur = gates + (size_t)seg * T * 1024; const bf16* gnxt = gates + (size_t)(seg < 2 ? seg + 1 : seg) * T * 1024;
#pragma unroll
        for (int ai = 0; ai < 2; ++ai) {
            u32x4 gv[4][2], nv[4][2];
#pragma unroll
            for (int m = 0; m < 4; ++m)
#pragma unroll
                for (int bj = 0; bj < 2; ++bj) { const size_t off = (size_t)(rowb + ai * 128 + m * 16) * 1024 + colb + 128 * bj; gv[m][bj] = *(const GAS u32x4*)(gcur + off); nv[m][bj] = *(const GAS u32x4*)(gnxt + off); }
#pragma unroll
            for (int m = 0; m < 4; ++m)
#pragma unroll
                for (int bj = 0; bj < 2; ++bj) {
                    float g[8], gn[8];
                    unpk8(gv[m][bj], g); unpk8(nv[m][bj], gn);
                    if (seg < 2) {
#pragma unroll
                        for (int n = 0; n < 2; ++n)
#pragma unroll
                            for (int j = 0; j < 4; ++j) acc[ai][bj][m][n][j] *= g[4 * n + j] * __builtin_amdgcn_rcpf(fmaxf(gn[4 * n + j], 1e-30f));
                    } else {
                        float o[8];
#pragma unroll
                        for (int n = 0; n < 2; ++n)
#pragma unroll
                            for (int j = 0; j < 4; ++j) o[4 * n + j] = acc[ai][bj][m][n][j] * g[4 * n + j];
                        *(GAS u32x4*)(MG + (size_t)(rowb + ai * 128 + m * 16) * 1024 + colb + 128 * bj) = pk8(o);
                    }
                }
        }
    }
};
struct SegOrder3 : pg8::StaticOrder {
    const char* wsb;
    DI bool next(int i, Unit& u) const { const int base = i / 3; if (!pg8::StaticOrder::next(base, u)) return false; u.seg = i - 3 * base; return true; }
    DI const char* a_ptr(const pg8::Gemm&, const Unit& u) const {
        const long long off = (long long)WS_AO + (long long)(u.seg == 1) * ((long long)WS_HO - (long long)WS_AO) + (long long)(u.seg == 2) * ((long long)WS_MO - (long long)WS_AO);
        return wsb + off; }
    DI const char* b_ptr(const pg8::Gemm& g, const Unit& u) const { return (const char*)g.Bt + (size_t)u.seg * ((size_t)1024 * 512 * 2); }
};

template <class Epi> DI void run_gemm(LAS unsigned char* lds, const bf16* A, const bf16* Bt, int M, int N, int K, int rot, const Epi& E) {
    int Kv = K, Nv = N, Mv = M; asm volatile("" : "+s"(Kv), "+s"(Nv), "+s"(Mv));
    pg8::Gemm g{A, Bt, Mv, Nv, Kv}; pg8::StaticOrder S; const int G = (int)gridDim.x;
    S.init(Mv, Nv, G, (int)((blockIdx.x + (unsigned)G - (unsigned)rot) % (unsigned)G));
    pg8::gemm_phase<Epi, pg8::StaticOrder, true, true>(lds, g, S, E);
}

#define MFMA32(a, b, c) __builtin_amdgcn_mfma_f32_32x32x16_bf16((a), (b), (c), 0, 0, 0)
template <int DQK, int DV, bool CAUSAL>
DI void attn_tile(const LAS unsigned char* kb, const LAS unsigned char* vb, const bf16x8 (&qf)[DQK / 16], f32x16 (&o)[DV / 32], float& mrun, float& lrun, int t, int qlo, int r, int h) {
    constexpr int KROW = DQK * 2 + 16, VROW = 136, KS = DQK / 16, NDB = DV / 32;
    f32x16 s0, s1;
    const float negm = -mrun;
#pragma unroll
    for (int i = 0; i < 16; ++i) { s0[i] = negm; s1[i] = negm; }
#pragma unroll
    for (int ks = 0; ks < KS; ++ks) {
        const bf16x8 k0 = *(const LAS bf16x8*)(kb + r * KROW + 32 * ks + 16 * h);
        const bf16x8 k1 = *(const LAS bf16x8*)(kb + (32 + r) * KROW + 32 * ks + 16 * h);
        s0 = MFMA32(k0, qf[ks], s0); s1 = MFMA32(k1, qf[ks], s1);
    }
    if (CAUSAL && (64 * t + 63 > qlo)) {
        const int qpos = qlo + r, kbase = 64 * t + 4 * h;
#pragma unroll
        for (int i = 0; i < 16; ++i) { const int key = kbase + (i & 3) + 8 * (i >> 2);
            if (key > qpos) s0[i] = -1e30f; if (key + 32 > qpos) s1[i] = -1e30f; }
    }
    float mx = fmaxf(s0[0], s1[0]);
#pragma unroll
    for (int i = 1; i < 16; ++i) mx = fmaxf(mx, fmaxf(s0[i], s1[i]));
    mx = fmaxf(mx, __shfl_xor(mx, 32));
    if (__builtin_amdgcn_ballot_w64(mx > 8.0f) != 0ull) {
        const float delta = fmaxf(mx, 0.f), alpha = __builtin_amdgcn_exp2f(-delta);
        mrun += delta; lrun *= alpha;
#pragma unroll
        for (int i = 0; i < 16; ++i) { s0[i] -= delta; s1[i] -= delta; }
#pragma unroll
        for (int db = 0; db < NDB; ++db)
#pragma unroll
            for (int i = 0; i < 16; ++i) o[db][i] *= alpha;
    }
    float ps = 0.f;
#pragma unroll
    for (int i = 0; i < 16; ++i) { s0[i] = __builtin_amdgcn_exp2f(s0[i]); s1[i] = __builtin_amdgcn_exp2f(s1[i]); ps += s0[i] + s1[i]; }
    lrun += ps;
#pragma unroll
    for (int kb2 = 0; kb2 < 2; ++kb2)
#pragma unroll
        for (int s = 0; s < 2; ++s) {
            u32x4 pw;
            if (kb2 == 0) { pw.x = pk2(s0[8 * s], s0[8 * s + 1]); pw.y = pk2(s0[8 * s + 2], s0[8 * s + 3]); pw.z = pk2(s0[8 * s + 4], s0[8 * s + 5]); pw.w = pk2(s0[8 * s + 6], s0[8 * s + 7]); }
            else { pw.x = pk2(s1[8 * s], s1[8 * s + 1]); pw.y = pk2(s1[8 * s + 2], s1[8 * s + 3]); pw.z = pk2(s1[8 * s + 4], s1[8 * s + 5]); pw.w = pk2(s1[8 * s + 6], s1[8 * s + 7]); }
            const bf16x8 pf = __builtin_bit_cast(bf16x8, pw);
            const int koff = (32 * kb2 + 16 * s + 4 * h) * 2;
#pragma unroll
            for (int db = 0; db < NDB; ++db) {
                const u32x2 lo = *(const LAS u32x2*)(vb + (32 * db + r) * VROW + koff), hi = *(const LAS u32x2*)(vb + (32 * db + r) * VROW + koff + 16);
                u32x4 vw; vw.x = lo.x; vw.y = lo.y; vw.z = hi.x; vw.w = hi.y;
                o[db] = MFMA32(__builtin_bit_cast(bf16x8, vw), pf, o[db]);
            }
        }
}

template <int DQK, int DV, bool CAUSAL>
DI void attn_item(LAS unsigned char* lds, const bf16* Qp, int qstride, const bf16* Kp, const bf16* VTp, int vt_stride, bf16* Op, int ostride, int q0, int nkeys,
                  const float* ssqq, const float* cosT, const float* sinT) {
    constexpr int KROW = DQK * 2 + 16, VROW = 136, KBYTES = 64 * KROW, VBYTES = DV * VROW, BUF = KBYTES + VBYTES;
    constexpr int NCK = 64 * DQK / 8, NCV = DV * 8, KS = DQK / 16, NDB = DV / 32;
    constexpr int CPR = DQK / 8;
    int tid_o = threadIdx.x; asm volatile("" : "+v"(tid_o)); const int tid = tid_o, wid = __builtin_amdgcn_readfirstlane(tid >> 6), lane = tid & 63, r = lane & 31, h = lane >> 5;
    const int ntiles = CAUSAL ? (q0 + 256) / 64 : nkeys / 64;
    const int qlo = q0 + wid * 32;
    bf16x8 qf[KS];
    { const bf16* qr = Qp + (size_t)(wid * 32 + r) * qstride + 8 * h;
#pragma unroll
      for (int ks = 0; ks < KS; ++ks) qf[ks] = *(const GAS bf16x8*)(qr + 16 * ks);
      if (CAUSAL) {
          const float* sp = ssqq + (size_t)(wid * 32 + r) * 16;
          const f32x4 a = *(const f32x4*)sp, b = *(const GAS f32x4*)(sp + 4), c = *(const GAS f32x4*)(sp + 8);
          const float rs = rsqrtf((((a.x + a.y) + (a.z + a.w)) + ((b.x + b.y) + (b.z + b.w)) + ((c.x + c.y) + (c.z + c.w))) * (1.0f / 384.0f) + EPS) * QSCALE_MLA;
#pragma unroll
          for (int ks = 0; ks < KS; ++ks) {
              float v[8]; unpk8(__builtin_bit_cast(u32x4, qf[ks]), v);
              if (ks >= 4) {
                  const int i0 = 8 * (ks - 4) + 4 * h;
                  const f32x4 cs = *(const GAS f32x4*)(cosT + (size_t)(wid * 32 + r) * 16 + i0), sn = *(const GAS f32x4*)(sinT + (size_t)(wid * 32 + r) * 16 + i0);
                  const float t0 = v[0], t1 = v[1], t2 = v[2], t3 = v[3], t4 = v[4], t5 = v[5], t6 = v[6], t7 = v[7];
                  v[0] = t0 * cs.x - t1 * sn.x; v[1] = t1 * cs.x + t0 * sn.x; v[2] = t2 * cs.y - t3 * sn.y; v[3] = t3 * cs.y + t2 * sn.y;
                  v[4] = t4 * cs.z - t5 * sn.z; v[5] = t5 * cs.z + t4 * sn.z; v[6] = t6 * cs.w - t7 * sn.w; v[7] = t7 * cs.w + t6 * sn.w;
              }
#pragma unroll
              for (int e = 0; e < 8; ++e) v[e] *= rs;
              qf[ks] = __builtin_bit_cast(bf16x8, pk8(v));
          }
      } }
    f32x16 o[NDB];
#pragma unroll
    for (int db = 0; db < NDB; ++db)
#pragma unroll
        for (int i = 0; i < 16; ++i) o[db][i] = 0.f;
    float mrun = 0.f, lrun = 0.f;
    const int kc0 = tid, kc1 = tid + 512; const bool k1on = kc1 < NCK;
    const int kr0 = kc0 / CPR, kcc0 = kc0 % CPR, kr1 = kc1 / CPR, kcc1 = kc1 % CPR;
    const int vc0 = tid, vc1 = tid + 512; const bool v1on = vc1 < NCV;
    const GAS u32x4* Kg = (const GAS u32x4*)Kp;
    u32x4 ak0, ak1 = {0, 0, 0, 0}, av0, av1 = {0, 0, 0, 0}, bk0, bk1 = {0, 0, 0, 0}, bv0, bv1 = {0, 0, 0, 0};
#define ATT_GLOAD(P, t_) do { P##k0 = Kg[(size_t)(t_) * NCK + kc0]; if (k1on) P##k1 = Kg[(size_t)(t_) * NCK + kc1]; \
        P##v0 = *(const GAS u32x4*)(VTp + (size_t)(vc0 >> 3) * vt_stride + (t_) * 64 + (vc0 & 7) * 8); \
        if (v1on) P##v1 = *(const GAS u32x4*)(VTp + (size_t)(vc1 >> 3) * vt_stride + (t_) * 64 + (vc1 & 7) * 8); } while (0)
#define ATT_LSTORE(P, buf_) do { LAS unsigned char* kb_ = lds + (buf_) * BUF; LAS unsigned char* vb_ = kb_ + KBYTES; \
        *(LAS u32x4*)(kb_ + kr0 * KROW + kcc0 * 16) = P##k0; if (k1on) *(LAS u32x4*)(kb_ + kr1 * KROW + kcc1 * 16) = P##k1; \
        { LAS u32x2* d_ = (LAS u32x2*)(vb_ + (vc0 >> 3) * VROW + (vc0 & 7) * 16); d_[0] = (u32x2){P##v0.x, P##v0.y}; d_[1] = (u32x2){P##v0.z, P##v0.w}; } \
        if (v1on) { LAS u32x2* d_ = (LAS u32x2*)(vb_ + (vc1 >> 3) * VROW + (vc1 & 7) * 16); d_[0] = (u32x2){P##v1.x, P##v1.y}; d_[1] = (u32x2){P##v1.z, P##v1.w}; } } while (0)
    ATT_GLOAD(a, 0); ATT_LSTORE(a, 0);
    if (ntiles > 1) ATT_GLOAD(a, 1);
    __syncthreads();
    for (int t = 0; t < ntiles; t += 2) {
        if (t + 2 < ntiles) ATT_GLOAD(b, t + 2);
        if (!CAUSAL || (64 * t <= qlo + 31)) attn_tile<DQK, DV, CAUSAL>(lds, lds + KBYTES, qf, o, mrun, lrun, t, qlo, r, h);
        if (t + 1 < ntiles) ATT_LSTORE(a, 1);
        __syncthreads();
        if (t + 1 < ntiles) {
            if (t + 3 < ntiles) ATT_GLOAD(a, t + 3);
            if (!CAUSAL || (64 * (t + 1) <= qlo + 31)) attn_tile<DQK, DV, CAUSAL>(lds + BUF, lds + BUF + KBYTES, qf, o, mrun, lrun, t + 1, qlo, r, h);
            if (t + 2 < ntiles) ATT_LSTORE(b, 0);
            __syncthreads();
        }
    }
#undef ATT_GLOAD
#undef ATT_LSTORE
    const float ltot = lrun + __shfl_xor(lrun, 32), inv = 1.0f / ltot;
    bf16* orow = Op + (size_t)(wid * 32 + r) * ostride + 4 * h;
#pragma unroll
    for (int db = 0; db < NDB; ++db)
#pragma unroll
        for (int g = 0; g < 4; ++g) {
            u32x2 w; w.x = pk2(o[db][4 * g] * inv, o[db][4 * g + 1] * inv); w.y = pk2(o[db][4 * g + 2] * inv, o[db][4 * g + 3] * inv);
            *(GAS u32x2*)(orow + 32 * db + 8 * g) = w;
        }
}

template <int KSTEPS> DI void lds_mma(f32x16& c, const LAS unsigned char* A, int astride, const LAS unsigned char* Bt, int bstride, int r, int h) {
#pragma unroll
    for (int s = 0; s < KSTEPS; ++s) {
        const bf16x8 a = *(const LAS bf16x8*)(A + r * astride + 32 * s + 16 * h);
        const bf16x8 b = *(const LAS bf16x8*)(Bt + r * bstride + 32 * s + 16 * h);
        c = MFMA32(a, b, c);
    }
}

DI void hgrn_b1(LAS unsigned char* lds, int ch, float* GG, const bf16* HK, const bf16* HV, bf16* LT, float* DEC) {
    int tid_o = threadIdx.x; asm volatile("" : "+v"(tid_o)); const int tid = tid_o, wid = __builtin_amdgcn_readfirstlane(tid >> 6), lane = tid & 63, r = lane & 31, h = lane >> 5;
    const int bh = ch >> 6, c = ch & 63, b = bh >> 2, hd = bh & 3;
    const size_t t0 = (size_t)b * SEQ + c * 64;
    const int k = tid & 127, seg = tid >> 7;
    LAS float* segsum = (LAS float*)lds;
    LAS unsigned char* kdT = lds + 2048;
    LAS unsigned char* vT = kdT + 128 * 144;
    float g[16]; float run = 0.f;
    GAS float* gp = (GAS float*)(GG + (t0 + seg * 16) * 512 + hd * 128 + k);
#pragma unroll
    for (int i = 0; i < 16; ++i) { run += gp[(size_t)i * 512]; g[i] = run; }
    segsum[seg * 128 + k] = run;
    __syncthreads();
    float off = 0.f, tot = 0.f;
#pragma unroll
    for (int s = 0; s < 4; ++s) { const float v = segsum[s * 128 + k]; if (s < seg) off += v; tot += v; }
    const GAS bf16* kp = (const GAS bf16*)(HK + (t0 + seg * 16) * 512 + hd * 128 + k);
    const GAS bf16* vp = (const GAS bf16*)(HV + (t0 + seg * 16) * 512 + hd * 128 + k);
#pragma unroll
    for (int i = 0; i < 16; ++i) {
        const float G = g[i] + off; gp[(size_t)i * 512] = G;
        const float kd = bf2f(kp[(size_t)i * 512]) * __expf(tot - G);
        *(LAS bf16*)(kdT + k * 144 + (seg * 16 + i) * 2) = f2bf(kd);
        *(LAS bf16*)(vT + k * 144 + (seg * 16 + i) * 2) = vp[(size_t)i * 512];
    }
    if (seg == 0) ((GAS float*)DEC)[(size_t)ch * 128 + k] = __expf(tot);
    __syncthreads();
    const int vb = wid >> 1;
#pragma unroll
    for (int q = 0; q < 2; ++q) {
        const int kb = (wid & 1) * 2 + q;
        f32x16 acc;
#pragma unroll
        for (int i = 0; i < 16; ++i) acc[i] = 0.f;
        lds_mma<4>(acc, vT + vb * 32 * 144, 144, kdT + kb * 32 * 144, 144, r, h);
        GAS bf16* lp = (GAS bf16*)(LT + (size_t)ch * 16384 + (size_t)(vb * 32 + 4 * h) * 128 + kb * 32 + r);
#pragma unroll
        for (int i = 0; i < 16; ++i) lp[(size_t)((i & 3) + 8 * (i >> 2)) * 128] = f2bf(acc[i]);
    }
    __syncthreads();
}

DI void hgrn_b3(LAS unsigned char* lds, int ch, const float* GG, const bf16* HQ, const bf16* HK, const bf16* HV, const bf16* HGT, const bf16* LT, const float* onorm, bf16* HO) {
    constexpr int RS = 272;
    int tid_o = threadIdx.x; asm volatile("" : "+v"(tid_o)); const int tid = tid_o, wid = __builtin_amdgcn_readfirstlane(tid >> 6), lane = tid & 63, r = lane & 31, h = lane >> 5;
    const int bh = ch >> 6, c = ch & 63, b = bh >> 2, hd = bh & 3;
    const size_t t0 = (size_t)b * SEQ + c * 64;
    LAS unsigned char* qG = lds;
    LAS unsigned char* q1 = qG + 64 * RS;
    LAS unsigned char* kA0 = q1 + 32 * RS;
    LAS unsigned char* kA1 = kA0 + 32 * RS;
    LAS unsigned char* ST = kA1 + 64 * RS;
    LAS unsigned char* vT = ST + 128 * RS;
    LAS unsigned char* Am = vT + 128 * 144;
    {
        const int k8 = tid & 15;
        const float* g31p = GG + (t0 + 31) * 512 + hd * 128 + k8 * 8;
        const f32x4 ga = *(const f32x4*)g31p, gb = *(const GAS f32x4*)(g31p + 4);
        const float g31[8] = {ga.x, ga.y, ga.z, ga.w, gb.x, gb.y, gb.z, gb.w};
#pragma unroll
        for (int pass = 0; pass < 2; ++pass) {
            const int t = (tid >> 4) + 32 * pass;
            const size_t off = (t0 + t) * 512 + hd * 128 + k8 * 8;
            const f32x4 a = *(const GAS f32x4*)(GG + off), bq = *(const GAS f32x4*)(GG + off + 4);
            const float G[8] = {a.x, a.y, a.z, a.w, bq.x, bq.y, bq.z, bq.w};
            float q[8], kk[8], o1[8], o2[8], o3[8];
            unpk8(*(const GAS u32x4*)(HQ + off), q); unpk8(*(const GAS u32x4*)(HK + off), kk);
#pragma unroll
            for (int e = 0; e < 8; ++e) o1[e] = q[e] * __expf(G[e]);
            *(LAS u32x4*)(qG + t * RS + k8 * 16) = pk8(o1);
            if (pass == 0) {
#pragma unroll
                for (int e = 0; e < 8; ++e) { o2[e] = kk[e] * __expf(fminf(-G[e], 80.f)); o3[e] = kk[e] * __expf(g31[e] - G[e]); }
                *(LAS u32x4*)(kA0 + t * RS + k8 * 16) = pk8(o2);
                *(LAS u32x4*)(kA1 + t * RS + k8 * 16) = pk8(o3);
            } else {
#pragma unroll
                for (int e = 0; e < 8; ++e) { o2[e] = q[e] * __expf(G[e] - g31[e]); o3[e] = kk[e] * __expf(fminf(g31[e] - G[e], 80.f)); }
                *(LAS u32x4*)(q1 + (t - 32) * RS + k8 * 16) = pk8(o2);
                *(LAS u32x4*)(kA1 + t * RS + k8 * 16) = pk8(o3);
            }
        }
        const bf16* lp = LT + (size_t)ch * 16384;
#pragma unroll
        for (int p = 0; p < 4; ++p) {
            const int idx = tid + 512 * p, v = idx >> 4, kk8 = idx & 15;
            *(LAS u32x4*)(ST + v * RS + kk8 * 16) = *(const GAS u32x4*)(lp + v * 128 + kk8 * 8);
        }
        const int v = tid & 127, seg = tid >> 7;
        const GAS bf16* vp = (const GAS bf16*)(HV + (t0 + seg * 16) * 512 + hd * 128 + v);
#pragma unroll
        for (int i = 0; i < 16; ++i) *(LAS bf16*)(vT + v * 144 + (seg * 16 + i) * 2) = vp[(size_t)i * 512];
    }
    __syncthreads();
    if (wid < 3) {
        f32x16 a;
#pragma unroll
        for (int i = 0; i < 16; ++i) a[i] = 0.f;
        const int tb = wid == 0 ? 0 : 1, sb = wid == 2 ? 1 : 0;
        if (wid == 0) lds_mma<8>(a, qG, RS, kA0, RS, r, h);
        else lds_mma<8>(a, q1, RS, kA1 + sb * 32 * RS, RS, r, h);
#pragma unroll
        for (int i = 0; i < 16; ++i) { const int tl = (i & 3) + 8 * (i >> 2) + 4 * h; float val = a[i]; if (tb == sb && r > tl) val = 0.f;
            *(LAS bf16*)(Am + (tb * 32 + tl) * 144 + (sb * 32 + r) * 2) = f2bf(val); }
    } else if (wid == 3) {
#pragma unroll
        for (int i = 0; i < 16; ++i) { const int tl = (i & 3) + 8 * (i >> 2) + 4 * h; *(LAS bf16*)(Am + tl * 144 + (32 + r) * 2) = (bf16)0; }
    }
    __syncthreads();
    f32x16 acc;
#pragma unroll
    for (int i = 0; i < 16; ++i) acc[i] = 0.f;
    const int tb = wid >> 2, vb = wid & 3;
    lds_mma<8>(acc, qG + tb * 32 * RS, RS, ST + vb * 32 * RS, RS, r, h);
    lds_mma<4>(acc, Am + tb * 32 * 144, 144, vT + vb * 32 * 144, 144, r, h);
    __syncthreads();
    LAS float* Ost = (LAS float*)ST;
#pragma unroll
    for (int i = 0; i < 16; ++i) Ost[(tb * 32 + (i & 3) + 8 * (i >> 2) + 4 * h) * 132 + vb * 32 + r] = acc[i];
    __syncthreads();
    {
        const int t = tid >> 3, part = tid & 7;
        float ov[16]; float ss = 0.f;
#pragma unroll
        for (int q4 = 0; q4 < 4; ++q4) { const f32x4 x = *(const LAS f32x4*)(Ost + t * 132 + part * 16 + q4 * 4); ov[4 * q4] = x.x; ov[4 * q4 + 1] = x.y; ov[4 * q4 + 2] = x.z; ov[4 * q4 + 3] = x.w; }
#pragma unroll
        for (int e = 0; e < 16; ++e) ss += ov[e] * ov[e];
        ss += __shfl_xor(ss, 1); ss += __shfl_xor(ss, 2); ss += __shfl_xor(ss, 4);
        const float rs = rsqrtf(ss * (1.0f / 128.0f) + EPS);
        const size_t off = (t0 + t) * 512 + hd * 128 + part * 16;
        float gt[16];
        unpk8(*(const GAS u32x4*)(HGT + off), gt); unpk8(*(const GAS u32x4*)(HGT + off + 8), gt + 8);
#pragma unroll
        for (int e = 0; e < 16; ++e) ov[e] = ov[e] * rs * ((const GAS float*)onorm)[part * 16 + e] * gt[e];
        *(GAS u32x4*)(HO + off) = pk8(ov); *(GAS u32x4*)(HO + off + 8) = pk8(ov + 8);
    }
    __syncthreads();
}

DI int dest_row(int mode, int n) {
    if (mode == 0) return n;
    if (mode == 1) { const int j = n < DFF ? n : n - DFF; return (j >> 7) * 256 + (n < DFF ? 0 : 128) + (j & 127); }
    if (mode == 2) { if (n < 640) return n; if (n < 672) { const int j = n - 640; return 640 + (j < 16 ? 2 * j : 2 * (j - 16) + 1); } if (n < 3232) return 768 + (n - 672); return 3328 + (n - 3232); }
    const int hd = n / 96, w = n - hd * 96; if (w < 64) return n; const int j = w - 64; return hd * 96 + 64 + (j < 16 ? 2 * j : 2 * (j - 16) + 1);
}
DI void conv_item(const float* W, int K, int N, bf16* WT, const float* gain, int mode, int row_off, LAS float* scr, int item, int lane) {
    const int nblk = N / 32, kb = item / nblk, nb = item - kb * nblk, k0 = 64 * kb, n0 = 32 * nb;
    float wv[32];
    const GAS float* wp = (const GAS float*)(W + (size_t)(k0 + (lane >> 5)) * N + n0 + (lane & 31));
#pragma unroll
    for (int i = 0; i < 32; ++i) wv[i] = __builtin_nontemporal_load(wp + (size_t)(2 * i) * N);
#pragma unroll
    for (int i = 0; i < 32; ++i) scr[(2 * i + (lane >> 5)) * 33 + (lane & 31)] = wv[i];
    asm volatile("s_waitcnt lgkmcnt(0)" ::: "memory");
    const int c = lane & 7;
    float gn[8];
#pragma unroll
    for (int e = 0; e < 8; ++e) gn[e] = gain ? ((const GAS float*)gain)[k0 + 8 * c + e] : 1.0f;
#pragma unroll
    for (int j = 0; j < 4; ++j) { const int n = (lane >> 3) + 8 * j; const LAS float* s = scr + (8 * c) * 33 + n;
        float v[8];
#pragma unroll
        for (int e = 0; e < 8; ++e) v[e] = s[e * 33] * gn[e];
        *(GAS u32x4*)(WT + (size_t)(row_off + dest_row(mode, n0 + n)) * K + k0 + 8 * c) = pk8(v); }
    asm volatile("s_waitcnt lgkmcnt(0)" ::: "memory");
}

#define XB_TMO      128
#define XB_XCNT(j)  (256  + 64 * (j))
#define XB_XSUB(j)  (1280 + 64 * (j))
#define XB_XGEN(j)  (2304 + 64 * (j))
#define XB_TOP      3328
#define XB_TOPGEN   3392
#define XCD_BAR_WORDS 3456
#define XB_SPIN_CAP (1u << 18)
static_assert(XCD_BAR_WORDS * 4 <= CTL_BYTES, "barrier words inside the memset region");
DI unsigned xb_ld(unsigned* p)              { return __hip_atomic_load((GAS unsigned*)p, __ATOMIC_RELAXED, __HIP_MEMORY_SCOPE_AGENT); }
DI unsigned xb_add(unsigned* p, unsigned v) { return __hip_atomic_fetch_add((GAS unsigned*)p, v, __ATOMIC_RELAXED, __HIP_MEMORY_SCOPE_AGENT); }
DI unsigned xb_xcc_id() { return (unsigned)__builtin_amdgcn_s_getreg((3 << 11) | 20) & 0xFu; }
#define XB_SPIN(cond, bar) do { unsigned _sp = 0; while (cond) { __builtin_amdgcn_s_sleep(1); \
    if ((++_sp & 255u) == 0u) { if (xb_ld(&(bar)[XB_TMO])) break; if (_sp > XB_SPIN_CAP) { atomicAdd(&(bar)[XB_TMO], 1u); break; } } } } while (0)
struct XcdBarrier { unsigned* bar; unsigned x; volatile LAS unsigned* st; };
DI void xcd_barrier_complete(unsigned* bar, unsigned x, unsigned& nloc, unsigned& nx) {
    const unsigned G = gridDim.x * gridDim.y * gridDim.z;
    unsigned sum, cnt, mine, sp = 0u;
    for (;;) {
        sum = 0u; cnt = 0u; mine = 0u;
#pragma unroll
        for (unsigned j = 0; j < 16; ++j) { const unsigned c = xb_ld(&bar[XB_XCNT(j)]); sum += c; cnt += (c > 0u) ? 1u : 0u; mine = (j == x) ? c : mine; }
        if (sum == G) break;
        __builtin_amdgcn_s_sleep(1);
        if ((++sp & 255u) == 0u) { if (xb_ld(&bar[XB_TMO])) break; if (sp > XB_SPIN_CAP) { atomicAdd(&bar[XB_TMO], 1u); break; } }
    }
    nloc = mine > 0u ? mine : 1u; nx = cnt > 0u ? cnt : 1u;
}
DI void xcd_barrier(const XcdBarrier& b) {
    asm volatile("s_waitcnt vmcnt(0)" ::: "memory");
    __syncthreads();
    if (threadIdx.x == 0) {
        unsigned* bar = b.bar;
        __builtin_amdgcn_s_waitcnt(0);
        unsigned nloc = b.st[0], nx = b.st[1];
        if (nloc == 0u) { xcd_barrier_complete(bar, b.x, nloc, nx); b.st[0] = nloc; b.st[1] = nx; }
        const unsigned old = xb_add(&bar[XB_XSUB(b.x)], 1u);
        const unsigned gen = old / nloc;
        if (old + 1u == (gen + 1u) * nloc) {
            __builtin_amdgcn_fence(__ATOMIC_RELEASE, "agent");
            asm volatile("s_waitcnt vmcnt(0)" ::: "memory");
            const unsigned og = xb_add(&bar[XB_TOP], 1u);
            const unsigned tg = og / nx;
            if (og + 1u == (tg + 1u) * nx) xb_add(&bar[XB_TOPGEN], 1u);
            else XB_SPIN(xb_ld(&bar[XB_TOPGEN]) == tg, bar);
            __builtin_amdgcn_fence(__ATOMIC_ACQUIRE, "agent");
            xb_add(&bar[XB_XGEN(b.x)], 1u);
            asm volatile("s_waitcnt vmcnt(0)" ::: "memory");
        } else {
            XB_SPIN(xb_ld(&bar[XB_XGEN(b.x)]) == gen, bar);
            __builtin_amdgcn_fence(__ATOMIC_ACQUIRE, "agent");
            asm volatile("s_waitcnt vmcnt(0)" ::: "memory");
        }
    }
    __syncthreads();
}

struct Args { const void* in[25]; float* out; unsigned char* ws; int ph_lo, ph_hi; };
typedef const __attribute__((address_space(4))) unsigned long long* ka_t;
DI unsigned long long KA(int i) { ka_t p = (ka_t)__builtin_amdgcn_kernarg_segment_ptr(); asm volatile("" : "+s"(p)); return p[i]; }
#define KIN(i) ((const float*)KA(i))
#define KOUT ((float*)KA(25))
#define KWS ((unsigned char*)KA(26))

DI void conv_set(int mask, int l, int bpart, int nbparts, LAS unsigned char* lds) {
    int tid_o = threadIdx.x; asm volatile("" : "+v"(tid_o)); const int tid = tid_o, wave = __builtin_amdgcn_readfirstlane(tid >> 6), lane = tid & 63;
    const int part = bpart * NWAVES + wave, nparts = nbparts * NWAVES, tpart = bpart * NTHREADS + tid, ntparts = nbparts * NTHREADS;
    LAS float* scr = (LAS float*)(lds + wave * 16384);
    unsigned char* ws = KWS;
    constexpr int I_FI = 16 * 176, I_FO = 44 * 32, I_WIN = 16 * 197, I_UQ = 6 * 24, I_UK = 4 * 16, I_WO = 8 * 32, I_SQ = 16 * 32;
    if (mask & 1) {
        const float* f1n = KIN(3) + l * 1024; const float* w1i = KIN(4) + (size_t)l * 1024 * 5632; const float* w1o = KIN(5) + (size_t)l * 2816 * 1024;
        for (int it = part; it < I_FI + I_FO; it += nparts) {
            if (it < I_FI) conv_item(w1i, 1024, 5632, (bf16*)(ws + WT_W1IN), f1n, 1, 0, scr, it, lane);
            else conv_item(w1o, 2816, 1024, (bf16*)(ws + WT_W1OUT), nullptr, 0, 0, scr, it - I_FI, lane);
        }
    }
    if (mask & 4) {
        const float* f2n = KIN(21) + l * 1024; const float* w2i = KIN(22) + (size_t)l * 1024 * 5632; const float* w2o = KIN(23) + (size_t)l * 2816 * 1024;
        for (int it = part; it < I_FI + I_FO; it += nparts) {
            if (it < I_FI) conv_item(w2i, 1024, 5632, (bf16*)(ws + WT_W2IN), f2n, 1, 0, scr, it, lane);
            else conv_item(w2o, 2816, 1024, (bf16*)(ws + WT_W2OUT), nullptr, 0, 0, scr, it - I_FI, lane);
        }
    }
    if (mask & 2) {
        const float* mxn = KIN(6) + l * 1024; const float* win = KIN(7) + (size_t)l * 1024 * DIN;
        for (int it = part; it < I_WIN; it += nparts) conv_item(win, 1024, DIN, (bf16*)(ws + WT_WIN), mxn, 2, 0, scr, it, lane);
        u32x4* pad = (u32x4*)(ws + WT_WIN + (size_t)672 * 1024 * 2);
        unsigned zz = 0u; asm volatile("" : "+v"(zz));
        for (int i = tpart; i < 96 * 1024 * 2 / 16; i += ntparts) ((GAS u32x4*)pad)[i] = (u32x4){zz, zz, zz, zz};
    }
    if (mask & 8) {
        const float* qln = KIN(8) + l * 384; const float* kvn = KIN(9) + l * 256;
        const float* wuq = KIN(10) + (size_t)l * 384 * 768; const float* wuk = KIN(11) + (size_t)l * 256 * 512; const float* wuv = KIN(12) + (size_t)l * 256 * 512;
        const float* womla = KIN(13) + (size_t)l * 512 * 1024; const float* wohg = KIN(16) + (size_t)l * 512 * 1024; const float* womem = KIN(19) + (size_t)l * 512 * 1024;
        const float* wout = KIN(20) + (size_t)l * 1024 * 1024;
        constexpr int NIT = I_UQ + 2 * I_UK + 3 * I_WO + I_SQ;
        for (int it = part; it < NIT; it += nparts) {
            int r = it;
            if (r < I_UQ) { conv_item(wuq, 384, 768, (bf16*)(ws + WT_WUQ), qln, 3, 0, scr, r, lane); continue; } r -= I_UQ;
            if (r < I_UK) { conv_item(wuk, 256, 512, (bf16*)(ws + WT_WUKV), kvn, 0, 0, scr, r, lane); continue; } r -= I_UK;
            if (r < I_UK) { conv_item(wuv, 256, 512, (bf16*)(ws + WT_WUKV), kvn, 0, 512, scr, r, lane); continue; } r -= I_UK;
            if (r < I_WO) { conv_item(womla, 512, 1024, (bf16*)(ws + WT_WOMLA), nullptr, 0, 0, scr, r, lane); continue; } r -= I_WO;
            if (r < I_WO) { conv_item(wohg, 512, 1024, (bf16*)(ws + WT_WOHG), nullptr, 0, 0, scr, r, lane); continue; } r -= I_WO;
            if (r < I_WO) { conv_item(womem, 512, 1024, (bf16*)(ws + WT_WOMEM), nullptr, 0, 0, scr, r, lane); continue; } r -= I_WO;
            conv_item(wout, 1024, 1024, (bf16*)(ws + WT_WOUT), nullptr, 0, 0, scr, r, lane);
        }
    }
    if (mask & 16) {
        const float* memn = KIN(17); const float* wmkv = KIN(18);
        for (int it = part; it < 4 * I_SQ; it += nparts) { const int ll = it / I_SQ, r = it - ll * I_SQ;
            conv_item(wmkv + (size_t)ll * 1024 * 1024, 1024, 1024, (bf16*)(ws + WT_WMEMKV) + (size_t)ll * 1024 * 1024, memn + ll * 1024, 0, 0, scr, r, lane); }
    }
    __syncthreads();
}
DI void conv_tail(int mask, int l, int nwg, LAS unsigned char* lds) {
    const int G = (int)gridDim.x, rem = nwg % G, c = (int)blockIdx.x;
    if (c < rem) return;
    conv_set(mask, l, c - rem, G - rem, lds);
}

DI void prep_phase() {
    int tid_o = threadIdx.x; asm volatile("" : "+v"(tid_o)); const int tid = tid_o, wave = __builtin_amdgcn_readfirstlane(tid >> 6), lane = tid & 63;
    const int gw = blockIdx.x * NWAVES + wave, NGW = gridDim.x * NWAVES;
    unsigned char* ws = KWS;
    const float* x = KIN(0); const float* mem = KIN(1); const int* pos = (const int*)KA(2);
    bf16* XB = (bf16*)(ws + WS_XB); float* SSQ = (float*)(ws + WS_SSQ);
    for (int m = gw; m < T; m += NGW) {
        const GAS f32x4* xr = (const GAS f32x4*)(x + (size_t)m * D) + lane; GAS u32x2* xb = (GAS u32x2*)(XB + (size_t)m * D) + lane;
        float s = 0.f;
#pragma unroll
        for (int j = 0; j < 4; ++j) { const f32x4 v = xr[64 * j]; u32x2 w; w.x = pk2(v.x, v.y); w.y = pk2(v.z, v.w); xb[64 * j] = w;
            const float a = bflo(w.x), b = bfhi(w.x), c = bflo(w.y), d = bfhi(w.y); s += (a * a + b * b) + (c * c + d * d); }
        s = wave_sum(s);
        if (lane < 16) ((GAS float*)SSQ)[(size_t)m * 16 + lane] = lane == 0 ? s : 0.f;
    }
    bf16* MEMB = (bf16*)(ws + WS_MEMB); float* MRS = (float*)(ws + WS_MEMRSTD);
    for (int m = gw; m < 1024; m += NGW) {
        const GAS f32x4* xr = (const GAS f32x4*)(mem + (size_t)m * D) + lane; GAS u32x2* xb = (GAS u32x2*)(MEMB + (size_t)m * D) + lane;
        float s = 0.f;
#pragma unroll
        for (int j = 0; j < 4; ++j) { const f32x4 v = xr[64 * j]; s += (v.x * v.x + v.y * v.y) + (v.z * v.z + v.w * v.w); u32x2 w; w.x = pk2(v.x, v.y); w.y = pk2(v.z, v.w); xb[64 * j] = w; }
        s = wave_sum(s);
        if (lane == 0) ((GAS float*)MRS)[m] = rsqrtf(s * (1.0f / 1024.0f) + EPS);
    }
    float* COS = (float*)(ws + WS_COS); float* SIN = (float*)(ws + WS_SIN);
    for (int i = blockIdx.x * NTHREADS + tid; i < T * 16; i += gridDim.x * NTHREADS) {
        const int row = i >> 4, fi = i & 15;
        const float invf = exp2f(-13.287712379549449f * (float)fi * (1.0f / 16.0f));
        const float ang = (float)((const GAS int*)pos)[row] * invf;
        const float kq = rintf(ang * 0.15915494309189535f);
        float rr = fmaf(-kq, 6.28125f, ang); rr = fmaf(-kq, 1.9353071795864769e-3f, rr);
        ((GAS float*)COS)[i] = __cosf(rr); ((GAS float*)SIN)[i] = __sinf(rr);
    }
    const float* hlb = KIN(14); float* LBS = (float*)(ws + WS_LBS);
    for (int i = blockIdx.x * NTHREADS + tid; i < 512; i += gridDim.x * NTHREADS) {
        const float a0 = hlb[i], a1 = hlb[512 + i], a2 = hlb[1024 + i], a3 = hlb[1536 + i];
        const float mx = fmaxf(fmaxf(a0, a1), fmaxf(a2, a3));
        const float e0 = __expf(a0 - mx), e1 = __expf(a1 - mx), e2 = __expf(a2 - mx), e3 = __expf(a3 - mx), inv = 1.0f / (e0 + e1 + e2 + e3);
        LBS[i] = 0.f; LBS[512 + i] = e1 * inv; LBS[1024 + i] = (e1 + e2) * inv; LBS[1536 + i] = (e1 + e2 + e3) * inv;
    }
}

__global__ void __launch_bounds__(NTHREADS, 2) fwd_kernel(Args A_unused) {
    extern __shared__ __attribute__((aligned(16))) unsigned char lds_raw[];
    LAS unsigned char* lds = (LAS unsigned char*)lds_raw;
    cg::grid_group grid = cg::this_grid();
    int ph = 0;
    int lo, hi; { const unsigned long long w = KA(27); lo = (int)(unsigned)w; hi = (int)(unsigned)(w >> 32); }
#define RUN (ph >= lo && ph < hi)
    volatile LAS unsigned* bst = (volatile LAS unsigned*)(lds + 131072 + 512);
    if (threadIdx.x < 2) bst[threadIdx.x] = 0u;
    __syncthreads();
    if (threadIdx.x == 0) (void)xb_add(&((unsigned*)(KWS + WS_CTL))[XB_XCNT(xb_xcc_id())], 1u);
#define SEAM do { if (ph >= lo && ph + 1 < hi) { XcdBarrier xb_; xb_.bar = (unsigned*)(KWS + WS_CTL); xb_.x = xb_xcc_id(); xb_.st = bst; xcd_barrier(xb_); } ++ph; } while (0)
    if (hi > 4096) grid.sync();
#define WSP(T_, name, off) T_* name = (T_*)(ws + (off))
#define REPEAT(n_) for (int rep_ = 0; rep_ < (n_); ++rep_, ((rep_ < (n_)) ? xcd_barrier(XcdBarrier{(unsigned*)(KWS + WS_CTL), xb_xcc_id(), bst}) : (void)0))

    if (RUN) { prep_phase(); }
    ++ph;
    for (int l = 0; l < DEPTH; ++l) {
        if (l == 0) {
            if (RUN) conv_set(1 | 2 | 16, 0, (int)blockIdx.x, (int)gridDim.x, lds);
            SEAM;
        }
#ifdef PROBE_NULL_P1
        if (RUN) { unsigned char* ws = KWS; PROBE_NULL_P1 E{(bf16*)(ws + WS_H)}; run_gemm(lds, (const bf16*)(ws + WS_XB), (const bf16*)(ws + WT_W1IN), T, 5632, 1024, 0, E);
            XcdBarrier xb_; xb_.bar = (unsigned*)(KWS + WS_CTL); xb_.x = xb_xcc_id(); xb_.st = bst; xcd_barrier(xb_); }
#endif
#ifndef SKIP_G1
        if (RUN) REPEAT(REP_P1) { unsigned char* ws = KWS; EpiSwiglu E{(bf16*)(ws + WS_H), (const float*)(ws + WS_SSQ), lds}; run_gemm(lds, (const bf16*)(ws + WS_XB), (const bf16*)(ws + WT_W1IN), T, 5632, 1024, 0, E);
            if (l == 0) {
                const int rem = (64 * 22) % (int)gridDim.x;
#pragma unroll 1
                for (int ll = 0; ll < DEPTH; ++ll) { unsigned char* ws2 = KWS; EpiMemKV E2{(bf16*)(ws2 + WS_MK) + (size_t)ll * 16 * 256 * 128, (bf16*)(ws2 + WS_MVT) + (size_t)ll * 16 * 128 * 256, (const float*)(ws2 + WS_MEMRSTD)};
                    run_gemm(lds, (const bf16*)(ws2 + WS_MEMB), (const bf16*)(ws2 + WT_WMEMKV) + (size_t)ll * 1024 * 1024, 1024, 1024, 1024, (rem + 16 * ll) % (int)gridDim.x, E2); }
            } else conv_tail(2, l, 64 * 22, lds);
        }
#endif
        SEAM;
#ifndef SKIP_G2
        if (RUN) { unsigned char* ws = KWS; EpiResid E{(bf16*)(ws + WS_XB), (float*)(ws + WS_SSQ), 0.5f}; run_gemm(lds, (const bf16*)(ws + WS_H), (const bf16*)(ws + WT_W1OUT), T, 1024, DFF, 0, E); }
#endif
        SEAM;
#ifndef SKIP_WIN
        if (RUN) REPEAT(REP_P3) { unsigned char* ws = KWS;
            EpiWin E{ws, (const float*)(ws + WS_LBS) + l * 512, lds};
            run_gemm(lds, (const bf16*)(ws + WS_XB), (const bf16*)(ws + WT_WIN), T, NIN, 1024, 0, E);
            conv_tail(4 | 8, l, 64 * 25, lds); }
#endif
        SEAM;
        if (RUN) {
#ifndef SKIP_G4
            REPEAT(REP_P4G) {
            { unsigned char* ws = KWS; EpiQ E{(bf16*)(ws + WS_Q)}; run_gemm(lds, (const bf16*)(ws + WS_CQ), (const bf16*)(ws + WT_WUQ), T, 768, 384, 0, E); }
            { unsigned char* ws = KWS; EpiKV E{(bf16*)(ws + WS_KC), (bf16*)(ws + WS_VT), (const float*)(ws + WS_SSQKV)}; run_gemm(lds, (const bf16*)(ws + WS_CKV), (const bf16*)(ws + WT_WUKV), T, 1024, 256, 64, E); }
            }
#endif
#ifndef SKIP_B1
            { unsigned char* ws = KWS; const int G = (int)gridDim.x;
              for (int ch = (int)blockIdx.x; ch < 1024; ch += G) hgrn_b1(lds, ch, (float*)(ws + WS_GG), (const bf16*)(ws + WS_HK), (const bf16*)(ws + WS_HV), (bf16*)(ws + WS_LT), (float*)(ws + WS_DEC)); }
#endif
        }
        SEAM;
        if (RUN) {
            unsigned char* ws = KWS; int tid_o = threadIdx.x; asm volatile("" : "+v"(tid_o)); const int G = (int)gridDim.x, bid = (int)blockIdx.x, tid = tid_o;
#ifndef SKIP_MLA
            REPEAT(REP_MLA) for (int it = bid; it < 256; it += G) {
                const int bh = it >> 3, pr = it & 7, b = bh >> 3, hd = bh & 7;
#pragma unroll 1
                for (int half = 0; half < 2; ++half) {
                    const int qb = half == 0 ? 15 - pr : pr;
                    const size_t row0 = (size_t)b * SEQ + qb * 256;
                    attn_item<96, 64, true>(lds, (const bf16*)(ws + WS_Q) + row0 * 768 + hd * 96, 768, (const bf16*)(ws + WS_KC) + (size_t)bh * SEQ * 96, (const bf16*)(ws + WS_VT) + (size_t)bh * 64 * SEQ, SEQ,
                                            (bf16*)(ws + WS_AO) + row0 * 512 + hd * 64, 512, qb * 256, SEQ, (const float*)(ws + WS_SSQQ) + row0 * 16, (const float*)(ws + WS_COS) + row0 * 16, (const float*)(ws + WS_SIN) + row0 * 16);
                }
            }
#endif
            unsigned* LT2 = (unsigned*)(ws + WS_LT); const float* DEC = (const float*)(ws + WS_DEC);
            for (int gt = bid * NTHREADS + tid; gt < 16 * 8192; gt += G * NTHREADS) {
                const int bh = gt >> 13, e2 = gt & 8191, k = (e2 & 63) * 2;
                GAS unsigned* lp = (GAS unsigned*)(LT2 + (size_t)bh * 64 * 8192 + e2); const GAS float* dp = (const GAS float*)(DEC + (size_t)bh * 64 * 128 + k);
                float run0 = 0.f, run1 = 0.f;
#pragma unroll 8
                for (int c = 0; c < 64; ++c) { const unsigned tmp = lp[(size_t)c * 8192]; const f32x2_t d = *(const GAS f32x2_t*)(dp + c * 128); lp[(size_t)c * 8192] = pk2(run0, run1); run0 = d.x * run0 + bflo(tmp); run1 = d.y * run1 + bfhi(tmp); }
            }
        }
        SEAM;
        if (RUN) REPEAT(REP_P6) {
            unsigned char* ws = KWS; const int G = (int)gridDim.x, bid = (int)blockIdx.x;
#ifndef SKIP_XATT
            for (int it = bid; it < 256; it += G) {
                const int b = it >> 6, hd = (it >> 4) & 3, qb = it & 15;
                const size_t row0 = (size_t)b * SEQ + qb * 256;
                attn_item<128, 128, false>(lds, (const bf16*)(ws + WS_MQ) + row0 * 512 + hd * 128, 512, (const bf16*)(ws + WS_MK) + (size_t)(l * 16 + b * 4 + hd) * 256 * 128, (const bf16*)(ws + WS_MVT) + (size_t)(l * 16 + b * 4 + hd) * 128 * 256, 256,
                                           (bf16*)(ws + WS_MO) + row0 * 512 + hd * 128, 512, 0, 256, nullptr, nullptr, nullptr);
            }
#endif
#ifndef SKIP_B3
            const float* onorm = KIN(15) + l * 128;
            for (int ch = bid; ch < 1024; ch += G) hgrn_b3(lds, ch, (const float*)(ws + WS_GG), (const bf16*)(ws + WS_HQ), (const bf16*)(ws + WS_HK), (const bf16*)(ws + WS_HV), (const bf16*)(ws + WS_HGT), (const bf16*)(ws + WS_LT), onorm, (bf16*)(ws + WS_HO));
#endif
        }
        SEAM;
#ifndef SKIP_G7
        if (RUN) REPEAT(REP_P7) {
            unsigned char* ws = KWS; EpiBranch3 E{(bf16*)(ws + WS_MERGED), (const bf16*)(ws + WS_GATES)};
            int Kv = 512, Nv = 1024, Mv = T; asm volatile("" : "+s"(Kv), "+s"(Nv), "+s"(Mv));
            pg8::Gemm g{(const bf16*)(ws + WS_AO), (const bf16*)(ws + WT_WOMLA), Mv, Nv, Kv};
            SegOrder3 S; S.init(Mv, Nv, (int)gridDim.x, (int)blockIdx.x); S.wsb = (const char*)ws;
            pg8::gemm_phase<EpiBranch3, SegOrder3, true, true>(lds, g, S, E);
        }
#endif
        SEAM;
#ifndef SKIP_G8
        if (RUN) { unsigned char* ws = KWS; EpiResid E{(bf16*)(ws + WS_XB), (float*)(ws + WS_SSQ), 1.0f}; run_gemm(lds, (const bf16*)(ws + WS_MERGED), (const bf16*)(ws + WT_WOUT), T, 1024, 1024, 0, E); }
#endif
        SEAM;
#ifndef SKIP_G9
        if (RUN) { unsigned char* ws = KWS; EpiSwiglu E{(bf16*)(ws + WS_H), (const float*)(ws + WS_SSQ), lds}; run_gemm(lds, (const bf16*)(ws + WS_XB), (const bf16*)(ws + WT_W2IN), T, 5632, 1024, 0, E);
            if (l + 1 < DEPTH) conv_tail(1, l + 1, 64 * 22, lds); }
#endif
        SEAM;
#ifndef SKIP_G10
        if (RUN) { unsigned char* ws = KWS; EpiResid E{(bf16*)(ws + WS_XB), (float*)(ws + WS_SSQ), 0.5f}; run_gemm(lds, (const bf16*)(ws + WS_H), (const bf16*)(ws + WT_W2OUT), T, 1024, DFF, 0, E); }
#endif
        SEAM;
    }
    if (RUN) {
        unsigned char* ws = KWS; float* X = KOUT; const float* SSQ = (const float*)(ws + WS_SSQ); const bf16* XB = (const bf16*)(ws + WS_XB);
        int tid_o = threadIdx.x; asm volatile("" : "+v"(tid_o)); const int tid = tid_o, wave = __builtin_amdgcn_readfirstlane(tid >> 6), lane = tid & 63, G = (int)gridDim.x;
        const float* fg = KIN(24);
        for (int m = (int)blockIdx.x * NWAVES + wave; m < T; m += G * NWAVES) {
            const float rs = rsqrtf(sum16(SSQ + (size_t)m * 16) * (1.0f / 1024.0f) + EPS);
            GAS f32x4* xr = (GAS f32x4*)(X + (size_t)m * D) + lane; const GAS f32x4* gr = (const GAS f32x4*)fg + lane; const GAS u32x2* xb = (const GAS u32x2*)(XB + (size_t)m * D) + lane;
#pragma unroll
            for (int j = 0; j < 4; ++j) { const u32x2 w = xb[64 * j]; const f32x4 g = gr[64 * j]; f32x4 v = {bflo(w.x), bfhi(w.x), bflo(w.y), bfhi(w.y)}; v = v * rs * g; xr[64 * j] = v; }
        }
    }
#undef RUN
#undef SEAM
}

constexpr int N_PHASES = 1 + 1 + DEPTH * 10 + 1;

extern "C" void kernel_launch(void* const* d_in, const int* in_sizes, int n_in, void* d_out, int out_size, void* d_ws, size_t ws_size, hipStream_t stream) {
    static int grid = 0;
    if (grid == 0) {
        if (n_in != 25 || out_size != T * D || ws_size < WS_END) { fprintf(stderr, "kernel_launch: unexpected shapes (n_in %d out %d ws %zu need %zu)\n", n_in, out_size, ws_size, (size_t)WS_END); grid = -1; return; }
        int dev = 0, cus = 0, per_cu = 0;
        hipGetDevice(&dev);
        hipDeviceGetAttribute(&cus, hipDeviceAttributeMultiprocessorCount, dev);
        if (hipFuncSetAttribute((const void*)fwd_kernel, hipFuncAttributeMaxDynamicSharedMemorySize, LDS_BYTES) != hipSuccess) { fprintf(stderr, "kernel_launch: hipFuncSetAttribute failed\n"); grid = -1; return; }
        if (hipOccupancyMaxActiveBlocksPerMultiprocessor(&per_cu, (const void*)fwd_kernel, NTHREADS, LDS_BYTES) != hipSuccess || per_cu < 1) { fprintf(stderr, "kernel_launch: occupancy query says %d\n", per_cu); per_cu = 1; }
        (void)hipGetLastError();
        grid = cus * 1;
        if (grid <= 0) grid = 256;
    }
    if (grid < 0) return;
    if (hipMemsetAsync((char*)d_ws + WS_CTL, 0, CTL_BYTES, stream) != hipSuccess) { fprintf(stderr, "kernel_launch: memset of the barrier words failed\n"); return; }
    Args a{};
    for (int i = 0; i < 25; ++i) a.in[i] = d_in[i];
    a.out = (float*)d_out; a.ws = (unsigned char*)d_ws; a.ph_lo = 0; a.ph_hi = N_PHASES;
    void* args[] = {&a};
    hipError_t e = hipLaunchCooperativeKernel((const void*)fwd_kernel, dim3(grid), dim3(NTHREADS), args, LDS_BYTES, stream);
    if (e != hipSuccess) fprintf(stderr, "cooperative launch failed: %s (grid %d)\n", hipGetErrorString(e), grid);
}
```
